# Optimizing an MI355X kernel written in HIP

```python
import jax
import jax.numpy as jnp
from jax import lax
import numpy as np

D_MODEL = 1024
BATCH = 4
SEQ = 8192
DEPTH = 1

GRID_W = 64
CTX_LEN = 256
N_MOD = 6
EPS = 1e-6
ROPE_BASE = 10000.0
Q_BLOCK = 128
RET_CHUNK = 128

MLA_HEADS = 8
MLA_NOPE = 64
MLA_ROPE = 32
MLA_QK = MLA_NOPE + MLA_ROPE
MLA_V = 64
Q_LORA = 256
KV_LORA = 128
RET_HEADS = 4
RET_DK = 64
RET_DV = 128
MIX_WIDTH = MLA_HEADS * MLA_V + RET_HEADS * RET_DV

OFF_Q = 0
OFF_KV = OFF_Q + Q_LORA
OFF_PE = OFF_KV + KV_LORA
OFF_RQ = OFF_PE + MLA_ROPE
OFF_RK = OFF_RQ + RET_HEADS * RET_DK
OFF_RV = OFF_RK + RET_HEADS * RET_DK
OFF_RG = OFF_RV + RET_HEADS * RET_DV
D_IN = OFF_RG + RET_HEADS * RET_DV

N_EXPERTS = 32
TOP_K = 4
D_FF = D_MODEL
SWIGLU_LIMIT = 7.0
SWIGLU_ALPHA = 1.702
MOE_BLOCK = 128

kernel_name = 'hybrid_mla_retention_moe_prefix_dit_layer'


def rms_norm(x, w):
    xf = x.astype(jnp.float32)
    y = xf * lax.rsqrt(jnp.mean(xf * xf, axis=-1, keepdims=True) + EPS)
    return (y * w.astype(jnp.float32)).astype(x.dtype)


def modulate(h, shift, scale):
    return h * (1 + scale) + shift


def axial_rope_tables(L, dim):
    rows = L // GRID_W
    nf = dim // 4
    inv = jnp.power(ROPE_BASE, -jnp.arange(nf, dtype=jnp.float32) / nf)
    row = jnp.repeat(jnp.arange(rows, dtype=jnp.float32), GRID_W)
    col = jnp.tile(jnp.arange(GRID_W, dtype=jnp.float32), rows)
    pos = jnp.stack([row, col], axis=-1)
    ang = pos[:, :, None] * inv
    ang = jnp.broadcast_to(ang[:, :, None, :], (L, 2, 2, nf)).reshape(L, dim)
    return jnp.cos(ang), jnp.sin(ang)


def apply_axial_rope(x, cos, sin):
    d = x.shape[-1]
    xa = x.reshape(x.shape[:-1] + (2, 2, d // 4))
    rot = jnp.stack([-xa[..., 1, :], xa[..., 0, :]], axis=-2).reshape(x.shape)
    return (x.astype(jnp.float32) * cos + rot.astype(jnp.float32) * sin).astype(x.dtype)


def merge_heads(o):
    B, H, L, dv = o.shape
    return o.transpose(0, 2, 1, 3).reshape(B, L, H * dv)


def mla_q(p, g_q_lora, w_q_up, g_q_head, rope):
    B, L, _ = p.shape
    c_q = rms_norm(p[..., OFF_Q:OFF_Q + Q_LORA], g_q_lora)
    q = (c_q @ w_q_up).reshape(B, L, MLA_HEADS, MLA_QK)
    q = rms_norm(q, g_q_head).transpose(0, 2, 1, 3)
    if rope is not None:
        q = jnp.concatenate([q[..., :MLA_NOPE], apply_axial_rope(q[..., MLA_NOPE:], *rope)], axis=-1)
    return q


def mla_kv(p, g_kv_lora, w_kv_up, g_k_head, rope):
    B, L, _ = p.shape
    c_kv = rms_norm(p[..., OFF_KV:OFF_KV + KV_LORA], g_kv_lora)
    k_pe = p[..., OFF_PE:OFF_PE + MLA_ROPE]
    kv = (c_kv @ w_kv_up).reshape(B, L, MLA_HEADS, MLA_NOPE + MLA_V)
    k_nope, v = kv[..., :MLA_NOPE], kv[..., MLA_NOPE:]
    k_pe = jnp.broadcast_to(k_pe[:, :, None, :], (B, L, MLA_HEADS, MLA_ROPE))
    k = rms_norm(jnp.concatenate([k_nope, k_pe], axis=-1), g_k_head).transpose(0, 2, 1, 3)
    if rope is not None:
        k = jnp.concatenate([k[..., :MLA_NOPE], apply_axial_rope(k[..., MLA_NOPE:], *rope)], axis=-1)
    return k, v.transpose(0, 2, 1, 3)


def attend_blocks(q, k, v):
    B, H, Lq, dq = q.shape
    nb = Lq // Q_BLOCK
    scale = dq ** -0.5
    qb = q.reshape(B, H, nb, Q_BLOCK, dq).transpose(2, 0, 1, 3, 4)

    def one_block(qi):
        s = jnp.einsum('bhqd,bhkd->bhqk', qi, k).astype(jnp.float32) * scale
        pr = jax.nn.softmax(s, axis=-1).astype(v.dtype)
        return jnp.einsum('bhqk,bhkd->bhqd', pr, v)

    o = lax.map(one_block, qb)
    return o.transpose(1, 2, 0, 3, 4).reshape(B, H, Lq, v.shape[-1])


def ret_q(p, rope):
    B, L, _ = p.shape
    q = p[..., OFF_RQ:OFF_RK].reshape(B, L, RET_HEADS, RET_DK).transpose(0, 2, 1, 3)
    return q if rope is None else apply_axial_rope(q, *rope)


def ret_kv(p, rope):
    B, L, _ = p.shape
    k = p[..., OFF_RK:OFF_RV].reshape(B, L, RET_HEADS, RET_DK).transpose(0, 2, 1, 3) * (RET_DK ** -0.5)
    v = p[..., OFF_RV:OFF_RG].reshape(B, L, RET_HEADS, RET_DV).transpose(0, 2, 1, 3)
    if rope is not None:
        k = apply_axial_rope(k, *rope)
    return k, v


def retention_state(k, v, log_gamma, reverse):
    L = k.shape[2]
    j = jnp.arange(L, dtype=jnp.float32)
    expo = j if reverse else (L - 1) - j
    w = jnp.exp(expo[None, :] * log_gamma[:, None])
    return jnp.einsum('bhld,bhle->bhde', k.astype(jnp.float32) * w[None, :, :, None],
                      v.astype(jnp.float32))


def retention_scan(q, k, v, log_gamma, s0):
    B, H, L, DK = q.shape
    DV = v.shape[-1]
    C = RET_CHUNK
    n = L // C
    to_chunks = lambda t: t.astype(jnp.float32).reshape(B, H, n, C, t.shape[-1]).transpose(2, 0, 1, 3, 4)
    i = jnp.arange(C, dtype=jnp.float32)
    diff = i[:, None] - i[None, :]
    causal = diff >= 0
    decay_mask = jnp.where(causal, jnp.exp(jnp.where(causal, diff, 0.0)[None] * log_gamma[:, None, None]), 0.0)
    q_decay = jnp.exp((i + 1.0)[None, :] * log_gamma[:, None])[..., None]
    k_decay = jnp.exp(((C - 1.0) - i)[None, :] * log_gamma[:, None])[..., None]
    chunk_decay = jnp.exp(C * log_gamma)[:, None, None]

    def step(s, inp):
        qc, kc, vc = inp
        inner = jnp.einsum('bhid,bhjd->bhij', qc, kc) * decay_mask
        o = jnp.einsum('bhij,bhje->bhie', inner, vc) + jnp.einsum('bhid,bhde->bhie', qc * q_decay, s)
        s_new = s * chunk_decay + jnp.einsum('bhjd,bhje->bhde', kc * k_decay, vc)
        return s_new, o

    _, o = lax.scan(step, s0.astype(jnp.float32), (to_chunks(q), to_chunks(k), to_chunks(v)))
    return o.transpose(1, 2, 0, 3, 4).reshape(B, H, L, DV)


def retention_bidir(q, k, v, log_gamma, s0_f, s0_b):
    flip = lambda t: jnp.flip(t, axis=2)
    o_f = retention_scan(q, k, v, log_gamma[0], s0_f)
    o_b = flip(retention_scan(flip(q), flip(k), flip(v), log_gamma[1], s0_b))
    return o_f + o_b


def ret_output(o, p, g_ret_out):
    B, H, L, DV = o.shape
    o = rms_norm(o.transpose(0, 2, 1, 3), g_ret_out.reshape(H, DV)).reshape(B, L, H * DV)
    gate = p[..., OFF_RG:D_IN].astype(jnp.float32)
    return (o * jax.nn.silu(gate)).astype(p.dtype)


def moe_ffn(h, w_router, b_router, w1, b1, w2, b2):
    T, D = h.shape
    N = T * TOP_K
    logits = (h @ w_router).astype(jnp.float32) + b_router.astype(jnp.float32)
    top_val, top_idx = lax.top_k(logits, TOP_K)
    gates = jax.nn.softmax(top_val, axis=-1)
    flat_e = top_idx.reshape(N).astype(jnp.int32)
    flat_g = gates.reshape(N)
    ar = jnp.arange(N, dtype=jnp.int32)
    flat_tok = ar // TOP_K
    order = jnp.argsort(flat_e)
    sorted_e = flat_e[order]
    counts = jax.ops.segment_sum(jnp.ones((N,), jnp.int32), flat_e, num_segments=N_EXPERTS)
    padded = ((counts + MOE_BLOCK - 1) // MOE_BLOCK) * MOE_BLOCK
    pad_end = jnp.cumsum(padded)
    pad_start = pad_end - padded
    start = jnp.cumsum(counts) - counts
    dest = pad_start[sorted_e] + (ar - start[sorted_e])
    n_blocks = -(-N // MOE_BLOCK) + N_EXPERTS
    n_pad = n_blocks * MOE_BLOCK
    buf_tok = jnp.full((n_pad,), T, jnp.int32).at[dest].set(flat_tok[order])
    buf_g = jnp.zeros((n_pad,), jnp.float32).at[dest].set(flat_g[order])
    block_e = jnp.minimum(jnp.searchsorted(pad_end, jnp.arange(n_blocks, dtype=jnp.int32) * MOE_BLOCK,
                                           side='right'), N_EXPERTS - 1).astype(jnp.int32)
    h_pad = jnp.concatenate([h, jnp.zeros((1, D), h.dtype)], axis=0)

    def expert_block(args):
        tok, g, e = args
        xb = h_pad[tok]
        u = (xb @ w1[e] + b1[e]).astype(jnp.float32)
        glu = jnp.minimum(u[:, 0::2], SWIGLU_LIMIT)
        lin = jnp.clip(u[:, 1::2], -SWIGLU_LIMIT, SWIGLU_LIMIT)
        act = glu * jax.nn.sigmoid(SWIGLU_ALPHA * glu) * (lin + 1.0)
        y = act.astype(xb.dtype) @ w2[e] + b2[e]
        return y.astype(jnp.float32) * g[:, None]

    ys = lax.map(expert_block, (buf_tok.reshape(n_blocks, MOE_BLOCK),
                                buf_g.reshape(n_blocks, MOE_BLOCK), block_e))
    out = jnp.zeros((T + 1, D), jnp.float32).at[buf_tok].add(ys.reshape(n_pad, D))[:T]
    return out.astype(h.dtype)


def setup_inputs(seed: int = 0) -> dict:
    key = jax.random.key(seed)
    ks = jax.random.split(key, 24)
    f32 = jnp.float32

    def nrm(k, shape, scale):
        return jax.random.normal(k, shape, f32) * scale

    def gain(k, shape):
        return 1.0 + 0.1 * jax.random.normal(k, shape, f32)

    dec0 = jnp.log(jnp.power(2.0, 5.0 + jnp.arange(RET_HEADS, dtype=f32)) - 1.0)
    return {
        'x': nrm(ks[0], (BATCH, SEQ, D_MODEL), 1.0),
        'c': nrm(ks[1], (BATCH, D_MODEL), 1.0),
        'ctx': nrm(ks[2], (BATCH, CTX_LEN, D_MODEL), 1.0),
        'c_ctx': nrm(ks[3], (D_MODEL,), 1.0),
        'g_attn': gain(ks[4], (DEPTH, D_MODEL)),
        'g_ffn': gain(ks[5], (DEPTH, D_MODEL)),
        'w_ada': nrm(ks[6], (DEPTH, D_MODEL, N_MOD * D_MODEL), 0.5 * D_MODEL ** -0.5),
        'b_ada': nrm(ks[7], (DEPTH, N_MOD * D_MODEL), 0.02),
        'w_in': nrm(ks[8], (DEPTH, D_MODEL, D_IN), D_MODEL ** -0.5),
        'g_q_lora': gain(ks[9], (DEPTH, Q_LORA)),
        'w_q_up': nrm(ks[10], (DEPTH, Q_LORA, MLA_HEADS * MLA_QK), Q_LORA ** -0.5),
        'g_q_head': gain(ks[11], (DEPTH, MLA_QK)),
        'g_kv_lora': gain(ks[12], (DEPTH, KV_LORA)),
        'w_kv_up': nrm(ks[13], (DEPTH, KV_LORA, MLA_HEADS * (MLA_NOPE + MLA_V)), KV_LORA ** -0.5),
        'g_k_head': gain(ks[14], (DEPTH, MLA_QK)),
        'ret_decay_logit': dec0 + nrm(ks[15], (DEPTH, 2, RET_HEADS), 0.1),
        'g_ret_out': gain(ks[16], (DEPTH, RET_HEADS * RET_DV)),
        'w_out': nrm(ks[17], (DEPTH, MIX_WIDTH, D_MODEL), MIX_WIDTH ** -0.5),
        'w_router': nrm(ks[18], (DEPTH, D_MODEL, N_EXPERTS), D_MODEL ** -0.5),
        'b_router': nrm(ks[19], (DEPTH, N_EXPERTS), 0.01),
        'w_mlp1': nrm(ks[20], (DEPTH, N_EXPERTS, D_MODEL, 2 * D_FF), D_MODEL ** -0.5),
        'b_mlp1': nrm(ks[21], (DEPTH, N_EXPERTS, 2 * D_FF), 0.02),
        'w_mlp2': nrm(ks[22], (DEPTH, N_EXPERTS, D_FF, D_MODEL), D_FF ** -0.5),
        'b_mlp2': nrm(ks[23], (DEPTH, N_EXPERTS, D_MODEL), 0.02),
    }


def reference(x, c, ctx, c_ctx, g_attn, g_ffn, w_ada, b_ada, w_in, g_q_lora, w_q_up, g_q_head,
              g_kv_lora, w_kv_up, g_k_head, ret_decay_logit, g_ret_out, w_out,
              w_router, b_router, w_mlp1, b_mlp1, w_mlp2, b_mlp2):
    B, L, D = x.shape
    Lc = ctx.shape[1]
    rope_mla = axial_rope_tables(L, MLA_ROPE)
    rope_ret = axial_rope_tables(L, RET_DK)
    for l in range(DEPTH):
        last = l == DEPTH - 1
        mod = (jax.nn.silu(c) @ w_ada[l] + b_ada[l]).reshape(B, N_MOD, 1, D)
        mod_c = (jax.nn.silu(c_ctx) @ w_ada[l] + b_ada[l]).reshape(N_MOD, 1, D)

        h = modulate(rms_norm(x, g_attn[l]), mod[:, 0], mod[:, 1])
        hc = modulate(rms_norm(ctx, g_attn[l]), mod_c[0], mod_c[1])
        p = h @ w_in[l]
        pc = hc @ w_in[l]

        k_c, v_c = mla_kv(pc, g_kv_lora[l], w_kv_up[l], g_k_head[l], None)
        k_x, v_x = mla_kv(p, g_kv_lora[l], w_kv_up[l], g_k_head[l], rope_mla)
        q_x = mla_q(p, g_q_lora[l], w_q_up[l], g_q_head[l], rope_mla)
        o_mla = attend_blocks(q_x, jnp.concatenate([k_c, k_x], axis=2), jnp.concatenate([v_c, v_x], axis=2))

        log_gamma = jax.nn.log_sigmoid(ret_decay_logit[l].astype(jnp.float32))
        kr_c, vr_c = ret_kv(pc, None)
        s0_f = retention_state(kr_c, vr_c, log_gamma[0], reverse=False)
        s0_b = retention_state(kr_c, vr_c, log_gamma[1], reverse=True)
        kr_x, vr_x = ret_kv(p, rope_ret)
        o_ret = retention_bidir(ret_q(p, rope_ret), kr_x, vr_x, log_gamma, s0_f, s0_b)

        mix = jnp.concatenate([merge_heads(o_mla), ret_output(o_ret, p, g_ret_out[l])], axis=-1)
        x = x + mod[:, 2] * (mix @ w_out[l])
        if not last:
            o_mla_c = attend_blocks(mla_q(pc, g_q_lora[l], w_q_up[l], g_q_head[l], None), k_c, v_c)
            s_zero = jnp.zeros((B, RET_HEADS, RET_DK, RET_DV), jnp.float32)
            o_ret_c = retention_bidir(ret_q(pc, None), kr_c, vr_c, log_gamma, s_zero, s_zero)
            mix_c = jnp.concatenate([merge_heads(o_mla_c), ret_output(o_ret_c, pc, g_ret_out[l])], axis=-1)
            ctx = ctx + mod_c[2] * (mix_c @ w_out[l])

        hf = modulate(rms_norm(x, g_ffn[l]), mod[:, 3], mod[:, 4]).reshape(B * L, D)
        moe_w = (w_router[l], b_router[l], w_mlp1[l], b_mlp1[l], w_mlp2[l], b_mlp2[l])
        if last:
            x = x + mod[:, 5] * moe_ffn(hf, *moe_w).reshape(B, L, D)
        else:
            hcf = modulate(rms_norm(ctx, g_ffn[l]), mod_c[3], mod_c[4]).reshape(B * Lc, D)
            y = moe_ffn(jnp.concatenate([hf, hcf], axis=0), *moe_w)
            x = x + mod[:, 5] * y[:B * L].reshape(B, L, D)
            ctx = ctx + mod_c[5] * y[B * L:].reshape(B, Lc, D)
    return x
```

```cpp
#include <hip/hip_runtime.h>
#include <cstdio>
#include <cstdint>

#ifndef MK_N_LAUNCHES
#define MK_N_LAUNCHES 11
#endif

#define LAS __attribute__((address_space(3)))
#define GAS __attribute__((address_space(1)))
typedef unsigned short bf16_t;
typedef short bf16x8 __attribute__((ext_vector_type(8)));
typedef short s16x4 __attribute__((ext_vector_type(4)));
typedef float f32x4 __attribute__((ext_vector_type(4)));
typedef float f32x16 __attribute__((ext_vector_type(16)));
typedef unsigned u32x4 __attribute__((ext_vector_type(4)));
typedef unsigned u32x2 __attribute__((ext_vector_type(2)));

constexpr int DM = 1024, NB = 4, SEQ = 8192, LC = 256;
constexpr int T = NB * SEQ;
constexpr int TC = NB * LC;
constexpr int TA = T + TC;
constexpr int DIN = 1952, DINP = 2048;
constexpr int OFF_Q = 0, OFF_KV = 256, OFF_PE = 384, OFF_RQ = 416, OFF_RK = 672, OFF_RV = 928, OFF_RG = 1440;
constexpr int NH = 8, QK = 96, DV = 64, SKV = LC + SEQ;
constexpr int RH = 4, RDK = 64, RDV = 128, RC = 128, NSLOT = 66;
constexpr int NE = 32, DFF = 1024, NPAIR = T * 4;
constexpr float EPS = 1e-6f;
constexpr float QSCALE = 0.10206207261596577f * 1.4426950408889634f;

constexpr size_t MiB = 1ull << 20;
constexpr size_t WS_CTL = 0, CTL_BYTES = 1 * MiB;
constexpr size_t WS_MOD = 1 * MiB;
constexpr size_t WS_TABM = WS_MOD + 128 * 1024;
constexpr size_t WS_TABR = WS_TABM + 16 * 1024;
constexpr size_t WS_WIN = 2 * MiB;
constexpr size_t WS_WQ = 6 * MiB;
constexpr size_t WS_WKV = 6 * MiB + 512 * 1024;
constexpr size_t WS_WO = 7 * MiB;
constexpr size_t WS_WR = 9 * MiB;
constexpr size_t WS_W1 = 10 * MiB;
constexpr size_t WS_W2 = 138 * MiB;
constexpr size_t WS_HF = 202 * MiB;
constexpr size_t WS_PG = 266 * MiB;
constexpr size_t WS_LIST = 267 * MiB;
constexpr size_t WS_H = 272 * MiB;
constexpr size_t WS_P = 338 * MiB;
constexpr size_t WS_Q = 470 * MiB;
constexpr size_t WS_K = 518 * MiB;
constexpr size_t WS_VT = 568 * MiB;
constexpr size_t WS_LST = 601 * MiB;
constexpr size_t WS_MIX = 667 * MiB;
constexpr size_t WS_ACT = 272 * MiB;
constexpr size_t WS_Y = 528 * MiB;
constexpr size_t WS_END = 784 * MiB;
constexpr int CW_BAR = 4096;
constexpr int CW_CNT = 16384;

constexpr int LDS_SCRATCH = 155648;
constexpr int LDS_MISC = LDS_SCRATCH;
constexpr int LDS_BYTES = LDS_SCRATCH + 256;

__device__ __forceinline__ float bf2f(bf16_t h) { return __uint_as_float((unsigned)h << 16); }
__device__ __forceinline__ unsigned f2bf(float f) { unsigned u = __float_as_uint(f); return (u + 0x7fffu + ((u >> 16) & 1u)) >> 16; }
__device__ __forceinline__ unsigned pk2(float lo, float hi) { return f2bf(lo) | (f2bf(hi) << 16); }
__device__ __forceinline__ float lo16(unsigned w) { return __uint_as_float(w << 16); }
__device__ __forceinline__ float hi16(unsigned w) { return __uint_as_float(w & 0xffff0000u); }
__device__ __forceinline__ float wave_sum(float v) {
#pragma unroll
    for (int o = 1; o < 64; o <<= 1) v += __shfl_xor(v, o);
    return v;
}
#define LDS_WAIT() asm volatile("s_waitcnt lgkmcnt(0)" ::: "memory")
__device__ __forceinline__ int opaque(int v) { asm volatile("" : "+v"(v)); return v; }

#define XB_TMO      128
#define XB_XCNT(j)  (256  + 64 * (j))
#define XB_XSUB(j)  (1280 + 64 * (j))
#define XB_XGEN(j)  (2304 + 64 * (j))
#define XB_TOP      3328
#define XB_TOPGEN   3392
#define XCD_BAR_WORDS 3456
#define XB_SPIN_CAP (1u << 20)
__device__ __forceinline__ unsigned xb_ld(unsigned* p)              { return __hip_atomic_load(p, __ATOMIC_RELAXED, __HIP_MEMORY_SCOPE_AGENT); }
__device__ __forceinline__ unsigned xb_add(unsigned* p, unsigned v) { return __hip_atomic_fetch_add(p, v, __ATOMIC_RELAXED, __HIP_MEMORY_SCOPE_AGENT); }
__device__ __forceinline__ unsigned xb_xcc_id() { return (unsigned)__builtin_amdgcn_s_getreg((3 << 11) | 20) & 0xFu; }
#define XB_SPIN(cond, bar) do { unsigned _sp = 0; while (cond) { __builtin_amdgcn_s_sleep(1); \
    if ((++_sp & 255u) == 0u) { if (xb_ld(&(bar)[XB_TMO])) break; if (_sp > XB_SPIN_CAP) { atomicAdd(&(bar)[XB_TMO], 1u); break; } } } } while (0)
struct XcdBarrier { unsigned* bar; unsigned x; volatile LAS unsigned* st; };
__device__ __forceinline__ XcdBarrier xcd_barrier_post(unsigned* bar, volatile LAS unsigned* st) {
    XcdBarrier b; b.bar = bar; b.x = xb_xcc_id(); b.st = st;
    if (threadIdx.x == 0) (void)xb_add(&bar[XB_XCNT(b.x)], 1u);
    return b;
}
__device__ __forceinline__ void xcd_barrier_complete(unsigned* bar, unsigned x, unsigned& nloc, unsigned& nx) {
    const unsigned G = gridDim.x * gridDim.y * gridDim.z;
    unsigned sum, cnt, mine, sp = 0u;
    for (;;) {
        sum = 0u; cnt = 0u; mine = 0u;
#pragma unroll
        for (unsigned j = 0; j < 16; ++j) { const unsigned c = xb_ld(&bar[XB_XCNT(j)]); sum += c; cnt += (c > 0u) ? 1u : 0u; mine = (j == x) ? c : mine; }
        if (sum == G) break;
        __builtin_amdgcn_s_sleep(1);
        if ((++sp & 255u) == 0u) { if (xb_ld(&bar[XB_TMO])) break; if (sp > XB_SPIN_CAP) { atomicAdd(&bar[XB_TMO], 1u); break; } }
    }
    nloc = mine > 0u ? mine : 1u; nx = cnt > 0u ? cnt : 1u;
}
__device__ __forceinline__ void xcd_barrier(const XcdBarrier& b) {
    asm volatile("s_waitcnt vmcnt(0)" ::: "memory");
    __syncthreads();
    if (threadIdx.x == 0) {
        unsigned* bar = b.bar;
        __builtin_amdgcn_s_waitcnt(0);
        unsigned nloc = b.st[0], nx = b.st[1];
        if (nloc == 0u) { xcd_barrier_complete(bar, b.x, nloc, nx); b.st[0] = nloc; b.st[1] = nx; }
        const unsigned old = xb_add(&bar[XB_XSUB(b.x)], 1u);
        const unsigned gen = old / nloc;
        if (old + 1u == (gen + 1u) * nloc) {
            __builtin_amdgcn_fence(__ATOMIC_RELEASE, "agent");
            asm volatile("s_waitcnt vmcnt(0)" ::: "memory");
            const unsigned og = xb_add(&bar[XB_TOP], 1u);
            const unsigned tg = og / nx;
            if (og + 1u == (tg + 1u) * nx) xb_add(&bar[XB_TOPGEN], 1u);
            else XB_SPIN(xb_ld(&bar[XB_TOPGEN]) == tg, bar);
            __builtin_amdgcn_fence(__ATOMIC_ACQUIRE, "agent");
            xb_add(&bar[XB_XGEN(b.x)], 1u);
            asm volatile("s_waitcnt vmcnt(0)" ::: "memory");
        } else {
            XB_SPIN(xb_ld(&bar[XB_XGEN(b.x)]) == gen, bar);
            __builtin_amdgcn_fence(__ATOMIC_ACQUIRE, "agent");
            asm volatile("s_waitcnt vmcnt(0)" ::: "memory");
        }
    }
    __syncthreads();
}

struct Args { const float* in[24]; float* out; unsigned char* ws; int ph_lo, ph_hi; };
enum { I_X = 0, I_C, I_CTX, I_CCTX, I_GATTN, I_GFFN, I_WADA, I_BADA, I_WIN, I_GQL, I_WQUP, I_GQH, I_GKVL, I_WKVUP, I_GKH, I_DECAY, I_GRET, I_WOUT,
       I_WR, I_BR, I_W1, I_B1, I_W2, I_B2 };

template <int MT, int NT, bool SWAP>
__device__ __forceinline__ void mma_ll(f32x4 (&acc)[MT][NT], const LAS bf16_t* sA, int lda, int m0, const LAS bf16_t* sB, int ldb, int n0, int K, int lane) {
    const int fr = lane & 15, fq = lane >> 4;
    for (int k = 0; k < K; k += 32) {
        bf16x8 a[MT], b[NT];
#pragma unroll
        for (int i = 0; i < MT; ++i) a[i] = *(const LAS bf16x8*)(sA + (m0 + 16 * i + fr) * lda + k + 8 * fq);
#pragma unroll
        for (int j = 0; j < NT; ++j) b[j] = *(const LAS bf16x8*)(sB + (n0 + 16 * j + fr) * ldb + k + 8 * fq);
#pragma unroll
        for (int i = 0; i < MT; ++i)
#pragma unroll
            for (int j = 0; j < NT; ++j)
                acc[i][j] = SWAP ? __builtin_amdgcn_mfma_f32_16x16x32_bf16(b[j], a[i], acc[i][j], 0, 0, 0) : __builtin_amdgcn_mfma_f32_16x16x32_bf16(a[i], b[j], acc[i][j], 0, 0, 0);
    }
}
template <int MT, int NT, bool SWAP>
__device__ __forceinline__ void mma_lg(f32x4 (&acc)[MT][NT], const LAS bf16_t* sA, int lda, int m0, const bf16_t* gB, int ldb, int n0, int K, int lane) {
    const int fr = lane & 15, fq = lane >> 4;
#pragma unroll 2
    for (int k = 0; k < K; k += 32) {
        bf16x8 a[MT], b[NT];
#pragma unroll
        for (int j = 0; j < NT; ++j) b[j] = *(const GAS bf16x8*)(gB + (size_t)(n0 + 16 * j + fr) * ldb + k + 8 * fq);
#pragma unroll
        for (int i = 0; i < MT; ++i) a[i] = *(const LAS bf16x8*)(sA + (m0 + 16 * i + fr) * lda + k + 8 * fq);
#pragma unroll
        for (int i = 0; i < MT; ++i)
#pragma unroll
            for (int j = 0; j < NT; ++j)
                acc[i][j] = SWAP ? __builtin_amdgcn_mfma_f32_16x16x32_bf16(b[j], a[i], acc[i][j], 0, 0, 0) : __builtin_amdgcn_mfma_f32_16x16x32_bf16(a[i], b[j], acc[i][j], 0, 0, 0);
    }
}

__device__ __forceinline__ void phase_mod(const Args& a, LAS unsigned char* lds) {
    const int tid = threadIdx.x, lane = tid & 63, wave = tid >> 6;
    LAS float* sv = (LAS float*)lds;
    LAS float* red = sv + 5 * 1024;
    float* mod = (float*)(a.ws + WS_MOD);
    for (int i = tid; i < 5 * 1024; i += 512) { const float v = (i < 4096) ? a.in[I_C][i] : a.in[I_CCTX][i - 4096]; sv[i] = v / (1.f + __expf(-v)); }
    __syncthreads();
    const float* W = a.in[I_WADA]; const float* bb = a.in[I_BADA];
    for (int u = blockIdx.x; u < 96; u += gridDim.x) {
        const int col = u * 64 + lane;
        float acc[5] = {0.f, 0.f, 0.f, 0.f, 0.f};
        for (int k = wave * 128; k < wave * 128 + 128; ++k) {
            const float w = W[(size_t)k * 6144 + col];
#pragma unroll
            for (int v = 0; v < 5; ++v) acc[v] += sv[v * 1024 + k] * w;
        }
#pragma unroll
        for (int v = 0; v < 5; ++v) red[(wave * 5 + v) * 64 + lane] = acc[v];
        __syncthreads();
        if (tid < 320) { const int v = tid >> 6; float s = bb[u * 64 + lane];
#pragma unroll
            for (int w = 0; w < 8; ++w) s += red[(w * 5 + v) * 64 + lane];
            mod[v * 6144 + u * 64 + lane] = s; }
        __syncthreads();
    }
    const int gt = blockIdx.x * 512 + tid;
    if (gt < 192 * 8) { const int pi = gt >> 3, f = gt & 7; const float pos = (float)(pi < 128 ? pi : pi - 128);
        const float inv = exp2f(-(float)f * (13.287712379549449f / 8.f)); const float rev = pos * inv * 0.15915494309189535f;
        float* tm = (float*)(a.ws + WS_TABM); tm[gt * 2] = __builtin_amdgcn_cosf(rev); tm[gt * 2 + 1] = __builtin_amdgcn_sinf(rev); }
    else if (gt < 192 * 8 + 192 * 16) { const int g2 = gt - 192 * 8; const int pi = g2 >> 4, f = g2 & 15; const float pos = (float)(pi < 128 ? pi : pi - 128);
        const float inv = exp2f(-(float)f * (13.287712379549449f / 16.f)); const float rev = pos * inv * 0.15915494309189535f;
        float* tr = (float*)(a.ws + WS_TABR); tr[g2 * 2] = __builtin_amdgcn_cosf(rev); tr[g2 * 2 + 1] = __builtin_amdgcn_sinf(rev); }
}

__device__ __forceinline__ void transpose_item(const float* W, int K, int N, bf16_t* WT, LAS float* scr, int item, int lane) {
    const int nblk = N / 32, kb = item / nblk, nb = item % nblk, k0 = 64 * kb, n0 = 32 * nb;
#pragma unroll 8
    for (int i = 0; i < 32; ++i) { const int kk = 2 * i + (lane >> 5); scr[kk * 33 + (lane & 31)] = W[(size_t)(k0 + kk) * N + n0 + (lane & 31)]; }
    LDS_WAIT();
    const int c = lane & 7;
#pragma unroll
    for (int j = 0; j < 4; ++j) { const int n = (lane >> 3) + 8 * j; const LAS float* s = scr + (8 * c) * 33 + n;
        u32x4 o; o.x = pk2(s[0 * 33], s[1 * 33]); o.y = pk2(s[2 * 33], s[3 * 33]); o.z = pk2(s[4 * 33], s[5 * 33]); o.w = pk2(s[6 * 33], s[7 * 33]);
        *(GAS u32x4*)(WT + (size_t)(n0 + n) * K + k0 + 8 * c) = o; }
    LDS_WAIT();
}
__device__ __forceinline__ void phase_prep(const Args& a, LAS unsigned char* lds) {
    const int tid = threadIdx.x, lane = tid & 63, wave = tid >> 6;
    LAS float* scr = (LAS float*)(lds + wave * 16384);
    const int gw = blockIdx.x * 8 + wave, NGW = gridDim.x * 8;
    constexpr int I_IN = 16 * 61, I_QU = 4 * 24, I_KVU = 2 * 32, I_O = 16 * 32, I_1 = 16 * 64, I_2 = 16 * 32;
    constexpr int NITEMS = I_IN + I_QU + I_KVU + I_O + 32 * I_1 + 32 * I_2;
    for (int it = gw; it < NITEMS; it += NGW) {
        int r = it;
        if (r < I_IN) { transpose_item(a.in[I_WIN], 1024, DIN, (bf16_t*)(a.ws + WS_WIN), scr, r, lane); continue; } r -= I_IN;
        if (r < I_QU) { transpose_item(a.in[I_WQUP], 256, 768, (bf16_t*)(a.ws + WS_WQ), scr, r, lane); continue; } r -= I_QU;
        if (r < I_KVU) { transpose_item(a.in[I_WKVUP], 128, 1024, (bf16_t*)(a.ws + WS_WKV), scr, r, lane); continue; } r -= I_KVU;
        if (r < I_O) { transpose_item(a.in[I_WOUT], 1024, 1024, (bf16_t*)(a.ws + WS_WO), scr, r, lane); continue; } r -= I_O;
        if (r < 32 * I_1) { const int e = r / I_1; transpose_item(a.in[I_W1] + (size_t)e * 1024 * 2048, 1024, 2048, (bf16_t*)(a.ws + WS_W1) + (size_t)e * 2048 * 1024, scr, r % I_1, lane); continue; } r -= 32 * I_1;
        { const int e = r / I_2; transpose_item(a.in[I_W2] + (size_t)e * 1024 * 1024, 1024, 1024, (bf16_t*)(a.ws + WS_W2) + (size_t)e * 1024 * 1024, scr, r % I_2, lane); }
    }
    const int gt = blockIdx.x * 512 + tid, NGT = gridDim.x * 512;
    for (int i = gt; i < 96 * 1024 / 8; i += NGT) *(GAS u32x4*)((bf16_t*)(a.ws + WS_WIN) + (size_t)DIN * 1024 + (size_t)i * 8) = (u32x4){0u, 0u, 0u, 0u};
    for (int i = gt; i < 32 * 1024; i += NGT) { const int n = i >> 10, k = i & 1023; const float w = a.in[I_WR][k * 32 + n]; const unsigned h = f2bf(w);
        bf16_t* wr = (bf16_t*)(a.ws + WS_WR); wr[i] = (bf16_t)h; wr[32768 + i] = (bf16_t)f2bf(w - bf2f((bf16_t)h)); }
    const float* mod = (const float*)(a.ws + WS_MOD); const float* g = a.in[I_GATTN];
    for (int m = gw; m < TA; m += NGW) {
        const float* xr; int mv;
        if (m < T) { xr = a.in[I_X] + (size_t)m * DM; mv = m >> 13; } else { xr = a.in[I_CTX] + (size_t)(m - T) * DM; mv = 4; }
        const float* sh = mod + mv * 6144; const float* sc = sh + 1024;
        f32x4 v[4]; float ss = 0.f;
#pragma unroll
        for (int j = 0; j < 4; ++j) { v[j] = *(const GAS f32x4*)(xr + j * 256 + lane * 4); ss += (v[j].x * v[j].x + v[j].y * v[j].y) + (v[j].z * v[j].z + v[j].w * v[j].w); }
        const float rstd = rsqrtf(wave_sum(ss) * (1.f / DM) + EPS);
        bf16_t* hr = (bf16_t*)(a.ws + WS_H) + (size_t)m * DM;
#pragma unroll
        for (int j = 0; j < 4; ++j) { const int c = j * 256 + lane * 4; const f32x4 gg = *(const GAS f32x4*)(g + c), s1 = *(const GAS f32x4*)(sc + c), s0 = *(const GAS f32x4*)(sh + c);
            const f32x4 o = (v[j] * rstd * gg) * (s1 + 1.f) + s0; u32x2 w; w.x = pk2(o.x, o.y); w.y = pk2(o.z, o.w); *(GAS u32x2*)(hr + c) = w; }
    }
}

struct GUnit { const bf16_t* Bt; int m0, n0, nvalid, e; };
template <class RowFn, class Epi>
__device__ __forceinline__ void gemm_tile(LAS unsigned char* lds, const bf16_t* A, int K, const GUnit& u, const RowFn& rowfn, const Epi& epi) {
    LAS bf16_t* sA = (LAS bf16_t*)lds;
    LAS bf16_t* sB = (LAS bf16_t*)(lds + 256 * 72 * 2);
    const int tid = opaque((int)threadIdx.x), lane = tid & 63, wave = tid >> 6, wm = wave >> 1, wn = wave & 1;
    const int ch = tid & 7, r0 = tid >> 3;
    const bf16_t* ap[4]; const bf16_t* bp[2];
#pragma unroll
    for (int i = 0; i < 4; ++i) { const int r = r0 + 64 * i; const int rr = r < u.nvalid ? r : 0; ap[i] = A + (size_t)rowfn(u, rr) * K + ch * 8; }
#pragma unroll
    for (int i = 0; i < 2; ++i) bp[i] = u.Bt + (size_t)(r0 + 64 * i) * K + ch * 8;
    f32x4 acc[4][4];
#pragma unroll
    for (int i = 0; i < 4; ++i)
#pragma unroll
        for (int j = 0; j < 4; ++j) acc[i][j] = (f32x4){0.f, 0.f, 0.f, 0.f};
    u32x4 ra[4], rb[2];
#pragma unroll
    for (int i = 0; i < 4; ++i) ra[i] = *(const GAS u32x4*)(ap[i]);
#pragma unroll
    for (int i = 0; i < 2; ++i) rb[i] = *(const GAS u32x4*)(bp[i]);
    const int nk = K / 64;
    for (int kt = 0; kt < nk; ++kt) {
        __syncthreads();
#pragma unroll
        for (int i = 0; i < 4; ++i) *(LAS u32x4*)(sA + (r0 + 64 * i) * 72 + ch * 8) = ra[i];
#pragma unroll
        for (int i = 0; i < 2; ++i) *(LAS u32x4*)(sB + (r0 + 64 * i) * 72 + ch * 8) = rb[i];
        __syncthreads();
        if (kt + 1 < nk) {
#pragma unroll
            for (int i = 0; i < 4; ++i) ra[i] = *(const GAS u32x4*)(ap[i] + (kt + 1) * 64);
#pragma unroll
            for (int i = 0; i < 2; ++i) rb[i] = *(const GAS u32x4*)(bp[i] + (kt + 1) * 64);
        }
        mma_ll<4, 4, true>(acc, sA, 72, wm * 64, sB, 72, wn * 64, 64, lane);
    }
    epi(acc, u, wm, wn, lane);
}
struct RowDense { __device__ __forceinline__ int operator()(const GUnit& u, int r) const { return u.m0 + r; } };
struct RowPairTok { const unsigned* list; __device__ __forceinline__ int operator()(const GUnit& u, int r) const { return (int)(list[(size_t)u.e * 32768 + u.m0 + r] >> 2); } };
struct RowPair { const unsigned* list; __device__ __forceinline__ int operator()(const GUnit& u, int r) const { return (int)list[(size_t)u.e * 32768 + u.m0 + r]; } };

struct EpiP { bf16_t* P;
    __device__ __forceinline__ void operator()(const f32x4 (&acc)[4][4], const GUnit& u, int wm, int wn, int lane) const {
        const int fr = lane & 15, fq = lane >> 4;
#pragma unroll
        for (int i = 0; i < 4; ++i) { const int row = u.m0 + wm * 64 + 16 * i + fr;
#pragma unroll
            for (int j = 0; j < 4; ++j) { const int col = u.n0 + wn * 64 + 16 * j + 4 * fq; u32x2 w; w.x = pk2(acc[i][j][0], acc[i][j][1]); w.y = pk2(acc[i][j][2], acc[i][j][3]);
                *(GAS u32x2*)(P + (size_t)row * DINP + col) = w; } }
    } };
struct EpiOut { const float* x; const float* mod; float* out;
    __device__ __forceinline__ void operator()(const f32x4 (&acc)[4][4], const GUnit& u, int wm, int wn, int lane) const {
        const int fr = lane & 15, fq = lane >> 4;
#pragma unroll
        for (int i = 0; i < 4; ++i) { const int row = u.m0 + wm * 64 + 16 * i + fr; const float* gate = mod + (row >> 13) * 6144 + 2 * 1024;
#pragma unroll
            for (int j = 0; j < 4; ++j) { const int col = u.n0 + wn * 64 + 16 * j + 4 * fq;
                const f32x4 xv = *(const GAS f32x4*)(x + (size_t)row * DM + col), gv = *(const GAS f32x4*)(gate + col);
                *(GAS f32x4*)(out + (size_t)row * DM + col) = xv + gv * acc[i][j]; } }
    } };
struct EpiM1 { const unsigned* list; const float* b1; bf16_t* act;
    __device__ __forceinline__ void operator()(const f32x4 (&acc)[4][4], const GUnit& u, int wm, int wn, int lane) const {
        const int fr = lane & 15, fq = lane >> 4;
#pragma unroll
        for (int i = 0; i < 4; ++i) { const int r = wm * 64 + 16 * i + fr; if (r >= u.nvalid) continue;
            const unsigned pair = list[(size_t)u.e * 32768 + u.m0 + r];
#pragma unroll
            for (int j = 0; j < 4; ++j) { const int col = u.n0 + wn * 64 + 16 * j + 4 * fq; const f32x4 bv = *(const GAS f32x4*)(b1 + (size_t)u.e * 2048 + col);
                const f32x4 v = acc[i][j] + bv;
                const float g0 = fminf(v[0], 7.f), l0 = fminf(fmaxf(v[1], -7.f), 7.f), g1 = fminf(v[2], 7.f), l1 = fminf(fmaxf(v[3], -7.f), 7.f);
                const float a0 = g0 / (1.f + __expf(-1.702f * g0)) * (l0 + 1.f), a1 = g1 / (1.f + __expf(-1.702f * g1)) * (l1 + 1.f);
                *(GAS unsigned*)(act + (size_t)pair * DFF + (col >> 1)) = pk2(a0, a1); } }
    } };
struct EpiM2 { const unsigned* list; const float* b2; const float* pg; bf16_t* y;
    __device__ __forceinline__ void operator()(const f32x4 (&acc)[4][4], const GUnit& u, int wm, int wn, int lane) const {
        const int fr = lane & 15, fq = lane >> 4;
#pragma unroll
        for (int i = 0; i < 4; ++i) { const int r = wm * 64 + 16 * i + fr; if (r >= u.nvalid) continue;
            const unsigned pair = list[(size_t)u.e * 32768 + u.m0 + r]; const float g = pg[pair];
#pragma unroll
            for (int j = 0; j < 4; ++j) { const int col = u.n0 + wn * 64 + 16 * j + 4 * fq; const f32x4 bv = *(const GAS f32x4*)(b2 + (size_t)u.e * 1024 + col);
                const f32x4 v = (acc[i][j] + bv) * g; u32x2 w; w.x = pk2(v[0], v[1]); w.y = pk2(v[2], v[3]);
                *(GAS u32x2*)(y + (size_t)pair * DM + col) = w; } }
    } };

__device__ __forceinline__ void mla_tile(const Args& a, LAS unsigned char* lds, int tile) {
    const int tid = opaque((int)threadIdx.x), lane = tid & 63, wave = __builtin_amdgcn_readfirstlane(tid >> 6), fr = lane & 15, fq = lane >> 4;
    const bool lat = tile < 256;
    const int prow0 = tile * 128;
    const int b = lat ? (prow0 >> 13) : ((prow0 - T) >> 8);
    const int tpos0 = lat ? (prow0 & 8191) : ((prow0 - T) & 255);
    const int key0 = lat ? (LC + tpos0) : tpos0;
    LAS bf16_t* Aq = (LAS bf16_t*)lds;
    LAS bf16_t* Akv = (LAS bf16_t*)(lds + 67584);
    LAS float* kpe = (LAS float*)(lds + 67584 + 34816);
    LAS float* sspe = (LAS float*)(lds + 67584 + 34816 + 16384);
    const bf16_t* P = (const bf16_t*)(a.ws + WS_P);
    const float* tabm = (const float*)(a.ws + WS_TABM);
    __syncthreads();
    {
        const int r = tid >> 2, part = tid & 3;
        const bf16_t* pr = P + (size_t)(prow0 + r) * DINP;
        u32x4 q[8]; float ss = 0.f;
#pragma unroll
        for (int i = 0; i < 8; ++i) { q[i] = *(const GAS u32x4*)(pr + OFF_Q + part * 64 + i * 8);
#pragma unroll
            for (int e = 0; e < 4; ++e) { const float lo = lo16(q[i][e]), hi = hi16(q[i][e]); ss += lo * lo + hi * hi; } }
        ss += __shfl_xor(ss, 1); ss += __shfl_xor(ss, 2);
        float rstd = rsqrtf(ss * (1.f / 256.f) + EPS);
        const float* gq = a.in[I_GQL] + part * 64;
#pragma unroll
        for (int i = 0; i < 8; ++i) { u32x4 o;
#pragma unroll
            for (int e = 0; e < 4; ++e) o[e] = pk2(lo16(q[i][e]) * rstd * gq[i * 8 + 2 * e], hi16(q[i][e]) * rstd * gq[i * 8 + 2 * e + 1]);
            *(LAS u32x4*)(Aq + r * 264 + part * 64 + i * 8) = o; }
        u32x4 kv[4]; ss = 0.f;
#pragma unroll
        for (int i = 0; i < 4; ++i) { kv[i] = *(const GAS u32x4*)(pr + OFF_KV + part * 32 + i * 8);
#pragma unroll
            for (int e = 0; e < 4; ++e) { const float lo = lo16(kv[i][e]), hi = hi16(kv[i][e]); ss += lo * lo + hi * hi; } }
        ss += __shfl_xor(ss, 1); ss += __shfl_xor(ss, 2);
        rstd = rsqrtf(ss * (1.f / 128.f) + EPS);
        const float* gkv = a.in[I_GKVL] + part * 32;
#pragma unroll
        for (int i = 0; i < 4; ++i) { u32x4 o;
#pragma unroll
            for (int e = 0; e < 4; ++e) o[e] = pk2(lo16(kv[i][e]) * rstd * gkv[i * 8 + 2 * e], hi16(kv[i][e]) * rstd * gkv[i * 8 + 2 * e + 1]);
            *(LAS u32x4*)(Akv + r * 136 + part * 32 + i * 8) = o; }
        const u32x4 pe = *(const GAS u32x4*)(pr + OFF_PE + part * 8); ss = 0.f;
#pragma unroll
        for (int e = 0; e < 4; ++e) { const float lo = lo16(pe[e]), hi = hi16(pe[e]); ss += lo * lo + hi * hi; kpe[r * 32 + part * 8 + 2 * e] = lo; kpe[r * 32 + part * 8 + 2 * e + 1] = hi; }
        ss += __shfl_xor(ss, 1); ss += __shfl_xor(ss, 2);
        if (part == 0) sspe[r] = ss;
    }
    __syncthreads();
    const int h = wave, bh = b * NH + h;
    if (lat) {
        const bf16_t* WQ = (const bf16_t*)(a.ws + WS_WQ) + (size_t)h * QK * 256;
        const float* gqh = a.in[I_GQH];
        bf16_t* Qo = (bf16_t*)(a.ws + WS_Q) + ((size_t)bh * SEQ + tpos0) * QK;
        for (int rh = 0; rh < 2; ++rh) {
            f32x4 acc[4][6];
#pragma unroll
            for (int i = 0; i < 4; ++i)
#pragma unroll
                for (int j = 0; j < 6; ++j) acc[i][j] = (f32x4){0.f, 0.f, 0.f, 0.f};
            mma_lg<4, 6, true>(acc, Aq, 264, rh * 64, WQ, 256, 0, 256, lane);
#pragma unroll
            for (int i = 0; i < 4; ++i) {
                const int row = rh * 64 + 16 * i + fr, t = tpos0 + row;
                float ss = 0.f;
#pragma unroll
                for (int j = 0; j < 6; ++j) ss += (acc[i][j][0] * acc[i][j][0] + acc[i][j][1] * acc[i][j][1]) + (acc[i][j][2] * acc[i][j][2] + acc[i][j][3] * acc[i][j][3]);
                ss += __shfl_xor(ss, 16); ss += __shfl_xor(ss, 32);
                const float rstd = rsqrtf(ss * (1.f / 96.f) + EPS) * QSCALE;
#pragma unroll
                for (int j = 0; j < 6; ++j) {
                    const int col = 16 * j + 4 * fq; const f32x4 gv = *(const GAS f32x4*)(gqh + col);
                    f32x4 v = acc[i][j] * gv * rstd;
                    if (j >= 4) {
                        const int ax = j - 4, pi = ax == 0 ? (t >> 6) : 128 + (t & 63), f0 = 4 * (fq & 1);
                        const float* cs = tabm + (pi * 8 + f0) * 2;
#pragma unroll
                        for (int r = 0; r < 4; ++r) { const float other = __shfl_xor(v[r], 32); const float c = cs[2 * r], s = cs[2 * r + 1];
                            v[r] = (fq < 2) ? (v[r] * c - other * s) : (v[r] * c + other * s); }
                    }
                    u32x2 w; w.x = pk2(v[0], v[1]); w.y = pk2(v[2], v[3]);
                    *(GAS u32x2*)(Qo + (size_t)row * QK + col) = w;
                }
            }
        }
    }
    {
        const bf16_t* WKV = (const bf16_t*)(a.ws + WS_WKV) + (size_t)h * 128 * 128;
        const float* gkh = a.in[I_GKH];
        bf16_t* Ko = (bf16_t*)(a.ws + WS_K) + ((size_t)bh * SKV + key0) * QK;
        bf16_t* Vo = (bf16_t*)(a.ws + WS_VT) + (size_t)bh * DV * SKV + key0;
        for (int rq = 0; rq < 4; ++rq) {
            f32x4 acc[2][8];
#pragma unroll
            for (int i = 0; i < 2; ++i)
#pragma unroll
                for (int j = 0; j < 8; ++j) acc[i][j] = (f32x4){0.f, 0.f, 0.f, 0.f};
            mma_lg<2, 8, true>(acc, Akv, 136, rq * 32, WKV, 128, 0, 128, lane);
#pragma unroll
            for (int i = 0; i < 2; ++i) {
                const int row = rq * 32 + 16 * i + fr, t = tpos0 + row;
                float ss = 0.f;
#pragma unroll
                for (int j = 0; j < 4; ++j) ss += (acc[i][j][0] * acc[i][j][0] + acc[i][j][1] * acc[i][j][1]) + (acc[i][j][2] * acc[i][j][2] + acc[i][j][3] * acc[i][j][3]);
                ss += __shfl_xor(ss, 16); ss += __shfl_xor(ss, 32);
                const float rstd = rsqrtf((ss + sspe[row]) * (1.f / 96.f) + EPS);
#pragma unroll
                for (int j = 0; j < 4; ++j) { const int col = 16 * j + 4 * fq; const f32x4 gv = *(const GAS f32x4*)(gkh + col); const f32x4 v = acc[i][j] * gv * rstd;
                    u32x2 w; w.x = pk2(v[0], v[1]); w.y = pk2(v[2], v[3]); *(GAS u32x2*)(Ko + (size_t)row * QK + col) = w; }
                {
                    const int ax = fq >> 1, f0 = 4 * (fq & 1), pi = ax == 0 ? (t >> 6) : 128 + (t & 63);
                    const float* cs = tabm + (pi * 8 + f0) * 2;
                    float o0[4], o1[4];
#pragma unroll
                    for (int r = 0; r < 4; ++r) { const int c0 = ax * 16 + f0 + r, c1 = c0 + 8;
                        const float x0 = kpe[row * 32 + c0] * rstd * gkh[64 + c0], x1 = kpe[row * 32 + c1] * rstd * gkh[64 + c1];
                        const float c = lat ? cs[2 * r] : 1.f, s = lat ? cs[2 * r + 1] : 0.f;
                        o0[r] = x0 * c - x1 * s; o1[r] = x1 * c + x0 * s; }
                    u32x2 w; w.x = pk2(o0[0], o0[1]); w.y = pk2(o0[2], o0[3]); *(GAS u32x2*)(Ko + (size_t)row * QK + 64 + ax * 16 + f0) = w;
                    w.x = pk2(o1[0], o1[1]); w.y = pk2(o1[2], o1[3]); *(GAS u32x2*)(Ko + (size_t)row * QK + 64 + ax * 16 + 8 + f0) = w;
                }
#pragma unroll
                for (int j = 4; j < 8; ++j)
#pragma unroll
                    for (int r = 0; r < 4; ++r) { const int d = 16 * (j - 4) + 4 * fq + r; Vo[(size_t)d * SKV + row] = (bf16_t)f2bf(acc[i][j][r]); }
            }
        }
    }
}

__device__ __forceinline__ float log_gamma(const float* logit) { const float x = *logit; return -log1pf(__expf(-x)); }

__device__ __forceinline__ void ret_local_unit(const Args& a, LAS unsigned char* lds, int unit) {
    const int tid = opaque((int)threadIdx.x), lane = tid & 63, wave = __builtin_amdgcn_readfirstlane(tid >> 6), fr = lane & 15, fq = lane >> 4;
    const int bh = unit / NSLOT, slot = unit % NSLOT, b = bh >> 2, h = bh & 3;
    const bool lat = slot >= 2;
    const int prow0 = lat ? b * SEQ + (slot - 2) * RC : T + b * LC + slot * RC;
    const int tpos0 = lat ? (slot - 2) * RC : 0;
    LAS bf16_t* KfT = (LAS bf16_t*)lds;
    LAS bf16_t* KbT = (LAS bf16_t*)(lds + 17408);
    LAS bf16_t* VT = (LAS bf16_t*)(lds + 34816);
    const bf16_t* P = (const bf16_t*)(a.ws + WS_P);
    const float* tabr = (const float*)(a.ws + WS_TABR);
    const float lgf = log_gamma(a.in[I_DECAY] + h), lgb = log_gamma(a.in[I_DECAY] + 4 + h);
    __syncthreads();
    for (int idx = tid; idx < 128 * 32; idx += 512) {
        const int j = idx >> 5, ax = (idx >> 4) & 1, f = idx & 15, t = tpos0 + j;
        const bf16_t* pr = P + (size_t)(prow0 + j) * DINP + OFF_RK + h * 64 + ax * 32 + f;
        const float x0 = bf2f(pr[0]) * 0.125f, x1 = bf2f(pr[16]) * 0.125f;
        float c = 1.f, s = 0.f;
        if (lat) { const int pi = ax == 0 ? (t >> 6) : 128 + (t & 63); c = tabr[(pi * 16 + f) * 2]; s = tabr[(pi * 16 + f) * 2 + 1]; }
        const float o0 = x0 * c - x1 * s, o1 = x1 * c + x0 * s;
        const float wf = __expf(lgf * (float)(127 - j)), wb = __expf(lgb * (float)j);
        const int d0 = ax * 32 + f, d1 = d0 + 16;
        KfT[d0 * 136 + j] = (bf16_t)f2bf(o0 * wf); KfT[d1 * 136 + j] = (bf16_t)f2bf(o1 * wf);
        KbT[d0 * 136 + j] = (bf16_t)f2bf(o0 * wb); KbT[d1 * 136 + j] = (bf16_t)f2bf(o1 * wb);
    }
    for (int idx = tid; idx < 128 * 16; idx += 512) {
        const int j = idx >> 4, c = idx & 15;
        const u32x4 v = *(const GAS u32x4*)(P + (size_t)(prow0 + j) * DINP + OFF_RV + h * 128 + c * 8);
#pragma unroll
        for (int e = 0; e < 4; ++e) { VT[(c * 8 + 2 * e) * 136 + j] = (bf16_t)(v[e] & 0xffffu); VT[(c * 8 + 2 * e + 1) * 136 + j] = (bf16_t)(v[e] >> 16); }
    }
    __syncthreads();
    const int dir = wave >> 2, mi = wave & 3;
    f32x4 acc[1][8];
#pragma unroll
    for (int j = 0; j < 8; ++j) acc[0][j] = (f32x4){0.f, 0.f, 0.f, 0.f};
    mma_ll<1, 8, false>(acc, dir ? KbT : KfT, 136, 16 * mi, VT, 136, 0, 128, lane);
    float* out = (float*)(a.ws + WS_LST) + ((size_t)(bh * 2 + dir) * NSLOT + slot) * 8192;
#pragma unroll
    for (int j = 0; j < 8; ++j) *(GAS f32x4*)(out + (size_t)(16 * j + fr) * 64 + 16 * mi + 4 * fq) = acc[0][j];
}

__device__ __forceinline__ void phase_ret_scan(const Args& a) {
    const int gt = blockIdx.x * 512 + threadIdx.x;
    if (gt >= 32 * 2048) return;
    const int bd = gt >> 11, v4 = gt & 2047, dir = bd & 1, h = (bd >> 1) & 3;
    const float lg = log_gamma(a.in[I_DECAY] + dir * 4 + h);
    const float g = __expf(lg * 128.f);
    float* base = (float*)(a.ws + WS_LST) + (size_t)bd * NSLOT * 8192 + v4 * 4;
    f32x4 S = (f32x4){0.f, 0.f, 0.f, 0.f};
    if (dir == 0) {
#pragma unroll 5
        for (int s = 0; s < 65; ++s) { const f32x4 L = *(const GAS f32x4*)(base + (size_t)s * 8192); S = S * g + L; *(GAS f32x4*)(base + (size_t)s * 8192) = S; }
    } else {
        { const f32x4 L = *(const GAS f32x4*)(base + (size_t)1 * 8192); S = S * g + L; *(GAS f32x4*)(base + (size_t)1 * 8192) = S; }
        { const f32x4 L = *(const GAS f32x4*)(base + (size_t)0 * 8192); S = S * g + L; *(GAS f32x4*)(base + (size_t)0 * 8192) = S; }
#pragma unroll 7
        for (int s = 65; s >= 3; --s) { const f32x4 L = *(const GAS f32x4*)(base + (size_t)s * 8192); S = S * g + L; *(GAS f32x4*)(base + (size_t)s * 8192) = S; }
    }
}

__device__ __forceinline__ void ret_out_unit(const Args& a, LAS unsigned char* lds, int unit) {
    const int tid = opaque((int)threadIdx.x), lane = tid & 63, wave = __builtin_amdgcn_readfirstlane(tid >> 6), fr = lane & 15, fq = lane >> 4;
    const int bh = unit >> 6, c = unit & 63, b = bh >> 2, h = bh & 3;
    const int prow0 = b * SEQ + c * RC, tpos0 = c * RC;
    LAS bf16_t* Qs = (LAS bf16_t*)lds;
    LAS bf16_t* Ks = (LAS bf16_t*)(lds + 18432);
    LAS bf16_t* VT = (LAS bf16_t*)(lds + 36864);
    LAS bf16_t* SfT = (LAS bf16_t*)(lds + 71680);
    LAS bf16_t* SbT = (LAS bf16_t*)(lds + 90112);
    LAS bf16_t* Ws = (LAS bf16_t*)(lds + 108544);
    const bf16_t* P = (const bf16_t*)(a.ws + WS_P);
    const float* tabr = (const float*)(a.ws + WS_TABR);
    const float lgf = log_gamma(a.in[I_DECAY] + h), lgb = log_gamma(a.in[I_DECAY] + 4 + h);
    __syncthreads();
    for (int idx = tid; idx < 128 * 32; idx += 512) {
        const int j = idx >> 5, ax = (idx >> 4) & 1, f = idx & 15, t = tpos0 + j;
        const int pi = ax == 0 ? (t >> 6) : 128 + (t & 63); const float cc = tabr[(pi * 16 + f) * 2], s = tabr[(pi * 16 + f) * 2 + 1];
        const bf16_t* pq = P + (size_t)(prow0 + j) * DINP + OFF_RQ + h * 64 + ax * 32 + f;
        const bf16_t* pk = P + (size_t)(prow0 + j) * DINP + OFF_RK + h * 64 + ax * 32 + f;
        const float q0 = bf2f(pq[0]), q1 = bf2f(pq[16]), k0 = bf2f(pk[0]) * 0.125f, k1 = bf2f(pk[16]) * 0.125f;
        const int d0 = ax * 32 + f, d1 = d0 + 16;
        Qs[j * 72 + d0] = (bf16_t)f2bf(q0 * cc - q1 * s); Qs[j * 72 + d1] = (bf16_t)f2bf(q1 * cc + q0 * s);
        Ks[j * 72 + d0] = (bf16_t)f2bf(k0 * cc - k1 * s); Ks[j * 72 + d1] = (bf16_t)f2bf(k1 * cc + k0 * s);
    }
    for (int idx = tid; idx < 128 * 16; idx += 512) {
        const int j = idx >> 4, cch = idx & 15;
        const u32x4 v = *(const GAS u32x4*)(P + (size_t)(prow0 + j) * DINP + OFF_RV + h * 128 + cch * 8);
#pragma unroll
        for (int e = 0; e < 4; ++e) { VT[(cch * 8 + 2 * e) * 136 + j] = (bf16_t)(v[e] & 0xffffu); VT[(cch * 8 + 2 * e + 1) * 136 + j] = (bf16_t)(v[e] >> 16); }
    }
    {
        const float* sf = (const float*)(a.ws + WS_LST) + ((size_t)(bh * 2 + 0) * NSLOT + (c + 1)) * 8192;
        const float* sb = (const float*)(a.ws + WS_LST) + ((size_t)(bh * 2 + 1) * NSLOT + (c == 63 ? 0 : c + 3)) * 8192;
        for (int idx = tid; idx < 2048; idx += 512) {
            const int e = idx >> 4, d = (idx & 15) * 4;
            const f32x4 x = *(const GAS f32x4*)(sf + idx * 4), y = *(const GAS f32x4*)(sb + idx * 4);
            u32x2 w; w.x = pk2(x[0], x[1]); w.y = pk2(x[2], x[3]); *(LAS u32x2*)(SfT + e * 72 + d) = w;
            w.x = pk2(y[0], y[1]); w.y = pk2(y[2], y[3]); *(LAS u32x2*)(SbT + e * 72 + d) = w;
        }
    }
    __syncthreads();
    const int i0 = 16 * wave, irow = i0 + fr;
    f32x4 accS[1][8], accF[1][8], accB[1][8], accO[1][8];
#pragma unroll
    for (int j = 0; j < 8; ++j) { accS[0][j] = (f32x4){0.f, 0.f, 0.f, 0.f}; accF[0][j] = accS[0][j]; accB[0][j] = accS[0][j]; accO[0][j] = accS[0][j]; }
    mma_ll<1, 8, true>(accS, Qs, 72, i0, Ks, 72, 0, 64, lane);
    mma_ll<1, 8, true>(accF, Qs, 72, i0, SfT, 72, 0, 64, lane);
    mma_ll<1, 8, true>(accB, Qs, 72, i0, SbT, 72, 0, 64, lane);
#pragma unroll
    for (int j = 0; j < 8; ++j) {
        float w[4];
#pragma unroll
        for (int r = 0; r < 4; ++r) { const int jj = 16 * j + 4 * fq + r; const int df = irow - jj;
            const float dec = df > 0 ? __expf(lgf * (float)df) : (df < 0 ? __expf(lgb * (float)(-df)) : 2.f);
            w[r] = accS[0][j][r] * dec; }
        u32x2 pw; pw.x = pk2(w[0], w[1]); pw.y = pk2(w[2], w[3]);
        *(LAS u32x2*)(Ws + irow * 136 + 16 * j + 4 * fq) = pw;
    }
    LDS_WAIT(); __builtin_amdgcn_wave_barrier();
    mma_ll<1, 8, true>(accO, Ws, 136, i0, VT, 136, 0, 128, lane);
    const float wf = __expf(lgf * (float)(irow + 1)), wb = __expf(lgb * (float)(128 - irow));
    float ss = 0.f;
#pragma unroll
    for (int j = 0; j < 8; ++j) { accO[0][j] = accO[0][j] + accF[0][j] * wf + accB[0][j] * wb;
        ss += (accO[0][j][0] * accO[0][j][0] + accO[0][j][1] * accO[0][j][1]) + (accO[0][j][2] * accO[0][j][2] + accO[0][j][3] * accO[0][j][3]); }
    ss += __shfl_xor(ss, 16); ss += __shfl_xor(ss, 32);
    const float rstd = rsqrtf(ss * (1.f / 128.f) + EPS);
    const float* gro = a.in[I_GRET] + h * 128;
    const bf16_t* pg = P + (size_t)(prow0 + irow) * DINP + OFF_RG + h * 128;
    bf16_t* mix = (bf16_t*)(a.ws + WS_MIX) + (size_t)(prow0 + irow) * DM + 512 + h * 128;
#pragma unroll
    for (int j = 0; j < 8; ++j) { const int e = 16 * j + 4 * fq; const f32x4 gv = *(const GAS f32x4*)(gro + e); const u32x2 gw = *(const GAS u32x2*)(pg + e);
        const float g0 = lo16(gw.x), g1 = hi16(gw.x), g2 = lo16(gw.y), g3 = hi16(gw.y);
        f32x4 v = accO[0][j] * gv * rstd;
        v[0] *= g0 / (1.f + __expf(-g0)); v[1] *= g1 / (1.f + __expf(-g1)); v[2] *= g2 / (1.f + __expf(-g2)); v[3] *= g3 / (1.f + __expf(-g3));
        u32x2 w; w.x = pk2(v[0], v[1]); w.y = pk2(v[2], v[3]); *(GAS u32x2*)(mix + e) = w; }
}

namespace att {
constexpr int KLD = 104, VLD = 68, KBUF = 64 * KLD * 2, VBUF = 64 * VLD * 2;
constexpr int L_K = 0, L_V = 2 * KBUF, L_WS = 2 * KBUF + 2 * VBUF;
__device__ __forceinline__ int crow(int r, int hi) { return (r & 3) + 8 * (r >> 2) + 4 * hi; }
typedef __bf16 bf16x2_t __attribute__((ext_vector_type(2))); typedef float f32x2_t __attribute__((ext_vector_type(2)));
__device__ __forceinline__ unsigned cvtpk(float lo, float hi) { f32x2_t v = {lo, hi}; bf16x2_t b = __builtin_convertvector(v, bf16x2_t); return __builtin_bit_cast(unsigned, b); }
#define SBAR() __builtin_amdgcn_sched_barrier(0)
__device__ __forceinline__ void qkt(f32x16& p0, f32x16& p1, const LAS bf16_t* Ks, const bf16x8* qr, float negm, int r32, int hi) {
#pragma unroll
    for (int r = 0; r < 16; ++r) { p0[r] = negm; p1[r] = negm; }
#pragma unroll
    for (int d0 = 0; d0 < 6; ++d0) {
        const bf16x8 k0 = *(const LAS bf16x8*)(Ks + r32 * KLD + d0 * 16 + hi * 8);
        const bf16x8 k1 = *(const LAS bf16x8*)(Ks + (32 + r32) * KLD + d0 * 16 + hi * 8);
        p0 = __builtin_amdgcn_mfma_f32_32x32x16_bf16(k0, qr[d0], p0, 0, 0, 0);
        p1 = __builtin_amdgcn_mfma_f32_32x32x16_bf16(k1, qr[d0], p1, 0, 0, 0);
    }
}
__device__ __forceinline__ void softmax_pack(f32x16& p0, f32x16& p1, float& l_reg, bf16x8& pa0, bf16x8& pa1, bf16x8& pa2, bf16x8& pa3) {
#pragma unroll
    for (int r = 0; r < 16; ++r) { p0[r] = __builtin_amdgcn_exp2f(p0[r]); p1[r] = __builtin_amdgcn_exp2f(p1[r]); }
    float s = 0.f;
#pragma unroll
    for (int r = 0; r < 16; ++r) s += p0[r] + p1[r];
    l_reg += s;
    u32x4 w;
    w = (u32x4){cvtpk(p0[0], p0[1]), cvtpk(p0[2], p0[3]), cvtpk(p0[4], p0[5]), cvtpk(p0[6], p0[7])}; pa0 = __builtin_bit_cast(bf16x8, w);
    w = (u32x4){cvtpk(p0[8], p0[9]), cvtpk(p0[10], p0[11]), cvtpk(p0[12], p0[13]), cvtpk(p0[14], p0[15])}; pa1 = __builtin_bit_cast(bf16x8, w);
    w = (u32x4){cvtpk(p1[0], p1[1]), cvtpk(p1[2], p1[3]), cvtpk(p1[4], p1[5]), cvtpk(p1[6], p1[7])}; pa2 = __builtin_bit_cast(bf16x8, w);
    w = (u32x4){cvtpk(p1[8], p1[9]), cvtpk(p1[10], p1[11]), cvtpk(p1[12], p1[13]), cvtpk(p1[14], p1[15])}; pa3 = __builtin_bit_cast(bf16x8, w);
}
__device__ __forceinline__ void pv(f32x16* o, const LAS bf16_t* Vs, bf16x8 pa0, bf16x8 pa1, bf16x8 pa2, bf16x8 pa3, int r32, int hi) {
#pragma unroll
    for (int d0 = 0; d0 < 2; ++d0) {
        const LAS bf16_t* vp = Vs + (d0 * 32 + r32) * VLD + 4 * hi;
        s16x4 lo[4], hh[4];
#pragma unroll
        for (int s = 0; s < 4; ++s) { lo[s] = *(const LAS s16x4*)(vp + 16 * s); hh[s] = *(const LAS s16x4*)(vp + 16 * s + 8); }
#define VF(s) (bf16x8){lo[s][0], lo[s][1], lo[s][2], lo[s][3], hh[s][0], hh[s][1], hh[s][2], hh[s][3]}
        o[d0] = __builtin_amdgcn_mfma_f32_32x32x16_bf16(pa0, VF(0), o[d0], 0, 0, 0);
        o[d0] = __builtin_amdgcn_mfma_f32_32x32x16_bf16(pa1, VF(1), o[d0], 0, 0, 0);
        o[d0] = __builtin_amdgcn_mfma_f32_32x32x16_bf16(pa2, VF(2), o[d0], 0, 0, 0);
        o[d0] = __builtin_amdgcn_mfma_f32_32x32x16_bf16(pa3, VF(3), o[d0], 0, 0, 0);
#undef VF
    }
}
__device__ __forceinline__ void unit(const Args& a, LAS unsigned char* lds, int bh, int qb, float negm) {
    const int tid = opaque((int)threadIdx.x), lane = tid & 63, wid = __builtin_amdgcn_readfirstlane(tid >> 6), r32 = lane & 31, hi = lane >> 5;
    const bf16_t* Qw = (const bf16_t*)(a.ws + WS_Q) + ((size_t)bh * SEQ + qb * 256 + wid * 32 + r32) * QK + hi * 8;
    const bf16_t* Kh = (const bf16_t*)(a.ws + WS_K) + (size_t)bh * SKV * QK;
    const bf16_t* Vh = (const bf16_t*)(a.ws + WS_VT) + (size_t)bh * DV * SKV;
    LAS bf16_t* Kl = (LAS bf16_t*)(lds + L_K); LAS bf16_t* Vl = (LAS bf16_t*)(lds + L_V);
    LAS float* wsf = (LAS float*)(lds + L_WS) + wid * 64;
    bf16x8 qr[6];
#pragma unroll
    for (int d0 = 0; d0 < 6; ++d0) qr[d0] = *(const GAS bf16x8*)(Qw + d0 * 16);
    const int kc0 = tid, kc1 = 512 + tid; const bool two = wid < 4;
    const int kl0 = (kc0 / 12) * KLD + (kc0 % 12) * 8, kl1 = (kc1 / 12) * KLD + (kc1 % 12) * 8;
    const int vd = tid >> 3, vk = (tid & 7) * 8, vl = vd * VLD + vk;
    const bf16_t* vsrc = Vh + (size_t)vd * SKV + vk;
    struct Stg { u32x4 k0, k1, v; } sE, sO;
#define SLOAD(S, t) do { const bf16_t* kp_ = Kh + (size_t)(t) * (64 * QK); S.k0 = *(const GAS u32x4*)(kp_ + kc0 * 8); if (two) S.k1 = *(const GAS u32x4*)(kp_ + kc1 * 8); \
        S.v = *(const GAS u32x4*)(vsrc + (t) * 64); } while (0)
#define SWRITE(bufi, S) do { *(LAS u32x4*)(Kl + (bufi) * (KBUF / 2) + kl0) = S.k0; if (two) *(LAS u32x4*)(Kl + (bufi) * (KBUF / 2) + kl1) = S.k1; \
        *(LAS u32x2*)(Vl + (bufi) * (VBUF / 2) + vl) = (u32x2){S.v.x, S.v.y}; *(LAS u32x2*)(Vl + (bufi) * (VBUF / 2) + vl + 4) = (u32x2){S.v.z, S.v.w}; } while (0)
    float l_reg = 0.f; f32x16 o[2];
#pragma unroll
    for (int r = 0; r < 16; ++r) { o[0][r] = 0.f; o[1][r] = 0.f; }
    f32x16 pA0, pA1, pB0, pB1; bf16x8 pa0, pa1, pa2, pa3;
    constexpr int NT = SKV / 64;
    __syncthreads();
    SLOAD(sE, 0); SWRITE(0, sE); __syncthreads();
    qkt(pA0, pA1, Kl, qr, negm, r32, hi);
    SLOAD(sO, 1); SLOAD(sE, 2);
    SWRITE(1, sO); __syncthreads();
    for (int j = 1; j + 1 < NT; j += 2) {
        SBAR(); qkt(pB0, pB1, Kl + KBUF / 2, qr, negm, r32, hi);
        softmax_pack(pA0, pA1, l_reg, pa0, pa1, pa2, pa3); SBAR();
        SLOAD(sO, j + 2); SBAR();
        pv(o, Vl, pa0, pa1, pa2, pa3, r32, hi);
        __syncthreads(); SWRITE(0, sE); __syncthreads();
        SBAR(); qkt(pA0, pA1, Kl, qr, negm, r32, hi);
        softmax_pack(pB0, pB1, l_reg, pa0, pa1, pa2, pa3); SBAR();
        if (j + 3 < NT) SLOAD(sE, j + 3); SBAR();
        pv(o, Vl + VBUF / 2, pa0, pa1, pa2, pa3, r32, hi);
        __syncthreads(); SWRITE(1, sO); __syncthreads();
    }
    SBAR(); qkt(pB0, pB1, Kl + KBUF / 2, qr, negm, r32, hi);
    softmax_pack(pA0, pA1, l_reg, pa0, pa1, pa2, pa3); SBAR();
    pv(o, Vl, pa0, pa1, pa2, pa3, r32, hi);
    softmax_pack(pB0, pB1, l_reg, pa0, pa1, pa2, pa3); SBAR();
    pv(o, Vl + VBUF / 2, pa0, pa1, pa2, pa3, r32, hi);
#undef SLOAD
#undef SWRITE
    l_reg += __shfl_xor(l_reg, 32);
    if (hi == 0) wsf[r32] = l_reg;
    LDS_WAIT(); __builtin_amdgcn_wave_barrier();
    const int b = bh >> 3, h = bh & 7;
    const int lz = opaque(lane), r32z = lz & 31, hiz = lz >> 5;
    bf16_t* Ow = (bf16_t*)(a.ws + WS_MIX) + ((size_t)b * SEQ + qb * 256 + wid * 32) * DM + h * DV;
    unsigned ooff = (unsigned)(4 * hiz * DM + r32z);
#pragma unroll
    for (int r = 0; r < 16; ++r) { const int orow = crow(r, hiz); const float rl = 1.f / wsf[orow];
        const unsigned off = ooff + (unsigned)(((r & 3) + 8 * (r >> 2)) * DM);
        Ow[off] = (bf16_t)f2bf(o[0][r] * rl); Ow[off + 32] = (bf16_t)f2bf(o[1][r] * rl); }
}
#undef SBAR
}

__device__ __forceinline__ void phase_router(const Args& a, LAS unsigned char* lds) {
    const int tid = opaque((int)threadIdx.x), lane = tid & 63, wave = __builtin_amdgcn_readfirstlane(tid >> 6), fr = lane & 15, fq = lane >> 4;
    LAS bf16_t* Ah = (LAS bf16_t*)lds;
    LAS bf16_t* Al = (LAS bf16_t*)(lds + 33024);
    LAS float* red = (LAS float*)(lds + 66048);
    LAS int* hist = (LAS int*)(lds + 66048 + 16384);
    LAS int* base = hist + 32;
    LAS int* pk_e = base + 32;
    LAS int* pk_r = pk_e + 512;
    LAS int* pk_p = pk_r + 512;
    const float* mod = (const float*)(a.ws + WS_MOD); const float* g = a.in[I_GFFN];
    const bf16_t* WR = (const bf16_t*)(a.ws + WS_WR);
    bf16_t* HF = (bf16_t*)(a.ws + WS_HF);
    float* PG = (float*)(a.ws + WS_PG);
    unsigned* cnt = (unsigned*)(a.ws + WS_CTL) + CW_CNT;
    unsigned* list = (unsigned*)(a.ws + WS_LIST);
    for (int tile = blockIdx.x; tile < T / 128; tile += gridDim.x) {
        __syncthreads();
        if (tid < 32) hist[tid] = 0;
        for (int it = 0; it < 8; ++it) {
            const int tok0 = tile * 128 + it * 16;
            __syncthreads();
#pragma unroll
            for (int rr = 0; rr < 2; ++rr) {
                const int row = wave * 2 + rr, tok = tok0 + row;
                const float* xr = a.out + (size_t)tok * DM; const float* sh = mod + (tok >> 13) * 6144 + 3 * 1024; const float* sc = sh + 1024;
                f32x4 v[4]; float ss = 0.f;
#pragma unroll
                for (int j = 0; j < 4; ++j) { v[j] = *(const GAS f32x4*)(xr + j * 256 + lane * 4); ss += (v[j].x * v[j].x + v[j].y * v[j].y) + (v[j].z * v[j].z + v[j].w * v[j].w); }
                const float rstd = rsqrtf(wave_sum(ss) * (1.f / DM) + EPS);
#pragma unroll
                for (int j = 0; j < 4; ++j) { const int c = j * 256 + lane * 4; const f32x4 gg = *(const GAS f32x4*)(g + c), s1 = *(const GAS f32x4*)(sc + c), s0 = *(const GAS f32x4*)(sh + c);
                    const f32x4 o = (v[j] * rstd * gg) * (s1 + 1.f) + s0;
                    const unsigned h0 = f2bf(o.x), h1 = f2bf(o.y), h2 = f2bf(o.z), h3 = f2bf(o.w);
                    u32x2 wh; wh.x = h0 | (h1 << 16); wh.y = h2 | (h3 << 16);
                    u32x2 wl; wl.x = pk2(o.x - bf2f((bf16_t)h0), o.y - bf2f((bf16_t)h1)); wl.y = pk2(o.z - bf2f((bf16_t)h2), o.w - bf2f((bf16_t)h3));
                    *(GAS u32x2*)(HF + (size_t)tok * DM + c) = wh;
                    *(LAS u32x2*)(Ah + row * 1032 + c) = wh; *(LAS u32x2*)(Al + row * 1032 + c) = wl; }
            }
            __syncthreads();
            {
                f32x4 acc[1][2]; acc[0][0] = (f32x4){0.f, 0.f, 0.f, 0.f}; acc[0][1] = acc[0][0];
                mma_lg<1, 2, false>(acc, Ah + wave * 128, 1032, 0, WR + wave * 128, 1024, 0, 128, lane);
                mma_lg<1, 2, false>(acc, Al + wave * 128, 1032, 0, WR + wave * 128, 1024, 0, 128, lane);
                mma_lg<1, 2, false>(acc, Ah + wave * 128, 1032, 0, WR + 32768 + wave * 128, 1024, 0, 128, lane);
#pragma unroll
                for (int j = 0; j < 2; ++j)
#pragma unroll
                    for (int r = 0; r < 4; ++r) red[(wave * 16 + 4 * fq + r) * 32 + 16 * j + fr] = acc[0][j][r];
            }
            __syncthreads();
            if (tid < 16) {
                const int tok = tok0 + tid;
                float best[4]; int bi[4];
#pragma unroll
                for (int k = 0; k < 4; ++k) { best[k] = -3.0e38f; bi[k] = 0; }
                for (int e = 0; e < 32; ++e) {
                    float s = a.in[I_BR][e];
#pragma unroll
                    for (int w = 0; w < 8; ++w) s += red[(w * 16 + tid) * 32 + e];
                    if (s > best[3]) {
                        if (s > best[0]) { best[3] = best[2]; bi[3] = bi[2]; best[2] = best[1]; bi[2] = bi[1]; best[1] = best[0]; bi[1] = bi[0]; best[0] = s; bi[0] = e; }
                        else if (s > best[1]) { best[3] = best[2]; bi[3] = bi[2]; best[2] = best[1]; bi[2] = bi[1]; best[1] = s; bi[1] = e; }
                        else if (s > best[2]) { best[3] = best[2]; bi[3] = bi[2]; best[2] = s; bi[2] = e; }
                        else { best[3] = s; bi[3] = e; }
                    }
                }
                const float e1 = __expf(best[1] - best[0]), e2 = __expf(best[2] - best[0]), e3 = __expf(best[3] - best[0]);
                const float inv = 1.f / (1.f + e1 + e2 + e3);
                const float gk[4] = {inv, e1 * inv, e2 * inv, e3 * inv};
#pragma unroll
                for (int k = 0; k < 4; ++k) { const int slot = (it * 16 + tid) * 4 + k; const int rk = __hip_atomic_fetch_add(hist + bi[k], 1, __ATOMIC_RELAXED, __HIP_MEMORY_SCOPE_WORKGROUP);
                    pk_e[slot] = bi[k]; pk_r[slot] = rk; pk_p[slot] = tok * 4 + k; PG[tok * 4 + k] = gk[k]; }
            }
        }
        __syncthreads();
        if (tid < 32) base[tid] = (int)__hip_atomic_fetch_add(cnt + 64 * tid, (unsigned)hist[tid], __ATOMIC_RELAXED, __HIP_MEMORY_SCOPE_AGENT);
        __syncthreads();
        { const int e = pk_e[tid]; list[(size_t)e * 32768 + base[e] + pk_r[tid]] = (unsigned)pk_p[tid]; }
    }
}

template <int NCOLT, class RowFn, class Epi>
__device__ __forceinline__ void phase_moe_gemm(const Args& a, LAS unsigned char* lds, const bf16_t* A, const bf16_t* Wt, int Nw, const RowFn& rowfn, const Epi& epi) {
    LAS int* pre = (LAS int*)(lds + 56 * 1024);
    const unsigned* cnt = (const unsigned*)(a.ws + WS_CTL) + CW_CNT;
    __syncthreads();
    if (threadIdx.x == 0) { int s = 0; for (int e = 0; e < NE; ++e) { const int c = (int)__hip_atomic_load(cnt + 64 * e, __ATOMIC_RELAXED, __HIP_MEMORY_SCOPE_AGENT); pre[e] = s; pre[33 + e] = c; s += (c + 255) >> 8; } pre[32] = s; }
    __syncthreads();
    const int ntile = pre[32], nunit = ntile * NCOLT;
    for (int id = blockIdx.x; id < nunit; id += gridDim.x) {
        const int ti = id / NCOLT, pn = id % NCOLT;
        int e = 0;
        for (int k = 1; k < NE; ++k) if (pre[k] <= ti) e = k;
        const int pm = ti - pre[e], c = pre[33 + e];
        GUnit u; u.e = e; u.m0 = pm * 256; u.n0 = pn * 128; u.nvalid = (c - pm * 256) < 256 ? (c - pm * 256) : 256;
        u.Bt = Wt + ((size_t)e * Nw + pn * 128) * 1024;
        gemm_tile(lds, A, 1024, u, rowfn, epi);
    }
}

__device__ __forceinline__ void phase_combine(const Args& a) {
    const int tid = threadIdx.x, lane = tid & 63, wave = tid >> 6;
    const int gw = blockIdx.x * 8 + wave, NGW = gridDim.x * 8;
    const float* mod = (const float*)(a.ws + WS_MOD);
    const bf16_t* Y = (const bf16_t*)(a.ws + WS_Y);
    for (int tok = gw; tok < T; tok += NGW) {
        const float* gate = mod + (tok >> 13) * 6144 + 5 * 1024;
        float* orow = a.out + (size_t)tok * DM;
#pragma unroll
        for (int j = 0; j < 4; ++j) { const int c = j * 256 + lane * 4;
            f32x4 s = (f32x4){0.f, 0.f, 0.f, 0.f};
#pragma unroll
            for (int k = 0; k < 4; ++k) { const u32x2 w = *(const GAS u32x2*)(Y + ((size_t)tok * 4 + k) * DM + c); s[0] += lo16(w.x); s[1] += hi16(w.x); s[2] += lo16(w.y); s[3] += hi16(w.y); }
            const f32x4 xv = *(const GAS f32x4*)(orow + c), gv = *(const GAS f32x4*)(gate + c);
            *(GAS f32x4*)(orow + c) = xv + gv * s; }
    }
}

constexpr int N_PHASES = 11;
__global__ void __launch_bounds__(512, 2) fwd_kernel(Args a) {
    extern __shared__ __attribute__((aligned(16))) unsigned char lds_raw[];
    LAS unsigned char* lds = (LAS unsigned char*)lds_raw;
    volatile LAS unsigned* MISC = (volatile LAS unsigned*)(lds + LDS_MISC);
    const int tid = threadIdx.x;
    if (tid < 64) MISC[tid] = 0u;
    __syncthreads();
    const int lo = a.ph_lo, hi = a.ph_hi;
    const bool use_bar = (hi - lo) > 1;
    XcdBarrier bar; bar.bar = (unsigned*)(a.ws + WS_CTL) + CW_BAR; bar.x = 0; bar.st = MISC + 8;
    if (use_bar) bar = xcd_barrier_post((unsigned*)(a.ws + WS_CTL) + CW_BAR, MISC + 8);
    const int G = gridDim.x, bx = blockIdx.x;
    const int vcu = (G % 8 == 0) ? (bx % 8) * (G / 8) + bx / 8 : bx;
#ifndef ONLY_PHASE
#define ONLY_PHASE -1
#endif
#define IN(k) (lo <= (k) && (k) < hi && (ONLY_PHASE < 0 || ONLY_PHASE == (k)))
#define SEAM(k) do { if (use_bar && (k) + 1 < hi) xcd_barrier(bar); } while (0)
    if (IN(0)) { phase_mod(a, lds); SEAM(0); }
    if (IN(1)) { phase_prep(a, lds); SEAM(1); }
    if (IN(2)) {
        EpiP E{(bf16_t*)(a.ws + WS_P)}; RowDense R;
        const bf16_t* A = (const bf16_t*)(a.ws + WS_H); const bf16_t* Wt = (const bf16_t*)(a.ws + WS_WIN);
        for (int id = bx; id < (TA / 256) * 16; id += G) { GUnit u; u.m0 = (id >> 4) * 256; u.n0 = (id & 15) * 128; u.nvalid = 256; u.e = 0; u.Bt = Wt + (size_t)u.n0 * 1024; gemm_tile(lds, A, 1024, u, R, E); }
        SEAM(2);
    }
    if (IN(3)) {
#ifndef NO_P3A
        for (int t = bx; t < TA / 128; t += G) mla_tile(a, lds, t);
#endif
#ifndef NO_P3B
        for (int u = bx; u < 16 * NSLOT; u += G) ret_local_unit(a, lds, u);
#endif
        SEAM(3);
    }
    if (IN(4)) { phase_ret_scan(a); SEAM(4); }
    if (IN(5)) {
        float negm;
        { float gq = 0.f, gk = 0.f; for (int i = 0; i < QK; ++i) { gq = fmaxf(gq, fabsf(a.in[I_GQH][i])); gk = fmaxf(gk, fabsf(a.in[I_GKH][i])); }
          negm = -(gq * gk * 96.f * QSCALE * 1.03f + 0.5f); }
#ifndef NO_P5A
        for (int i = 0; i < 4; ++i) { const int w = vcu * 4 + i; if (w < 1024) att::unit(a, lds, w >> 5, w & 31, negm); }
        if (G != 256) for (int w = G * 4 + bx; w < 1024; w += G) att::unit(a, lds, w >> 5, w & 31, negm);
#endif
#ifndef NO_P5B
        for (int u = bx; u < 16 * 64; u += G) ret_out_unit(a, lds, u);
#endif
        SEAM(5);
    }
    if (IN(6)) {
        EpiOut E{a.in[I_X], (const float*)(a.ws + WS_MOD), a.out}; RowDense R;
        const bf16_t* A = (const bf16_t*)(a.ws + WS_MIX); const bf16_t* Wt = (const bf16_t*)(a.ws + WS_WO);
        for (int id = bx; id < (T / 256) * 8; id += G) { GUnit u; u.m0 = (id >> 3) * 256; u.n0 = (id & 7) * 128; u.nvalid = 256; u.e = 0; u.Bt = Wt + (size_t)u.n0 * 1024; gemm_tile(lds, A, 1024, u, R, E); }
        SEAM(6);
    }
    if (IN(7)) { phase_router(a, lds); SEAM(7); }
    if (IN(8)) {
        RowPairTok R{(const unsigned*)(a.ws + WS_LIST)}; EpiM1 E{(const unsigned*)(a.ws + WS_LIST), a.in[I_B1], (bf16_t*)(a.ws + WS_ACT)};
        phase_moe_gemm<16>(a, lds, (const bf16_t*)(a.ws + WS_HF), (const bf16_t*)(a.ws + WS_W1), 2048, R, E);
        SEAM(8);
    }
    if (IN(9)) {
        RowPair R{(const unsigned*)(a.ws + WS_LIST)}; EpiM2 E{(const unsigned*)(a.ws + WS_LIST), a.in[I_B2], (const float*)(a.ws + WS_PG), (bf16_t*)(a.ws + WS_Y)};
        phase_moe_gemm<8>(a, lds, (const bf16_t*)(a.ws + WS_ACT), (const bf16_t*)(a.ws + WS_W2), 1024, R, E);
        SEAM(9);
    }
    if (IN(10)) { phase_combine(a); }
#undef IN
#undef SEAM
}

extern "C" void kernel_launch(void* const* d_in, const int* in_sizes, int n_in, void* d_out, int out_size, void* d_ws, size_t ws_size, hipStream_t stream) {
    static int grid = 0;
    if (grid == 0) {
        if (n_in != 24 || out_size != T * DM || ws_size < WS_END) { fprintf(stderr, "kernel_launch: unexpected shapes (n_in %d out %d ws %zu)\n", n_in, out_size, ws_size); grid = -1; return; }
        int dev = 0, cus = 0, per_cu = 0;
        if (hipGetDevice(&dev) != hipSuccess || hipDeviceGetAttribute(&cus, hipDeviceAttributeMultiprocessorCount, dev) != hipSuccess) { grid = -1; return; }
        if (hipFuncSetAttribute((const void*)fwd_kernel, hipFuncAttributeMaxDynamicSharedMemorySize, LDS_BYTES) != hipSuccess) { fprintf(stderr, "kernel_launch: hipFuncSetAttribute failed\n"); grid = -1; return; }
        if (hipOccupancyMaxActiveBlocksPerMultiprocessor(&per_cu, (const void*)fwd_kernel, 512, LDS_BYTES) != hipSuccess || per_cu < 1) { fprintf(stderr, "kernel_launch: occupancy query says %d\n", per_cu); per_cu = 1; }
        (void)hipGetLastError();
        grid = cus;
    }
    if (grid < 0) return;
    (void)hipMemsetAsync((char*)d_ws + WS_CTL, 0, CTL_BYTES, stream);
    Args a{};
    for (int i = 0; i < 24; ++i) a.in[i] = (const float*)d_in[i];
    a.out = (float*)d_out; a.ws = (unsigned char*)d_ws;
#if MK_N_LAUNCHES == 1
    a.ph_lo = 0; a.ph_hi = N_PHASES;
    void* params[] = {&a};
    hipError_t e = hipLaunchCooperativeKernel((const void*)fwd_kernel, dim3(grid), dim3(512), params, LDS_BYTES, stream);
    if (e != hipSuccess) fprintf(stderr, "kernel_launch: cooperative launch failed: %s (grid %d)\n", hipGetErrorString(e), grid);
#else
    for (int p = 0; p < N_PHASES; ++p) { a.ph_lo = p; a.ph_hi = p + 1; hipLaunchKernelGGL(fwd_kernel, dim3(grid), dim3(512), LDS_BYTES, stream, a); }
#endif
}
```

```cpp
#include <hip/hip_runtime.h>
#include <cstdio>
#include <cstdint>

#ifndef MK_N_LAUNCHES
#define MK_N_LAUNCHES 1
#endif

#define LAS __attribute__((address_space(3)))
#define GAS __attribute__((address_space(1)))
typedef unsigned short bf16_t;
typedef short bf16x8 __attribute__((ext_vector_type(8)));
typedef short s16x4 __attribute__((ext_vector_type(4)));
typedef float f32x4 __attribute__((ext_vector_type(4)));
typedef float f32x16 __attribute__((ext_vector_type(16)));
typedef unsigned u32x4 __attribute__((ext_vector_type(4)));
typedef unsigned u32x2 __attribute__((ext_vector_type(2)));

constexpr int DM = 1024, NB = 4, SEQ = 8192, LC = 256;
constexpr int T = NB * SEQ;
constexpr int TC = NB * LC;
constexpr int TA = T + TC;
constexpr int DIN = 1952, DINP = 2048;
constexpr int OFF_Q = 0, OFF_KV = 256, OFF_PE = 384, OFF_RQ = 416, OFF_RK = 672, OFF_RV = 928, OFF_RG = 1440;
constexpr int NH = 8, QK = 96, QK8 = 128, DV = 64, SKV = LC + SEQ;
constexpr int RH = 4, RDK = 64, RDV = 128, RC = 128, NSLOT = 66;
constexpr int NE = 32, DFF = 1024, NPAIR = T * 4;
constexpr float EPS = 1e-6f;
constexpr float QSCALE = 0.10206207261596577f * 1.4426950408889634f;

constexpr size_t MiB = 1ull << 20;
constexpr size_t WS_CTL = 0, CTL_BYTES = 1 * MiB;
constexpr size_t WS_MOD = 1 * MiB;
constexpr size_t WS_TABM = WS_MOD + 128 * 1024;
constexpr size_t WS_TABR = WS_TABM + 16 * 1024;
constexpr size_t WS_WIN = 2 * MiB;
constexpr size_t WS_WQ = 6 * MiB;
constexpr size_t WS_WKV = 6 * MiB + 512 * 1024;
constexpr size_t WS_WO = 7 * MiB;
constexpr size_t WS_WR = 9 * MiB;
constexpr size_t WS_W1 = 10 * MiB;
constexpr size_t WS_W2 = 138 * MiB;
constexpr size_t WS_HF = 202 * MiB;
constexpr size_t WS_PG = 266 * MiB;
constexpr size_t WS_LIST = 267 * MiB;
constexpr size_t WS_H = 272 * MiB;
constexpr size_t WS_P = 338 * MiB;
constexpr size_t WS_Q = 470 * MiB;
constexpr size_t WS_K = 518 * MiB;
constexpr size_t WS_VT = 568 * MiB;
constexpr size_t WS_LST = 601 * MiB;
constexpr size_t WS_MIX = 667 * MiB;
constexpr size_t WS_ACT = 272 * MiB;
constexpr size_t WS_Y = 528 * MiB;
constexpr size_t WS_END = 784 * MiB;
constexpr size_t WS_PRM = WS_MOD + 256 * 1024;
constexpr int PRM_GQL = 0, PRM_GKVL = 256, PRM_GQH = 384, PRM_GKH = 480, PRM_DECAY = 576, PRM_GRET = 584, PRM_BR = 1096, PRM_GFFN = 1128, PRM_B1 = 2152, PRM_B2 = 67688, PRM_END = 100456;
constexpr int CW_BAR = 4096;
constexpr int CW_CNT = 16384;
constexpr int CW_DIAG = 20480;
#ifndef DIAG
#define DIAG 0
#endif

constexpr int LDS_SCRATCH = 159744;
constexpr int LDS_MISC = LDS_SCRATCH;
constexpr int LDS_BYTES = LDS_SCRATCH + 256;

__device__ __forceinline__ float bf2f(bf16_t h) { return __uint_as_float((unsigned)h << 16); }
__device__ __forceinline__ unsigned f2bf(float f) { unsigned u = __float_as_uint(f); return (u + 0x7fffu + ((u >> 16) & 1u)) >> 16; }
__device__ __forceinline__ unsigned pk2(float lo, float hi) { return f2bf(lo) | (f2bf(hi) << 16); }
__device__ __forceinline__ float lo16(unsigned w) { return __uint_as_float(w << 16); }
__device__ __forceinline__ float hi16(unsigned w) { return __uint_as_float(w & 0xffff0000u); }
__device__ __forceinline__ float wave_sum(float v) {
#pragma unroll
    for (int o = 1; o < 64; o <<= 1) v += __shfl_xor(v, o);
    return v;
}
#define LDS_WAIT() asm volatile("s_waitcnt lgkmcnt(0)" ::: "memory")
__device__ __forceinline__ unsigned cvt4_fp8(float a, float b, float c, float d) { int p = 0; p = __builtin_amdgcn_cvt_pk_fp8_f32(a, b, p, false); p = __builtin_amdgcn_cvt_pk_fp8_f32(c, d, p, true); return (unsigned)p; }
constexpr float WQ_SCALE = 16.f, WKV_SCALE = 8.f, WKV_INV = 1.f / 8.f;
constexpr float WSCALE = 64.f, WINV = 1.f / 64.f;
__device__ __forceinline__ int opaque(int v) { asm volatile("" : "+v"(v)); return v; }
__device__ __forceinline__ int sopaque(int v) { asm volatile("" : "+s"(v)); return v; }
__device__ __forceinline__ int tid_of(int wv) { return sopaque(wv) * 64 + opaque((int)__builtin_amdgcn_mbcnt_hi(~0u, __builtin_amdgcn_mbcnt_lo(~0u, 0u))); }

#define XB_TMO      128
#define XB_XCNT(j)  (256  + 64 * (j))
#define XB_XSUB(j)  (1280 + 64 * (j))
#define XB_XGEN(j)  (2304 + 64 * (j))
#define XB_TOP      3328
#define XB_TOPGEN   3392
#define XCD_BAR_WORDS 3456
#define XB_SPIN_CAP (1u << 20)
__device__ __forceinline__ unsigned xb_ld(unsigned* p)              { return __hip_atomic_load(p, __ATOMIC_RELAXED, __HIP_MEMORY_SCOPE_AGENT); }
__device__ __forceinline__ unsigned xb_add(unsigned* p, unsigned v) { return __hip_atomic_fetch_add(p, v, __ATOMIC_RELAXED, __HIP_MEMORY_SCOPE_AGENT); }
__device__ __forceinline__ unsigned xb_xcc_id() { return (unsigned)__builtin_amdgcn_s_getreg((3 << 11) | 20) & 0xFu; }
#define XB_SPIN(cond, bar) do { unsigned _sp = 0; while (cond) { __builtin_amdgcn_s_sleep(1); \
    if ((++_sp & 255u) == 0u) { if (xb_ld(&(bar)[XB_TMO])) break; if (_sp > XB_SPIN_CAP) { atomicAdd(&(bar)[XB_TMO], 1u); break; } } } } while (0)
struct XcdBarrier { unsigned* bar; unsigned x; volatile LAS unsigned* st; int wv; };
__device__ __forceinline__ XcdBarrier xcd_barrier_post(unsigned* bar, volatile LAS unsigned* st, int wv) {
    XcdBarrier b; b.bar = bar; b.x = xb_xcc_id(); b.st = st; b.wv = wv;
    if (tid_of(wv) == 0) (void)xb_add(&bar[XB_XCNT(b.x)], 1u);
    return b;
}
__device__ __forceinline__ void xcd_barrier_complete(unsigned* bar, unsigned x, unsigned& nloc, unsigned& nx) {
    const unsigned G = gridDim.x * gridDim.y * gridDim.z;
    unsigned sum, cnt, mine, sp = 0u;
    for (;;) {
        sum = 0u; cnt = 0u; mine = 0u;
#pragma unroll 1
        for (unsigned j = 0; j < 16; ++j) { const unsigned c = xb_ld(&bar[XB_XCNT(j)]); sum += c; cnt += (c > 0u) ? 1u : 0u; mine = (j == x) ? c : mine; }
        if (sum == G) break;
        __builtin_amdgcn_s_sleep(1);
        if ((++sp & 255u) == 0u) { if (xb_ld(&bar[XB_TMO])) break; if (sp > XB_SPIN_CAP) { atomicAdd(&bar[XB_TMO], 1u); break; } }
    }
    nloc = mine > 0u ? mine : 1u; nx = cnt > 0u ? cnt : 1u;
}
__device__ __forceinline__ void xcd_barrier(const XcdBarrier& b) {
    asm volatile("s_waitcnt vmcnt(0)" ::: "memory");
    __syncthreads();
    if (tid_of(b.wv) == 0) {
        unsigned* bar = b.bar; asm volatile("" : "+s"(bar));
        __builtin_amdgcn_s_waitcnt(0);
        unsigned nloc = b.st[0], nx = b.st[1];
        if (nloc == 0u) { xcd_barrier_complete(bar, b.x, nloc, nx); b.st[0] = nloc; b.st[1] = nx; }
        const unsigned old = xb_add(&bar[XB_XSUB(b.x)], 1u);
        const unsigned gen = old / nloc;
        if (old + 1u == (gen + 1u) * nloc) {
            __builtin_amdgcn_fence(__ATOMIC_RELEASE, "agent");
            asm volatile("s_waitcnt vmcnt(0)" ::: "memory");
            const unsigned og = xb_add(&bar[XB_TOP], 1u);
            const unsigned tg = og / nx;
            if (og + 1u == (tg + 1u) * nx) xb_add(&bar[XB_TOPGEN], 1u);
            else XB_SPIN(xb_ld(&bar[XB_TOPGEN]) == tg, bar);
            __builtin_amdgcn_fence(__ATOMIC_ACQUIRE, "agent");
            xb_add(&bar[XB_XGEN(b.x)], 1u);
            asm volatile("s_waitcnt vmcnt(0)" ::: "memory");
        } else {
            XB_SPIN(xb_ld(&bar[XB_XGEN(b.x)]) == gen, bar);
            __builtin_amdgcn_fence(__ATOMIC_ACQUIRE, "agent");
            asm volatile("s_waitcnt vmcnt(0)" ::: "memory");
        }
    }
    __syncthreads();
}

struct Args { const float* in[24]; float* out; unsigned char* ws; int ph_lo, ph_hi; int wv, pad; };
#define CAS __attribute__((address_space(4)))
__device__ __forceinline__ Args load_args() { auto p = __builtin_amdgcn_kernarg_segment_ptr(); asm volatile("" : "+s"(p)); Args r; __builtin_memcpy(&r, p, sizeof(Args)); return r; }
enum { I_X = 0, I_C, I_CTX, I_CCTX, I_GATTN, I_GFFN, I_WADA, I_BADA, I_WIN, I_GQL, I_WQUP, I_GQH, I_GKVL, I_WKVUP, I_GKH, I_DECAY, I_GRET, I_WOUT,
       I_WR, I_BR, I_W1, I_B1, I_W2, I_B2 };

template <int MT, int NT, bool SWAP>
__device__ __forceinline__ void mma_ll(f32x4 (&acc)[MT][NT], const LAS bf16_t* sA, int lda, int m0, const LAS bf16_t* sB, int ldb, int n0, int K, int lane) {
    const int fr = lane & 15, fq = lane >> 4;
    for (int k = 0; k < K; k += 32) {
        bf16x8 a[MT], b[NT];
#pragma unroll
        for (int i = 0; i < MT; ++i) a[i] = *(const LAS bf16x8*)(sA + (m0 + 16 * i + fr) * lda + k + 8 * fq);
#pragma unroll
        for (int j = 0; j < NT; ++j) b[j] = *(const LAS bf16x8*)(sB + (n0 + 16 * j + fr) * ldb + k + 8 * fq);
#pragma unroll
        for (int i = 0; i < MT; ++i)
#pragma unroll
            for (int j = 0; j < NT; ++j)
                acc[i][j] = SWAP ? __builtin_amdgcn_mfma_f32_16x16x32_bf16(b[j], a[i], acc[i][j], 0, 0, 0) : __builtin_amdgcn_mfma_f32_16x16x32_bf16(a[i], b[j], acc[i][j], 0, 0, 0);
    }
}
template <int MT, int NT, bool SWAP>
__device__ __forceinline__ void mma_lg(f32x4 (&acc)[MT][NT], const LAS bf16_t* sA, int lda, int m0, const bf16_t* gB, int ldb, int n0, int K, int lane) {
    const int fr = lane & 15, fq = lane >> 4;
#pragma unroll 2
    for (int k = 0; k < K; k += 32) {
        bf16x8 a[MT], b[NT];
#pragma unroll
        for (int j = 0; j < NT; ++j) b[j] = *(const GAS bf16x8*)(gB + (size_t)(n0 + 16 * j + fr) * ldb + k + 8 * fq);
#pragma unroll
        for (int i = 0; i < MT; ++i) a[i] = *(const LAS bf16x8*)(sA + (m0 + 16 * i + fr) * lda + k + 8 * fq);
#pragma unroll
        for (int i = 0; i < MT; ++i)
#pragma unroll
            for (int j = 0; j < NT; ++j)
                acc[i][j] = SWAP ? __builtin_amdgcn_mfma_f32_16x16x32_bf16(b[j], a[i], acc[i][j], 0, 0, 0) : __builtin_amdgcn_mfma_f32_16x16x32_bf16(a[i], b[j], acc[i][j], 0, 0, 0);
    }
}

__device__ __forceinline__ void phase_mod(const Args& a, LAS unsigned char* lds) {
    const int tid = tid_of(a.wv), lane = tid & 63, wave = tid >> 6;
    LAS float* sv = (LAS float*)lds;
    LAS float* red = sv + 5 * 1024;
    float* mod = (float*)(a.ws + WS_MOD);
    for (int i = tid; i < 5 * 1024; i += 512) { const float v = (i < 4096) ? a.in[I_C][i] : a.in[I_CCTX][i - 4096]; sv[i] = v / (1.f + __expf(-v)); }
    __syncthreads();
    const float* W = a.in[I_WADA]; const float* bb = a.in[I_BADA];
    for (int u = blockIdx.x; u < 96; u += gridDim.x) {
        const int col = u * 64 + lane;
        float acc[5] = {0.f, 0.f, 0.f, 0.f, 0.f};
        for (int k = wave * 128; k < wave * 128 + 128; ++k) {
            const float w = W[(size_t)k * 6144 + col];
#pragma unroll
            for (int v = 0; v < 5; ++v) acc[v] += sv[v * 1024 + k] * w;
        }
#pragma unroll
        for (int v = 0; v < 5; ++v) red[(wave * 5 + v) * 64 + lane] = acc[v];
        __syncthreads();
        if (tid < 320) { const int v = tid >> 6; float s = bb[u * 64 + lane];
#pragma unroll
            for (int w = 0; w < 8; ++w) s += red[(w * 5 + v) * 64 + lane];
            mod[v * 6144 + u * 64 + lane] = s; }
        __syncthreads();
    }
    const int gt = blockIdx.x * 512 + tid;
    if (gt < 192 * 8) { const int pi = gt >> 3, f = gt & 7; const float pos = (float)(pi < 128 ? pi : pi - 128);
        const float inv = exp2f(-(float)f * (13.287712379549449f / 8.f)); const float rev = pos * inv * 0.15915494309189535f;
        float* tm = (float*)(a.ws + WS_TABM); tm[gt * 2] = __builtin_amdgcn_cosf(rev); tm[gt * 2 + 1] = __builtin_amdgcn_sinf(rev); }
    else if (gt < 192 * 8 + 192 * 16) { const int g2 = gt - 192 * 8; const int pi = g2 >> 4, f = g2 & 15; const float pos = (float)(pi < 128 ? pi : pi - 128);
        const float inv = exp2f(-(float)f * (13.287712379549449f / 16.f)); const float rev = pos * inv * 0.15915494309189535f;
        float* tr = (float*)(a.ws + WS_TABR); tr[g2 * 2] = __builtin_amdgcn_cosf(rev); tr[g2 * 2 + 1] = __builtin_amdgcn_sinf(rev); }
}

__device__ __forceinline__ void transpose_item(const float* W, int K, int N, bf16_t* WT, LAS float* scr, int item, int lane) {
    const int nblk = N / 32, kb = item / nblk, nb = item % nblk, k0 = 64 * kb, n0 = 32 * nb;
    float wv_[32];
#pragma unroll
    for (int i = 0; i < 32; ++i) { const int kk = 2 * i + (lane >> 5); wv_[i] = W[(size_t)(k0 + kk) * N + n0 + (lane & 31)]; }
#pragma unroll
    for (int i = 0; i < 32; ++i) { const int kk = 2 * i + (lane >> 5); scr[kk * 33 + (lane & 31)] = wv_[i]; }
    LDS_WAIT();
    const int c = lane & 7;
#pragma unroll
    for (int j = 0; j < 4; ++j) { const int n = (lane >> 3) + 8 * j; const LAS float* s = scr + (8 * c) * 33 + n;
        u32x4 o; o.x = pk2(s[0 * 33], s[1 * 33]); o.y = pk2(s[2 * 33], s[3 * 33]); o.z = pk2(s[4 * 33], s[5 * 33]); o.w = pk2(s[6 * 33], s[7 * 33]);
        *(GAS u32x4*)(WT + (size_t)(n0 + n) * K + k0 + 8 * c) = o; }
    LDS_WAIT();
}
__device__ __forceinline__ void transpose_item8(const float* W, int K, int N, unsigned char* WT, float sc, LAS float* scr, int item, int lane) {
    const int nblk = N / 32, kb = item / nblk, nb = item % nblk, k0 = 64 * kb, n0 = 32 * nb;
    float wv_[32];
#pragma unroll
    for (int i = 0; i < 32; ++i) { const int kk = 2 * i + (lane >> 5); wv_[i] = W[(size_t)(k0 + kk) * N + n0 + (lane & 31)]; }
#pragma unroll
    for (int i = 0; i < 32; ++i) { const int kk = 2 * i + (lane >> 5); scr[kk * 33 + (lane & 31)] = wv_[i]; }
    LDS_WAIT();
    const int c = lane & 7;
#pragma unroll
    for (int j = 0; j < 4; ++j) { const int n = (lane >> 3) + 8 * j; const LAS float* s = scr + (8 * c) * 33 + n;
        u32x2 o; o.x = cvt4_fp8(s[0 * 33] * sc, s[1 * 33] * sc, s[2 * 33] * sc, s[3 * 33] * sc); o.y = cvt4_fp8(s[4 * 33] * sc, s[5 * 33] * sc, s[6 * 33] * sc, s[7 * 33] * sc);
        *(GAS u32x2*)(WT + (size_t)(n0 + n) * K + k0 + 8 * c) = o; }
    LDS_WAIT();
}
__device__ __forceinline__ void phase_prep(const Args& a, LAS unsigned char* lds) {
    const int tid = tid_of(a.wv), lane = tid & 63, wave = tid >> 6;
    LAS float* scr = (LAS float*)(lds + wave * 16384);
    const int gw = blockIdx.x * 8 + wave, NGW = gridDim.x * 8;
    constexpr int I_IN = 16 * 61, I_QU = 4 * 24, I_KVU = 2 * 32, I_O = 16 * 32, I_1 = 16 * 64, I_2 = 16 * 32;
    constexpr int NITEMS = I_IN + I_QU + I_KVU + I_O + 32 * I_1 + 32 * I_2;
    const int nitems = gridDim.x == 256 ? I_IN + I_QU + I_KVU + I_O : NITEMS;
    for (int it = gw; it < nitems; it += NGW) {
        int r = it;
        if (r < I_IN) { transpose_item(a.in[I_WIN], 1024, DIN, (bf16_t*)(a.ws + WS_WIN), scr, r, lane); continue; } r -= I_IN;
        if (r < I_QU) { transpose_item8(a.in[I_WQUP], 256, 768, a.ws + WS_WQ, WQ_SCALE, scr, r, lane); continue; } r -= I_QU;
        if (r < I_KVU) { transpose_item8(a.in[I_WKVUP], 128, 1024, a.ws + WS_WKV, WKV_SCALE, scr, r, lane); continue; } r -= I_KVU;
        if (r < I_O) { transpose_item(a.in[I_WOUT], 1024, 1024, (bf16_t*)(a.ws + WS_WO), scr, r, lane); continue; } r -= I_O;
        if (r < 32 * I_1) { const int e = r / I_1; transpose_item8(a.in[I_W1] + (size_t)e * 1024 * 2048, 1024, 2048, a.ws + WS_W1 + (size_t)e * 2048 * 1024, WSCALE, scr, r % I_1, lane); continue; } r -= 32 * I_1;
        { const int e = r / I_2; transpose_item8(a.in[I_W2] + (size_t)e * 1024 * 1024, 1024, 1024, a.ws + WS_W2 + (size_t)e * 1024 * 1024, WSCALE, scr, r % I_2, lane); }
    }
    const int gt = blockIdx.x * 512 + tid, NGT = gridDim.x * 512;
    for (int i = gt; i < 96 * 1024 / 8; i += NGT) *(GAS u32x4*)((bf16_t*)(a.ws + WS_WIN) + (size_t)DIN * 1024 + (size_t)i * 8) = (u32x4){0u, 0u, 0u, 0u};
    for (int i = gt; i < 32 * 1024; i += NGT) { const int n = i >> 10, k = i & 1023; const float w = a.in[I_WR][k * 32 + n]; const unsigned h = f2bf(w);
        bf16_t* wr = (bf16_t*)(a.ws + WS_WR); wr[i] = (bf16_t)h; wr[32768 + i] = (bf16_t)f2bf(w - bf2f((bf16_t)h)); }
    {
        float* prm = (float*)(a.ws + WS_PRM);
        for (int i = gt; i < PRM_END; i += NGT) {
            float v;
            if (i < PRM_GKVL) v = a.in[I_GQL][i - PRM_GQL]; else if (i < PRM_GQH) v = a.in[I_GKVL][i - PRM_GKVL]; else if (i < PRM_GKH) v = a.in[I_GQH][i - PRM_GQH];
            else if (i < PRM_DECAY) v = a.in[I_GKH][i - PRM_GKH]; else if (i < PRM_GRET) v = a.in[I_DECAY][i - PRM_DECAY]; else if (i < PRM_BR) v = a.in[I_GRET][i - PRM_GRET];
            else if (i < PRM_GFFN) v = a.in[I_BR][i - PRM_BR]; else if (i < PRM_B1) v = a.in[I_GFFN][i - PRM_GFFN]; else if (i < PRM_B2) v = a.in[I_B1][i - PRM_B1]; else v = a.in[I_B2][i - PRM_B2];
            prm[i] = v;
        }
    }
    const float* mod = (const float*)(a.ws + WS_MOD); const float* g = a.in[I_GATTN];
    for (int m = gw; m < TA; m += NGW) {
        const float* xr; int mv;
        if (m < T) { xr = a.in[I_X] + (size_t)m * DM; mv = m >> 13; } else { xr = a.in[I_CTX] + (size_t)(m - T) * DM; mv = 4; }
        const float* sh = mod + mv * 6144; const float* sc = sh + 1024;
        f32x4 v[4]; float ss = 0.f;
#pragma unroll
        for (int j = 0; j < 4; ++j) { v[j] = *(const GAS f32x4*)(xr + j * 256 + lane * 4); ss += (v[j].x * v[j].x + v[j].y * v[j].y) + (v[j].z * v[j].z + v[j].w * v[j].w); }
        const float rstd = rsqrtf(wave_sum(ss) * (1.f / DM) + EPS);
        bf16_t* hr = (bf16_t*)(a.ws + WS_H) + (size_t)m * DM;
#pragma unroll
        for (int j = 0; j < 4; ++j) { const int c = j * 256 + lane * 4; const f32x4 gg = *(const GAS f32x4*)(g + c), s1 = *(const GAS f32x4*)(sc + c), s0 = *(const GAS f32x4*)(sh + c);
            const f32x4 o = (v[j] * rstd * gg) * (s1 + 1.f) + s0; u32x2 w; w.x = pk2(o.x, o.y); w.y = pk2(o.z, o.w); *(GAS u32x2*)(hr + c) = w; }
    }
}

#define MOE_ITEM(it_, P_, D_, N_) do { constexpr int I_1 = 16 * 64, I_2 = 16 * 32; \
    const bool up_ = (it_) < 32 * I_1; const int r_ = up_ ? (it_) : (it_) - 32 * I_1; N_ = up_ ? 2048 : 1024; const int per_ = up_ ? I_1 : I_2, e_ = r_ / per_, item_ = r_ % per_; \
    const int nblk_ = N_ / 32, kb_ = item_ / nblk_, nb_ = item_ % nblk_, k0_ = 64 * kb_, n0_ = 32 * nb_; \
    P_ = (up_ ? a.in[I_W1] : a.in[I_W2]) + (size_t)e_ * 1024 * N_ + (size_t)(k0_ + (lane >> 5)) * N_ + n0_ + (lane & 31); \
    D_ = a.ws + (up_ ? WS_W1 : WS_W2) + (size_t)e_ * N_ * 1024 + (size_t)n0_ * 1024 + k0_; } while (0)
__device__ __forceinline__ void moe_convert(const Args& a, LAS unsigned char* lds, int cu) {
    const int tid = tid_of(a.wv), lane = tid & 63, wave = tid >> 6;
    LAS float* scr = (LAS float*)(lds + wave * 16384);
    constexpr int NIT = 32 * (16 * 64 + 16 * 32);
    __syncthreads();
    float wc[32], wn[32];
    int it = cu * 8 + wave;
    const float* pc; unsigned char* dc; int nc;
    MOE_ITEM(it, pc, dc, nc);
#pragma unroll
    for (int i = 0; i < 32; ++i) wc[i] = pc[(size_t)(2 * i) * nc];
#pragma unroll 1
    while (it < NIT) {
        const int itn = it + 256 * 8; const bool more = itn < NIT;
        const float* pn; unsigned char* dn; int nn; const int itx = more ? itn : it;
        MOE_ITEM(itx, pn, dn, nn);
        if (more) {
#pragma unroll
            for (int i = 0; i < 32; ++i) wn[i] = pn[(size_t)(2 * i) * nn]; }
#pragma unroll
        for (int i = 0; i < 32; ++i) { const int kk = 2 * i + (lane >> 5); scr[kk * 33 + (lane & 31)] = wc[i]; }
        LDS_WAIT();
        const int c = lane & 7;
#pragma unroll
        for (int j = 0; j < 4; ++j) { const int n = (lane >> 3) + 8 * j; const LAS float* s_ = scr + (8 * c) * 33 + n;
            u32x2 o; o.x = cvt4_fp8(s_[0 * 33] * WSCALE, s_[1 * 33] * WSCALE, s_[2 * 33] * WSCALE, s_[3 * 33] * WSCALE); o.y = cvt4_fp8(s_[4 * 33] * WSCALE, s_[5 * 33] * WSCALE, s_[6 * 33] * WSCALE, s_[7 * 33] * WSCALE);
            *(GAS u32x2*)(dc + (size_t)n * 1024 + 8 * c) = o; }
        LDS_WAIT();
#pragma unroll
        for (int i = 0; i < 32; ++i) wc[i] = wn[i];
        dc = dn; it = itn;
    }
    __syncthreads();
}
#undef MOE_ITEM

struct GUnit { const bf16_t* Bt; int m0, n0, nvalid, e; };
template <class RowFn, class Epi>
__device__ __forceinline__ void gemm_tile(LAS unsigned char* lds, const bf16_t* A, int K, const GUnit& u, const RowFn& rowfn, const Epi& epi) {
    LAS bf16_t* sA = (LAS bf16_t*)lds;
    LAS bf16_t* sB = (LAS bf16_t*)(lds + 256 * 72 * 2);
    const int tid = opaque((int)threadIdx.x), lane = tid & 63, wave = tid >> 6, wm = wave >> 1, wn = wave & 1;
    const int ch = tid & 7, r0 = tid >> 3;
    const bf16_t* ap[4]; const bf16_t* bp[2];
#pragma unroll
    for (int i = 0; i < 4; ++i) { const int r = r0 + 64 * i; const int rr = r < u.nvalid ? r : 0; ap[i] = A + (size_t)rowfn(u, rr) * K + ch * 8; }
#pragma unroll
    for (int i = 0; i < 2; ++i) bp[i] = u.Bt + (size_t)(r0 + 64 * i) * K + ch * 8;
    f32x4 acc[4][4];
#pragma unroll
    for (int i = 0; i < 4; ++i)
#pragma unroll
        for (int j = 0; j < 4; ++j) acc[i][j] = (f32x4){0.f, 0.f, 0.f, 0.f};
    u32x4 ra[4], rb[2];
#pragma unroll
    for (int i = 0; i < 4; ++i) ra[i] = *(const GAS u32x4*)(ap[i]);
#pragma unroll
    for (int i = 0; i < 2; ++i) rb[i] = *(const GAS u32x4*)(bp[i]);
    const int nk = K / 64;
    for (int kt = 0; kt < nk; ++kt) {
        __syncthreads();
#pragma unroll
        for (int i = 0; i < 4; ++i) *(LAS u32x4*)(sA + (r0 + 64 * i) * 72 + ch * 8) = ra[i];
#pragma unroll
        for (int i = 0; i < 2; ++i) *(LAS u32x4*)(sB + (r0 + 64 * i) * 72 + ch * 8) = rb[i];
        __syncthreads();
        if (kt + 1 < nk) {
#pragma unroll
            for (int i = 0; i < 4; ++i) ra[i] = *(const GAS u32x4*)(ap[i] + (kt + 1) * 64);
#pragma unroll
            for (int i = 0; i < 2; ++i) rb[i] = *(const GAS u32x4*)(bp[i] + (kt + 1) * 64);
        }
        mma_ll<4, 4, true>(acc, sA, 72, wm * 64, sB, 72, wn * 64, 64, lane);
    }
    epi(acc, u, wm, wn, lane);
}
struct RowDense { __device__ __forceinline__ int operator()(const GUnit& u, int r) const { return u.m0 + r; } };
struct RowPairTok { const unsigned* list; __device__ __forceinline__ int operator()(const GUnit& u, int r) const { return (int)(list[(size_t)u.e * 32768 + u.m0 + r] >> 2); } };
struct RowPair { const unsigned* list; __device__ __forceinline__ int operator()(const GUnit& u, int r) const { return (int)list[(size_t)u.e * 32768 + u.m0 + r]; } };

struct EpiP { bf16_t* P;
    __device__ __forceinline__ void operator()(const f32x4 (&acc)[4][4], const GUnit& u, int wm, int wn, int lane) const {
        const int fr = lane & 15, fq = lane >> 4;
#pragma unroll
        for (int i = 0; i < 4; ++i) { const int row = u.m0 + wm * 64 + 16 * i + fr;
#pragma unroll
            for (int j = 0; j < 4; ++j) { const int col = u.n0 + wn * 64 + 16 * j + 4 * fq; u32x2 w; w.x = pk2(acc[i][j][0], acc[i][j][1]); w.y = pk2(acc[i][j][2], acc[i][j][3]);
                *(GAS u32x2*)(P + (size_t)row * DINP + col) = w; } }
    } };
struct EpiOut { const float* x; const float* mod; float* out;
    __device__ __forceinline__ void operator()(const f32x4 (&acc)[4][4], const GUnit& u, int wm, int wn, int lane) const {
        const int fr = lane & 15, fq = lane >> 4;
#pragma unroll
        for (int i = 0; i < 4; ++i) { const int row = u.m0 + wm * 64 + 16 * i + fr; const float* gate = mod + (row >> 13) * 6144 + 2 * 1024;
#pragma unroll
            for (int j = 0; j < 4; ++j) { const int col = u.n0 + wn * 64 + 16 * j + 4 * fq;
                const f32x4 xv = *(const GAS f32x4*)(x + (size_t)row * DM + col), gv = *(const GAS f32x4*)(gate + col);
                *(GAS f32x4*)(out + (size_t)row * DM + col) = xv + gv * acc[i][j]; } }
    } };
struct EpiM1 { const unsigned* list; const float* b1; bf16_t* act;
    __device__ __forceinline__ void operator()(const f32x4 (&acc)[4][4], const GUnit& u, int wm, int wn, int lane) const {
        const int fr = lane & 15, fq = lane >> 4;
#pragma unroll
        for (int i = 0; i < 4; ++i) { const int r = wm * 64 + 16 * i + fr; if (r >= u.nvalid) continue;
            const unsigned pair = list[(size_t)u.e * 32768 + u.m0 + r];
#pragma unroll
            for (int j = 0; j < 4; ++j) { const int col = u.n0 + wn * 64 + 16 * j + 4 * fq; const f32x4 bv = *(const GAS f32x4*)(b1 + (size_t)u.e * 2048 + col);
                const f32x4 v = acc[i][j] + bv;
                const float g0 = fminf(v[0], 7.f), l0 = fminf(fmaxf(v[1], -7.f), 7.f), g1 = fminf(v[2], 7.f), l1 = fminf(fmaxf(v[3], -7.f), 7.f);
                const float a0 = g0 / (1.f + __expf(-1.702f * g0)) * (l0 + 1.f), a1 = g1 / (1.f + __expf(-1.702f * g1)) * (l1 + 1.f);
                *(GAS unsigned*)(act + (size_t)pair * DFF + (col >> 1)) = pk2(a0, a1); } }
    } };
struct EpiM2 { const unsigned* list; const float* b2; const float* pg; bf16_t* y;
    __device__ __forceinline__ void operator()(const f32x4 (&acc)[4][4], const GUnit& u, int wm, int wn, int lane) const {
        const int fr = lane & 15, fq = lane >> 4;
#pragma unroll
        for (int i = 0; i < 4; ++i) { const int r = wm * 64 + 16 * i + fr; if (r >= u.nvalid) continue;
            const unsigned pair = list[(size_t)u.e * 32768 + u.m0 + r]; const float g = pg[pair];
#pragma unroll
            for (int j = 0; j < 4; ++j) { const int col = u.n0 + wn * 64 + 16 * j + 4 * fq; const f32x4 bv = *(const GAS f32x4*)(b2 + (size_t)u.e * 1024 + col);
                const f32x4 v = (acc[i][j] + bv) * g; u32x2 w; w.x = pk2(v[0], v[1]); w.y = pk2(v[2], v[3]);
                *(GAS u32x2*)(y + (size_t)pair * DM + col) = w; } }
    } };

namespace pg8 {
constexpr int BM = 256, BK = 64, HALF = 128, HTB = HALF * BK * 2, STAGE_BYTES = 8 * HTB, NXCD = 8, WGM = 8;
__host__ __device__ __forceinline__ int lds_byte(int r, int c) { const int st = (r >> 4) * 2 + (c >> 5), rr = r & 15, cc = c & 31, ob = rr * 64 + cc * 2; return st * 1024 + (ob ^ (((ob >> 9) & 1) << 5)); }
__host__ __device__ __forceinline__ void stage_rc(int b, int& R, int& C) { const int st = b / 1024, sb = b % 1024, swz = sb ^ (((sb >> 9) & 1) << 5); R = (st >> 1) * 16 + swz / 64; C = (st & 1) * 32 + (swz % 64) / 2; }
__host__ __device__ __forceinline__ int perm32(int rho) { const int n = rho >> 4, i = rho & 15; return 8 * (i >> 2) + 4 * n + (i & 3); }
struct Unit { int pm, pn; const char* A; const char* B; int e, nvalid, ul; };
struct DenseOrder {
    int nM, nN, nwg, G, c; const char* A; const char* B; size_t tstep;
    __device__ void init(const void* A_, const void* B_, int M, int N, int K, int G_, int c_) { nM = M / BM; nN = N / BM; nwg = nM * nN; G = G_; c = c_; A = (const char*)A_; B = (const char*)B_; tstep = (size_t)BM * K * 2; }
    __device__ bool next(int i, Unit& u) const {
        const long L = (long)i * G + c; if (L >= nwg) return false;
        int wgid = (int)L; { const int q = nwg / NXCD, r = nwg % NXCD, xcd = wgid % NXCD, off = wgid / NXCD; wgid = (xcd < r ? xcd * (q + 1) : r * (q + 1) + (xcd - r) * q) + off; }
        const int nig = WGM * nN, gid = wgid / nig, fm = gid * WGM, gsz = (nM - fm) < WGM ? (nM - fm) : WGM;
        u.pm = fm + ((wgid % nig) % gsz); u.pn = (wgid % nig) / gsz; u.A = A + (size_t)u.pm * tstep; u.B = B + (size_t)u.pn * tstep; u.e = 0; u.nvalid = 256; u.ul = 0; return true;
    }
};
template <int NCT> struct ExpertOrder {
    const LAS int* pre; int G, c; const char* A; const char* W; size_t wstride; int rowbytes;
    __device__ bool next(int i, Unit& u) const {
        const int L = i * G + c; const int nunit = pre[32] * NCT; if (L >= nunit) return false;
        const int ti = L / NCT; u.pn = L % NCT; int e = 0;
        for (int k = 1; k < 32; ++k) if (pre[k] <= ti) e = k;
        u.pm = ti - pre[e]; u.e = e; const int cnt = pre[33 + e]; u.nvalid = (cnt - u.pm * 256) < 256 ? (cnt - u.pm * 256) : 256; u.ul = i;
        u.A = A; u.B = W + (size_t)e * wstride + (size_t)u.pn * 256 * rowbytes; return true;
    }
};
__device__ __forceinline__ unsigned cvt_pk_bf16(float lo, float hi) { unsigned r; asm volatile("v_cvt_pk_bf16_f32 %0, %1, %2" : "=v"(r) : "v"(lo), "v"(hi)); return r; }
typedef int i32x4 __attribute__((ext_vector_type(4))); typedef int i32x8 __attribute__((ext_vector_type(8)));
__device__ __forceinline__ bf16x8 lo8(i32x8 v) { return __builtin_bit_cast(bf16x8, (i32x4)__builtin_shufflevector(v, v, 0, 1, 2, 3)); }
__device__ __forceinline__ bf16x8 hi8(i32x8 v) { return __builtin_bit_cast(bf16x8, (i32x4)__builtin_shufflevector(v, v, 4, 5, 6, 7)); }

template <class Epi, class Sched, bool GATHER, bool FP8 = false>
__device__ __forceinline__ void gemm_phase(LAS unsigned char* lds, const LAS int* tab, const LAS bf16_t* aux, int ashift, int K, const Sched& S, const Epi& E, int wv) {
    const int tid = tid_of(wv), wid = wv, lane = tid & 63, wr = wid >> 2, wc = wid & 3, fr = lane & 15, fq = lane >> 4;
    const int nt = K / BK;
    unsigned voffA[2], voffB[2]; unsigned cb0 = 0; int rg0 = 0;
#pragma unroll
    for (int i = 0; i < 2; ++i) { int R, C; stage_rc(tid * 16 + i * 8192, R, C); const int Rb = (R & ~31) + perm32(R & 31);
        voffA[i] = (unsigned)(R * K + C) * 2u; voffB[i] = (unsigned)(Rb * K + C) * 2u; if (i == 0) { cb0 = (unsigned)C * 2u; rg0 = R; } }
    const size_t kstep = (size_t)(BK * 2);
    const size_t hstep = (size_t)HALF * K * 2;
    const size_t hstepA = GATHER ? 0 : hstep;
    const unsigned ldsw = (unsigned)wid * 1024u;
    const int aoff = lds_byte(wr * 64 + fr, fq * 8), boff = lds_byte(wc * 32 + fr, fq * 8);
    int cul = 0, nul = 0;
#define PG8_SA(b, h) (((b) * 2 + (h)) * HTB)
#define PG8_SB(b, h) ((4 + (b) * 2 + (h)) * HTB)
#define PG8_STAGE(bufoff, gbase, voff) do { _Pragma("unroll") for (int _i = 0; _i < 2; ++_i) \
        __builtin_amdgcn_global_load_lds((const unsigned*)((const char*)(gbase) + (voff)[_i]), (LAS unsigned*)(lds + (bufoff) + ldsw + _i * 8192), 16, 0, 0); } while (0)
#define PG8_STAGE_A(bufoff, gbase, h, usenext) do { const int ulx_ = (usenext) ? nul : cul; _Pragma("unroll") for (int _i = 0; _i < 2; ++_i) { \
        unsigned vo_; if constexpr (GATHER) vo_ = (unsigned)(tab[ulx_ * 256 + (h) * 128 + rg0 + 64 * _i] >> ashift) * (unsigned)(K * 2) + cb0; else vo_ = voffA[_i]; \
        __builtin_amdgcn_global_load_lds((const unsigned*)((const char*)(gbase) + (h) * hstepA + vo_), (LAS unsigned*)(lds + (bufoff) + ldsw + _i * 8192), 16, 0, 0); } } while (0)
#define PG8_LDA(dst, b, h) do { _Pragma("unroll") for (int m = 0; m < 4; ++m) { const i32x4 lo_ = *(const LAS i32x4*)(lds + PG8_SA(b, h) + aoff + m * 2048), hi_ = *(const LAS i32x4*)(lds + PG8_SA(b, h) + aoff + m * 2048 + 1024); \
        dst[m] = __builtin_shufflevector(lo_, hi_, 0, 1, 2, 3, 4, 5, 6, 7); } } while (0)
#define PG8_LDB(dst, b, h) do { _Pragma("unroll") for (int n = 0; n < 2; ++n) { const i32x4 lo_ = *(const LAS i32x4*)(lds + PG8_SB(b, h) + boff + n * 2048), hi_ = *(const LAS i32x4*)(lds + PG8_SB(b, h) + boff + n * 2048 + 1024); \
        dst[n] = __builtin_shufflevector(lo_, hi_, 0, 1, 2, 3, 4, 5, 6, 7); } } while (0)
#define PG8_MMA(ai, bj, At, Bt) do { __builtin_amdgcn_s_setprio(1); _Pragma("unroll") for (int m = 0; m < 4; ++m) _Pragma("unroll") for (int n = 0; n < 2; ++n) { \
        if constexpr (FP8) { asm("v_mfma_f32_16x16x128_f8f6f4 %0, %1, %2, %0" : "+v"(acc[ai][bj][m][n]) : "v"(Bt[n]), "v"(At[m])); } \
        else { acc[ai][bj][m][n] = __builtin_amdgcn_mfma_f32_16x16x32_bf16(lo8(Bt[n]), lo8(At[m]), acc[ai][bj][m][n], 0, 0, 0); \
               acc[ai][bj][m][n] = __builtin_amdgcn_mfma_f32_16x16x32_bf16(hi8(Bt[n]), hi8(At[m]), acc[ai][bj][m][n], 0, 0, 0); } } \
        __builtin_amdgcn_s_setprio(0); } while (0)
#define PG8_WAIT_V(n) asm volatile("s_waitcnt vmcnt(" #n ")" ::: "memory")
#define PG8_WAIT_L(n) asm volatile("s_waitcnt lgkmcnt(" #n ")" ::: "memory")
#define PG8_BAR __builtin_amdgcn_s_barrier()
#define PG8_SCHED __builtin_amdgcn_sched_barrier(0)
    Unit cur, nxt; int ui = 0;
    if (!S.next(0, cur)) return;
    cul = cur.ul; nul = cur.ul;
    f32x4 acc[2][2][4][2];
#pragma unroll
    for (int a = 0; a < 2; ++a)
#pragma unroll
        for (int b = 0; b < 2; ++b)
#pragma unroll
            for (int m = 0; m < 4; ++m)
#pragma unroll
                for (int n = 0; n < 2; ++n) acc[a][b][m][n] = (f32x4){0.f, 0.f, 0.f, 0.f};
    i32x8 At[4], B0[2], B1[2];
    const char* cA = cur.A; const char* cB = cur.B;
    PG8_STAGE(PG8_SB(0, 0), cB, voffB); PG8_STAGE(PG8_SB(0, 1), cB + hstep, voffB); PG8_STAGE_A(PG8_SA(0, 0), cA, 0, false); PG8_STAGE_A(PG8_SA(0, 1), cA, 1, false);
    if (wr == 1) PG8_BAR;
    PG8_WAIT_V(2); PG8_BAR;
    PG8_STAGE(PG8_SB(1, 0), cB + kstep, voffB); PG8_STAGE_A(PG8_SA(1, 0), cA + kstep, 0, false); PG8_STAGE(PG8_SB(1, 1), cB + hstep + kstep, voffB);
    PG8_WAIT_V(6); PG8_BAR;
    for (;;) {
        const bool has_next = S.next(ui + 1, nxt);
        const char* nA = has_next ? nxt.A : cA; const char* nB = has_next ? nxt.B : cB;
        nul = has_next ? nxt.ul : cur.ul;
#pragma unroll 1
        for (int t = 0; t < nt; t += 2) {
            const bool last = (t == nt - 2);
            const char* a1 = cA + (size_t)(t + 1) * kstep;
            const char* a2 = last ? nA : cA + (size_t)(t + 2) * kstep; const char* b2 = last ? nB : cB + (size_t)(t + 2) * kstep;
            const char* a3 = a2 + kstep; const char* b3 = b2 + kstep;
            PG8_LDB(B0, 0, 0); PG8_LDB(B1, 0, 1); PG8_SCHED; PG8_LDA(At, 0, 0); PG8_STAGE_A(PG8_SA(1, 1), a1, 1, false);
            PG8_WAIT_V(8); PG8_WAIT_L(0); PG8_BAR; PG8_MMA(0, 0, At, B0); PG8_MMA(0, 1, At, B1); PG8_BAR; PG8_SCHED;
            PG8_LDA(At, 0, 1); PG8_STAGE(PG8_SB(0, 0), b2, voffB); PG8_STAGE(PG8_SB(0, 1), b2 + hstep, voffB); PG8_STAGE_A(PG8_SA(0, 0), a2, 0, last);
            PG8_WAIT_V(8); PG8_WAIT_L(0); PG8_BAR; PG8_MMA(1, 0, At, B0); PG8_MMA(1, 1, At, B1); PG8_BAR; PG8_SCHED;
            PG8_LDB(B0, 1, 0); PG8_LDB(B1, 1, 1); PG8_SCHED; PG8_LDA(At, 1, 0); PG8_STAGE_A(PG8_SA(0, 1), a2, 1, last);
            PG8_WAIT_V(8); PG8_WAIT_L(0); PG8_BAR; PG8_MMA(0, 0, At, B0); PG8_MMA(0, 1, At, B1); PG8_BAR; PG8_SCHED;
            PG8_LDA(At, 1, 1); PG8_STAGE(PG8_SB(1, 0), b3, voffB); PG8_STAGE(PG8_SB(1, 1), b3 + hstep, voffB); PG8_STAGE_A(PG8_SA(1, 0), a3, 0, last);
            PG8_WAIT_V(8); PG8_WAIT_L(0); PG8_BAR; PG8_MMA(1, 0, At, B0); PG8_MMA(1, 1, At, B1); PG8_BAR; PG8_SCHED;
        }
        if (wr == 0) PG8_BAR;
        if constexpr (FP8) asm volatile("s_nop 15\n\ts_nop 7" ::: "memory");
        E(acc, cur, tab, aux, wr, wc, fr, fq);
        if (!has_next) break;
#pragma unroll
        for (int a = 0; a < 2; ++a)
#pragma unroll
            for (int b = 0; b < 2; ++b)
#pragma unroll
                for (int m = 0; m < 4; ++m)
#pragma unroll
                    for (int n = 0; n < 2; ++n) acc[a][b][m][n] = (f32x4){0.f, 0.f, 0.f, 0.f};
        cur = nxt; cA = nA; cB = nB; ++ui;
        cul = cur.ul;
        if (wr == 1) PG8_BAR;
    }
    PG8_WAIT_V(0);
    PG8_BAR;
#undef PG8_SA
#undef PG8_SB
#undef PG8_STAGE
#undef PG8_STAGE_A
#undef PG8_LDA
#undef PG8_LDB
#undef PG8_MMA
#undef PG8_WAIT_V
#undef PG8_WAIT_L
#undef PG8_BAR
#undef PG8_SCHED
}

struct EpiP { bf16_t* P;
    __device__ __forceinline__ void operator()(const f32x4 (&acc)[2][2][4][2], const Unit& u, const LAS int*, const LAS bf16_t*, int wr, int wc, int fr, int fq) const {
        const int row0 = u.pm * BM + wr * 64 + fr, col0 = u.pn * BM + wc * 32 + 8 * fq;
#pragma unroll
        for (int ai = 0; ai < 2; ++ai)
#pragma unroll
            for (int m = 0; m < 4; ++m) { bf16_t* rowp = P + (size_t)(row0 + ai * HALF + m * 16) * DINP + col0;
#pragma unroll
                for (int bj = 0; bj < 2; ++bj) { const f32x4 v0 = acc[ai][bj][m][0], v1 = acc[ai][bj][m][1]; u32x4 w;
                    w.x = cvt_pk_bf16(v0[0], v0[1]); w.y = cvt_pk_bf16(v0[2], v0[3]); w.z = cvt_pk_bf16(v1[0], v1[1]); w.w = cvt_pk_bf16(v1[2], v1[3]);
                    *(GAS u32x4*)(rowp + bj * HALF) = w; } }
    } };
struct EpiOut { const float* x; const float* mod; float* out;
    __device__ __forceinline__ void operator()(const f32x4 (&acc)[2][2][4][2], const Unit& u, const LAS int*, const LAS bf16_t*, int wr, int wc, int fr, int fq) const {
        const int row0 = u.pm * BM + wr * 64 + fr, col0 = u.pn * BM + wc * 32 + 8 * fq;
        const float* gate = mod + (row0 >> 13) * 6144 + 2 * 1024;
#pragma unroll
        for (int bj = 0; bj < 2; ++bj) { const f32x4 g0 = *(const GAS f32x4*)(gate + col0 + bj * HALF), g1 = *(const GAS f32x4*)(gate + col0 + bj * HALF + 4);
#pragma unroll
            for (int ai = 0; ai < 2; ++ai)
#pragma unroll
                for (int m = 0; m < 4; ++m) { const size_t off = (size_t)(row0 + ai * HALF + m * 16) * DM + col0 + bj * HALF;
                    const f32x4 x0 = *(const GAS f32x4*)(x + off), x1 = *(const GAS f32x4*)(x + off + 4);
                    *(GAS f32x4*)(out + off) = x0 + g0 * acc[ai][bj][m][0]; *(GAS f32x4*)(out + off + 4) = x1 + g1 * acc[ai][bj][m][1]; } }
    } };
struct EpiM1 { unsigned char* act;
    __device__ __forceinline__ void operator()(const f32x4 (&acc)[2][2][4][2], const Unit& u, const LAS int* tab, const LAS bf16_t* aux, int wr, int wc, int fr, int fq) const {
        const int cl = wc * 32 + 8 * fq, col0 = u.pn * BM + cl;
        f32x4 bv[2][2];
#pragma unroll
        for (int bj = 0; bj < 2; ++bj) { const u32x4 w = *(const LAS u32x4*)(aux + u.ul * 256 + bj * HALF + cl);
            bv[bj][0] = (f32x4){lo16(w[0]), hi16(w[0]), lo16(w[1]), hi16(w[1])}; bv[bj][1] = (f32x4){lo16(w[2]), hi16(w[2]), lo16(w[3]), hi16(w[3])}; }
#pragma unroll
        for (int ai = 0; ai < 2; ++ai)
#pragma unroll
            for (int m = 0; m < 4; ++m) { const int r = ai * HALF + wr * 64 + m * 16 + fr; const bool ok = r < u.nvalid;
                const int pair = tab[u.ul * 256 + r]; unsigned char* rowp = act + (size_t)pair * DFF + (col0 >> 1);
#pragma unroll
                for (int bj = 0; bj < 2; ++bj) { float o[4];
#pragma unroll
                    for (int n = 0; n < 2; ++n) { const f32x4 v = acc[ai][bj][m][n] * WINV + bv[bj][n];
                        const float g0 = fminf(v[0], 7.f), l0 = fminf(fmaxf(v[1], -7.f), 7.f), g1 = fminf(v[2], 7.f), l1 = fminf(fmaxf(v[3], -7.f), 7.f);
                        o[2 * n] = g0 * __builtin_amdgcn_rcpf(1.f + __builtin_amdgcn_exp2f(-2.4554669595930156f * g0)) * (l0 + 1.f);
                        o[2 * n + 1] = g1 * __builtin_amdgcn_rcpf(1.f + __builtin_amdgcn_exp2f(-2.4554669595930156f * g1)) * (l1 + 1.f); }
                    const unsigned w = cvt4_fp8(o[0], o[1], o[2], o[3]); if (ok) *(GAS unsigned*)(rowp + bj * (HALF / 2)) = w; } }
    } };
constexpr float YSCALE = 8.f, YINV = 1.f / 8.f;
struct EpiM2 { unsigned char* y;
    __device__ __forceinline__ void operator()(const f32x4 (&acc)[2][2][4][2], const Unit& u, const LAS int* tab, const LAS bf16_t* aux, int wr, int wc, int fr, int fq) const {
        const int cl = wc * 32 + 8 * fq, col0 = u.pn * BM + cl;
        f32x4 bv[2][2];
#pragma unroll
        for (int bj = 0; bj < 2; ++bj) { const u32x4 w = *(const LAS u32x4*)(aux + u.ul * 256 + bj * HALF + cl);
            bv[bj][0] = (f32x4){lo16(w[0]), hi16(w[0]), lo16(w[1]), hi16(w[1])}; bv[bj][1] = (f32x4){lo16(w[2]), hi16(w[2]), lo16(w[3]), hi16(w[3])}; }
#pragma unroll
        for (int ai = 0; ai < 2; ++ai)
#pragma unroll
            for (int m = 0; m < 4; ++m) { const int r = ai * HALF + wr * 64 + m * 16 + fr; const bool ok = r < u.nvalid;
                const int pair = tab[u.ul * 256 + r]; const float g = bf2f(aux[9 * 256 + u.ul * 256 + r]) * YSCALE; unsigned char* rowp = y + (size_t)pair * DM + col0;
#pragma unroll
                for (int bj = 0; bj < 2; ++bj) { const f32x4 v0 = (acc[ai][bj][m][0] * WINV + bv[bj][0]) * g, v1 = (acc[ai][bj][m][1] * WINV + bv[bj][1]) * g; u32x2 w;
                    w.x = cvt4_fp8(v0[0], v0[1], v0[2], v0[3]); w.y = cvt4_fp8(v1[0], v1[1], v1[2], v1[3]);
                    if (ok) *(GAS u32x2*)(rowp + bj * HALF) = w; } }
    } };
}
constexpr int PG8_TAB_OFF = pg8::STAGE_BYTES;
constexpr int PG8_AUX_OFF = PG8_TAB_OFF + 18 * 1024;
constexpr int PG8_PRE_OFF = PG8_AUX_OFF + 9 * 1024;
static_assert(PG8_PRE_OFF + 512 <= LDS_SCRATCH, "LDS map");

template <int NCT, class Epi>
__device__ __forceinline__ void phase_moe_pg8(const Args& a, LAS unsigned char* lds, const unsigned char* A, int ashift, const unsigned char* Wt, size_t wstride, const float* bias, int nbias, const float* gates, const Epi& E) {
    LAS int* tab = (LAS int*)(lds + PG8_TAB_OFF); LAS int* pre = (LAS int*)(lds + PG8_PRE_OFF); LAS bf16_t* aux = (LAS bf16_t*)(lds + PG8_AUX_OFF);
    const unsigned* cnt = (const unsigned*)(a.ws + WS_CTL) + CW_CNT; const unsigned* list = (const unsigned*)(a.ws + WS_LIST);
    __syncthreads();
    const int tidm = tid_of(a.wv);
    if (tidm == 0) { int s = 0;
#pragma unroll 1
        for (int e = 0; e < NE; ++e) { const int c = (int)__hip_atomic_load(cnt + 64 * e, __ATOMIC_RELAXED, __HIP_MEMORY_SCOPE_AGENT); pre[e] = s; pre[33 + e] = c; s += (c + 255) >> 8; } pre[32] = s; }
    __syncthreads();
    pg8::ExpertOrder<NCT> S{pre, (int)gridDim.x, (int)blockIdx.x, (const char*)A, (const char*)Wt, wstride, 1024};
    pg8::Unit u;
    for (int i = 0; i < (gates ? 9 : 18) && S.next(i, u); ++i) {
        const unsigned* lp = list + (size_t)u.e * 32768 + u.pm * 256;
        if (tidm < 256) { const int pair = (int)lp[tidm < u.nvalid ? tidm : 0]; tab[i * 256 + tidm] = pair; if (gates) aux[9 * 256 + i * 256 + tidm] = (bf16_t)f2bf(gates[pair]); }
        else aux[i * 256 + tidm - 256] = (bf16_t)f2bf(bias[(size_t)u.e * nbias + u.pn * 256 + tidm - 256]);
    }
    __syncthreads();
    pg8::gemm_phase<Epi, pg8::ExpertOrder<NCT>, true, true>(lds, tab, aux, ashift, 512, S, E, a.wv);
}

__device__ __forceinline__ void mla_tile(const Args& a, LAS unsigned char* lds, int tile, int r0 = 0, int nrows = 128) {
    const int tid = tid_of(a.wv), lane = tid & 63, wave = a.wv, fr = lane & 15, fq = lane >> 4;
    const bool lat = tile < 256;
    const int prow0 = tile * 128;
    const int b = lat ? (prow0 >> 13) : ((prow0 - T) >> 8);
    const int tpos0 = lat ? (prow0 & 8191) : ((prow0 - T) & 255);
    const int key0 = lat ? (LC + tpos0) : tpos0;
    LAS unsigned char* Aq = lds;
    LAS unsigned char* Akv = lds + 34816;
    LAS float* kpe = (LAS float*)(lds + 34816 + 18432);
    LAS float* sspe = (LAS float*)(lds + 34816 + 18432 + 16384);
    const bf16_t* P = (const bf16_t*)(a.ws + WS_P);
    const float* tabm = (const float*)(a.ws + WS_TABM);
    __syncthreads();
    if ((tid >> 2) >= r0 && (tid >> 2) < r0 + nrows) {
        const int r = tid >> 2, part = tid & 3;
        const bf16_t* pr = P + (size_t)(prow0 + r) * DINP;
        u32x4 q[8]; float ss = 0.f;
#pragma unroll
        for (int i = 0; i < 8; ++i) { q[i] = *(const GAS u32x4*)(pr + OFF_Q + part * 64 + i * 8);
#pragma unroll
            for (int e = 0; e < 4; ++e) { const float lo = lo16(q[i][e]), hi = hi16(q[i][e]); ss += lo * lo + hi * hi; } }
        ss += __shfl_xor(ss, 1); ss += __shfl_xor(ss, 2);
        float rstd = rsqrtf(ss * (1.f / 256.f) + EPS);
        const float* gq = a.in[I_GQL] + part * 64;
#pragma unroll
        for (int i = 0; i < 8; ++i) { u32x2 o;
#pragma unroll
            for (int e = 0; e < 2; ++e) o[e] = cvt4_fp8(lo16(q[i][2 * e]) * rstd * gq[i * 8 + 4 * e], hi16(q[i][2 * e]) * rstd * gq[i * 8 + 4 * e + 1], lo16(q[i][2 * e + 1]) * rstd * gq[i * 8 + 4 * e + 2], hi16(q[i][2 * e + 1]) * rstd * gq[i * 8 + 4 * e + 3]);
            *(LAS u32x2*)(Aq + r * 272 + part * 64 + i * 8) = o; }
        u32x4 kv[4]; ss = 0.f;
#pragma unroll
        for (int i = 0; i < 4; ++i) { kv[i] = *(const GAS u32x4*)(pr + OFF_KV + part * 32 + i * 8);
#pragma unroll
            for (int e = 0; e < 4; ++e) { const float lo = lo16(kv[i][e]), hi = hi16(kv[i][e]); ss += lo * lo + hi * hi; } }
        ss += __shfl_xor(ss, 1); ss += __shfl_xor(ss, 2);
        rstd = rsqrtf(ss * (1.f / 128.f) + EPS);
        const float* gkv = a.in[I_GKVL] + part * 32;
#pragma unroll
        for (int i = 0; i < 4; ++i) { u32x2 o;
#pragma unroll
            for (int e = 0; e < 2; ++e) o[e] = cvt4_fp8(lo16(kv[i][2 * e]) * rstd * gkv[i * 8 + 4 * e], hi16(kv[i][2 * e]) * rstd * gkv[i * 8 + 4 * e + 1], lo16(kv[i][2 * e + 1]) * rstd * gkv[i * 8 + 4 * e + 2], hi16(kv[i][2 * e + 1]) * rstd * gkv[i * 8 + 4 * e + 3]);
            *(LAS u32x2*)(Akv + r * 144 + part * 32 + i * 8) = o; }
        const u32x4 pe = *(const GAS u32x4*)(pr + OFF_PE + part * 8); ss = 0.f;
#pragma unroll
        for (int e = 0; e < 4; ++e) { const float lo = lo16(pe[e]), hi = hi16(pe[e]); ss += lo * lo + hi * hi; kpe[r * 32 + part * 8 + 2 * e] = lo; kpe[r * 32 + part * 8 + 2 * e + 1] = hi; }
        ss += __shfl_xor(ss, 1); ss += __shfl_xor(ss, 2);
        if (part == 0) sspe[r] = ss;
    }
    __syncthreads();
    const int h = wave, bh = b * NH + h;
    typedef int i32x4m __attribute__((ext_vector_type(4))); typedef int i32x8m __attribute__((ext_vector_type(8)));
#define LD32G(p) __builtin_shufflevector(*(const GAS i32x4m*)(p), *(const GAS i32x4m*)((p) + 16), 0, 1, 2, 3, 4, 5, 6, 7)
#define LD32L(p) __builtin_shufflevector(*(const LAS i32x4m*)(p), *(const LAS i32x4m*)((p) + 16), 0, 1, 2, 3, 4, 5, 6, 7)
    if (lat) {
        const unsigned char* WQ = a.ws + WS_WQ + (size_t)h * QK * 256;
        const float* gqh = a.in[I_GQH];
        unsigned char* Qo = a.ws + WS_Q + ((size_t)bh * SEQ + tpos0) * QK8;
        i32x8m bq[2][6];
#pragma unroll
        for (int s2 = 0; s2 < 2; ++s2)
#pragma unroll
            for (int j = 0; j < 6; ++j) bq[s2][j] = LD32G(WQ + (size_t)(16 * j + fr) * 256 + 128 * s2 + 32 * fq);
#pragma unroll 1
        for (int rq = 0; rq < 4; ++rq) {
            f32x4 acc[2][6];
#pragma unroll
            for (int i = 0; i < 2; ++i)
#pragma unroll
                for (int j = 0; j < 6; ++j) acc[i][j] = (f32x4){0.f, 0.f, 0.f, 0.f};
#pragma unroll
            for (int s2 = 0; s2 < 2; ++s2)
#pragma unroll
                for (int i = 0; i < 2; ++i) { const i32x8m af = LD32L(Aq + (rq * 32 + 16 * i + fr) * 272 + 128 * s2 + 32 * fq);
#pragma unroll
                    for (int j = 0; j < 6; ++j) acc[i][j] = __builtin_amdgcn_mfma_scale_f32_16x16x128_f8f6f4(bq[s2][j], af, acc[i][j], 0, 0, 0, 0, 0, 0); }
#pragma unroll
            for (int i = 0; i < 2; ++i) {
                const int row = rq * 32 + 16 * i + fr, t = tpos0 + row;
                float ss = 0.f;
#pragma unroll
                for (int j = 0; j < 6; ++j) ss += (acc[i][j][0] * acc[i][j][0] + acc[i][j][1] * acc[i][j][1]) + (acc[i][j][2] * acc[i][j][2] + acc[i][j][3] * acc[i][j][3]);
                ss += __shfl_xor(ss, 16); ss += __shfl_xor(ss, 32);
                const float rstd = rsqrtf(ss * (1.f / 96.f) + EPS * (WQ_SCALE * WQ_SCALE)) * QSCALE;
#pragma unroll
                for (int j = 0; j < 6; ++j) {
                    const int col = 16 * j + 4 * fq; const f32x4 gv = *(const GAS f32x4*)(gqh + col);
                    f32x4 v = acc[i][j] * gv * rstd;
                    if (j >= 4) {
                        const int ax = j - 4, pi = ax == 0 ? (t >> 6) : 128 + (t & 63), f0 = 4 * (fq & 1);
                        const float* cs = tabm + (pi * 8 + f0) * 2;
#pragma unroll
                        for (int r = 0; r < 4; ++r) { const float other = __shfl_xor(v[r], 32); const float c = cs[2 * r], sn = cs[2 * r + 1];
                            v[r] = (fq < 2) ? (v[r] * c - other * sn) : (v[r] * c + other * sn); }
                    }
                    *(GAS unsigned*)(Qo + (size_t)row * QK8 + col) = cvt4_fp8(v[0], v[1], v[2], v[3]);
                }
                *(GAS u32x2*)(Qo + (size_t)row * QK8 + QK + 8 * fq) = (u32x2){0u, 0u};
            }
        }
    }
    {
        const unsigned char* WKV = a.ws + WS_WKV + (size_t)h * 128 * 128;
        const float* gkh = a.in[I_GKH];
        unsigned char* Ko = a.ws + WS_K + ((size_t)bh * SKV + key0) * QK8;
        unsigned char* Vo = a.ws + WS_VT + (size_t)bh * DV * SKV + key0;
        i32x8m bkv[8];
#pragma unroll
        for (int j = 0; j < 8; ++j) bkv[j] = LD32G(WKV + (size_t)(16 * j + fr) * 128 + 32 * fq);
#pragma unroll 1
        for (int rq = r0 >> 4; rq < ((r0 + nrows) >> 4); ++rq) {
            f32x4 acc[1][8];
#pragma unroll
            for (int i = 0; i < 1; ++i)
#pragma unroll
                for (int j = 0; j < 8; ++j) acc[i][j] = (f32x4){0.f, 0.f, 0.f, 0.f};
            { const i32x8m af = LD32L(Akv + (rq * 16 + fr) * 144 + 32 * fq);
#pragma unroll
              for (int j = 0; j < 8; ++j) acc[0][j] = __builtin_amdgcn_mfma_scale_f32_16x16x128_f8f6f4(bkv[j], af, acc[0][j], 0, 0, 0, 0, 0, 0) ; }
#pragma unroll
            for (int j = 0; j < 8; ++j) acc[0][j] = acc[0][j] * WKV_INV;
#pragma unroll
            for (int i = 0; i < 1; ++i) {
                const int row = rq * 16 + 16 * i + fr, t = tpos0 + row;
                const int kk = row & 63; const int vrow = (row & 64) + 32 * ((kk >> 2) & 1) + (kk & 3) + 4 * ((kk & 31) >> 3) + 16 * (kk >> 5);
                float ss = 0.f;
#pragma unroll
                for (int j = 0; j < 4; ++j) ss += (acc[i][j][0] * acc[i][j][0] + acc[i][j][1] * acc[i][j][1]) + (acc[i][j][2] * acc[i][j][2] + acc[i][j][3] * acc[i][j][3]);
                ss += __shfl_xor(ss, 16); ss += __shfl_xor(ss, 32);
                const float rstd = rsqrtf((ss + sspe[row]) * (1.f / 96.f) + EPS);
#pragma unroll
                for (int j = 0; j < 4; ++j) { const int col = 16 * j + 4 * fq; const f32x4 gv = *(const GAS f32x4*)(gkh + col); const f32x4 v = acc[i][j] * gv * rstd;
                    *(GAS unsigned*)(Ko + (size_t)row * QK8 + col) = cvt4_fp8(v[0], v[1], v[2], v[3]); }
                {
                    const int ax = fq >> 1, f0 = 4 * (fq & 1), pi = ax == 0 ? (t >> 6) : 128 + (t & 63);
                    const float* cs = tabm + (pi * 8 + f0) * 2;
                    float o0[4], o1[4];
#pragma unroll
                    for (int r = 0; r < 4; ++r) { const int c0 = ax * 16 + f0 + r, c1 = c0 + 8;
                        const float x0 = kpe[row * 32 + c0] * rstd * gkh[64 + c0], x1 = kpe[row * 32 + c1] * rstd * gkh[64 + c1];
                        const float c = lat ? cs[2 * r] : 1.f, s = lat ? cs[2 * r + 1] : 0.f;
                        o0[r] = x0 * c - x1 * s; o1[r] = x1 * c + x0 * s; }
                    *(GAS unsigned*)(Ko + (size_t)row * QK8 + 64 + ax * 16 + f0) = cvt4_fp8(o0[0], o0[1], o0[2], o0[3]);
                    *(GAS unsigned*)(Ko + (size_t)row * QK8 + 64 + ax * 16 + 8 + f0) = cvt4_fp8(o1[0], o1[1], o1[2], o1[3]);
                    *(GAS u32x2*)(Ko + (size_t)row * QK8 + QK + 8 * fq) = (u32x2){0u, 0u};
                }
#pragma unroll
                for (int j = 4; j < 8; ++j)
#pragma unroll
                    for (int r = 0; r < 4; ++r) { const int d = 16 * (j - 4) + 4 * fq + r; Vo[(size_t)d * SKV + vrow] = (unsigned char)(cvt4_fp8(acc[i][j][r], 0.f, 0.f, 0.f) & 0xffu); }
            }
        }
    }
}

__device__ __forceinline__ float log_gamma(const float* logit) { const float x = *logit; return -log1pf(__expf(-x)); }

__device__ __forceinline__ void rope16(float (&out)[16], const bf16_t* rowp  , int part, const float* cs  , float scale) {
    const u32x4 a0 = *(const GAS u32x4*)(rowp + part * 16), a1 = *(const GAS u32x4*)(rowp + part * 16 + 8);
    const u32x4 b0 = *(const GAS u32x4*)(rowp + (part ^ 1) * 16), b1 = *(const GAS u32x4*)(rowp + (part ^ 1) * 16 + 8);
    float xs[16], xo[16];
#pragma unroll
    for (int e = 0; e < 4; ++e) { xs[2 * e] = lo16(a0[e]); xs[2 * e + 1] = hi16(a0[e]); xs[8 + 2 * e] = lo16(a1[e]); xs[8 + 2 * e + 1] = hi16(a1[e]);
        xo[2 * e] = lo16(b0[e]); xo[2 * e + 1] = hi16(b0[e]); xo[8 + 2 * e] = lo16(b1[e]); xo[8 + 2 * e + 1] = hi16(b1[e]); }
    if (cs) {
        const float sg = (part & 1) ? 1.f : -1.f;
#pragma unroll
        for (int q = 0; q < 8; ++q) { const f32x4 t = *(const GAS f32x4*)(cs + 4 * q);
            out[2 * q] = (xs[2 * q] * t[0] + sg * xo[2 * q] * t[1]) * scale; out[2 * q + 1] = (xs[2 * q + 1] * t[2] + sg * xo[2 * q + 1] * t[3]) * scale; }
    } else {
#pragma unroll
        for (int f = 0; f < 16; ++f) out[f] = xs[f] * scale;
    }
}

__device__ __forceinline__ void ret_local_unit(const Args& a, LAS unsigned char* lds, int unit) {
    const int tid = tid_of(a.wv), lane = tid & 63, wave = a.wv, fr = lane & 15, fq = lane >> 4;
    const int bh = unit / NSLOT, slot = unit % NSLOT, b = bh >> 2, h = bh & 3;
    const bool lat = slot >= 2;
    const int prow0 = lat ? b * SEQ + (slot - 2) * RC : T + b * LC + slot * RC;
    const int tpos0 = lat ? (slot - 2) * RC : 0;
    LAS bf16_t* KfT = (LAS bf16_t*)lds;
    LAS bf16_t* KbT = (LAS bf16_t*)(lds + 17408);
    LAS bf16_t* VT = (LAS bf16_t*)(lds + 34816);
    const bf16_t* P = (const bf16_t*)(a.ws + WS_P);
    const float* tabr = (const float*)(a.ws + WS_TABR);
    const float lgf = log_gamma(a.in[I_DECAY] + h), lgb = log_gamma(a.in[I_DECAY] + 4 + h);
    __syncthreads();
    {
        const int j = tid >> 2, part = tid & 3, t = tpos0 + j, ax = part >> 1;
        const int pi = ax == 0 ? (t >> 6) : 128 + (t & 63);
        float o[16]; rope16(o, P + (size_t)(prow0 + j) * DINP + OFF_RK + h * 64, part, lat ? tabr + pi * 32 : nullptr, 0.125f);
        const float wf = __expf(lgf * (float)(127 - j)), wb = __expf(lgb * (float)j);
#pragma unroll
        for (int f = 0; f < 16; ++f) { const int d = part * 16 + f; KfT[d * 136 + j] = (bf16_t)f2bf(o[f] * wf); KbT[d * 136 + j] = (bf16_t)f2bf(o[f] * wb); }
    }
    for (int idx = tid; idx < 128 * 16; idx += 512) {
        const int j = idx >> 4, c = idx & 15;
        const u32x4 v = *(const GAS u32x4*)(P + (size_t)(prow0 + j) * DINP + OFF_RV + h * 128 + c * 8);
#pragma unroll
        for (int e = 0; e < 4; ++e) { VT[(c * 8 + 2 * e) * 136 + j] = (bf16_t)(v[e] & 0xffffu); VT[(c * 8 + 2 * e + 1) * 136 + j] = (bf16_t)(v[e] >> 16); }
    }
    __syncthreads();
    const int dir = wave >> 2, mi = wave & 3;
    f32x4 acc[1][8];
#pragma unroll
    for (int j = 0; j < 8; ++j) acc[0][j] = (f32x4){0.f, 0.f, 0.f, 0.f};
    mma_ll<1, 8, false>(acc, dir ? KbT : KfT, 136, 16 * mi, VT, 136, 0, 128, lane);
    float* out = (float*)(a.ws + WS_LST) + ((size_t)(bh * 2 + dir) * NSLOT + slot) * 8192;
#pragma unroll
    for (int j = 0; j < 8; ++j) *(GAS f32x4*)(out + (size_t)(16 * j + fr) * 64 + 16 * mi + 4 * fq) = acc[0][j];
}

__device__ __forceinline__ void phase_ret_scan(const Args& a) {
    const int gt = blockIdx.x * 512 + tid_of(a.wv);
    if (gt >= 32 * 2048) return;
    const int bd = gt >> 11, v4 = gt & 2047, dir = bd & 1, h = (bd >> 1) & 3;
    const float lg = log_gamma(a.in[I_DECAY] + dir * 4 + h);
    const float g = __expf(lg * 128.f);
    float* base = (float*)(a.ws + WS_LST) + (size_t)bd * NSLOT * 8192 + v4 * 4;
    f32x4 S = (f32x4){0.f, 0.f, 0.f, 0.f};
#pragma unroll 1
    for (int bt = 0; bt < 5; ++bt) {
        f32x4 L[13];
#pragma unroll
        for (int q = 0; q < 13; ++q) { const int n = bt * 13 + q; const int slot = dir == 0 ? n : (n == 0 ? 1 : (n == 1 ? 0 : 67 - n)); L[q] = *(const GAS f32x4*)(base + (size_t)slot * 8192); }
#pragma unroll
        for (int q = 0; q < 13; ++q) { const int n = bt * 13 + q; const int slot = dir == 0 ? n : (n == 0 ? 1 : (n == 1 ? 0 : 67 - n)); S = S * g + L[q]; *(GAS f32x4*)(base + (size_t)slot * 8192) = S; }
    }
}

__device__ __forceinline__ void ret_out_unit(const Args& a, LAS unsigned char* lds, int unit) {
    const int tid = tid_of(a.wv), lane = tid & 63, wave = a.wv, fr = lane & 15, fq = lane >> 4;
    const int bh = unit >> 6, c = unit & 63, b = bh >> 2, h = bh & 3;
    const int prow0 = b * SEQ + c * RC, tpos0 = c * RC;
    LAS bf16_t* Qs = (LAS bf16_t*)lds;
    LAS bf16_t* Ks = (LAS bf16_t*)(lds + 18432);
    LAS bf16_t* VT = (LAS bf16_t*)(lds + 36864);
    LAS bf16_t* SfT = (LAS bf16_t*)(lds + 71680);
    LAS bf16_t* SbT = (LAS bf16_t*)(lds + 90112);
    LAS bf16_t* Ws = (LAS bf16_t*)(lds + 108544);
    const bf16_t* P = (const bf16_t*)(a.ws + WS_P);
    const float* tabr = (const float*)(a.ws + WS_TABR);
    const float lgf = log_gamma(a.in[I_DECAY] + h), lgb = log_gamma(a.in[I_DECAY] + 4 + h);
    __syncthreads();
    {
        const int j = tid >> 2, part = tid & 3, t = tpos0 + j, ax = part >> 1;
        const int pi = ax == 0 ? (t >> 6) : 128 + (t & 63);
        float oq[16], ok[16];
        rope16(oq, P + (size_t)(prow0 + j) * DINP + OFF_RQ + h * 64, part, tabr + pi * 32, 1.f);
        rope16(ok, P + (size_t)(prow0 + j) * DINP + OFF_RK + h * 64, part, tabr + pi * 32, 0.125f);
        u32x4 w0, w1;
        w0 = (u32x4){pk2(oq[0], oq[1]), pk2(oq[2], oq[3]), pk2(oq[4], oq[5]), pk2(oq[6], oq[7])}; w1 = (u32x4){pk2(oq[8], oq[9]), pk2(oq[10], oq[11]), pk2(oq[12], oq[13]), pk2(oq[14], oq[15])};
        *(LAS u32x4*)(Qs + j * 72 + part * 16) = w0; *(LAS u32x4*)(Qs + j * 72 + part * 16 + 8) = w1;
        w0 = (u32x4){pk2(ok[0], ok[1]), pk2(ok[2], ok[3]), pk2(ok[4], ok[5]), pk2(ok[6], ok[7])}; w1 = (u32x4){pk2(ok[8], ok[9]), pk2(ok[10], ok[11]), pk2(ok[12], ok[13]), pk2(ok[14], ok[15])};
        *(LAS u32x4*)(Ks + j * 72 + part * 16) = w0; *(LAS u32x4*)(Ks + j * 72 + part * 16 + 8) = w1;
    }
    for (int idx = tid; idx < 128 * 16; idx += 512) {
        const int j = idx >> 4, cch = idx & 15;
        const u32x4 v = *(const GAS u32x4*)(P + (size_t)(prow0 + j) * DINP + OFF_RV + h * 128 + cch * 8);
#pragma unroll
        for (int e = 0; e < 4; ++e) { VT[(cch * 8 + 2 * e) * 136 + j] = (bf16_t)(v[e] & 0xffffu); VT[(cch * 8 + 2 * e + 1) * 136 + j] = (bf16_t)(v[e] >> 16); }
    }
    {
        const float* sf = (const float*)(a.ws + WS_LST) + ((size_t)(bh * 2 + 0) * NSLOT + (c + 1)) * 8192;
        const float* sb = (const float*)(a.ws + WS_LST) + ((size_t)(bh * 2 + 1) * NSLOT + (c == 63 ? 0 : c + 3)) * 8192;
        for (int idx = tid; idx < 2048; idx += 512) {
            const int e = idx >> 4, d = (idx & 15) * 4;
            const f32x4 x = *(const GAS f32x4*)(sf + idx * 4), y = *(const GAS f32x4*)(sb + idx * 4);
            u32x2 w; w.x = pk2(x[0], x[1]); w.y = pk2(x[2], x[3]); *(LAS u32x2*)(SfT + e * 72 + d) = w;
            w.x = pk2(y[0], y[1]); w.y = pk2(y[2], y[3]); *(LAS u32x2*)(SbT + e * 72 + d) = w;
        }
    }
    __syncthreads();
    const int i0 = 16 * wave, irow = i0 + fr;
    f32x4 accS[1][8], accF[1][8], accB[1][8], accO[1][8];
#pragma unroll
    for (int j = 0; j < 8; ++j) { accS[0][j] = (f32x4){0.f, 0.f, 0.f, 0.f}; accF[0][j] = accS[0][j]; accB[0][j] = accS[0][j]; accO[0][j] = accS[0][j]; }
    mma_ll<1, 8, true>(accS, Qs, 72, i0, Ks, 72, 0, 64, lane);
    mma_ll<1, 8, true>(accF, Qs, 72, i0, SfT, 72, 0, 64, lane);
    mma_ll<1, 8, true>(accB, Qs, 72, i0, SbT, 72, 0, 64, lane);
#pragma unroll
    for (int j = 0; j < 8; ++j) {
        float w[4];
#pragma unroll
        for (int r = 0; r < 4; ++r) { const int jj = 16 * j + 4 * fq + r; const int df = irow - jj;
            const float dec = df > 0 ? __expf(lgf * (float)df) : (df < 0 ? __expf(lgb * (float)(-df)) : 2.f);
            w[r] = accS[0][j][r] * dec; }
        u32x2 pw; pw.x = pk2(w[0], w[1]); pw.y = pk2(w[2], w[3]);
        *(LAS u32x2*)(Ws + irow * 136 + 16 * j + 4 * fq) = pw;
    }
    LDS_WAIT(); __builtin_amdgcn_wave_barrier();
    mma_ll<1, 8, true>(accO, Ws, 136, i0, VT, 136, 0, 128, lane);
    const float wf = __expf(lgf * (float)(irow + 1)), wb = __expf(lgb * (float)(128 - irow));
    float ss = 0.f;
#pragma unroll
    for (int j = 0; j < 8; ++j) { accO[0][j] = accO[0][j] + accF[0][j] * wf + accB[0][j] * wb;
        ss += (accO[0][j][0] * accO[0][j][0] + accO[0][j][1] * accO[0][j][1]) + (accO[0][j][2] * accO[0][j][2] + accO[0][j][3] * accO[0][j][3]); }
    ss += __shfl_xor(ss, 16); ss += __shfl_xor(ss, 32);
    const float rstd = rsqrtf(ss * (1.f / 128.f) + EPS);
    const float* gro = a.in[I_GRET] + h * 128;
    const bf16_t* pg = P + (size_t)(prow0 + irow) * DINP + OFF_RG + h * 128;
    bf16_t* mix = (bf16_t*)(a.ws + WS_MIX) + (size_t)(prow0 + irow) * DM + 512 + h * 128;
#pragma unroll
    for (int j = 0; j < 8; ++j) { const int e = 16 * j + 4 * fq; const f32x4 gv = *(const GAS f32x4*)(gro + e); const u32x2 gw = *(const GAS u32x2*)(pg + e);
        const float g0 = lo16(gw.x), g1 = hi16(gw.x), g2 = lo16(gw.y), g3 = hi16(gw.y);
        f32x4 v = accO[0][j] * gv * rstd;
        v[0] *= g0 / (1.f + __expf(-g0)); v[1] *= g1 / (1.f + __expf(-g1)); v[2] *= g2 / (1.f + __expf(-g2)); v[3] *= g3 / (1.f + __expf(-g3));
        u32x2 w; w.x = pk2(v[0], v[1]); w.y = pk2(v[2], v[3]); *(GAS u32x2*)(mix + e) = w; }
}

namespace att {
constexpr int KLD8 = 144  , VLD8 = 80  , KBUF = 64 * KLD8, VBUF = 64 * VLD8, NKB = 3, NVB = 4;
constexpr int L_K = 0, L_V = NKB * KBUF, L_WS = NKB * KBUF + NVB * VBUF;
__device__ __forceinline__ int crow(int r, int hi) { return (r & 3) + 8 * (r >> 2) + 4 * hi; }
typedef __bf16 bf16x2_t __attribute__((ext_vector_type(2))); typedef float f32x2_t __attribute__((ext_vector_type(2)));
__device__ __forceinline__ unsigned cvtpk(float lo, float hi) { f32x2_t v = {lo, hi}; bf16x2_t b = __builtin_convertvector(v, bf16x2_t); return __builtin_bit_cast(unsigned, b); }
#define SBAR() __builtin_amdgcn_sched_barrier(0)
typedef int i32x4 __attribute__((ext_vector_type(4))); typedef int i32x8 __attribute__((ext_vector_type(8)));
constexpr float PSHIFT = 2.f;
template <bool SHIFT>
__device__ __forceinline__ i32x8 softmax_pack8(f32x16& p0, f32x16& p1, float negm) {
    const float sh = negm + 8.f - PSHIFT;
#pragma unroll
    for (int r = 0; r < 16; ++r) { p0[r] = __builtin_amdgcn_exp2f(SHIFT ? p0[r] + sh : p0[r]); p1[r] = __builtin_amdgcn_exp2f(SHIFT ? p1[r] + sh : p1[r]); }
    i32x8 w;
#pragma unroll
    for (int q = 0; q < 4; ++q) { w[q] = (int)cvt4_fp8(p0[4 * q], p0[4 * q + 1], p0[4 * q + 2], p0[4 * q + 3]); w[4 + q] = (int)cvt4_fp8(p1[4 * q], p1[4 * q + 1], p1[4 * q + 2], p1[4 * q + 3]); }
    return w;
}
template <bool SHIFT>
__device__ __forceinline__ void unit64(const Args& a, LAS unsigned char* lds, int bh, int qb, float negm) {
    const int wid = sopaque(a.wv), tid = tid_of(wid), lane = tid & 63, r32 = lane & 31, hi = lane >> 5;
    const unsigned char* QwA = a.ws + WS_Q + ((size_t)bh * SEQ + qb * 512 + wid * 64 + r32) * QK8 + hi * 32;
    const unsigned char* Kh = a.ws + WS_K + (size_t)bh * SKV * QK8;
    const unsigned char* Vh = a.ws + WS_VT + (size_t)bh * DV * SKV;
    LAS unsigned char* Kl = lds + L_K; LAS unsigned char* Vl = lds + L_V;
    LAS float* wsf = (LAS float*)(lds + L_WS) + wid * 64;
    i32x8 qA8[2], qB8[2];
#pragma unroll
    for (int s2 = 0; s2 < 2; ++s2) { const i32x4 a0_ = *(const GAS i32x4*)(QwA + 64 * s2), a1_ = *(const GAS i32x4*)(QwA + 64 * s2 + 16), b0_ = *(const GAS i32x4*)(QwA + 32 * QK8 + 64 * s2), b1_ = *(const GAS i32x4*)(QwA + 32 * QK8 + 64 * s2 + 16);
        qA8[s2] = __builtin_shufflevector(a0_, a1_, 0, 1, 2, 3, 4, 5, 6, 7); qB8[s2] = __builtin_shufflevector(b0_, b1_, 0, 1, 2, 3, 4, 5, 6, 7); }
    unsigned soff[2]; int dsto[2];
#pragma unroll
    for (int m = 0; m < 2; ++m) { const int j = (wid + 8 * m) < 14 ? wid + 8 * m : wid + 8 * m - 8;
        if (j < 9) { const int p = j * 64 + lane, row = p / 9, c = p % 9; soff[m] = (unsigned)(row * QK8 + (c < 8 ? c : 7) * 16); dsto[m] = L_K + j * 1024; }
        else { const int jv = j - 9, p = jv * 64 + lane, d = p / 5, c = p % 5; soff[m] = (unsigned)(d * SKV + (c < 4 ? c : 3) * 16); dsto[m] = L_V + jv * 1024; } }
    const char* Kb = (const char*)Kh; const char* Vb = (const char*)Vh;
#define DMA(t, kslot, vslot) do { _Pragma("unroll") for (int pm_ = 0; pm_ < 2; ++pm_) { const int j_ = (wid + 8 * pm_) < 14 ? wid + 8 * pm_ : wid + 8 * pm_ - 8; { \
        const char* src_ = (j_ < 9 ? Kb + (size_t)(t) * (64 * QK8) : Vb + (size_t)(t) * 64) + soff[pm_]; \
        __builtin_amdgcn_global_load_lds((const unsigned*)src_, (LAS unsigned*)(lds + dsto[pm_] + (j_ < 9 ? (kslot) * KBUF : (vslot) * VBUF)), 16, 0, 0); } } } while (0)
    i32x8 ones8;
#pragma unroll
    for (int q = 0; q < 8; ++q) ones8[q] = r32 == 0 ? 0x38383838 : 0;
    f32x16 oA[2], oB[2], sA, sB;
#pragma unroll
    for (int r = 0; r < 16; ++r) { oA[0][r] = 0.f; oA[1][r] = 0.f; oB[0][r] = 0.f; oB[1][r] = 0.f; sA[r] = 0.f; sB[r] = 0.f; }
    constexpr int NT = SKV / 64;
    __syncthreads();
    DMA(0, 0, 0); DMA(1, 1, 1); __syncthreads();
#ifndef ATT_STAGGER
#define ATT_STAGGER 0
#endif
    const bool late = ATT_STAGGER && wid >= 4;
#define TILE_BAR(more) do { if (more) asm volatile("s_waitcnt vmcnt(2) lgkmcnt(0)\n\ts_barrier" ::: "memory"); else asm volatile("s_waitcnt vmcnt(0) lgkmcnt(0)\n\ts_barrier" ::: "memory"); } while (0)
    int ks = 0, vs = 0;
    for (int i = 0; i < NT; ++i) {
        const bool more = i + 2 < NT;
        if (more) DMA(i + 2, (ks == 0 ? 2 : ks - 1), ((vs + 2) & 3));
        SBAR();
        f32x16 pA0, pA1, pB0, pB1;
#pragma unroll
        for (int r = 0; r < 16; ++r) { pA0[r] = PSHIFT; pA1[r] = PSHIFT; pB0[r] = PSHIFT; pB1[r] = PSHIFT; }
        const LAS unsigned char* Ks = Kl + ks * KBUF + r32 * KLD8 + 32 * hi;
#pragma unroll
        for (int s2 = 0; s2 < 2; ++s2) {
            const i32x4 c0_ = *(const LAS i32x4*)(Ks + 64 * s2), c1_ = *(const LAS i32x4*)(Ks + 64 * s2 + 16), d0_ = *(const LAS i32x4*)(Ks + 32 * KLD8 + 64 * s2), d1_ = *(const LAS i32x4*)(Ks + 32 * KLD8 + 64 * s2 + 16);
            const i32x8 k0 = __builtin_shufflevector(c0_, c1_, 0, 1, 2, 3, 4, 5, 6, 7), k1 = __builtin_shufflevector(d0_, d1_, 0, 1, 2, 3, 4, 5, 6, 7);
            pA0 = __builtin_amdgcn_mfma_scale_f32_32x32x64_f8f6f4(k0, qA8[s2], pA0, 0, 0, 0, 0, 0, 0); pB0 = __builtin_amdgcn_mfma_scale_f32_32x32x64_f8f6f4(k0, qB8[s2], pB0, 0, 0, 0, 0, 0, 0);
            pA1 = __builtin_amdgcn_mfma_scale_f32_32x32x64_f8f6f4(k1, qA8[s2], pA1, 0, 0, 0, 0, 0, 0); pB1 = __builtin_amdgcn_mfma_scale_f32_32x32x64_f8f6f4(k1, qB8[s2], pB1, 0, 0, 0, 0, 0, 0);
        }
        SBAR();
        if (late) TILE_BAR(more);
        const LAS unsigned char* Vs = Vl + vs * VBUF + r32 * VLD8 + 32 * hi;
        const i32x4 e0_ = *(const LAS i32x4*)(Vs), e1_ = *(const LAS i32x4*)(Vs + 16), f0_ = *(const LAS i32x4*)(Vs + 32 * VLD8), f1_ = *(const LAS i32x4*)(Vs + 32 * VLD8 + 16);
        const i32x8 v0 = __builtin_shufflevector(e0_, e1_, 0, 1, 2, 3, 4, 5, 6, 7), v1 = __builtin_shufflevector(f0_, f1_, 0, 1, 2, 3, 4, 5, 6, 7);
        { const i32x8 pa = softmax_pack8<SHIFT>(pA0, pA1, negm);
          oA[0] = __builtin_amdgcn_mfma_scale_f32_32x32x64_f8f6f4(pa, v0, oA[0], 0, 0, 0, 0, 0, 0); oA[1] = __builtin_amdgcn_mfma_scale_f32_32x32x64_f8f6f4(pa, v1, oA[1], 0, 0, 0, 0, 0, 0);
          sA = __builtin_amdgcn_mfma_scale_f32_32x32x64_f8f6f4(pa, ones8, sA, 0, 0, 0, 0, 0, 0); }
        { const i32x8 pa = softmax_pack8<SHIFT>(pB0, pB1, negm);
          oB[0] = __builtin_amdgcn_mfma_scale_f32_32x32x64_f8f6f4(pa, v0, oB[0], 0, 0, 0, 0, 0, 0); oB[1] = __builtin_amdgcn_mfma_scale_f32_32x32x64_f8f6f4(pa, v1, oB[1], 0, 0, 0, 0, 0, 0);
          sB = __builtin_amdgcn_mfma_scale_f32_32x32x64_f8f6f4(pa, ones8, sB, 0, 0, 0, 0, 0, 0); }
        SBAR();
        if (!late) TILE_BAR(more);
        ks = ks == 2 ? 0 : ks + 1; vs = (vs + 1) & 3;
    }
#undef DMA
#undef TILE_BAR
    if (r32 == 0) {
#pragma unroll
        for (int r = 0; r < 16; ++r) { wsf[crow(r, hi)] = sA[r]; wsf[32 + crow(r, hi)] = sB[r]; } }
    LDS_WAIT(); __builtin_amdgcn_wave_barrier();
    const int b = bh >> 3, h = bh & 7;
    const int lz = opaque(lane), r32z = lz & 31, hiz = lz >> 5;
    bf16_t* Ow = (bf16_t*)(a.ws + WS_MIX) + ((size_t)b * SEQ + qb * 512 + wid * 64) * DM + h * DV;
    const unsigned ooff = (unsigned)(4 * hiz * DM + r32z);
#pragma unroll
    for (int r = 0; r < 16; ++r) { const int orow = crow(r, hiz); const float rlA = 1.f / wsf[orow], rlB = 1.f / wsf[32 + orow];
        const unsigned off = ooff + (unsigned)(((r & 3) + 8 * (r >> 2)) * DM);
        Ow[off] = (bf16_t)f2bf(oA[0][r] * rlA); Ow[off + 32] = (bf16_t)f2bf(oA[1][r] * rlA);
        Ow[off + 32 * DM] = (bf16_t)f2bf(oB[0][r] * rlB); Ow[off + 32 * DM + 32] = (bf16_t)f2bf(oB[1][r] * rlB); }
}
#undef SBAR
}


#if DIAG == 5
__device__ __forceinline__ void attn_selfcheck(const Args& a, LAS unsigned char* lds) {
    const int tid = tid_of(a.wv);
    LAS float* red = (LAS float*)lds;
    __syncthreads();
    if (blockIdx.x == 0) {
        const int row = tid >> 3, ds = (tid & 7) * 8;
        const unsigned char* q = a.ws + WS_Q + (size_t)row * QK8; const unsigned char* K = a.ws + WS_K; const unsigned char* V = a.ws + WS_VT;
        float qf[96];
        float acc[8] = {0.f, 0.f, 0.f, 0.f, 0.f, 0.f, 0.f, 0.f}; float l = 0.f;
        for (int key = 0; key < SKV; ++key) {
            float s = 0.f;
            for (int c = 0; c < 96; c += 4) { const int kw = *(const GAS int*)(K + (size_t)key * QK8 + c), qw = *(const GAS int*)(q + c);
                s += __builtin_amdgcn_cvt_f32_fp8(kw, 0) * __builtin_amdgcn_cvt_f32_fp8(qw, 0) + __builtin_amdgcn_cvt_f32_fp8(kw, 1) * __builtin_amdgcn_cvt_f32_fp8(qw, 1)
                   + __builtin_amdgcn_cvt_f32_fp8(kw, 2) * __builtin_amdgcn_cvt_f32_fp8(qw, 2) + __builtin_amdgcn_cvt_f32_fp8(kw, 3) * __builtin_amdgcn_cvt_f32_fp8(qw, 3); }
            const float p = exp2f(s);
            const int kk = key & 63, pos = (key & ~63) + 32 * ((kk >> 2) & 1) + (kk & 3) + 4 * ((kk & 31) >> 3) + 16 * (kk >> 5);
            l += p;
#pragma unroll
            for (int e = 0; e < 8; ++e) { const int w = V[(size_t)(ds + e) * SKV + pos]; acc[e] += p * __builtin_amdgcn_cvt_f32_fp8(w, 0); }
        }
        (void)qf;
        float emax = 0.f, omax = 0.f;
        const bf16_t* mix = (const bf16_t*)(a.ws + WS_MIX) + (size_t)row * DM + ds;
#pragma unroll
        for (int e = 0; e < 8; ++e) { const float o = acc[e] / l; emax = fmaxf(emax, fabsf(o - bf2f(mix[e]))); omax = fmaxf(omax, fabsf(o)); }
        red[tid] = emax; red[512 + tid] = omax;
        __syncthreads();
        if (tid == 0) { float e = 0.f, o = 0.f; for (int i = 0; i < 512; ++i) { e = fmaxf(e, red[i]); o = fmaxf(o, red[512 + i]); }
            ((unsigned*)(a.ws + WS_CTL))[CW_DIAG] = __float_as_uint(e / o * 0.1f); }
    }
    __syncthreads();
}
#endif

__device__ __forceinline__ void phase_router(const Args& a, LAS unsigned char* lds) {
    const int tid = tid_of(a.wv), lane = tid & 63, wave = a.wv, fr = lane & 15, fq = lane >> 4;
    LAS bf16_t* Ah = (LAS bf16_t*)lds;
    LAS bf16_t* Al = (LAS bf16_t*)(lds + 33024);
    LAS float* red = (LAS float*)(lds + 66048);
    LAS int* hist = (LAS int*)(lds + 66048 + 16384);
    LAS int* base = hist + 32;
    LAS int* pk_e = base + 32;
    LAS int* pk_r = pk_e + 512;
    LAS int* pk_p = pk_r + 512;
    const float* mod = (const float*)(a.ws + WS_MOD); const float* g = a.in[I_GFFN];
    const bf16_t* WR = (const bf16_t*)(a.ws + WS_WR);
    unsigned char* HF = a.ws + WS_HF;
    float* PG = (float*)(a.ws + WS_PG);
    unsigned* cnt = (unsigned*)(a.ws + WS_CTL) + CW_CNT;
    unsigned* list = (unsigned*)(a.ws + WS_LIST);
    for (int tile = blockIdx.x; tile < T / 128; tile += gridDim.x) {
        __syncthreads();
        if (tid < 32) hist[tid] = 0;
        for (int it = 0; it < 8; ++it) {
            const int tok0 = tile * 128 + it * 16;
            __syncthreads();
#pragma unroll
            for (int rr = 0; rr < 2; ++rr) {
                const int row = wave * 2 + rr, tok = tok0 + row;
                const float* xr = a.out + (size_t)tok * DM; const float* sh = mod + (tok >> 13) * 6144 + 3 * 1024; const float* sc = sh + 1024;
                f32x4 v[4]; float ss = 0.f;
#pragma unroll
                for (int j = 0; j < 4; ++j) { v[j] = *(const GAS f32x4*)(xr + j * 256 + lane * 4); ss += (v[j].x * v[j].x + v[j].y * v[j].y) + (v[j].z * v[j].z + v[j].w * v[j].w); }
                const float rstd = rsqrtf(wave_sum(ss) * (1.f / DM) + EPS);
#pragma unroll
                for (int j = 0; j < 4; ++j) { const int c = j * 256 + lane * 4; const f32x4 gg = *(const GAS f32x4*)(g + c), s1 = *(const GAS f32x4*)(sc + c), s0 = *(const GAS f32x4*)(sh + c);
                    const f32x4 o = (v[j] * rstd * gg) * (s1 + 1.f) + s0;
                    const unsigned h0 = f2bf(o.x), h1 = f2bf(o.y), h2 = f2bf(o.z), h3 = f2bf(o.w);
                    u32x2 wh; wh.x = h0 | (h1 << 16); wh.y = h2 | (h3 << 16);
                    u32x2 wl; wl.x = pk2(o.x - bf2f((bf16_t)h0), o.y - bf2f((bf16_t)h1)); wl.y = pk2(o.z - bf2f((bf16_t)h2), o.w - bf2f((bf16_t)h3));
                    *(GAS unsigned*)(HF + (size_t)tok * DM + c) = cvt4_fp8(o.x, o.y, o.z, o.w);
                    *(LAS u32x2*)(Ah + row * 1032 + c) = wh; *(LAS u32x2*)(Al + row * 1032 + c) = wl; }
            }
            __syncthreads();
            {
                f32x4 acc[1][2]; acc[0][0] = (f32x4){0.f, 0.f, 0.f, 0.f}; acc[0][1] = acc[0][0];
                mma_lg<1, 2, false>(acc, Ah + wave * 128, 1032, 0, WR + wave * 128, 1024, 0, 128, lane);
                mma_lg<1, 2, false>(acc, Al + wave * 128, 1032, 0, WR + wave * 128, 1024, 0, 128, lane);
                mma_lg<1, 2, false>(acc, Ah + wave * 128, 1032, 0, WR + 32768 + wave * 128, 1024, 0, 128, lane);
#pragma unroll
                for (int j = 0; j < 2; ++j)
#pragma unroll
                    for (int r = 0; r < 4; ++r) red[(wave * 16 + 4 * fq + r) * 32 + 16 * j + fr] = acc[0][j][r];
            }
            __syncthreads();
            if (tid < 16) {
                const int tok = tok0 + tid;
                float best[4]; int bi[4];
#pragma unroll
                for (int k = 0; k < 4; ++k) { best[k] = -3.0e38f; bi[k] = 0; }
                for (int e = 0; e < 32; ++e) {
                    float s = a.in[I_BR][e];
#pragma unroll
                    for (int w = 0; w < 8; ++w) s += red[(w * 16 + tid) * 32 + e];
                    if (s > best[3]) {
                        if (s > best[0]) { best[3] = best[2]; bi[3] = bi[2]; best[2] = best[1]; bi[2] = bi[1]; best[1] = best[0]; bi[1] = bi[0]; best[0] = s; bi[0] = e; }
                        else if (s > best[1]) { best[3] = best[2]; bi[3] = bi[2]; best[2] = best[1]; bi[2] = bi[1]; best[1] = s; bi[1] = e; }
                        else if (s > best[2]) { best[3] = best[2]; bi[3] = bi[2]; best[2] = s; bi[2] = e; }
                        else { best[3] = s; bi[3] = e; }
                    }
                }
                const float e1 = __expf(best[1] - best[0]), e2 = __expf(best[2] - best[0]), e3 = __expf(best[3] - best[0]);
                const float inv = 1.f / (1.f + e1 + e2 + e3);
                const float gk[4] = {inv, e1 * inv, e2 * inv, e3 * inv};
#pragma unroll
                for (int k = 0; k < 4; ++k) { const int slot = (it * 16 + tid) * 4 + k; const int rk = __hip_atomic_fetch_add(hist + bi[k], 1, __ATOMIC_RELAXED, __HIP_MEMORY_SCOPE_WORKGROUP);
                    pk_e[slot] = bi[k]; pk_r[slot] = rk; pk_p[slot] = tok * 4 + k; PG[tok * 4 + k] = gk[k]; }
            }
        }
        __syncthreads();
        if (tid < 32) base[tid] = (int)__hip_atomic_fetch_add(cnt + 64 * tid, (unsigned)hist[tid], __ATOMIC_RELAXED, __HIP_MEMORY_SCOPE_AGENT);
        __syncthreads();
        { const int e = pk_e[tid]; list[(size_t)e * 32768 + base[e] + pk_r[tid]] = (unsigned)pk_p[tid]; }
    }
}

__device__ __forceinline__ void phase_combine(const Args& a) {
    const int tid = tid_of(a.wv), lane = tid & 63, wave = tid >> 6;
    const int gw = blockIdx.x * 8 + wave, NGW = gridDim.x * 8;
    const float* mod = (const float*)(a.ws + WS_MOD);
    const unsigned char* Y = a.ws + WS_Y;
#if DIAG == 1
    const float dz = 0.1f;
#elif DIAG >= 2
    const float dz = sqrtf(__uint_as_float(__hip_atomic_load((unsigned*)(a.ws + WS_CTL) + CW_DIAG, __ATOMIC_RELAXED, __HIP_MEMORY_SCOPE_AGENT)));
#else
    const float dz = 0.f;
#endif
    for (int tok = gw; tok < T; tok += NGW) {
        const float* gate = mod + (tok >> 13) * 6144 + 5 * 1024;
        float* orow = a.out + (size_t)tok * DM;
#pragma unroll
        for (int j = 0; j < 4; ++j) { const int c = j * 256 + lane * 4;
            f32x4 s = (f32x4){0.f, 0.f, 0.f, 0.f};
#pragma unroll
            for (int k = 0; k < 4; ++k) { const int w = *(const GAS int*)(Y + ((size_t)tok * 4 + k) * DM + c);
                s[0] += __builtin_amdgcn_cvt_f32_fp8(w, 0); s[1] += __builtin_amdgcn_cvt_f32_fp8(w, 1); s[2] += __builtin_amdgcn_cvt_f32_fp8(w, 2); s[3] += __builtin_amdgcn_cvt_f32_fp8(w, 3); }
            s = s * pg8::YINV;
            const f32x4 xv = *(const GAS f32x4*)(orow + c), gv = *(const GAS f32x4*)(gate + c);
            *(GAS f32x4*)(orow + c) = xv + gv * s + dz; }
    }
}

constexpr int N_PHASES = 11;
__global__ void __launch_bounds__(512, 2) fwd_kernel(Args a0) {
    Args a;
    extern __shared__ __attribute__((aligned(16))) unsigned char lds_raw[];
    LAS unsigned char* lds = (LAS unsigned char*)lds_raw;
    volatile LAS unsigned* MISC = (volatile LAS unsigned*)(lds + LDS_MISC);
    const int wv0 = __builtin_amdgcn_readfirstlane((int)threadIdx.x >> 6);
    const int tid = threadIdx.x;
    if (tid < 64) MISC[tid] = 0u;
    __syncthreads();
    const int lo = sopaque(a0.ph_lo), hi = sopaque(a0.ph_hi);
#define use_bar ((hi - lo) > 1)
    XcdBarrier bar; bar.bar = (unsigned*)(a0.ws + WS_CTL) + CW_BAR; bar.x = 0; bar.st = MISC + 8;
    bar.wv = wv0;
    if (use_bar) bar = xcd_barrier_post((unsigned*)(a0.ws + WS_CTL) + CW_BAR, MISC + 8, wv0);
    const int G = sopaque((int)gridDim.x), bx = sopaque((int)blockIdx.x);
    const int vcu = (G % 8 == 0) ? (bx % 8) * (G / 8) + bx / 8 : bx;
#ifndef ONLY_PHASE
#define ONLY_PHASE -1
#endif
#ifndef PHASE_MASK
#define PHASE_MASK 0x7ff
#endif
#define IN(k) (lo <= (k) && (k) < hi && (ONLY_PHASE < 0 || ONLY_PHASE == (k)) && ((PHASE_MASK >> (k)) & 1))
#define SEAM(k) do { if (use_bar && (k) + 1 < hi) xcd_barrier(bar); } while (0)
#ifndef REPEAT_MASK
#define REPEAT_MASK 0
#endif
#define REP(k) for (int rep_ = 0; rep_ <= ((REPEAT_MASK >> (k)) & 1); ++rep_)
    a = a0; a.wv = wv0;
    if (IN(0)) { phase_mod(a, lds); SEAM(0); }
    REP(1) if (IN(1)) { phase_prep(a, lds); SEAM(1); }
    {
        float* prm = (float*)(a0.ws + WS_PRM);
        a.ws = a0.ws; a.out = a0.out; a.in[I_X] = a0.in[I_X]; a.wv = wv0;
        a.in[I_GQL] = prm + PRM_GQL; a.in[I_GKVL] = prm + PRM_GKVL; a.in[I_GQH] = prm + PRM_GQH; a.in[I_GKH] = prm + PRM_GKH; a.in[I_DECAY] = prm + PRM_DECAY;
        a.in[I_GRET] = prm + PRM_GRET; a.in[I_BR] = prm + PRM_BR; a.in[I_GFFN] = prm + PRM_GFFN; a.in[I_B1] = prm + PRM_B1; a.in[I_B2] = prm + PRM_B2;
    }
    REP(2) if (IN(2)) {
        pg8::DenseOrder S; S.init(a.ws + WS_H, a.ws + WS_WIN, TA, DINP, 1024, G, bx);
        pg8::EpiP E{(bf16_t*)(a.ws + WS_P)};
        pg8::gemm_phase<pg8::EpiP, pg8::DenseOrder, false>(lds, nullptr, nullptr, 0, 1024, S, E, a.wv);
        SEAM(2);
    }
    REP(3) if (IN(3)) {
        if (G == 256) {
            int u0, nu;
            if (bx < 32) { u0 = 3 * bx; nu = 3; }
            else { const int c = bx - 32; u0 = 96 + 4 * c + (c < 64 ? c : 64); nu = 4 + (c < 64 ? 1 : 0); }
            for (int k2 = 0; k2 < (bx < 32 ? 2 : 1); ++k2) mla_tile(a, lds, k2 ? 256 + (bx >> 2) : bx, k2 ? 32 * (bx & 3) : 0, k2 ? 32 : 128);
            for (int u = u0; u < u0 + nu; ++u) ret_local_unit(a, lds, u);
        } else { for (int t = bx; t < TA / 128; t += G) mla_tile(a, lds, t); for (int u = bx; u < 16 * NSLOT; u += G) ret_local_unit(a, lds, u); }
        SEAM(3);
    }
    if (IN(4)) { phase_ret_scan(a); SEAM(4); }
    REP(5) if (IN(5)) {
        float negm;
        { float gq = 0.f, gk = 0.f; for (int i = 0; i < QK; ++i) { gq = fmaxf(gq, fabsf(a.in[I_GQH][i])); gk = fmaxf(gk, fabsf(a.in[I_GKH][i])); }
          negm = -(gq * gk * 96.f * QSCALE * 1.03f + 0.5f); negm = __uint_as_float(__builtin_amdgcn_readfirstlane(__float_as_uint(negm))); }
        const bool shift = negm < -64.f;
        __builtin_amdgcn_s_setreg((0 << 11) | (23 << 6) | 1, 1);
#ifndef REP5A
#define REP5A 0
#endif
#ifndef REP5B
#define REP5B 0
#endif
        if (G == 256) {
            const int xg = vcu >> 5, c = vcu & 31, cg = vcu & 3;
#pragma unroll 1
            for (int step = 0; step < 4; ++step) {
                if (step == cg) moe_convert(a, lds, vcu);
                if (step < 2) { const int bh = xg * 4 + 2 * step + (c >> 4), qb = c & 15; if (shift) att::unit64<true>(a, lds, bh, qb, negm); else att::unit64<false>(a, lds, bh, qb, negm); }
                else if (step == 2) { for (int u = bx; u < 16 * 64; u += G) ret_out_unit(a, lds, u); }
            }
        } else {
            for (int w = bx; w < 512; w += G) { if (shift) att::unit64<true>(a, lds, w >> 4, w & 15, negm); else att::unit64<false>(a, lds, w >> 4, w & 15, negm); }
            for (int u = bx; u < 16 * 64; u += G) ret_out_unit(a, lds, u);
        }
        SEAM(5);
    }
    REP(6) if (IN(6)) {
        pg8::DenseOrder S; S.init(a.ws + WS_MIX, a.ws + WS_WO, T, DM, 1024, G, bx);
        pg8::EpiOut E{a.in[I_X], (const float*)(a.ws + WS_MOD), a.out};
        pg8::gemm_phase<pg8::EpiOut, pg8::DenseOrder, false>(lds, nullptr, nullptr, 0, 1024, S, E, a.wv);
        SEAM(6);
    }
    if (IN(7)) { phase_router(a, lds); SEAM(7); }
    REP(8) if (IN(8)) {
        pg8::EpiM1 E{a.ws + WS_ACT};
        phase_moe_pg8<8>(a, lds, a.ws + WS_HF, 2, a.ws + WS_W1, (size_t)2048 * 1024, a.in[I_B1], 2048, nullptr, E);
        SEAM(8);
    }
    REP(9) if (IN(9)) {
        pg8::EpiM2 E{a.ws + WS_Y};
        phase_moe_pg8<4>(a, lds, a.ws + WS_ACT, 0, a.ws + WS_W2, (size_t)1024 * 1024, a.in[I_B2], 1024, (const float*)(a.ws + WS_PG), E);
        SEAM(9);
    }
    if (IN(10)) { phase_combine(a); }
#undef IN
#undef SEAM
#undef use_bar
}

extern "C" void kernel_launch(void* const* d_in, const int* in_sizes, int n_in, void* d_out, int out_size, void* d_ws, size_t ws_size, hipStream_t stream) {
    static int grid = 0;
    if (grid == 0) {
        if (n_in != 24 || out_size != T * DM || ws_size < WS_END) { fprintf(stderr, "kernel_launch: unexpected shapes (n_in %d out %d ws %zu)\n", n_in, out_size, ws_size); grid = -1; return; }
        int dev = 0, cus = 0, per_cu = 0;
        if (hipGetDevice(&dev) != hipSuccess || hipDeviceGetAttribute(&cus, hipDeviceAttributeMultiprocessorCount, dev) != hipSuccess) { grid = -1; return; }
        if (hipFuncSetAttribute((const void*)fwd_kernel, hipFuncAttributeMaxDynamicSharedMemorySize, LDS_BYTES) != hipSuccess) { fprintf(stderr, "kernel_launch: hipFuncSetAttribute failed\n"); grid = -1; return; }
        if (hipOccupancyMaxActiveBlocksPerMultiprocessor(&per_cu, (const void*)fwd_kernel, 512, LDS_BYTES) != hipSuccess || per_cu < 1) { fprintf(stderr, "kernel_launch: occupancy query says %d\n", per_cu); per_cu = 1; }
        (void)hipGetLastError();
        grid = cus;
    }
    if (grid < 0) return;
    (void)hipMemsetAsync((char*)d_ws + WS_CTL, 0, CTL_BYTES, stream);
    Args a{};
    for (int i = 0; i < 24; ++i) a.in[i] = (const float*)d_in[i];
    a.out = (float*)d_out; a.ws = (unsigned char*)d_ws;
#if MK_N_LAUNCHES == 1
    a.ph_lo = 0; a.ph_hi = N_PHASES;
    void* params[] = {&a};
    hipError_t e = hipLaunchCooperativeKernel((const void*)fwd_kernel, dim3(grid), dim3(512), params, LDS_BYTES, stream);
    if (e != hipSuccess) fprintf(stderr, "kernel_launch: cooperative launch failed: %s (grid %d)\n", hipGetErrorString(e), grid);
#else
    for (int p = 0; p < N_PHASES; ++p) { a.ph_lo = p; a.ph_hi = p + 1; hipLaunchKernelGGL(fwd_kernel, dim3(grid), dim3(512), LDS_BYTES, stream, a); }
#endif
}
```

```cpp
#include <hip/hip_runtime.h>
#include <cstdio>
#include <cstdint>

#ifndef MK_N_LAUNCHES
#define MK_N_LAUNCHES 1
#endif

#define LAS __attribute__((address_space(3)))
#define GAS __attribute__((address_space(1)))
typedef unsigned short bf16_t;
typedef short bf16x8 __attribute__((ext_vector_type(8)));
typedef short s16x4 __attribute__((ext_vector_type(4)));
typedef float f32x4 __attribute__((ext_vector_type(4)));
typedef float f32x16 __attribute__((ext_vector_type(16)));
typedef unsigned u32x4 __attribute__((ext_vector_type(4)));
typedef unsigned u32x2 __attribute__((ext_vector_type(2)));

constexpr int DM = 1024, NB = 4, SEQ = 8192, LC = 256;
constexpr int T = NB * SEQ;
constexpr int TC = NB * LC;
constexpr int TA = T + TC;
constexpr int DIN = 1952, DINP = 2048;
constexpr int OFF_Q = 0, OFF_KV = 256, OFF_PE = 384, OFF_RQ = 416, OFF_RK = 672, OFF_RV = 928, OFF_RG = 1440;
constexpr int NH = 8, QK = 96, QK8 = 128, DV = 64, SKV = LC + SEQ;
constexpr int RH = 4, RDK = 64, RDV = 128, RC = 128, NSLOT = 66;
constexpr int NE = 32, DFF = 1024, NPAIR = T * 4;
constexpr float EPS = 1e-6f;
constexpr float QSCALE = 0.10206207261596577f * 1.4426950408889634f;

constexpr size_t MiB = 1ull << 20;
constexpr size_t WS_CTL = 0, CTL_BYTES = 1 * MiB;
constexpr size_t WS_MOD = 1 * MiB;
constexpr size_t WS_TABM = WS_MOD + 128 * 1024;
constexpr size_t WS_TABR = WS_TABM + 16 * 1024;
constexpr size_t WS_WIN = 2 * MiB;
constexpr size_t WS_WQ = 6 * MiB;
constexpr size_t WS_WKV = 6 * MiB + 512 * 1024;
constexpr size_t WS_WO = 7 * MiB;
constexpr size_t WS_WR = 9 * MiB;
constexpr size_t WS_W1 = 10 * MiB;
constexpr size_t WS_W2 = 138 * MiB;
constexpr size_t WS_HF = 202 * MiB;
constexpr size_t WS_PG = 266 * MiB;
constexpr size_t WS_LIST = 267 * MiB;
constexpr size_t WS_H = 272 * MiB;
constexpr size_t WS_P = 338 * MiB;
constexpr size_t WS_Q = 470 * MiB;
constexpr size_t WS_K = 518 * MiB;
constexpr size_t WS_VT = 568 * MiB;
constexpr size_t WS_LST = 601 * MiB;
constexpr size_t WS_MIX = 667 * MiB;
constexpr size_t WS_ACT = 272 * MiB;
constexpr size_t WS_Y = 528 * MiB;
constexpr size_t WS_END = 784 * MiB;
constexpr size_t WS_PRM = WS_MOD + 256 * 1024;
constexpr int PRM_GQL = 0, PRM_GKVL = 256, PRM_GQH = 384, PRM_GKH = 480, PRM_DECAY = 576, PRM_GRET = 584, PRM_BR = 1096, PRM_GFFN = 1128, PRM_B1 = 2152, PRM_B2 = 67688, PRM_END = 100456;
constexpr int CW_BAR = 4096;
constexpr int CW_CNT = 16384;
constexpr int CW_DIAG = 20480;
#ifndef DIAG
#define DIAG 0
#endif

constexpr int LDS_SCRATCH = 159744;
constexpr int LDS_MISC = LDS_SCRATCH;
constexpr int LDS_BYTES = LDS_SCRATCH + 256;

__device__ __forceinline__ float bf2f(bf16_t h) { return __uint_as_float((unsigned)h << 16); }
__device__ __forceinline__ unsigned f2bf(float f) { unsigned u = __float_as_uint(f); return (u + 0x7fffu + ((u >> 16) & 1u)) >> 16; }
__device__ __forceinline__ unsigned pk2(float lo, float hi) { return f2bf(lo) | (f2bf(hi) << 16); }
__device__ __forceinline__ float lo16(unsigned w) { return __uint_as_float(w << 16); }
__device__ __forceinline__ float hi16(unsigned w) { return __uint_as_float(w & 0xffff0000u); }
__device__ __forceinline__ float wave_sum(float v) {
#pragma unroll
    for (int o = 1; o < 64; o <<= 1) v += __shfl_xor(v, o);
    return v;
}
#define LDS_WAIT() asm volatile("s_waitcnt lgkmcnt(0)" ::: "memory")
__device__ __forceinline__ unsigned cvt4_fp8(float a, float b, float c, float d) { int p = 0; p = __builtin_amdgcn_cvt_pk_fp8_f32(a, b, p, false); p = __builtin_amdgcn_cvt_pk_fp8_f32(c, d, p, true); return (unsigned)p; }
constexpr float WQ_SCALE = 16.f, WKV_SCALE = 8.f, WKV_INV = 1.f / 8.f;
constexpr float WSCALE = 64.f, WINV = 1.f / 64.f;
__device__ __forceinline__ int opaque(int v) { asm volatile("" : "+v"(v)); return v; }
__device__ __forceinline__ int sopaque(int v) { asm volatile("" : "+s"(v)); return v; }
__device__ __forceinline__ int tid_of(int wv) { return sopaque(wv) * 64 + opaque((int)__builtin_amdgcn_mbcnt_hi(~0u, __builtin_amdgcn_mbcnt_lo(~0u, 0u))); }

#define XB_TMO      128
#define XB_XCNT(j)  (256  + 64 * (j))
#define XB_XSUB(j)  (1280 + 64 * (j))
#define XB_XGEN(j)  (2304 + 64 * (j))
#define XB_TOP      3328
#define XB_TOPGEN   3392
#define XCD_BAR_WORDS 3456
#define XB_SPIN_CAP (1u << 20)
__device__ __forceinline__ unsigned xb_ld(unsigned* p)              { return __hip_atomic_load(p, __ATOMIC_RELAXED, __HIP_MEMORY_SCOPE_AGENT); }
__device__ __forceinline__ unsigned xb_add(unsigned* p, unsigned v) { return __hip_atomic_fetch_add(p, v, __ATOMIC_RELAXED, __HIP_MEMORY_SCOPE_AGENT); }
__device__ __forceinline__ unsigned xb_xcc_id() { return (unsigned)__builtin_amdgcn_s_getreg((3 << 11) | 20) & 0xFu; }
#define XB_SPIN(cond, bar) do { unsigned _sp = 0; while (cond) { __builtin_amdgcn_s_sleep(1); \
    if ((++_sp & 255u) == 0u) { if (xb_ld(&(bar)[XB_TMO])) break; if (_sp > XB_SPIN_CAP) { atomicAdd(&(bar)[XB_TMO], 1u); break; } } } } while (0)
struct XcdBarrier { unsigned* bar; unsigned x; volatile LAS unsigned* st; int wv; };
__device__ __forceinline__ XcdBarrier xcd_barrier_post(unsigned* bar, volatile LAS unsigned* st, int wv) {
    XcdBarrier b; b.bar = bar; b.x = xb_xcc_id(); b.st = st; b.wv = wv;
    if (tid_of(wv) == 0) (void)xb_add(&bar[XB_XCNT(b.x)], 1u);
    return b;
}
__device__ __forceinline__ void xcd_barrier_complete(unsigned* bar, unsigned x, unsigned& nloc, unsigned& nx) {
    const unsigned G = gridDim.x * gridDim.y * gridDim.z;
    unsigned sum, cnt, mine, sp = 0u;
    for (;;) {
        sum = 0u; cnt = 0u; mine = 0u;
#pragma unroll 1
        for (unsigned j = 0; j < 16; ++j) { const unsigned c = xb_ld(&bar[XB_XCNT(j)]); sum += c; cnt += (c > 0u) ? 1u : 0u; mine = (j == x) ? c : mine; }
        if (sum == G) break;
        __builtin_amdgcn_s_sleep(1);
        if ((++sp & 255u) == 0u) { if (xb_ld(&bar[XB_TMO])) break; if (sp > XB_SPIN_CAP) { atomicAdd(&bar[XB_TMO], 1u); break; } }
    }
    nloc = mine > 0u ? mine : 1u; nx = cnt > 0u ? cnt : 1u;
}
__device__ __forceinline__ void xcd_barrier(const XcdBarrier& b) {
    asm volatile("s_waitcnt vmcnt(0)" ::: "memory");
    __syncthreads();
    if (tid_of(b.wv) == 0) {
        unsigned* bar = b.bar; asm volatile("" : "+s"(bar));
        __builtin_amdgcn_s_waitcnt(0);
        unsigned nloc = b.st[0], nx = b.st[1];
        if (nloc == 0u) { xcd_barrier_complete(bar, b.x, nloc, nx); b.st[0] = nloc; b.st[1] = nx; }
        const unsigned old = xb_add(&bar[XB_XSUB(b.x)], 1u);
        const unsigned gen = old / nloc;
        if (old + 1u == (gen + 1u) * nloc) {
            __builtin_amdgcn_fence(__ATOMIC_RELEASE, "agent");
            asm volatile("s_waitcnt vmcnt(0)" ::: "memory");
            const unsigned og = xb_add(&bar[XB_TOP], 1u);
            const unsigned tg = og / nx;
            if (og + 1u == (tg + 1u) * nx) xb_add(&bar[XB_TOPGEN], 1u);
            else XB_SPIN(xb_ld(&bar[XB_TOPGEN]) == tg, bar);
            __builtin_amdgcn_fence(__ATOMIC_ACQUIRE, "agent");
            xb_add(&bar[XB_XGEN(b.x)], 1u);
            asm volatile("s_waitcnt vmcnt(0)" ::: "memory");
        } else {
            XB_SPIN(xb_ld(&bar[XB_XGEN(b.x)]) == gen, bar);
            __builtin_amdgcn_fence(__ATOMIC_ACQUIRE, "agent");
            asm volatile("s_waitcnt vmcnt(0)" ::: "memory");
        }
    }
    __syncthreads();
}

struct Args { const float* in[24]; float* out; unsigned char* ws; int ph_lo, ph_hi; int wv, pad; };
#define CAS __attribute__((address_space(4)))
__device__ __forceinline__ Args load_args() { auto p = __builtin_amdgcn_kernarg_segment_ptr(); asm volatile("" : "+s"(p)); Args r; __builtin_memcpy(&r, p, sizeof(Args)); return r; }
enum { I_X = 0, I_C, I_CTX, I_CCTX, I_GATTN, I_GFFN, I_WADA, I_BADA, I_WIN, I_GQL, I_WQUP, I_GQH, I_GKVL, I_WKVUP, I_GKH, I_DECAY, I_GRET, I_WOUT,
       I_WR, I_BR, I_W1, I_B1, I_W2, I_B2 };

template <int MT, int NT, bool SWAP>
__device__ __forceinline__ void mma_ll(f32x4 (&acc)[MT][NT], const LAS bf16_t* sA, int lda, int m0, const LAS bf16_t* sB, int ldb, int n0, int K, int lane) {
    const int fr = lane & 15, fq = lane >> 4;
    for (int k = 0; k < K; k += 32) {
        bf16x8 a[MT], b[NT];
#pragma unroll
        for (int i = 0; i < MT; ++i) a[i] = *(const LAS bf16x8*)(sA + (m0 + 16 * i + fr) * lda + k + 8 * fq);
#pragma unroll
        for (int j = 0; j < NT; ++j) b[j] = *(const LAS bf16x8*)(sB + (n0 + 16 * j + fr) * ldb + k + 8 * fq);
#pragma unroll
        for (int i = 0; i < MT; ++i)
#pragma unroll
            for (int j = 0; j < NT; ++j)
                acc[i][j] = SWAP ? __builtin_amdgcn_mfma_f32_16x16x32_bf16(b[j], a[i], acc[i][j], 0, 0, 0) : __builtin_amdgcn_mfma_f32_16x16x32_bf16(a[i], b[j], acc[i][j], 0, 0, 0);
    }
}
template <int MT, int NT, bool SWAP>
__device__ __forceinline__ void mma_lg(f32x4 (&acc)[MT][NT], const LAS bf16_t* sA, int lda, int m0, const bf16_t* gB, int ldb, int n0, int K, int lane) {
    const int fr = lane & 15, fq = lane >> 4;
#pragma unroll 2
    for (int k = 0; k < K; k += 32) {
        bf16x8 a[MT], b[NT];
#pragma unroll
        for (int j = 0; j < NT; ++j) b[j] = *(const GAS bf16x8*)(gB + (size_t)(n0 + 16 * j + fr) * ldb + k + 8 * fq);
#pragma unroll
        for (int i = 0; i < MT; ++i) a[i] = *(const LAS bf16x8*)(sA + (m0 + 16 * i + fr) * lda + k + 8 * fq);
#pragma unroll
        for (int i = 0; i < MT; ++i)
#pragma unroll
            for (int j = 0; j < NT; ++j)
                acc[i][j] = SWAP ? __builtin_amdgcn_mfma_f32_16x16x32_bf16(b[j], a[i], acc[i][j], 0, 0, 0) : __builtin_amdgcn_mfma_f32_16x16x32_bf16(a[i], b[j], acc[i][j], 0, 0, 0);
    }
}

__device__ __forceinline__ void phase_mod(const Args& a, LAS unsigned char* lds) {
    const int tid = tid_of(a.wv), lane = tid & 63, wave = tid >> 6;
    LAS float* sv = (LAS float*)lds;
    LAS float* red = sv + 5 * 1024;
    float* mod = (float*)(a.ws + WS_MOD);
    for (int i = tid; i < 5 * 1024; i += 512) { const float v = (i < 4096) ? a.in[I_C][i] : a.in[I_CCTX][i - 4096]; sv[i] = v / (1.f + __expf(-v)); }
    __syncthreads();
    const float* W = a.in[I_WADA]; const float* bb = a.in[I_BADA];
    for (int u = blockIdx.x; u < 96; u += gridDim.x) {
        const int col = u * 64 + lane;
        float acc[5] = {0.f, 0.f, 0.f, 0.f, 0.f};
        for (int k = wave * 128; k < wave * 128 + 128; ++k) {
            const float w = W[(size_t)k * 6144 + col];
#pragma unroll
            for (int v = 0; v < 5; ++v) acc[v] += sv[v * 1024 + k] * w;
        }
#pragma unroll
        for (int v = 0; v < 5; ++v) red[(wave * 5 + v) * 64 + lane] = acc[v];
        __syncthreads();
        if (tid < 320) { const int v = tid >> 6; float s = bb[u * 64 + lane];
#pragma unroll
            for (int w = 0; w < 8; ++w) s += red[(w * 5 + v) * 64 + lane];
            mod[v * 6144 + u * 64 + lane] = s; }
        __syncthreads();
    }
    const int gt = blockIdx.x * 512 + tid;
    if (gt < 192 * 8) { const int pi = gt >> 3, f = gt & 7; const float pos = (float)(pi < 128 ? pi : pi - 128);
        const float inv = exp2f(-(float)f * (13.287712379549449f / 8.f)); const float rev = pos * inv * 0.15915494309189535f;
        float* tm = (float*)(a.ws + WS_TABM); tm[gt * 2] = __builtin_amdgcn_cosf(rev); tm[gt * 2 + 1] = __builtin_amdgcn_sinf(rev); }
    else if (gt < 192 * 8 + 192 * 16) { const int g2 = gt - 192 * 8; const int pi = g2 >> 4, f = g2 & 15; const float pos = (float)(pi < 128 ? pi : pi - 128);
        const float inv = exp2f(-(float)f * (13.287712379549449f / 16.f)); const float rev = pos * inv * 0.15915494309189535f;
        float* tr = (float*)(a.ws + WS_TABR); tr[g2 * 2] = __builtin_amdgcn_cosf(rev); tr[g2 * 2 + 1] = __builtin_amdgcn_sinf(rev); }
}

__device__ __forceinline__ void transpose_item(const float* W, int K, int N, bf16_t* WT, LAS float* scr, int item, int lane) {
    const int nblk = N / 32, kb = item / nblk, nb = item % nblk, k0 = 64 * kb, n0 = 32 * nb;
    float wv_[32];
#pragma unroll
    for (int i = 0; i < 32; ++i) { const int kk = 2 * i + (lane >> 5); wv_[i] = W[(size_t)(k0 + kk) * N + n0 + (lane & 31)]; }
#pragma unroll
    for (int i = 0; i < 32; ++i) { const int kk = 2 * i + (lane >> 5); scr[kk * 33 + (lane & 31)] = wv_[i]; }
    LDS_WAIT();
    const int c = lane & 7;
#pragma unroll
    for (int j = 0; j < 4; ++j) { const int n = (lane >> 3) + 8 * j; const LAS float* s = scr + (8 * c) * 33 + n;
        u32x4 o; o.x = pk2(s[0 * 33], s[1 * 33]); o.y = pk2(s[2 * 33], s[3 * 33]); o.z = pk2(s[4 * 33], s[5 * 33]); o.w = pk2(s[6 * 33], s[7 * 33]);
        *(GAS u32x4*)(WT + (size_t)(n0 + n) * K + k0 + 8 * c) = o; }
    LDS_WAIT();
}
__device__ __forceinline__ void transpose_item8(const float* W, int K, int N, unsigned char* WT, float sc, LAS float* scr, int item, int lane) {
    const int nblk = N / 32, kb = item / nblk, nb = item % nblk, k0 = 64 * kb, n0 = 32 * nb;
    float wv_[32];
#pragma unroll
    for (int i = 0; i < 32; ++i) { const int kk = 2 * i + (lane >> 5); wv_[i] = W[(size_t)(k0 + kk) * N + n0 + (lane & 31)]; }
#pragma unroll
    for (int i = 0; i < 32; ++i) { const int kk = 2 * i + (lane >> 5); scr[kk * 33 + (lane & 31)] = wv_[i]; }
    LDS_WAIT();
    const int c = lane & 7;
#pragma unroll
    for (int j = 0; j < 4; ++j) { const int n = (lane >> 3) + 8 * j; const LAS float* s = scr + (8 * c) * 33 + n;
        u32x2 o; o.x = cvt4_fp8(s[0 * 33] * sc, s[1 * 33] * sc, s[2 * 33] * sc, s[3 * 33] * sc); o.y = cvt4_fp8(s[4 * 33] * sc, s[5 * 33] * sc, s[6 * 33] * sc, s[7 * 33] * sc);
        *(GAS u32x2*)(WT + (size_t)(n0 + n) * K + k0 + 8 * c) = o; }
    LDS_WAIT();
}
__device__ __forceinline__ void phase_prep(const Args& a, LAS unsigned char* lds) {
    const int tid = tid_of(a.wv), lane = tid & 63, wave = tid >> 6;
    LAS float* scr = (LAS float*)(lds + wave * 16384);
    const int gw = blockIdx.x * 8 + wave, NGW = gridDim.x * 8;
    constexpr int I_IN = 16 * 61, I_QU = 4 * 24, I_KVU = 2 * 32, I_O = 16 * 32, I_1 = 16 * 64, I_2 = 16 * 32;
    constexpr int NITEMS = I_IN + I_QU + I_KVU + I_O + 32 * I_1 + 32 * I_2;
    const int nitems = gridDim.x == 256 ? I_IN + I_QU + I_KVU + I_O : NITEMS;
    for (int it = gw; it < nitems; it += NGW) {
        int r = it;
        if (r < I_IN) { transpose_item(a.in[I_WIN], 1024, DIN, (bf16_t*)(a.ws + WS_WIN), scr, r, lane); continue; } r -= I_IN;
        if (r < I_QU) { transpose_item8(a.in[I_WQUP], 256, 768, a.ws + WS_WQ, WQ_SCALE, scr, r, lane); continue; } r -= I_QU;
        if (r < I_KVU) { transpose_item8(a.in[I_WKVUP], 128, 1024, a.ws + WS_WKV, WKV_SCALE, scr, r, lane); continue; } r -= I_KVU;
        if (r < I_O) { transpose_item(a.in[I_WOUT], 1024, 1024, (bf16_t*)(a.ws + WS_WO), scr, r, lane); continue; } r -= I_O;
        if (r < 32 * I_1) { const int e = r / I_1; transpose_item8(a.in[I_W1] + (size_t)e * 1024 * 2048, 1024, 2048, a.ws + WS_W1 + (size_t)e * 2048 * 1024, WSCALE, scr, r % I_1, lane); continue; } r -= 32 * I_1;
        { const int e = r / I_2; transpose_item8(a.in[I_W2] + (size_t)e * 1024 * 1024, 1024, 1024, a.ws + WS_W2 + (size_t)e * 1024 * 1024, WSCALE, scr, r % I_2, lane); }
    }
    const int gt = blockIdx.x * 512 + tid, NGT = gridDim.x * 512;
    for (int i = gt; i < 96 * 1024 / 8; i += NGT) *(GAS u32x4*)((bf16_t*)(a.ws + WS_WIN) + (size_t)DIN * 1024 + (size_t)i * 8) = (u32x4){0u, 0u, 0u, 0u};
    for (int i = gt; i < 32 * 1024; i += NGT) { const int n = i >> 10, k = i & 1023; const float w = a.in[I_WR][k * 32 + n]; const unsigned h = f2bf(w);
        bf16_t* wr = (bf16_t*)(a.ws + WS_WR); wr[i] = (bf16_t)h; wr[32768 + i] = (bf16_t)f2bf(w - bf2f((bf16_t)h)); }
    {
        float* prm = (float*)(a.ws + WS_PRM);
        for (int i = gt; i < PRM_END; i += NGT) {
            float v;
            if (i < PRM_GKVL) v = a.in[I_GQL][i - PRM_GQL]; else if (i < PRM_GQH) v = a.in[I_GKVL][i - PRM_GKVL]; else if (i < PRM_GKH) v = a.in[I_GQH][i - PRM_GQH];
            else if (i < PRM_DECAY) v = a.in[I_GKH][i - PRM_GKH]; else if (i < PRM_GRET) v = a.in[I_DECAY][i - PRM_DECAY]; else if (i < PRM_BR) v = a.in[I_GRET][i - PRM_GRET];
            else if (i < PRM_GFFN) v = a.in[I_BR][i - PRM_BR]; else if (i < PRM_B1) v = a.in[I_GFFN][i - PRM_GFFN]; else if (i < PRM_B2) v = a.in[I_B1][i - PRM_B1]; else v = a.in[I_B2][i - PRM_B2];
            prm[i] = v;
        }
    }
    const float* mod = (const float*)(a.ws + WS_MOD); const float* g = a.in[I_GATTN];
    for (int m = gw; m < TA; m += NGW) {
        const float* xr; int mv;
        if (m < T) { xr = a.in[I_X] + (size_t)m * DM; mv = m >> 13; } else { xr = a.in[I_CTX] + (size_t)(m - T) * DM; mv = 4; }
        const float* sh = mod + mv * 6144; const float* sc = sh + 1024;
        f32x4 v[4]; float ss = 0.f;
#pragma unroll
        for (int j = 0; j < 4; ++j) { v[j] = *(const GAS f32x4*)(xr + j * 256 + lane * 4); ss += (v[j].x * v[j].x + v[j].y * v[j].y) + (v[j].z * v[j].z + v[j].w * v[j].w); }
        const float rstd = rsqrtf(wave_sum(ss) * (1.f / DM) + EPS);
        bf16_t* hr = (bf16_t*)(a.ws + WS_H) + (size_t)m * DM;
#pragma unroll
        for (int j = 0; j < 4; ++j) { const int c = j * 256 + lane * 4; const f32x4 gg = *(const GAS f32x4*)(g + c), s1 = *(const GAS f32x4*)(sc + c), s0 = *(const GAS f32x4*)(sh + c);
            const f32x4 o = (v[j] * rstd * gg) * (s1 + 1.f) + s0; u32x2 w; w.x = pk2(o.x, o.y); w.y = pk2(o.z, o.w); *(GAS u32x2*)(hr + c) = w; }
    }
}

#define MOE_ITEM(it_, P_, D_, N_) do { constexpr int I_1 = 16 * 64, I_2 = 16 * 32; \
    const bool up_ = (it_) < 32 * I_1; const int r_ = up_ ? (it_) : (it_) - 32 * I_1; N_ = up_ ? 2048 : 1024; const int per_ = up_ ? I_1 : I_2, e_ = r_ / per_, item_ = r_ % per_; \
    const int nblk_ = N_ / 32, kb_ = item_ / nblk_, nb_ = item_ % nblk_, k0_ = 64 * kb_, n0_ = 32 * nb_; \
    P_ = (up_ ? a.in[I_W1] : a.in[I_W2]) + (size_t)e_ * 1024 * N_ + (size_t)(k0_ + (lane >> 5)) * N_ + n0_ + (lane & 31); \
    D_ = a.ws + (up_ ? WS_W1 : WS_W2) + (size_t)e_ * N_ * 1024 + (size_t)n0_ * 1024 + k0_; } while (0)
__device__ __forceinline__ void moe_convert(const Args& a, LAS unsigned char* lds, int cu) {
    const int tid = tid_of(a.wv), lane = tid & 63, wave = tid >> 6;
    LAS float* scr = (LAS float*)(lds + wave * 16384);
    constexpr int NIT = 32 * (16 * 64 + 16 * 32);
    __syncthreads();
    float wc[32], wn[32];
    int it = cu * 8 + wave;
    const float* pc; unsigned char* dc; int nc;
    MOE_ITEM(it, pc, dc, nc);
#pragma unroll
    for (int i = 0; i < 32; ++i) wc[i] = pc[(size_t)(2 * i) * nc];
#pragma unroll 1
    while (it < NIT) {
        const int itn = it + 256 * 8; const bool more = itn < NIT;
        const float* pn; unsigned char* dn; int nn; const int itx = more ? itn : it;
        MOE_ITEM(itx, pn, dn, nn);
        if (more) {
#pragma unroll
            for (int i = 0; i < 32; ++i) wn[i] = pn[(size_t)(2 * i) * nn]; }
#pragma unroll
        for (int i = 0; i < 32; ++i) { const int kk = 2 * i + (lane >> 5); scr[kk * 33 + (lane & 31)] = wc[i]; }
        LDS_WAIT();
        const int c = lane & 7;
#pragma unroll
        for (int j = 0; j < 4; ++j) { const int n = (lane >> 3) + 8 * j; const LAS float* s_ = scr + (8 * c) * 33 + n;
            u32x2 o; o.x = cvt4_fp8(s_[0 * 33] * WSCALE, s_[1 * 33] * WSCALE, s_[2 * 33] * WSCALE, s_[3 * 33] * WSCALE); o.y = cvt4_fp8(s_[4 * 33] * WSCALE, s_[5 * 33] * WSCALE, s_[6 * 33] * WSCALE, s_[7 * 33] * WSCALE);
            *(GAS u32x2*)(dc + (size_t)n * 1024 + 8 * c) = o; }
        LDS_WAIT();
#pragma unroll
        for (int i = 0; i < 32; ++i) wc[i] = wn[i];
        dc = dn; it = itn;
    }
    __syncthreads();
}
#undef MOE_ITEM

struct GUnit { const bf16_t* Bt; int m0, n0, nvalid, e; };
template <class RowFn, class Epi>
__device__ __forceinline__ void gemm_tile(LAS unsigned char* lds, const bf16_t* A, int K, const GUnit& u, const RowFn& rowfn, const Epi& epi) {
    LAS bf16_t* sA = (LAS bf16_t*)lds;
    LAS bf16_t* sB = (LAS bf16_t*)(lds + 256 * 72 * 2);
    const int tid = opaque((int)threadIdx.x), lane = tid & 63, wave = tid >> 6, wm = wave >> 1, wn = wave & 1;
    const int ch = tid & 7, r0 = tid >> 3;
    const bf16_t* ap[4]; const bf16_t* bp[2];
#pragma unroll
    for (int i = 0; i < 4; ++i) { const int r = r0 + 64 * i; const int rr = r < u.nvalid ? r : 0; ap[i] = A + (size_t)rowfn(u, rr) * K + ch * 8; }
#pragma unroll
    for (int i = 0; i < 2; ++i) bp[i] = u.Bt + (size_t)(r0 + 64 * i) * K + ch * 8;
    f32x4 acc[4][4];
#pragma unroll
    for (int i = 0; i < 4; ++i)
#pragma unroll
        for (int j = 0; j < 4; ++j) acc[i][j] = (f32x4){0.f, 0.f, 0.f, 0.f};
    u32x4 ra[4], rb[2];
#pragma unroll
    for (int i = 0; i < 4; ++i) ra[i] = *(const GAS u32x4*)(ap[i]);
#pragma unroll
    for (int i = 0; i < 2; ++i) rb[i] = *(const GAS u32x4*)(bp[i]);
    const int nk = K / 64;
    for (int kt = 0; kt < nk; ++kt) {
        __syncthreads();
#pragma unroll
        for (int i = 0; i < 4; ++i) *(LAS u32x4*)(sA + (r0 + 64 * i) * 72 + ch * 8) = ra[i];
#pragma unroll
        for (int i = 0; i < 2; ++i) *(LAS u32x4*)(sB + (r0 + 64 * i) * 72 + ch * 8) = rb[i];
        __syncthreads();
        if (kt + 1 < nk) {
#pragma unroll
            for (int i = 0; i < 4; ++i) ra[i] = *(const GAS u32x4*)(ap[i] + (kt + 1) * 64);
#pragma unroll
            for (int i = 0; i < 2; ++i) rb[i] = *(const GAS u32x4*)(bp[i] + (kt + 1) * 64);
        }
        mma_ll<4, 4, true>(acc, sA, 72, wm * 64, sB, 72, wn * 64, 64, lane);
    }
    epi(acc, u, wm, wn, lane);
}
struct RowDense { __device__ __forceinline__ int operator()(const GUnit& u, int r) const { return u.m0 + r; } };
struct RowPairTok { const unsigned* list; __device__ __forceinline__ int operator()(const GUnit& u, int r) const { return (int)(list[(size_t)u.e * 32768 + u.m0 + r] >> 2); } };
struct RowPair { const unsigned* list; __device__ __forceinline__ int operator()(const GUnit& u, int r) const { return (int)list[(size_t)u.e * 32768 + u.m0 + r]; } };

struct EpiP { bf16_t* P;
    __device__ __forceinline__ void operator()(const f32x4 (&acc)[4][4], const GUnit& u, int wm, int wn, int lane) const {
        const int fr = lane & 15, fq = lane >> 4;
#pragma unroll
        for (int i = 0; i < 4; ++i) { const int row = u.m0 + wm * 64 + 16 * i + fr;
#pragma unroll
            for (int j = 0; j < 4; ++j) { const int col = u.n0 + wn * 64 + 16 * j + 4 * fq; u32x2 w; w.x = pk2(acc[i][j][0], acc[i][j][1]); w.y = pk2(acc[i][j][2], acc[i][j][3]);
                *(GAS u32x2*)(P + (size_t)row * DINP + col) = w; } }
    } };
struct EpiOut { const float* x; const float* mod; float* out;
    __device__ __forceinline__ void operator()(const f32x4 (&acc)[4][4], const GUnit& u, int wm, int wn, int lane) const {
        const int fr = lane & 15, fq = lane >> 4;
#pragma unroll
        for (int i = 0; i < 4; ++i) { const int row = u.m0 + wm * 64 + 16 * i + fr; const float* gate = mod + (row >> 13) * 6144 + 2 * 1024;
#pragma unroll
            for (int j = 0; j < 4; ++j) { const int col = u.n0 + wn * 64 + 16 * j + 4 * fq;
                const f32x4 xv = *(const GAS f32x4*)(x + (size_t)row * DM + col), gv = *(const GAS f32x4*)(gate + col);
                *(GAS f32x4*)(out + (size_t)row * DM + col) = xv + gv * acc[i][j]; } }
    } };
struct EpiM1 { const unsigned* list; const float* b1; bf16_t* act;
    __device__ __forceinline__ void operator()(const f32x4 (&acc)[4][4], const GUnit& u, int wm, int wn, int lane) const {
        const int fr = lane & 15, fq = lane >> 4;
#pragma unroll
        for (int i = 0; i < 4; ++i) { const int r = wm * 64 + 16 * i + fr; if (r >= u.nvalid) continue;
            const unsigned pair = list[(size_t)u.e * 32768 + u.m0 + r];
#pragma unroll
            for (int j = 0; j < 4; ++j) { const int col = u.n0 + wn * 64 + 16 * j + 4 * fq; const f32x4 bv = *(const GAS f32x4*)(b1 + (size_t)u.e * 2048 + col);
                const f32x4 v = acc[i][j] + bv;
                const float g0 = fminf(v[0], 7.f), l0 = fminf(fmaxf(v[1], -7.f), 7.f), g1 = fminf(v[2], 7.f), l1 = fminf(fmaxf(v[3], -7.f), 7.f);
                const float a0 = g0 / (1.f + __expf(-1.702f * g0)) * (l0 + 1.f), a1 = g1 / (1.f + __expf(-1.702f * g1)) * (l1 + 1.f);
                *(GAS unsigned*)(act + (size_t)pair * DFF + (col >> 1)) = pk2(a0, a1); } }
    } };
struct EpiM2 { const unsigned* list; const float* b2; const float* pg; bf16_t* y;
    __device__ __forceinline__ void operator()(const f32x4 (&acc)[4][4], const GUnit& u, int wm, int wn, int lane) const {
        const int fr = lane & 15, fq = lane >> 4;
#pragma unroll
        for (int i = 0; i < 4; ++i) { const int r = wm * 64 + 16 * i + fr; if (r >= u.nvalid) continue;
            const unsigned pair = list[(size_t)u.e * 32768 + u.m0 + r]; const float g = pg[pair];
#pragma unroll
            for (int j = 0; j < 4; ++j) { const int col = u.n0 + wn * 64 + 16 * j + 4 * fq; const f32x4 bv = *(const GAS f32x4*)(b2 + (size_t)u.e * 1024 + col);
                const f32x4 v = (acc[i][j] + bv) * g; u32x2 w; w.x = pk2(v[0], v[1]); w.y = pk2(v[2], v[3]);
                *(GAS u32x2*)(y + (size_t)pair * DM + col) = w; } }
    } };

namespace pg8 {
constexpr int BM = 256, BK = 64, HALF = 128, HTB = HALF * BK * 2, STAGE_BYTES = 8 * HTB, NXCD = 8, WGM = 8;
__host__ __device__ __forceinline__ int lds_byte(int r, int c) { const int st = (r >> 4) * 2 + (c >> 5), rr = r & 15, cc = c & 31, ob = rr * 64 + cc * 2; return st * 1024 + (ob ^ (((ob >> 9) & 1) << 5)); }
__host__ __device__ __forceinline__ void stage_rc(int b, int& R, int& C) { const int st = b / 1024, sb = b % 1024, swz = sb ^ (((sb >> 9) & 1) << 5); R = (st >> 1) * 16 + swz / 64; C = (st & 1) * 32 + (swz % 64) / 2; }
__host__ __device__ __forceinline__ int perm32(int rho) { const int n = rho >> 4, i = rho & 15; return 8 * (i >> 2) + 4 * n + (i & 3); }
struct Unit { int pm, pn; const char* A; const char* B; int e, nvalid, ul; };
struct DenseOrder {
    int nM, nN, nwg, G, c; const char* A; const char* B; size_t tstep;
    __device__ void init(const void* A_, const void* B_, int M, int N, int K, int G_, int c_) { nM = M / BM; nN = N / BM; nwg = nM * nN; G = G_; c = c_; A = (const char*)A_; B = (const char*)B_; tstep = (size_t)BM * K * 2; }
    __device__ bool next(int i, Unit& u) const {
        const long L = (long)i * G + c; if (L >= nwg) return false;
        int wgid = (int)L; { const int q = nwg / NXCD, r = nwg % NXCD, xcd = wgid % NXCD, off = wgid / NXCD; wgid = (xcd < r ? xcd * (q + 1) : r * (q + 1) + (xcd - r) * q) + off; }
        const int nig = WGM * nN, gid = wgid / nig, fm = gid * WGM, gsz = (nM - fm) < WGM ? (nM - fm) : WGM;
        u.pm = fm + ((wgid % nig) % gsz); u.pn = (wgid % nig) / gsz; u.A = A + (size_t)u.pm * tstep; u.B = B + (size_t)u.pn * tstep; u.e = 0; u.nvalid = 256; u.ul = 0; return true;
    }
};
template <int NCT> struct ExpertOrder {
    const LAS int* pre; int G, c; const char* A; const char* W; size_t wstride; int rowbytes;
    __device__ bool next(int i, Unit& u) const {
        const int L = i * G + c; const int nunit = pre[32] * NCT; if (L >= nunit) return false;
        const int ti = L / NCT; u.pn = L % NCT; int e = 0;
        for (int k = 1; k < 32; ++k) if (pre[k] <= ti) e = k;
        u.pm = ti - pre[e]; u.e = e; const int cnt = pre[33 + e]; u.nvalid = (cnt - u.pm * 256) < 256 ? (cnt - u.pm * 256) : 256; u.ul = i;
        u.A = A; u.B = W + (size_t)e * wstride + (size_t)u.pn * 256 * rowbytes; return true;
    }
};
__device__ __forceinline__ unsigned cvt_pk_bf16(float lo, float hi) { unsigned r; asm volatile("v_cvt_pk_bf16_f32 %0, %1, %2" : "=v"(r) : "v"(lo), "v"(hi)); return r; }
typedef int i32x4 __attribute__((ext_vector_type(4))); typedef int i32x8 __attribute__((ext_vector_type(8)));
__device__ __forceinline__ bf16x8 lo8(i32x8 v) { return __builtin_bit_cast(bf16x8, (i32x4)__builtin_shufflevector(v, v, 0, 1, 2, 3)); }
__device__ __forceinline__ bf16x8 hi8(i32x8 v) { return __builtin_bit_cast(bf16x8, (i32x4)__builtin_shufflevector(v, v, 4, 5, 6, 7)); }

template <class Epi, class Sched, bool GATHER, bool FP8 = false>
__device__ __forceinline__ void gemm_phase(LAS unsigned char* lds, const LAS int* tab, const LAS bf16_t* aux, int ashift, int K, const Sched& S, const Epi& E, int wv) {
    const int tid = tid_of(wv), wid = wv, lane = tid & 63, wr = wid >> 2, wc = wid & 3, fr = lane & 15, fq = lane >> 4;
    const int nt = K / BK;
    unsigned voffA[2], voffB[2]; unsigned cb0 = 0; int rg0 = 0;
#pragma unroll
    for (int i = 0; i < 2; ++i) { int R, C; stage_rc(tid * 16 + i * 8192, R, C); const int Rb = (R & ~31) + perm32(R & 31);
        voffA[i] = (unsigned)(R * K + C) * 2u; voffB[i] = (unsigned)(Rb * K + C) * 2u; if (i == 0) { cb0 = (unsigned)C * 2u; rg0 = R; } }
    const size_t kstep = (size_t)(BK * 2);
    const size_t hstep = (size_t)HALF * K * 2;
    const size_t hstepA = GATHER ? 0 : hstep;
    const unsigned ldsw = (unsigned)wid * 1024u;
    const int aoff = lds_byte(wr * 64 + fr, fq * 8), boff = lds_byte(wc * 32 + fr, fq * 8);
    int cul = 0, nul = 0;
#define PG8_SA(b, h) (((b) * 2 + (h)) * HTB)
#define PG8_SB(b, h) ((4 + (b) * 2 + (h)) * HTB)
#define PG8_STAGE(bufoff, gbase, voff) do { _Pragma("unroll") for (int _i = 0; _i < 2; ++_i) \
        __builtin_amdgcn_global_load_lds((const unsigned*)((const char*)(gbase) + (voff)[_i]), (LAS unsigned*)(lds + (bufoff) + ldsw + _i * 8192), 16, 0, 0); } while (0)
#define PG8_STAGE_A(bufoff, gbase, h, usenext) do { const int ulx_ = (usenext) ? nul : cul; _Pragma("unroll") for (int _i = 0; _i < 2; ++_i) { \
        unsigned vo_; if constexpr (GATHER) vo_ = (unsigned)(tab[ulx_ * 256 + (h) * 128 + rg0 + 64 * _i] >> ashift) * (unsigned)(K * 2) + cb0; else vo_ = voffA[_i]; \
        __builtin_amdgcn_global_load_lds((const unsigned*)((const char*)(gbase) + (h) * hstepA + vo_), (LAS unsigned*)(lds + (bufoff) + ldsw + _i * 8192), 16, 0, 0); } } while (0)
#define PG8_LDA(dst, b, h) do { _Pragma("unroll") for (int m = 0; m < 4; ++m) { const i32x4 lo_ = *(const LAS i32x4*)(lds + PG8_SA(b, h) + aoff + m * 2048), hi_ = *(const LAS i32x4*)(lds + PG8_SA(b, h) + aoff + m * 2048 + 1024); \
        dst[m] = __builtin_shufflevector(lo_, hi_, 0, 1, 2, 3, 4, 5, 6, 7); } } while (0)
#define PG8_LDB(dst, b, h) do { _Pragma("unroll") for (int n = 0; n < 2; ++n) { const i32x4 lo_ = *(const LAS i32x4*)(lds + PG8_SB(b, h) + boff + n * 2048), hi_ = *(const LAS i32x4*)(lds + PG8_SB(b, h) + boff + n * 2048 + 1024); \
        dst[n] = __builtin_shufflevector(lo_, hi_, 0, 1, 2, 3, 4, 5, 6, 7); } } while (0)
#define PG8_MMA(ai, bj, At, Bt) do { __builtin_amdgcn_s_setprio(1); _Pragma("unroll") for (int m = 0; m < 4; ++m) _Pragma("unroll") for (int n = 0; n < 2; ++n) { \
        if constexpr (FP8) { asm("v_mfma_f32_16x16x128_f8f6f4 %0, %1, %2, %0" : "+v"(acc[ai][bj][m][n]) : "v"(Bt[n]), "v"(At[m])); } \
        else { acc[ai][bj][m][n] = __builtin_amdgcn_mfma_f32_16x16x32_bf16(lo8(Bt[n]), lo8(At[m]), acc[ai][bj][m][n], 0, 0, 0); \
               acc[ai][bj][m][n] = __builtin_amdgcn_mfma_f32_16x16x32_bf16(hi8(Bt[n]), hi8(At[m]), acc[ai][bj][m][n], 0, 0, 0); } } \
        __builtin_amdgcn_s_setprio(0); } while (0)
#define PG8_WAIT_V(n) asm volatile("s_waitcnt vmcnt(" #n ")" ::: "memory")
#define PG8_WAIT_L(n) asm volatile("s_waitcnt lgkmcnt(" #n ")" ::: "memory")
#define PG8_BAR __builtin_amdgcn_s_barrier()
#define PG8_SCHED __builtin_amdgcn_sched_barrier(0)
    Unit cur, nxt; int ui = 0;
    if (!S.next(0, cur)) return;
    cul = cur.ul; nul = cur.ul;
    f32x4 acc[2][2][4][2];
#pragma unroll
    for (int a = 0; a < 2; ++a)
#pragma unroll
        for (int b = 0; b < 2; ++b)
#pragma unroll
            for (int m = 0; m < 4; ++m)
#pragma unroll
                for (int n = 0; n < 2; ++n) acc[a][b][m][n] = (f32x4){0.f, 0.f, 0.f, 0.f};
    i32x8 At[4], B0[2], B1[2];
    const char* cA = cur.A; const char* cB = cur.B;
    PG8_STAGE(PG8_SB(0, 0), cB, voffB); PG8_STAGE(PG8_SB(0, 1), cB + hstep, voffB); PG8_STAGE_A(PG8_SA(0, 0), cA, 0, false); PG8_STAGE_A(PG8_SA(0, 1), cA, 1, false);
    if (wr == 1) PG8_BAR;
    PG8_WAIT_V(2); PG8_BAR;
    PG8_STAGE(PG8_SB(1, 0), cB + kstep, voffB); PG8_STAGE_A(PG8_SA(1, 0), cA + kstep, 0, false); PG8_STAGE(PG8_SB(1, 1), cB + hstep + kstep, voffB);
    PG8_WAIT_V(6); PG8_BAR;
    for (;;) {
        const bool has_next = S.next(ui + 1, nxt);
        const char* nA = has_next ? nxt.A : cA; const char* nB = has_next ? nxt.B : cB;
        nul = has_next ? nxt.ul : cur.ul;
#if DIAG >= 10
        long long tk0_ = 0; if (DIAG == 10 + Epi::ID && ui == 0) tk0_ = (long long)__builtin_amdgcn_s_memtime();
        if (DIAG == 20 + Epi::ID && ui <= 1) { const long long tn_ = (long long)__builtin_amdgcn_s_memtime();
            if (ui == 0) { if (blockIdx.x == 0 && tid == 0) { ((volatile LAS unsigned*)(lds + 159744))[41] = (unsigned)tn_; } }
            else if (blockIdx.x == 0 && tid == 0) { const unsigned d_ = (unsigned)tn_ - ((volatile LAS unsigned*)(lds + 159744))[41]; const float q = rintf((float)d_ * (1.f / 1000.f));
                ((volatile LAS unsigned*)(lds + 159744))[40] = __float_as_uint(q * 1e-5f); } }
#endif
#pragma unroll 1
        for (int t = 0; t < nt; t += 2) {
            const bool last = (t == nt - 2);
            const char* a1 = cA + (size_t)(t + 1) * kstep;
            const char* a2 = last ? nA : cA + (size_t)(t + 2) * kstep; const char* b2 = last ? nB : cB + (size_t)(t + 2) * kstep;
            const char* a3 = a2 + kstep; const char* b3 = b2 + kstep;
            PG8_LDB(B0, 0, 0); PG8_LDB(B1, 0, 1); PG8_SCHED; PG8_LDA(At, 0, 0); PG8_STAGE_A(PG8_SA(1, 1), a1, 1, false);
            PG8_WAIT_V(8); PG8_WAIT_L(0); PG8_BAR; PG8_MMA(0, 0, At, B0); PG8_MMA(0, 1, At, B1); PG8_BAR; PG8_SCHED;
            PG8_LDA(At, 0, 1); PG8_STAGE(PG8_SB(0, 0), b2, voffB); PG8_STAGE(PG8_SB(0, 1), b2 + hstep, voffB); PG8_STAGE_A(PG8_SA(0, 0), a2, 0, last);
            PG8_WAIT_V(8); PG8_WAIT_L(0); PG8_BAR; PG8_MMA(1, 0, At, B0); PG8_MMA(1, 1, At, B1); PG8_BAR; PG8_SCHED;
            PG8_LDB(B0, 1, 0); PG8_LDB(B1, 1, 1); PG8_SCHED; PG8_LDA(At, 1, 0); PG8_STAGE_A(PG8_SA(0, 1), a2, 1, last);
            PG8_WAIT_V(8); PG8_WAIT_L(0); PG8_BAR; PG8_MMA(0, 0, At, B0); PG8_MMA(0, 1, At, B1); PG8_BAR; PG8_SCHED;
            PG8_LDA(At, 1, 1); PG8_STAGE(PG8_SB(1, 0), b3, voffB); PG8_STAGE(PG8_SB(1, 1), b3 + hstep, voffB); PG8_STAGE_A(PG8_SA(1, 0), a3, 0, last);
            PG8_WAIT_V(8); PG8_WAIT_L(0); PG8_BAR; PG8_MMA(1, 0, At, B0); PG8_MMA(1, 1, At, B1); PG8_BAR; PG8_SCHED;
        }
#if DIAG >= 10
        if (DIAG == 10 + Epi::ID && ui == 0) { const long long tk1_ = (long long)__builtin_amdgcn_s_memtime();
            if (blockIdx.x == 0 && tid == 0) { const float perk = (float)(tk1_ - tk0_) / (float)nt; const float q = rintf(perk * (1.f / 250.f));
                ((volatile LAS unsigned*)(lds + 159744))[40] = __float_as_uint(q * 2e-5f); } }
#endif
        if (wr == 0) PG8_BAR;
        if constexpr (FP8) asm volatile("s_nop 15\n\ts_nop 7" ::: "memory");
        E(acc, cur, tab, aux, wr, wc, fr, fq);
        if (!has_next) break;
#pragma unroll
        for (int a = 0; a < 2; ++a)
#pragma unroll
            for (int b = 0; b < 2; ++b)
#pragma unroll
                for (int m = 0; m < 4; ++m)
#pragma unroll
                    for (int n = 0; n < 2; ++n) acc[a][b][m][n] = (f32x4){0.f, 0.f, 0.f, 0.f};
        cur = nxt; cA = nA; cB = nB; ++ui;
        cul = cur.ul;
        if (wr == 1) PG8_BAR;
    }
    PG8_WAIT_V(0);
    PG8_BAR;
#undef PG8_SA
#undef PG8_SB
#undef PG8_STAGE
#undef PG8_STAGE_A
#undef PG8_LDA
#undef PG8_LDB
#undef PG8_MMA
#undef PG8_WAIT_V
#undef PG8_WAIT_L
#undef PG8_BAR
#undef PG8_SCHED
}

struct EpiP { static constexpr int ID = 2; bf16_t* P;
    __device__ __forceinline__ void operator()(const f32x4 (&acc)[2][2][4][2], const Unit& u, const LAS int*, const LAS bf16_t*, int wr, int wc, int fr, int fq) const {
        const int row0 = u.pm * BM + wr * 64 + fr, col0 = u.pn * BM + wc * 32 + 8 * fq;
#pragma unroll
        for (int ai = 0; ai < 2; ++ai)
#pragma unroll
            for (int m = 0; m < 4; ++m) { bf16_t* rowp = P + (size_t)(row0 + ai * HALF + m * 16) * DINP + col0;
#pragma unroll
                for (int bj = 0; bj < 2; ++bj) { const f32x4 v0 = acc[ai][bj][m][0], v1 = acc[ai][bj][m][1]; u32x4 w;
                    w.x = cvt_pk_bf16(v0[0], v0[1]); w.y = cvt_pk_bf16(v0[2], v0[3]); w.z = cvt_pk_bf16(v1[0], v1[1]); w.w = cvt_pk_bf16(v1[2], v1[3]);
                    *(GAS u32x4*)(rowp + bj * HALF) = w; } }
    } };
struct EpiOut { static constexpr int ID = 6; const float* x; const float* mod; float* out;
    __device__ __forceinline__ void operator()(const f32x4 (&acc)[2][2][4][2], const Unit& u, const LAS int*, const LAS bf16_t*, int wr, int wc, int fr, int fq) const {
        const int row0 = u.pm * BM + wr * 64 + fr, col0 = u.pn * BM + wc * 32 + 8 * fq;
        const float* gate = mod + (row0 >> 13) * 6144 + 2 * 1024;
#pragma unroll
        for (int bj = 0; bj < 2; ++bj) { const f32x4 g0 = *(const GAS f32x4*)(gate + col0 + bj * HALF), g1 = *(const GAS f32x4*)(gate + col0 + bj * HALF + 4);
#pragma unroll
            for (int ai = 0; ai < 2; ++ai)
#pragma unroll
                for (int m = 0; m < 4; ++m) { const size_t off = (size_t)(row0 + ai * HALF + m * 16) * DM + col0 + bj * HALF;
                    const f32x4 x0 = *(const GAS f32x4*)(x + off), x1 = *(const GAS f32x4*)(x + off + 4);
                    *(GAS f32x4*)(out + off) = x0 + g0 * acc[ai][bj][m][0]; *(GAS f32x4*)(out + off + 4) = x1 + g1 * acc[ai][bj][m][1]; } }
    } };
struct EpiM1 { static constexpr int ID = 8; unsigned char* act;
    __device__ __forceinline__ void operator()(const f32x4 (&acc)[2][2][4][2], const Unit& u, const LAS int* tab, const LAS bf16_t* aux, int wr, int wc, int fr, int fq) const {
        const int cl = wc * 32 + 8 * fq, col0 = u.pn * BM + cl;
        f32x4 bv[2][2];
#pragma unroll
        for (int bj = 0; bj < 2; ++bj) { const u32x4 w = *(const LAS u32x4*)(aux + u.ul * 256 + bj * HALF + cl);
            bv[bj][0] = (f32x4){lo16(w[0]), hi16(w[0]), lo16(w[1]), hi16(w[1])}; bv[bj][1] = (f32x4){lo16(w[2]), hi16(w[2]), lo16(w[3]), hi16(w[3])}; }
#pragma unroll
        for (int ai = 0; ai < 2; ++ai)
#pragma unroll
            for (int m = 0; m < 4; ++m) { const int r = ai * HALF + wr * 64 + m * 16 + fr; const bool ok = r < u.nvalid;
                const int pair = tab[u.ul * 256 + r]; unsigned char* rowp = act + (size_t)pair * DFF + (col0 >> 1);
#pragma unroll
                for (int bj = 0; bj < 2; ++bj) { float o[4];
#pragma unroll
                    for (int n = 0; n < 2; ++n) { const f32x4 v = acc[ai][bj][m][n] * WINV + bv[bj][n];
                        const float g0 = fminf(v[0], 7.f), l0 = fminf(fmaxf(v[1], -7.f), 7.f), g1 = fminf(v[2], 7.f), l1 = fminf(fmaxf(v[3], -7.f), 7.f);
                        o[2 * n] = g0 * __builtin_amdgcn_rcpf(1.f + __builtin_amdgcn_exp2f(-2.4554669595930156f * g0)) * (l0 + 1.f);
                        o[2 * n + 1] = g1 * __builtin_amdgcn_rcpf(1.f + __builtin_amdgcn_exp2f(-2.4554669595930156f * g1)) * (l1 + 1.f); }
                    const unsigned w = cvt4_fp8(o[0], o[1], o[2], o[3]); if (ok) *(GAS unsigned*)(rowp + bj * (HALF / 2)) = w; } }
    } };
constexpr float YSCALE = 8.f, YINV = 1.f / 8.f;
struct EpiM2 { static constexpr int ID = 9; unsigned char* y;
    __device__ __forceinline__ void operator()(const f32x4 (&acc)[2][2][4][2], const Unit& u, const LAS int* tab, const LAS bf16_t* aux, int wr, int wc, int fr, int fq) const {
        const int cl = wc * 32 + 8 * fq, col0 = u.pn * BM + cl;
        f32x4 bv[2][2];
#pragma unroll
        for (int bj = 0; bj < 2; ++bj) { const u32x4 w = *(const LAS u32x4*)(aux + u.ul * 256 + bj * HALF + cl);
            bv[bj][0] = (f32x4){lo16(w[0]), hi16(w[0]), lo16(w[1]), hi16(w[1])}; bv[bj][1] = (f32x4){lo16(w[2]), hi16(w[2]), lo16(w[3]), hi16(w[3])}; }
#pragma unroll
        for (int ai = 0; ai < 2; ++ai)
#pragma unroll
            for (int m = 0; m < 4; ++m) { const int r = ai * HALF + wr * 64 + m * 16 + fr; const bool ok = r < u.nvalid;
                const int pair = tab[u.ul * 256 + r]; const float g = bf2f(aux[9 * 256 + u.ul * 256 + r]) * YSCALE; unsigned char* rowp = y + (size_t)pair * DM + col0;
#pragma unroll
                for (int bj = 0; bj < 2; ++bj) { const f32x4 v0 = (acc[ai][bj][m][0] * WINV + bv[bj][0]) * g, v1 = (acc[ai][bj][m][1] * WINV + bv[bj][1]) * g; u32x2 w;
                    w.x = cvt4_fp8(v0[0], v0[1], v0[2], v0[3]); w.y = cvt4_fp8(v1[0], v1[1], v1[2], v1[3]);
                    if (ok) *(GAS u32x2*)(rowp + bj * HALF) = w; } }
    } };
}
constexpr int PG8_TAB_OFF = pg8::STAGE_BYTES;
constexpr int PG8_AUX_OFF = PG8_TAB_OFF + 18 * 1024;
constexpr int PG8_PRE_OFF = PG8_AUX_OFF + 9 * 1024;
static_assert(PG8_PRE_OFF + 512 <= LDS_SCRATCH, "LDS map");

template <int NCT, class Epi>
__device__ __forceinline__ void phase_moe_pg8(const Args& a, LAS unsigned char* lds, const unsigned char* A, int ashift, const unsigned char* Wt, size_t wstride, const float* bias, int nbias, const float* gates, const Epi& E) {
    LAS int* tab = (LAS int*)(lds + PG8_TAB_OFF); LAS int* pre = (LAS int*)(lds + PG8_PRE_OFF); LAS bf16_t* aux = (LAS bf16_t*)(lds + PG8_AUX_OFF);
    const unsigned* cnt = (const unsigned*)(a.ws + WS_CTL) + CW_CNT; const unsigned* list = (const unsigned*)(a.ws + WS_LIST);
    __syncthreads();
    const int tidm = tid_of(a.wv);
    if (tidm < NE) pre[33 + tidm] = (int)__hip_atomic_load(cnt + 64 * tidm, __ATOMIC_RELAXED, __HIP_MEMORY_SCOPE_AGENT);
    __syncthreads();
    if (tidm == 0) { int s = 0;
#pragma unroll 1
        for (int e = 0; e < NE; ++e) { const int c = pre[33 + e]; pre[e] = s; s += (c + 255) >> 8; } pre[32] = s; }
    __syncthreads();
    pg8::ExpertOrder<NCT> S{pre, (int)gridDim.x, (int)blockIdx.x, (const char*)A, (const char*)Wt, wstride, 1024};
    constexpr int NU = NCT == 8 ? 18 : 9; constexpr bool HASG = NCT == 4;
    const int nunit_ = pre[32] * NCT;
    unsigned val[NU]; float gv[NU];
#pragma unroll
    for (int i = 0; i < NU; ++i) { pg8::Unit u; val[i] = 0u;
        if (S.next(i, u)) { if (tidm < 256) val[i] = list[(size_t)u.e * 32768 + u.pm * 256 + (tidm < u.nvalid ? tidm : 0)]; else val[i] = __float_as_uint(bias[(size_t)u.e * nbias + u.pn * 256 + tidm - 256]); } }
#pragma unroll
    for (int i = 0; i < NU; ++i) { gv[i] = 0.f; if (HASG && tidm < 256 && i * (int)gridDim.x + (int)blockIdx.x < nunit_) gv[i] = gates[val[i]]; }
#pragma unroll
    for (int i = 0; i < NU; ++i) if (i * (int)gridDim.x + (int)blockIdx.x < nunit_) {
        if (tidm < 256) { tab[i * 256 + tidm] = (int)val[i]; if (HASG) aux[9 * 256 + i * 256 + tidm] = (bf16_t)f2bf(gv[i]); }
        else aux[i * 256 + tidm - 256] = (bf16_t)f2bf(__uint_as_float(val[i])); }
    __syncthreads();
    pg8::gemm_phase<Epi, pg8::ExpertOrder<NCT>, true, true>(lds, tab, aux, ashift, 512, S, E, a.wv);
}

__device__ __forceinline__ void mla_tile(const Args& a, LAS unsigned char* lds, int tile, int r0 = 0, int nrows = 128) {
    const int tid = tid_of(a.wv), lane = tid & 63, wave = a.wv, fr = lane & 15, fq = lane >> 4;
    const bool lat = tile < 256;
    const int prow0 = tile * 128;
    const int b = lat ? (prow0 >> 13) : ((prow0 - T) >> 8);
    const int tpos0 = lat ? (prow0 & 8191) : ((prow0 - T) & 255);
    const int key0 = lat ? (LC + tpos0) : tpos0;
    LAS unsigned char* Aq = lds;
    LAS unsigned char* Akv = lds + 34816;
    LAS float* kpe = (LAS float*)(lds + 34816 + 18432);
    LAS float* sspe = (LAS float*)(lds + 34816 + 18432 + 16384);
    const bf16_t* P = (const bf16_t*)(a.ws + WS_P);
    const float* tabm = (const float*)(a.ws + WS_TABM);
    __syncthreads();
    if ((tid >> 2) >= r0 && (tid >> 2) < r0 + nrows) {
        const int r = tid >> 2, part = tid & 3;
        const bf16_t* pr = P + (size_t)(prow0 + r) * DINP;
        u32x4 q[8]; float ss = 0.f;
#pragma unroll
        for (int i = 0; i < 8; ++i) { q[i] = *(const GAS u32x4*)(pr + OFF_Q + part * 64 + i * 8);
#pragma unroll
            for (int e = 0; e < 4; ++e) { const float lo = lo16(q[i][e]), hi = hi16(q[i][e]); ss += lo * lo + hi * hi; } }
        ss += __shfl_xor(ss, 1); ss += __shfl_xor(ss, 2);
        float rstd = rsqrtf(ss * (1.f / 256.f) + EPS);
        const float* gq = a.in[I_GQL] + part * 64;
#pragma unroll
        for (int i = 0; i < 8; ++i) { u32x2 o;
#pragma unroll
            for (int e = 0; e < 2; ++e) o[e] = cvt4_fp8(lo16(q[i][2 * e]) * rstd * gq[i * 8 + 4 * e], hi16(q[i][2 * e]) * rstd * gq[i * 8 + 4 * e + 1], lo16(q[i][2 * e + 1]) * rstd * gq[i * 8 + 4 * e + 2], hi16(q[i][2 * e + 1]) * rstd * gq[i * 8 + 4 * e + 3]);
            *(LAS u32x2*)(Aq + r * 272 + part * 64 + i * 8) = o; }
        u32x4 kv[4]; ss = 0.f;
#pragma unroll
        for (int i = 0; i < 4; ++i) { kv[i] = *(const GAS u32x4*)(pr + OFF_KV + part * 32 + i * 8);
#pragma unroll
            for (int e = 0; e < 4; ++e) { const float lo = lo16(kv[i][e]), hi = hi16(kv[i][e]); ss += lo * lo + hi * hi; } }
        ss += __shfl_xor(ss, 1); ss += __shfl_xor(ss, 2);
        rstd = rsqrtf(ss * (1.f / 128.f) + EPS);
        const float* gkv = a.in[I_GKVL] + part * 32;
#pragma unroll
        for (int i = 0; i < 4; ++i) { u32x2 o;
#pragma unroll
            for (int e = 0; e < 2; ++e) o[e] = cvt4_fp8(lo16(kv[i][2 * e]) * rstd * gkv[i * 8 + 4 * e], hi16(kv[i][2 * e]) * rstd * gkv[i * 8 + 4 * e + 1], lo16(kv[i][2 * e + 1]) * rstd * gkv[i * 8 + 4 * e + 2], hi16(kv[i][2 * e + 1]) * rstd * gkv[i * 8 + 4 * e + 3]);
            *(LAS u32x2*)(Akv + r * 144 + part * 32 + i * 8) = o; }
        const u32x4 pe = *(const GAS u32x4*)(pr + OFF_PE + part * 8); ss = 0.f;
#pragma unroll
        for (int e = 0; e < 4; ++e) { const float lo = lo16(pe[e]), hi = hi16(pe[e]); ss += lo * lo + hi * hi; kpe[r * 32 + part * 8 + 2 * e] = lo; kpe[r * 32 + part * 8 + 2 * e + 1] = hi; }
        ss += __shfl_xor(ss, 1); ss += __shfl_xor(ss, 2);
        if (part == 0) sspe[r] = ss;
    }
    __syncthreads();
    const int h = wave, bh = b * NH + h;
    typedef int i32x4m __attribute__((ext_vector_type(4))); typedef int i32x8m __attribute__((ext_vector_type(8)));
#define LD32G(p) __builtin_shufflevector(*(const GAS i32x4m*)(p), *(const GAS i32x4m*)((p) + 16), 0, 1, 2, 3, 4, 5, 6, 7)
#define LD32L(p) __builtin_shufflevector(*(const LAS i32x4m*)(p), *(const LAS i32x4m*)((p) + 16), 0, 1, 2, 3, 4, 5, 6, 7)
    if (lat) {
        const unsigned char* WQ = a.ws + WS_WQ + (size_t)h * QK * 256;
        const float* gqh = a.in[I_GQH];
        unsigned char* Qo = a.ws + WS_Q + ((size_t)bh * SEQ + tpos0) * QK8;
        i32x8m bq[2][6];
#pragma unroll
        for (int s2 = 0; s2 < 2; ++s2)
#pragma unroll
            for (int j = 0; j < 6; ++j) bq[s2][j] = LD32G(WQ + (size_t)(16 * j + fr) * 256 + 128 * s2 + 32 * fq);
#pragma unroll 1
        for (int rq = 0; rq < 4; ++rq) {
            f32x4 acc[2][6];
#pragma unroll
            for (int i = 0; i < 2; ++i)
#pragma unroll
                for (int j = 0; j < 6; ++j) acc[i][j] = (f32x4){0.f, 0.f, 0.f, 0.f};
#pragma unroll
            for (int s2 = 0; s2 < 2; ++s2)
#pragma unroll
                for (int i = 0; i < 2; ++i) { const i32x8m af = LD32L(Aq + (rq * 32 + 16 * i + fr) * 272 + 128 * s2 + 32 * fq);
#pragma unroll
                    for (int j = 0; j < 6; ++j) acc[i][j] = __builtin_amdgcn_mfma_scale_f32_16x16x128_f8f6f4(bq[s2][j], af, acc[i][j], 0, 0, 0, 0, 0, 0); }
#pragma unroll
            for (int i = 0; i < 2; ++i) {
                const int row = rq * 32 + 16 * i + fr, t = tpos0 + row;
                float ss = 0.f;
#pragma unroll
                for (int j = 0; j < 6; ++j) ss += (acc[i][j][0] * acc[i][j][0] + acc[i][j][1] * acc[i][j][1]) + (acc[i][j][2] * acc[i][j][2] + acc[i][j][3] * acc[i][j][3]);
                ss += __shfl_xor(ss, 16); ss += __shfl_xor(ss, 32);
                const float rstd = rsqrtf(ss * (1.f / 96.f) + EPS * (WQ_SCALE * WQ_SCALE)) * QSCALE;
#pragma unroll
                for (int j = 0; j < 6; ++j) {
                    const int col = 16 * j + 4 * fq; const f32x4 gv = *(const GAS f32x4*)(gqh + col);
                    f32x4 v = acc[i][j] * gv * rstd;
                    if (j >= 4) {
                        const int ax = j - 4, pi = ax == 0 ? (t >> 6) : 128 + (t & 63), f0 = 4 * (fq & 1);
                        const float* cs = tabm + (pi * 8 + f0) * 2;
#pragma unroll
                        for (int r = 0; r < 4; ++r) { const float other = __shfl_xor(v[r], 32); const float c = cs[2 * r], sn = cs[2 * r + 1];
                            v[r] = (fq < 2) ? (v[r] * c - other * sn) : (v[r] * c + other * sn); }
                    }
                    *(GAS unsigned*)(Qo + (size_t)row * QK8 + col) = cvt4_fp8(v[0], v[1], v[2], v[3]);
                }
                *(GAS u32x2*)(Qo + (size_t)row * QK8 + QK + 8 * fq) = (u32x2){0u, 0u};
            }
        }
    }
    {
        const unsigned char* WKV = a.ws + WS_WKV + (size_t)h * 128 * 128;
        const float* gkh = a.in[I_GKH];
        unsigned char* Ko = a.ws + WS_K + ((size_t)bh * SKV + key0) * QK8;
        unsigned char* Vo = a.ws + WS_VT + (size_t)bh * DV * SKV + key0;
        i32x8m bkv[8];
#pragma unroll
        for (int j = 0; j < 8; ++j) bkv[j] = LD32G(WKV + (size_t)(16 * j + fr) * 128 + 32 * fq);
#pragma unroll 1
        for (int rq = r0 >> 4; rq < ((r0 + nrows) >> 4); ++rq) {
            f32x4 acc[1][8];
#pragma unroll
            for (int i = 0; i < 1; ++i)
#pragma unroll
                for (int j = 0; j < 8; ++j) acc[i][j] = (f32x4){0.f, 0.f, 0.f, 0.f};
            { const i32x8m af = LD32L(Akv + (rq * 16 + fr) * 144 + 32 * fq);
#pragma unroll
              for (int j = 0; j < 8; ++j) acc[0][j] = __builtin_amdgcn_mfma_scale_f32_16x16x128_f8f6f4(bkv[j], af, acc[0][j], 0, 0, 0, 0, 0, 0) ; }
#pragma unroll
            for (int j = 0; j < 8; ++j) acc[0][j] = acc[0][j] * WKV_INV;
#pragma unroll
            for (int i = 0; i < 1; ++i) {
                const int row = rq * 16 + 16 * i + fr, t = tpos0 + row;
                const int kk = row & 63; const int vrow = (row & 64) + 32 * ((kk >> 2) & 1) + (kk & 3) + 4 * ((kk & 31) >> 3) + 16 * (kk >> 5);
                float ss = 0.f;
#pragma unroll
                for (int j = 0; j < 4; ++j) ss += (acc[i][j][0] * acc[i][j][0] + acc[i][j][1] * acc[i][j][1]) + (acc[i][j][2] * acc[i][j][2] + acc[i][j][3] * acc[i][j][3]);
                ss += __shfl_xor(ss, 16); ss += __shfl_xor(ss, 32);
                const float rstd = rsqrtf((ss + sspe[row]) * (1.f / 96.f) + EPS);
#pragma unroll
                for (int j = 0; j < 4; ++j) { const int col = 16 * j + 4 * fq; const f32x4 gv = *(const GAS f32x4*)(gkh + col); const f32x4 v = acc[i][j] * gv * rstd;
                    *(GAS unsigned*)(Ko + (size_t)row * QK8 + col) = cvt4_fp8(v[0], v[1], v[2], v[3]); }
                {
                    const int ax = fq >> 1, f0 = 4 * (fq & 1), pi = ax == 0 ? (t >> 6) : 128 + (t & 63);
                    const float* cs = tabm + (pi * 8 + f0) * 2;
                    float o0[4], o1[4];
#pragma unroll
                    for (int r = 0; r < 4; ++r) { const int c0 = ax * 16 + f0 + r, c1 = c0 + 8;
                        const float x0 = kpe[row * 32 + c0] * rstd * gkh[64 + c0], x1 = kpe[row * 32 + c1] * rstd * gkh[64 + c1];
                        const float c = lat ? cs[2 * r] : 1.f, s = lat ? cs[2 * r + 1] : 0.f;
                        o0[r] = x0 * c - x1 * s; o1[r] = x1 * c + x0 * s; }
                    *(GAS unsigned*)(Ko + (size_t)row * QK8 + 64 + ax * 16 + f0) = cvt4_fp8(o0[0], o0[1], o0[2], o0[3]);
                    *(GAS unsigned*)(Ko + (size_t)row * QK8 + 64 + ax * 16 + 8 + f0) = cvt4_fp8(o1[0], o1[1], o1[2], o1[3]);
                    *(GAS u32x2*)(Ko + (size_t)row * QK8 + QK + 8 * fq) = (u32x2){0u, 0u};
                }
#pragma unroll
                for (int j = 4; j < 8; ++j)
#pragma unroll
                    for (int r = 0; r < 4; ++r) { const int d = 16 * (j - 4) + 4 * fq + r; Vo[(size_t)d * SKV + vrow] = (unsigned char)(cvt4_fp8(acc[i][j][r], 0.f, 0.f, 0.f) & 0xffu); }
            }
        }
    }
}

__device__ __forceinline__ float log_gamma(const float* logit) { const float x = *logit; return -log1pf(__expf(-x)); }

__device__ __forceinline__ void rope16(float (&out)[16], const bf16_t* rowp  , int part, const float* cs  , float scale) {
    const u32x4 a0 = *(const GAS u32x4*)(rowp + part * 16), a1 = *(const GAS u32x4*)(rowp + part * 16 + 8);
    const u32x4 b0 = *(const GAS u32x4*)(rowp + (part ^ 1) * 16), b1 = *(const GAS u32x4*)(rowp + (part ^ 1) * 16 + 8);
    float xs[16], xo[16];
#pragma unroll
    for (int e = 0; e < 4; ++e) { xs[2 * e] = lo16(a0[e]); xs[2 * e + 1] = hi16(a0[e]); xs[8 + 2 * e] = lo16(a1[e]); xs[8 + 2 * e + 1] = hi16(a1[e]);
        xo[2 * e] = lo16(b0[e]); xo[2 * e + 1] = hi16(b0[e]); xo[8 + 2 * e] = lo16(b1[e]); xo[8 + 2 * e + 1] = hi16(b1[e]); }
    if (cs) {
        const float sg = (part & 1) ? 1.f : -1.f;
#pragma unroll
        for (int q = 0; q < 8; ++q) { const f32x4 t = *(const GAS f32x4*)(cs + 4 * q);
            out[2 * q] = (xs[2 * q] * t[0] + sg * xo[2 * q] * t[1]) * scale; out[2 * q + 1] = (xs[2 * q + 1] * t[2] + sg * xo[2 * q + 1] * t[3]) * scale; }
    } else {
#pragma unroll
        for (int f = 0; f < 16; ++f) out[f] = xs[f] * scale;
    }
}

__device__ __forceinline__ void ret_local_unit(const Args& a, LAS unsigned char* lds, int unit) {
    const int tid = tid_of(a.wv), lane = tid & 63, wave = a.wv, fr = lane & 15, fq = lane >> 4;
    const int bh = unit / NSLOT, slot = unit % NSLOT, b = bh >> 2, h = bh & 3;
    const bool lat = slot >= 2;
    const int prow0 = lat ? b * SEQ + (slot - 2) * RC : T + b * LC + slot * RC;
    const int tpos0 = lat ? (slot - 2) * RC : 0;
    LAS bf16_t* KfT = (LAS bf16_t*)lds;
    LAS bf16_t* KbT = (LAS bf16_t*)(lds + 17408);
    LAS bf16_t* VT = (LAS bf16_t*)(lds + 34816);
    const bf16_t* P = (const bf16_t*)(a.ws + WS_P);
    const float* tabr = (const float*)(a.ws + WS_TABR);
    const float lgf = log_gamma(a.in[I_DECAY] + h), lgb = log_gamma(a.in[I_DECAY] + 4 + h);
    __syncthreads();
    {
        const int j = tid >> 2, part = tid & 3, t = tpos0 + j, ax = part >> 1;
        const int pi = ax == 0 ? (t >> 6) : 128 + (t & 63);
        float o[16]; rope16(o, P + (size_t)(prow0 + j) * DINP + OFF_RK + h * 64, part, lat ? tabr + pi * 32 : nullptr, 0.125f);
        const float wf = __expf(lgf * (float)(127 - j)), wb = __expf(lgb * (float)j);
#pragma unroll
        for (int f = 0; f < 16; ++f) { const int d = part * 16 + f; KfT[d * 136 + j] = (bf16_t)f2bf(o[f] * wf); KbT[d * 136 + j] = (bf16_t)f2bf(o[f] * wb); }
    }
    for (int idx = tid; idx < 128 * 16; idx += 512) {
        const int j = idx >> 4, c = idx & 15;
        const u32x4 v = *(const GAS u32x4*)(P + (size_t)(prow0 + j) * DINP + OFF_RV + h * 128 + c * 8);
#pragma unroll
        for (int e = 0; e < 4; ++e) { VT[(c * 8 + 2 * e) * 136 + j] = (bf16_t)(v[e] & 0xffffu); VT[(c * 8 + 2 * e + 1) * 136 + j] = (bf16_t)(v[e] >> 16); }
    }
    __syncthreads();
    const int dir = wave >> 2, mi = wave & 3;
    f32x4 acc[1][8];
#pragma unroll
    for (int j = 0; j < 8; ++j) acc[0][j] = (f32x4){0.f, 0.f, 0.f, 0.f};
    mma_ll<1, 8, false>(acc, dir ? KbT : KfT, 136, 16 * mi, VT, 136, 0, 128, lane);
    float* out = (float*)(a.ws + WS_LST) + ((size_t)(bh * 2 + dir) * NSLOT + slot) * 8192;
#pragma unroll
    for (int j = 0; j < 8; ++j) *(GAS f32x4*)(out + (size_t)(16 * j + fr) * 64 + 16 * mi + 4 * fq) = acc[0][j];
}

__device__ __forceinline__ void phase_ret_scan(const Args& a) {
    const int gt = blockIdx.x * 512 + tid_of(a.wv);
    if (gt >= 32 * 2048) return;
    const int bd = gt >> 11, v4 = gt & 2047, dir = bd & 1, h = (bd >> 1) & 3;
    const float lg = log_gamma(a.in[I_DECAY] + dir * 4 + h);
    const float g = __expf(lg * 128.f);
    float* base = (float*)(a.ws + WS_LST) + (size_t)bd * NSLOT * 8192 + v4 * 4;
    f32x4 S = (f32x4){0.f, 0.f, 0.f, 0.f};
#pragma unroll 1
    for (int bt = 0; bt < 5; ++bt) {
        f32x4 L[13];
#pragma unroll
        for (int q = 0; q < 13; ++q) { const int n = bt * 13 + q; const int slot = dir == 0 ? n : (n == 0 ? 1 : (n == 1 ? 0 : 67 - n)); L[q] = *(const GAS f32x4*)(base + (size_t)slot * 8192); }
#pragma unroll
        for (int q = 0; q < 13; ++q) { const int n = bt * 13 + q; const int slot = dir == 0 ? n : (n == 0 ? 1 : (n == 1 ? 0 : 67 - n)); S = S * g + L[q]; *(GAS f32x4*)(base + (size_t)slot * 8192) = S; }
    }
}

__device__ __forceinline__ void ret_out_unit(const Args& a, LAS unsigned char* lds, int unit) {
    const int tid = tid_of(a.wv), lane = tid & 63, wave = a.wv, fr = lane & 15, fq = lane >> 4;
    const int bh = unit >> 6, c = unit & 63, b = bh >> 2, h = bh & 3;
    const int prow0 = b * SEQ + c * RC, tpos0 = c * RC;
    LAS bf16_t* Qs = (LAS bf16_t*)lds;
    LAS bf16_t* Ks = (LAS bf16_t*)(lds + 18432);
    LAS bf16_t* VT = (LAS bf16_t*)(lds + 36864);
    LAS bf16_t* SfT = (LAS bf16_t*)(lds + 71680);
    LAS bf16_t* SbT = (LAS bf16_t*)(lds + 90112);
    LAS bf16_t* Ws = (LAS bf16_t*)(lds + 108544);
    const bf16_t* P = (const bf16_t*)(a.ws + WS_P);
    const float* tabr = (const float*)(a.ws + WS_TABR);
    const float lgf = log_gamma(a.in[I_DECAY] + h), lgb = log_gamma(a.in[I_DECAY] + 4 + h);
    __syncthreads();
    {
        const int j = tid >> 2, part = tid & 3, t = tpos0 + j, ax = part >> 1;
        const int pi = ax == 0 ? (t >> 6) : 128 + (t & 63);
        float oq[16], ok[16];
        rope16(oq, P + (size_t)(prow0 + j) * DINP + OFF_RQ + h * 64, part, tabr + pi * 32, 1.f);
        rope16(ok, P + (size_t)(prow0 + j) * DINP + OFF_RK + h * 64, part, tabr + pi * 32, 0.125f);
        u32x4 w0, w1;
        w0 = (u32x4){pk2(oq[0], oq[1]), pk2(oq[2], oq[3]), pk2(oq[4], oq[5]), pk2(oq[6], oq[7])}; w1 = (u32x4){pk2(oq[8], oq[9]), pk2(oq[10], oq[11]), pk2(oq[12], oq[13]), pk2(oq[14], oq[15])};
        *(LAS u32x4*)(Qs + j * 72 + part * 16) = w0; *(LAS u32x4*)(Qs + j * 72 + part * 16 + 8) = w1;
        w0 = (u32x4){pk2(ok[0], ok[1]), pk2(ok[2], ok[3]), pk2(ok[4], ok[5]), pk2(ok[6], ok[7])}; w1 = (u32x4){pk2(ok[8], ok[9]), pk2(ok[10], ok[11]), pk2(ok[12], ok[13]), pk2(ok[14], ok[15])};
        *(LAS u32x4*)(Ks + j * 72 + part * 16) = w0; *(LAS u32x4*)(Ks + j * 72 + part * 16 + 8) = w1;
    }
    for (int idx = tid; idx < 128 * 16; idx += 512) {
        const int j = idx >> 4, cch = idx & 15;
        const u32x4 v = *(const GAS u32x4*)(P + (size_t)(prow0 + j) * DINP + OFF_RV + h * 128 + cch * 8);
#pragma unroll
        for (int e = 0; e < 4; ++e) { VT[(cch * 8 + 2 * e) * 136 + j] = (bf16_t)(v[e] & 0xffffu); VT[(cch * 8 + 2 * e + 1) * 136 + j] = (bf16_t)(v[e] >> 16); }
    }
    {
        const float* sf = (const float*)(a.ws + WS_LST) + ((size_t)(bh * 2 + 0) * NSLOT + (c + 1)) * 8192;
        const float* sb = (const float*)(a.ws + WS_LST) + ((size_t)(bh * 2 + 1) * NSLOT + (c == 63 ? 0 : c + 3)) * 8192;
        for (int idx = tid; idx < 2048; idx += 512) {
            const int e = idx >> 4, d = (idx & 15) * 4;
            const f32x4 x = *(const GAS f32x4*)(sf + idx * 4), y = *(const GAS f32x4*)(sb + idx * 4);
            u32x2 w; w.x = pk2(x[0], x[1]); w.y = pk2(x[2], x[3]); *(LAS u32x2*)(SfT + e * 72 + d) = w;
            w.x = pk2(y[0], y[1]); w.y = pk2(y[2], y[3]); *(LAS u32x2*)(SbT + e * 72 + d) = w;
        }
    }
    __syncthreads();
    const int i0 = 16 * wave, irow = i0 + fr;
    f32x4 accS[1][8], accF[1][8], accB[1][8], accO[1][8];
#pragma unroll
    for (int j = 0; j < 8; ++j) { accS[0][j] = (f32x4){0.f, 0.f, 0.f, 0.f}; accF[0][j] = accS[0][j]; accB[0][j] = accS[0][j]; accO[0][j] = accS[0][j]; }
    mma_ll<1, 8, true>(accS, Qs, 72, i0, Ks, 72, 0, 64, lane);
    mma_ll<1, 8, true>(accF, Qs, 72, i0, SfT, 72, 0, 64, lane);
    mma_ll<1, 8, true>(accB, Qs, 72, i0, SbT, 72, 0, 64, lane);
#pragma unroll
    for (int j = 0; j < 8; ++j) {
        float w[4];
#pragma unroll
        for (int r = 0; r < 4; ++r) { const int jj = 16 * j + 4 * fq + r; const int df = irow - jj;
            const float dec = df > 0 ? __expf(lgf * (float)df) : (df < 0 ? __expf(lgb * (float)(-df)) : 2.f);
            w[r] = accS[0][j][r] * dec; }
        u32x2 pw; pw.x = pk2(w[0], w[1]); pw.y = pk2(w[2], w[3]);
        *(LAS u32x2*)(Ws + irow * 136 + 16 * j + 4 * fq) = pw;
    }
    LDS_WAIT(); __builtin_amdgcn_wave_barrier();
    mma_ll<1, 8, true>(accO, Ws, 136, i0, VT, 136, 0, 128, lane);
    const float wf = __expf(lgf * (float)(irow + 1)), wb = __expf(lgb * (float)(128 - irow));
    float ss = 0.f;
#pragma unroll
    for (int j = 0; j < 8; ++j) { accO[0][j] = accO[0][j] + accF[0][j] * wf + accB[0][j] * wb;
        ss += (accO[0][j][0] * accO[0][j][0] + accO[0][j][1] * accO[0][j][1]) + (accO[0][j][2] * accO[0][j][2] + accO[0][j][3] * accO[0][j][3]); }
    ss += __shfl_xor(ss, 16); ss += __shfl_xor(ss, 32);
    const float rstd = rsqrtf(ss * (1.f / 128.f) + EPS);
    const float* gro = a.in[I_GRET] + h * 128;
    const bf16_t* pg = P + (size_t)(prow0 + irow) * DINP + OFF_RG + h * 128;
    bf16_t* mix = (bf16_t*)(a.ws + WS_MIX) + (size_t)(prow0 + irow) * DM + 512 + h * 128;
#pragma unroll
    for (int j = 0; j < 8; ++j) { const int e = 16 * j + 4 * fq; const f32x4 gv = *(const GAS f32x4*)(gro + e); const u32x2 gw = *(const GAS u32x2*)(pg + e);
        const float g0 = lo16(gw.x), g1 = hi16(gw.x), g2 = lo16(gw.y), g3 = hi16(gw.y);
        f32x4 v = accO[0][j] * gv * rstd;
        v[0] *= g0 / (1.f + __expf(-g0)); v[1] *= g1 / (1.f + __expf(-g1)); v[2] *= g2 / (1.f + __expf(-g2)); v[3] *= g3 / (1.f + __expf(-g3));
        u32x2 w; w.x = pk2(v[0], v[1]); w.y = pk2(v[2], v[3]); *(GAS u32x2*)(mix + e) = w; }
}

namespace att {
constexpr int KLD8 = 144  , VLD8 = 80  , KBUF = 64 * KLD8, VBUF = 64 * VLD8, NKB = 3, NVB = 4;
constexpr int L_K = 0, L_V = NKB * KBUF, L_WS = NKB * KBUF + NVB * VBUF;
__device__ __forceinline__ int crow(int r, int hi) { return (r & 3) + 8 * (r >> 2) + 4 * hi; }
typedef __bf16 bf16x2_t __attribute__((ext_vector_type(2))); typedef float f32x2_t __attribute__((ext_vector_type(2)));
__device__ __forceinline__ unsigned cvtpk(float lo, float hi) { f32x2_t v = {lo, hi}; bf16x2_t b = __builtin_convertvector(v, bf16x2_t); return __builtin_bit_cast(unsigned, b); }
#define SBAR() __builtin_amdgcn_sched_barrier(0)
typedef int i32x4 __attribute__((ext_vector_type(4))); typedef int i32x8 __attribute__((ext_vector_type(8)));
constexpr float PSHIFT = 2.f;
template <bool SHIFT>
__device__ __forceinline__ i32x8 softmax_pack8(f32x16& p0, f32x16& p1, float negm) {
    const float sh = negm + 8.f - PSHIFT;
#pragma unroll
    for (int r = 0; r < 16; ++r) { p0[r] = __builtin_amdgcn_exp2f(SHIFT ? p0[r] + sh : p0[r]); p1[r] = __builtin_amdgcn_exp2f(SHIFT ? p1[r] + sh : p1[r]); }
    i32x8 w;
#pragma unroll
    for (int q = 0; q < 4; ++q) { w[q] = (int)cvt4_fp8(p0[4 * q], p0[4 * q + 1], p0[4 * q + 2], p0[4 * q + 3]); w[4 + q] = (int)cvt4_fp8(p1[4 * q], p1[4 * q + 1], p1[4 * q + 2], p1[4 * q + 3]); }
    return w;
}
template <bool SHIFT>
__device__ __forceinline__ void unit64(const Args& a, LAS unsigned char* lds, int bh, int qb, float negm) {
    const int wid = sopaque(a.wv), tid = tid_of(wid), lane = tid & 63, r32 = lane & 31, hi = lane >> 5;
    const unsigned char* QwA = a.ws + WS_Q + ((size_t)bh * SEQ + qb * 512 + wid * 64 + r32) * QK8 + hi * 32;
    const unsigned char* Kh = a.ws + WS_K + (size_t)bh * SKV * QK8;
    const unsigned char* Vh = a.ws + WS_VT + (size_t)bh * DV * SKV;
    LAS unsigned char* Kl = lds + L_K; LAS unsigned char* Vl = lds + L_V;
    LAS float* wsf = (LAS float*)(lds + L_WS) + wid * 64;
    i32x8 qA8[2], qB8[2];
#pragma unroll
    for (int s2 = 0; s2 < 2; ++s2) { const i32x4 a0_ = *(const GAS i32x4*)(QwA + 64 * s2), a1_ = *(const GAS i32x4*)(QwA + 64 * s2 + 16), b0_ = *(const GAS i32x4*)(QwA + 32 * QK8 + 64 * s2), b1_ = *(const GAS i32x4*)(QwA + 32 * QK8 + 64 * s2 + 16);
        qA8[s2] = __builtin_shufflevector(a0_, a1_, 0, 1, 2, 3, 4, 5, 6, 7); qB8[s2] = __builtin_shufflevector(b0_, b1_, 0, 1, 2, 3, 4, 5, 6, 7); }
    unsigned soff[2]; int dsto[2];
#pragma unroll
    for (int m = 0; m < 2; ++m) { const int j = (wid + 8 * m) < 14 ? wid + 8 * m : wid + 8 * m - 8;
        if (j < 9) { const int p = j * 64 + lane, row = p / 9, c = p % 9; soff[m] = (unsigned)(row * QK8 + (c < 8 ? c : 7) * 16); dsto[m] = L_K + j * 1024; }
        else { const int jv = j - 9, p = jv * 64 + lane, d = p / 5, c = p % 5; soff[m] = (unsigned)(d * SKV + (c < 4 ? c : 3) * 16); dsto[m] = L_V + jv * 1024; } }
    const char* Kb = (const char*)Kh; const char* Vb = (const char*)Vh;
#define DMA(t, kslot, vslot) do { _Pragma("unroll") for (int pm_ = 0; pm_ < 2; ++pm_) { const int j_ = (wid + 8 * pm_) < 14 ? wid + 8 * pm_ : wid + 8 * pm_ - 8; { \
        const char* src_ = (j_ < 9 ? Kb + (size_t)(t) * (64 * QK8) : Vb + (size_t)(t) * 64) + soff[pm_]; \
        __builtin_amdgcn_global_load_lds((const unsigned*)src_, (LAS unsigned*)(lds + dsto[pm_] + (j_ < 9 ? (kslot) * KBUF : (vslot) * VBUF)), 16, 0, 0); } } } while (0)
    i32x8 ones8;
#pragma unroll
    for (int q = 0; q < 8; ++q) ones8[q] = r32 == 0 ? 0x38383838 : 0;
    f32x16 oA[2], oB[2], sA, sB;
#pragma unroll
    for (int r = 0; r < 16; ++r) { oA[0][r] = 0.f; oA[1][r] = 0.f; oB[0][r] = 0.f; oB[1][r] = 0.f; sA[r] = 0.f; sB[r] = 0.f; }
    constexpr int NT = SKV / 64;
    __syncthreads();
    DMA(0, 0, 0); DMA(1, 1, 1); __syncthreads();
#ifndef ATT_STAGGER
#define ATT_STAGGER 0
#endif
    const bool late = ATT_STAGGER && wid >= 4;
#define TILE_BAR(more) do { if (more) asm volatile("s_waitcnt vmcnt(2) lgkmcnt(0)\n\ts_barrier" ::: "memory"); else asm volatile("s_waitcnt vmcnt(0) lgkmcnt(0)\n\ts_barrier" ::: "memory"); } while (0)
    int ks = 0, vs = 0;
    for (int i = 0; i < NT; ++i) {
        const bool more = i + 2 < NT;
        if (more) DMA(i + 2, (ks == 0 ? 2 : ks - 1), ((vs + 2) & 3));
        SBAR();
        f32x16 pA0, pA1, pB0, pB1;
#pragma unroll
        for (int r = 0; r < 16; ++r) { pA0[r] = PSHIFT; pA1[r] = PSHIFT; pB0[r] = PSHIFT; pB1[r] = PSHIFT; }
        const LAS unsigned char* Ks = Kl + ks * KBUF + r32 * KLD8 + 32 * hi;
#pragma unroll
        for (int s2 = 0; s2 < 2; ++s2) {
            const i32x4 c0_ = *(const LAS i32x4*)(Ks + 64 * s2), c1_ = *(const LAS i32x4*)(Ks + 64 * s2 + 16), d0_ = *(const LAS i32x4*)(Ks + 32 * KLD8 + 64 * s2), d1_ = *(const LAS i32x4*)(Ks + 32 * KLD8 + 64 * s2 + 16);
            const i32x8 k0 = __builtin_shufflevector(c0_, c1_, 0, 1, 2, 3, 4, 5, 6, 7), k1 = __builtin_shufflevector(d0_, d1_, 0, 1, 2, 3, 4, 5, 6, 7);
            pA0 = __builtin_amdgcn_mfma_scale_f32_32x32x64_f8f6f4(k0, qA8[s2], pA0, 0, 0, 0, 0, 0, 0); pB0 = __builtin_amdgcn_mfma_scale_f32_32x32x64_f8f6f4(k0, qB8[s2], pB0, 0, 0, 0, 0, 0, 0);
            pA1 = __builtin_amdgcn_mfma_scale_f32_32x32x64_f8f6f4(k1, qA8[s2], pA1, 0, 0, 0, 0, 0, 0); pB1 = __builtin_amdgcn_mfma_scale_f32_32x32x64_f8f6f4(k1, qB8[s2], pB1, 0, 0, 0, 0, 0, 0);
        }
        SBAR();
        if (late) TILE_BAR(more);
        const LAS unsigned char* Vs = Vl + vs * VBUF + r32 * VLD8 + 32 * hi;
        const i32x4 e0_ = *(const LAS i32x4*)(Vs), e1_ = *(const LAS i32x4*)(Vs + 16), f0_ = *(const LAS i32x4*)(Vs + 32 * VLD8), f1_ = *(const LAS i32x4*)(Vs + 32 * VLD8 + 16);
        const i32x8 v0 = __builtin_shufflevector(e0_, e1_, 0, 1, 2, 3, 4, 5, 6, 7), v1 = __builtin_shufflevector(f0_, f1_, 0, 1, 2, 3, 4, 5, 6, 7);
        { const i32x8 pa = softmax_pack8<SHIFT>(pA0, pA1, negm);
          oA[0] = __builtin_amdgcn_mfma_scale_f32_32x32x64_f8f6f4(pa, v0, oA[0], 0, 0, 0, 0, 0, 0); oA[1] = __builtin_amdgcn_mfma_scale_f32_32x32x64_f8f6f4(pa, v1, oA[1], 0, 0, 0, 0, 0, 0);
          sA = __builtin_amdgcn_mfma_scale_f32_32x32x64_f8f6f4(pa, ones8, sA, 0, 0, 0, 0, 0, 0); }
        { const i32x8 pa = softmax_pack8<SHIFT>(pB0, pB1, negm);
          oB[0] = __builtin_amdgcn_mfma_scale_f32_32x32x64_f8f6f4(pa, v0, oB[0], 0, 0, 0, 0, 0, 0); oB[1] = __builtin_amdgcn_mfma_scale_f32_32x32x64_f8f6f4(pa, v1, oB[1], 0, 0, 0, 0, 0, 0);
          sB = __builtin_amdgcn_mfma_scale_f32_32x32x64_f8f6f4(pa, ones8, sB, 0, 0, 0, 0, 0, 0); }
        SBAR();
        if (!late) TILE_BAR(more);
        ks = ks == 2 ? 0 : ks + 1; vs = (vs + 1) & 3;
    }
#undef DMA
#undef TILE_BAR
    if (r32 == 0) {
#pragma unroll
        for (int r = 0; r < 16; ++r) { wsf[crow(r, hi)] = sA[r]; wsf[32 + crow(r, hi)] = sB[r]; } }
    LDS_WAIT(); __builtin_amdgcn_wave_barrier();
    const int b = bh >> 3, h = bh & 7;
    const int lz = opaque(lane), r32z = lz & 31, hiz = lz >> 5;
    bf16_t* Ow = (bf16_t*)(a.ws + WS_MIX) + ((size_t)b * SEQ + qb * 512 + wid * 64) * DM + h * DV;
    const unsigned ooff = (unsigned)(4 * hiz * DM + r32z);
#pragma unroll
    for (int r = 0; r < 16; ++r) { const int orow = crow(r, hiz); const float rlA = 1.f / wsf[orow], rlB = 1.f / wsf[32 + orow];
        const unsigned off = ooff + (unsigned)(((r & 3) + 8 * (r >> 2)) * DM);
        Ow[off] = (bf16_t)f2bf(oA[0][r] * rlA); Ow[off + 32] = (bf16_t)f2bf(oA[1][r] * rlA);
        Ow[off + 32 * DM] = (bf16_t)f2bf(oB[0][r] * rlB); Ow[off + 32 * DM + 32] = (bf16_t)f2bf(oB[1][r] * rlB); }
}
#undef SBAR
}


#if DIAG == 5
__device__ __forceinline__ void attn_selfcheck(const Args& a, LAS unsigned char* lds) {
    const int tid = tid_of(a.wv);
    LAS float* red = (LAS float*)lds;
    __syncthreads();
    if (blockIdx.x == 0) {
        const int row = tid >> 3, ds = (tid & 7) * 8;
        const unsigned char* q = a.ws + WS_Q + (size_t)row * QK8; const unsigned char* K = a.ws + WS_K; const unsigned char* V = a.ws + WS_VT;
        float qf[96];
        float acc[8] = {0.f, 0.f, 0.f, 0.f, 0.f, 0.f, 0.f, 0.f}; float l = 0.f;
        for (int key = 0; key < SKV; ++key) {
            float s = 0.f;
            for (int c = 0; c < 96; c += 4) { const int kw = *(const GAS int*)(K + (size_t)key * QK8 + c), qw = *(const GAS int*)(q + c);
                s += __builtin_amdgcn_cvt_f32_fp8(kw, 0) * __builtin_amdgcn_cvt_f32_fp8(qw, 0) + __builtin_amdgcn_cvt_f32_fp8(kw, 1) * __builtin_amdgcn_cvt_f32_fp8(qw, 1)
                   + __builtin_amdgcn_cvt_f32_fp8(kw, 2) * __builtin_amdgcn_cvt_f32_fp8(qw, 2) + __builtin_amdgcn_cvt_f32_fp8(kw, 3) * __builtin_amdgcn_cvt_f32_fp8(qw, 3); }
            const float p = exp2f(s);
            const int kk = key & 63, pos = (key & ~63) + 32 * ((kk >> 2) & 1) + (kk & 3) + 4 * ((kk & 31) >> 3) + 16 * (kk >> 5);
            l += p;
#pragma unroll
            for (int e = 0; e < 8; ++e) { const int w = V[(size_t)(ds + e) * SKV + pos]; acc[e] += p * __builtin_amdgcn_cvt_f32_fp8(w, 0); }
        }
        (void)qf;
        float emax = 0.f, omax = 0.f;
        const bf16_t* mix = (const bf16_t*)(a.ws + WS_MIX) + (size_t)row * DM + ds;
#pragma unroll
        for (int e = 0; e < 8; ++e) { const float o = acc[e] / l; emax = fmaxf(emax, fabsf(o - bf2f(mix[e]))); omax = fmaxf(omax, fabsf(o)); }
        red[tid] = emax; red[512 + tid] = omax;
        __syncthreads();
        if (tid == 0) { float e = 0.f, o = 0.f; for (int i = 0; i < 512; ++i) { e = fmaxf(e, red[i]); o = fmaxf(o, red[512 + i]); }
            ((unsigned*)(a.ws + WS_CTL))[CW_DIAG] = __float_as_uint(e / o * 0.1f); }
    }
    __syncthreads();
}
#endif

__device__ __forceinline__ void phase_router(const Args& a, LAS unsigned char* lds) {
    const int tid = tid_of(a.wv), lane = tid & 63, wave = a.wv, fr = lane & 15, fq = lane >> 4;
    LAS bf16_t* Ah = (LAS bf16_t*)lds;
    LAS bf16_t* Al = (LAS bf16_t*)(lds + 33024);
    LAS float* red = (LAS float*)(lds + 66048);
    LAS int* hist = (LAS int*)(lds + 66048 + 16384);
    LAS int* base = hist + 32;
    LAS int* pk_e = base + 32;
    LAS int* pk_r = pk_e + 512;
    LAS int* pk_p = pk_r + 512;
    const float* mod = (const float*)(a.ws + WS_MOD); const float* g = a.in[I_GFFN];
    const bf16_t* WR = (const bf16_t*)(a.ws + WS_WR);
    unsigned char* HF = a.ws + WS_HF;
    float* PG = (float*)(a.ws + WS_PG);
    unsigned* cnt = (unsigned*)(a.ws + WS_CTL) + CW_CNT;
    unsigned* list = (unsigned*)(a.ws + WS_LIST);
    LAS float* lg = (LAS float*)(pk_p + 512);
    bf16x8 bh[4][2], bl[4][2];
#pragma unroll
    for (int ks = 0; ks < 4; ++ks)
#pragma unroll
        for (int j = 0; j < 2; ++j) { bh[ks][j] = *(const GAS bf16x8*)(WR + (size_t)(16 * j + fr) * 1024 + wave * 128 + 32 * ks + 8 * fq); bl[ks][j] = *(const GAS bf16x8*)(WR + 32768 + (size_t)(16 * j + fr) * 1024 + wave * 128 + 32 * ks + 8 * fq); }
    for (int tile = blockIdx.x; tile < T / 128; tile += gridDim.x) {
        __syncthreads();
        if (tid < 32) hist[tid] = 0;
        f32x4 v[2][4];
#pragma unroll
        for (int rr = 0; rr < 2; ++rr) { const float* xr = a.out + (size_t)(tile * 128 + wave * 2 + rr) * DM;
#pragma unroll
            for (int j = 0; j < 4; ++j) v[rr][j] = *(const GAS f32x4*)(xr + j * 256 + lane * 4); }
#pragma unroll 1
        for (int it = 0; it < 8; ++it) {
            const int tok0 = tile * 128 + it * 16;
#pragma unroll
            for (int rr = 0; rr < 2; ++rr) {
                const int row = wave * 2 + rr, tok = tok0 + row;
                const float* sh = mod + (tok >> 13) * 6144 + 3 * 1024; const float* sc = sh + 1024;
                float ss = 0.f;
#pragma unroll
                for (int j = 0; j < 4; ++j) ss += (v[rr][j].x * v[rr][j].x + v[rr][j].y * v[rr][j].y) + (v[rr][j].z * v[rr][j].z + v[rr][j].w * v[rr][j].w);
                const float rstd = rsqrtf(wave_sum(ss) * (1.f / DM) + EPS);
#pragma unroll
                for (int j = 0; j < 4; ++j) { const int c = j * 256 + lane * 4; const f32x4 gg = *(const GAS f32x4*)(g + c), s1 = *(const GAS f32x4*)(sc + c), s0 = *(const GAS f32x4*)(sh + c);
                    const f32x4 o = (v[rr][j] * rstd * gg) * (s1 + 1.f) + s0;
                    const unsigned h0 = f2bf(o.x), h1 = f2bf(o.y), h2 = f2bf(o.z), h3 = f2bf(o.w);
                    u32x2 wh; wh.x = h0 | (h1 << 16); wh.y = h2 | (h3 << 16);
                    u32x2 wl; wl.x = pk2(o.x - bf2f((bf16_t)h0), o.y - bf2f((bf16_t)h1)); wl.y = pk2(o.z - bf2f((bf16_t)h2), o.w - bf2f((bf16_t)h3));
                    *(GAS unsigned*)(HF + (size_t)tok * DM + c) = cvt4_fp8(o.x, o.y, o.z, o.w);
                    *(LAS u32x2*)(Ah + row * 1032 + c) = wh; *(LAS u32x2*)(Al + row * 1032 + c) = wl; }
            }
            if (it < 7) {
#pragma unroll
                for (int rr = 0; rr < 2; ++rr) { const float* xr = a.out + (size_t)(tok0 + 16 + wave * 2 + rr) * DM;
#pragma unroll
                    for (int j = 0; j < 4; ++j) v[rr][j] = *(const GAS f32x4*)(xr + j * 256 + lane * 4); } }
            __syncthreads();
            {
                f32x4 acc[2]; acc[0] = (f32x4){0.f, 0.f, 0.f, 0.f}; acc[1] = acc[0];
#pragma unroll
                for (int ks = 0; ks < 4; ++ks) { const bf16x8 ah = *(const LAS bf16x8*)(Ah + fr * 1032 + wave * 128 + 32 * ks + 8 * fq), al = *(const LAS bf16x8*)(Al + fr * 1032 + wave * 128 + 32 * ks + 8 * fq);
#pragma unroll
                    for (int j = 0; j < 2; ++j) { acc[j] = __builtin_amdgcn_mfma_f32_16x16x32_bf16(ah, bh[ks][j], acc[j], 0, 0, 0); acc[j] = __builtin_amdgcn_mfma_f32_16x16x32_bf16(al, bh[ks][j], acc[j], 0, 0, 0);
                        acc[j] = __builtin_amdgcn_mfma_f32_16x16x32_bf16(ah, bl[ks][j], acc[j], 0, 0, 0); } }
#pragma unroll
                for (int j = 0; j < 2; ++j)
#pragma unroll
                    for (int r = 0; r < 4; ++r) red[(wave * 16 + 4 * fq + r) * 32 + 16 * j + fr] = acc[j][r];
            }
            __syncthreads();
            { const int tk = tid >> 5, e = tid & 31; float sl = a.in[I_BR][e];
#pragma unroll
              for (int w = 0; w < 8; ++w) sl += red[(w * 16 + tk) * 32 + e];
              lg[tk * 32 + e] = sl; }
            __syncthreads();
            if (tid < 16) {
                const int tok = tok0 + tid;
                float best[4]; int bi[4];
#pragma unroll
                for (int k = 0; k < 4; ++k) { best[k] = -3.0e38f; bi[k] = 0; }
                for (int e = 0; e < 32; ++e) {
                    const float s = lg[tid * 32 + e];
                    if (s > best[3]) {
                        if (s > best[0]) { best[3] = best[2]; bi[3] = bi[2]; best[2] = best[1]; bi[2] = bi[1]; best[1] = best[0]; bi[1] = bi[0]; best[0] = s; bi[0] = e; }
                        else if (s > best[1]) { best[3] = best[2]; bi[3] = bi[2]; best[2] = best[1]; bi[2] = bi[1]; best[1] = s; bi[1] = e; }
                        else if (s > best[2]) { best[3] = best[2]; bi[3] = bi[2]; best[2] = s; bi[2] = e; }
                        else { best[3] = s; bi[3] = e; }
                    }
                }
                const float e1 = __expf(best[1] - best[0]), e2 = __expf(best[2] - best[0]), e3 = __expf(best[3] - best[0]);
                const float inv = 1.f / (1.f + e1 + e2 + e3);
                const float gk[4] = {inv, e1 * inv, e2 * inv, e3 * inv};
#pragma unroll
                for (int k = 0; k < 4; ++k) { const int slot = (it * 16 + tid) * 4 + k; const int rk = __hip_atomic_fetch_add(hist + bi[k], 1, __ATOMIC_RELAXED, __HIP_MEMORY_SCOPE_WORKGROUP);
                    pk_e[slot] = bi[k]; pk_r[slot] = rk; pk_p[slot] = tok * 4 + k; PG[tok * 4 + k] = gk[k]; }
            }
        }
        __syncthreads();
        if (tid < 32) base[tid] = (int)__hip_atomic_fetch_add(cnt + 64 * tid, (unsigned)hist[tid], __ATOMIC_RELAXED, __HIP_MEMORY_SCOPE_AGENT);
        __syncthreads();
        { const int e = pk_e[tid]; list[(size_t)e * 32768 + base[e] + pk_r[tid]] = (unsigned)pk_p[tid]; }
    }
}

__device__ __forceinline__ void phase_combine(const Args& a) {
    const int tid = tid_of(a.wv), lane = tid & 63, wave = tid >> 6;
    const int gw = blockIdx.x * 8 + wave, NGW = gridDim.x * 8;
    const float* mod = (const float*)(a.ws + WS_MOD);
    const unsigned char* Y = a.ws + WS_Y;
#if DIAG == 1
    const float dz = 0.1f;
#elif DIAG >= 2
    const float dz = sqrtf(__uint_as_float(__hip_atomic_load((unsigned*)(a.ws + WS_CTL) + CW_DIAG, __ATOMIC_RELAXED, __HIP_MEMORY_SCOPE_AGENT)));
#else
    const float dz = 0.f;
#endif
    for (int tok = gw; tok < T; tok += NGW) {
        const float* gate = mod + (tok >> 13) * 6144 + 5 * 1024;
        float* orow = a.out + (size_t)tok * DM;
#pragma unroll
        for (int j = 0; j < 4; ++j) { const int c = j * 256 + lane * 4;
            f32x4 s = (f32x4){0.f, 0.f, 0.f, 0.f};
#pragma unroll
            for (int k = 0; k < 4; ++k) { const int w = *(const GAS int*)(Y + ((size_t)tok * 4 + k) * DM + c);
                s[0] += __builtin_amdgcn_cvt_f32_fp8(w, 0); s[1] += __builtin_amdgcn_cvt_f32_fp8(w, 1); s[2] += __builtin_amdgcn_cvt_f32_fp8(w, 2); s[3] += __builtin_amdgcn_cvt_f32_fp8(w, 3); }
            s = s * pg8::YINV;
            const f32x4 xv = *(const GAS f32x4*)(orow + c), gv = *(const GAS f32x4*)(gate + c);
            *(GAS f32x4*)(orow + c) = xv + gv * s + dz; }
    }
}

constexpr int N_PHASES = 11;
__global__ void __launch_bounds__(512, 2) fwd_kernel(Args a0) {
    Args a;
    extern __shared__ __attribute__((aligned(16))) unsigned char lds_raw[];
    LAS unsigned char* lds = (LAS unsigned char*)lds_raw;
    volatile LAS unsigned* MISC = (volatile LAS unsigned*)(lds + LDS_MISC);
    const int wv0 = __builtin_amdgcn_readfirstlane((int)threadIdx.x >> 6);
    const int tid = threadIdx.x;
    if (tid < 64) MISC[tid] = 0u;
    __syncthreads();
    const int lo = sopaque(a0.ph_lo), hi = sopaque(a0.ph_hi);
#define use_bar ((hi - lo) > 1)
    XcdBarrier bar; bar.bar = (unsigned*)(a0.ws + WS_CTL) + CW_BAR; bar.x = 0; bar.st = MISC + 8;
    bar.wv = wv0;
    if (use_bar) bar = xcd_barrier_post((unsigned*)(a0.ws + WS_CTL) + CW_BAR, MISC + 8, wv0);
    const int G = sopaque((int)gridDim.x), bx = sopaque((int)blockIdx.x);
    const int vcu = (G % 8 == 0) ? (bx % 8) * (G / 8) + bx / 8 : bx;
#ifndef ONLY_PHASE
#define ONLY_PHASE -1
#endif
#ifndef PHASE_MASK
#define PHASE_MASK 0x7ff
#endif
#define IN(k) (lo <= (k) && (k) < hi && (ONLY_PHASE < 0 || ONLY_PHASE == (k)) && ((PHASE_MASK >> (k)) & 1))
#if DIAG >= 40
    unsigned long long tprev_ = __builtin_amdgcn_s_memrealtime();
#define TSTAMP(k) do { const unsigned long long tn_ = __builtin_amdgcn_s_memrealtime(); if (DIAG - 40 == (k) && blockIdx.x == 0 && tid == 0) MISC[40] = __float_as_uint(rintf((float)(tn_ - tprev_) * (1.f / 1000.f)) * 1e-5f); tprev_ = tn_; } while (0)
#else
#define TSTAMP(k) do { } while (0)
#endif
#define SEAM(k) do { if ((k) == 9) TSTAMP(k); if ((k) == 9 && DIAG >= 10 && blockIdx.x == 0 && tid == 0) __hip_atomic_store((unsigned*)(a0.ws + WS_CTL) + CW_DIAG, MISC[40], __ATOMIC_RELAXED, __HIP_MEMORY_SCOPE_AGENT); \
        if (use_bar && (k) + 1 < hi) xcd_barrier(bar); if ((k) != 9) TSTAMP(k); } while (0)
#ifndef REPEAT_MASK
#define REPEAT_MASK 0
#endif
#define REP(k) for (int rep_ = 0; rep_ <= ((REPEAT_MASK >> (k)) & 1); ++rep_)
    a = a0; a.wv = wv0;
    if (IN(0)) { phase_mod(a, lds); SEAM(0); }
    REP(1) if (IN(1)) { phase_prep(a, lds); SEAM(1); }
    {
        float* prm = (float*)(a0.ws + WS_PRM);
        a.ws = a0.ws; a.out = a0.out; a.in[I_X] = a0.in[I_X]; a.wv = wv0;
        a.in[I_GQL] = prm + PRM_GQL; a.in[I_GKVL] = prm + PRM_GKVL; a.in[I_GQH] = prm + PRM_GQH; a.in[I_GKH] = prm + PRM_GKH; a.in[I_DECAY] = prm + PRM_DECAY;
        a.in[I_GRET] = prm + PRM_GRET; a.in[I_BR] = prm + PRM_BR; a.in[I_GFFN] = prm + PRM_GFFN; a.in[I_B1] = prm + PRM_B1; a.in[I_B2] = prm + PRM_B2;
    }
    REP(2) if (IN(2)) {
        pg8::DenseOrder S; S.init(a.ws + WS_H, a.ws + WS_WIN, TA, DINP, 1024, G, bx);
        pg8::EpiP E{(bf16_t*)(a.ws + WS_P)};
        pg8::gemm_phase<pg8::EpiP, pg8::DenseOrder, false>(lds, nullptr, nullptr, 0, 1024, S, E, a.wv);
        SEAM(2);
    }
    REP(3) if (IN(3)) {
        if (G == 256) {
            int u0, nu;
            if (bx < 32) { u0 = 3 * bx; nu = 3; }
            else { const int c = bx - 32; u0 = 96 + 4 * c + (c < 64 ? c : 64); nu = 4 + (c < 64 ? 1 : 0); }
            for (int k2 = 0; k2 < (bx < 32 ? 2 : 1); ++k2) mla_tile(a, lds, k2 ? 256 + (bx >> 2) : bx, k2 ? 32 * (bx & 3) : 0, k2 ? 32 : 128);
            for (int u = u0; u < u0 + nu; ++u) ret_local_unit(a, lds, u);
        } else { for (int t = bx; t < TA / 128; t += G) mla_tile(a, lds, t); for (int u = bx; u < 16 * NSLOT; u += G) ret_local_unit(a, lds, u); }
        SEAM(3);
    }
    if (IN(4)) { phase_ret_scan(a); SEAM(4); }
    REP(5) if (IN(5)) {
        float negm;
        { float gq = 0.f, gk = 0.f; for (int i = 0; i < QK; ++i) { gq = fmaxf(gq, fabsf(a.in[I_GQH][i])); gk = fmaxf(gk, fabsf(a.in[I_GKH][i])); }
          negm = -(gq * gk * 96.f * QSCALE * 1.03f + 0.5f); negm = __uint_as_float(__builtin_amdgcn_readfirstlane(__float_as_uint(negm))); }
        const bool shift = negm < -64.f;
        __builtin_amdgcn_s_setreg((0 << 11) | (23 << 6) | 1, 1);
#ifndef REP5A
#define REP5A 0
#endif
#ifndef REP5B
#define REP5B 0
#endif
        if (G == 256) {
            const int xg = vcu >> 5, c = vcu & 31, cg = vcu & 3;
#pragma unroll 1
            for (int step = 0; step < 4; ++step) {
                if (step == cg) moe_convert(a, lds, vcu);
                if (step < 2) { const int bh = xg * 4 + 2 * step + (c >> 4), qb = c & 15; if (shift) att::unit64<true>(a, lds, bh, qb, negm); else att::unit64<false>(a, lds, bh, qb, negm); }
                else if (step == 2) { for (int u = bx; u < 16 * 64; u += G) ret_out_unit(a, lds, u); }
            }
        } else {
            for (int w = bx; w < 512; w += G) { if (shift) att::unit64<true>(a, lds, w >> 4, w & 15, negm); else att::unit64<false>(a, lds, w >> 4, w & 15, negm); }
            for (int u = bx; u < 16 * 64; u += G) ret_out_unit(a, lds, u);
        }
        SEAM(5);
    }
    REP(6) if (IN(6)) {
        pg8::DenseOrder S; S.init(a.ws + WS_MIX, a.ws + WS_WO, T, DM, 1024, G, bx);
        pg8::EpiOut E{a.in[I_X], (const float*)(a.ws + WS_MOD), a.out};
        pg8::gemm_phase<pg8::EpiOut, pg8::DenseOrder, false>(lds, nullptr, nullptr, 0, 1024, S, E, a.wv);
        SEAM(6);
    }
    if (IN(7)) { phase_router(a, lds); SEAM(7); }
    REP(8) if (IN(8)) {
        pg8::EpiM1 E{a.ws + WS_ACT};
        phase_moe_pg8<8>(a, lds, a.ws + WS_HF, 2, a.ws + WS_W1, (size_t)2048 * 1024, a.in[I_B1], 2048, nullptr, E);
        SEAM(8);
    }
    REP(9) if (IN(9)) {
        pg8::EpiM2 E{a.ws + WS_Y};
        phase_moe_pg8<4>(a, lds, a.ws + WS_ACT, 0, a.ws + WS_W2, (size_t)1024 * 1024, a.in[I_B2], 1024, (const float*)(a.ws + WS_PG), E);
        SEAM(9);
    }
    if (IN(10)) { phase_combine(a); }
#undef IN
#undef SEAM
#undef use_bar
}

extern "C" void kernel_launch(void* const* d_in, const int* in_sizes, int n_in, void* d_out, int out_size, void* d_ws, size_t ws_size, hipStream_t stream) {
    static int grid = 0;
    if (grid == 0) {
        if (n_in != 24 || out_size != T * DM || ws_size < WS_END) { fprintf(stderr, "kernel_launch: unexpected shapes (n_in %d out %d ws %zu)\n", n_in, out_size, ws_size); grid = -1; return; }
        int dev = 0, cus = 0, per_cu = 0;
        if (hipGetDevice(&dev) != hipSuccess || hipDeviceGetAttribute(&cus, hipDeviceAttributeMultiprocessorCount, dev) != hipSuccess) { grid = -1; return; }
        if (hipFuncSetAttribute((const void*)fwd_kernel, hipFuncAttributeMaxDynamicSharedMemorySize, LDS_BYTES) != hipSuccess) { fprintf(stderr, "kernel_launch: hipFuncSetAttribute failed\n"); grid = -1; return; }
        if (hipOccupancyMaxActiveBlocksPerMultiprocessor(&per_cu, (const void*)fwd_kernel, 512, LDS_BYTES) != hipSuccess || per_cu < 1) { fprintf(stderr, "kernel_launch: occupancy query says %d\n", per_cu); per_cu = 1; }
        (void)hipGetLastError();
        grid = cus;
    }
    if (grid < 0) return;
    (void)hipMemsetAsync((char*)d_ws + WS_CTL, 0, CTL_BYTES, stream);
    Args a{};
    for (int i = 0; i < 24; ++i) a.in[i] = (const float*)d_in[i];
    a.out = (float*)d_out; a.ws = (unsigned char*)d_ws;
#if MK_N_LAUNCHES == 1
    a.ph_lo = 0; a.ph_hi = N_PHASES;
    void* params[] = {&a};
    hipError_t e = hipLaunchCooperativeKernel((const void*)fwd_kernel, dim3(grid), dim3(512), params, LDS_BYTES, stream);
    if (e != hipSuccess) fprintf(stderr, "kernel_launch: cooperative launch failed: %s (grid %d)\n", hipGetErrorString(e), grid);
#else
    for (int p = 0; p < N_PHASES; ++p) { a.ph_lo = p; a.ph_hi = p + 1; hipLaunchKernelGGL(fwd_kernel, dim3(grid), dim3(512), LDS_BYTES, stream, a); }
#endif
}
```

```cpp
#include <hip/hip_runtime.h>
#include <cstdio>
#include <cstdint>

#ifndef MK_N_LAUNCHES
#define MK_N_LAUNCHES 1
#endif

#define LAS __attribute__((address_space(3)))
#define GAS __attribute__((address_space(1)))
typedef unsigned short bf16_t;
typedef short bf16x8 __attribute__((ext_vector_type(8)));
typedef short s16x4 __attribute__((ext_vector_type(4)));
typedef float f32x4 __attribute__((ext_vector_type(4)));
typedef float f32x16 __attribute__((ext_vector_type(16)));
typedef unsigned u32x4 __attribute__((ext_vector_type(4)));
typedef unsigned u32x2 __attribute__((ext_vector_type(2)));

constexpr int DM = 1024, NB = 4, SEQ = 8192, LC = 256;
constexpr int T = NB * SEQ;
constexpr int TC = NB * LC;
constexpr int TA = T + TC;
constexpr int DIN = 1952, DINP = 2048;
constexpr int OFF_Q = 0, OFF_KV = 256, OFF_PE = 384, OFF_RQ = 416, OFF_RK = 672, OFF_RV = 928, OFF_RG = 1440;
constexpr int NH = 8, QK = 96, QK8 = 128, DV = 64, SKV = LC + SEQ;
constexpr int RH = 4, RDK = 64, RDV = 128, RC = 128, NSLOT = 66;
constexpr int NE = 32, DFF = 1024, NPAIR = T * 4;
constexpr float EPS = 1e-6f;
constexpr float QSCALE = 0.10206207261596577f * 1.4426950408889634f;

constexpr size_t MiB = 1ull << 20;
constexpr size_t WS_CTL = 0, CTL_BYTES = 1 * MiB;
constexpr size_t WS_MOD = 1 * MiB;
constexpr size_t WS_TABM = WS_MOD + 128 * 1024;
constexpr size_t WS_TABR = WS_TABM + 16 * 1024;
constexpr size_t WS_WIN = 2 * MiB;
constexpr size_t WS_WQ = 6 * MiB;
constexpr size_t WS_WKV = 6 * MiB + 512 * 1024;
constexpr size_t WS_WO = 7 * MiB;
constexpr size_t WS_WR = 9 * MiB;
constexpr size_t WS_W1 = 10 * MiB;
constexpr size_t WS_W2 = 138 * MiB;
constexpr size_t WS_HF = 202 * MiB;
constexpr size_t WS_PG = 266 * MiB;
constexpr size_t WS_LIST = 267 * MiB;
constexpr size_t WS_H = 272 * MiB;
constexpr size_t WS_P = 338 * MiB;
constexpr size_t WS_Q = 470 * MiB;
constexpr size_t WS_K = 518 * MiB;
constexpr size_t WS_VT = 568 * MiB;
constexpr size_t WS_LST = 601 * MiB;
constexpr size_t WS_MIX = 667 * MiB;
constexpr size_t WS_ACT = 272 * MiB;
constexpr size_t WS_Y = 528 * MiB;
constexpr size_t WS_END = 784 * MiB;
constexpr size_t WS_PRM = WS_MOD + 256 * 1024;
constexpr int PRM_GQL = 0, PRM_GKVL = 256, PRM_GQH = 384, PRM_GKH = 480, PRM_DECAY = 576, PRM_GRET = 584, PRM_BR = 1096, PRM_GFFN = 1128, PRM_B1 = 2152, PRM_B2 = 67688, PRM_END = 100456;
constexpr int CW_BAR = 4096;
constexpr int CW_CNT = 16384;
constexpr int CW_DIAG = 20480;
#ifndef DIAG
#define DIAG 0
#endif

constexpr int LDS_SCRATCH = 159744;
constexpr int LDS_MISC = LDS_SCRATCH;
constexpr int LDS_BYTES = LDS_SCRATCH + 256;

__device__ __forceinline__ float bf2f(bf16_t h) { return __uint_as_float((unsigned)h << 16); }
__device__ __forceinline__ unsigned f2bf(float f) { unsigned u = __float_as_uint(f); return (u + 0x7fffu + ((u >> 16) & 1u)) >> 16; }
__device__ __forceinline__ unsigned pk2(float lo, float hi) { return f2bf(lo) | (f2bf(hi) << 16); }
__device__ __forceinline__ float lo16(unsigned w) { return __uint_as_float(w << 16); }
__device__ __forceinline__ float hi16(unsigned w) { return __uint_as_float(w & 0xffff0000u); }
__device__ __forceinline__ float wave_sum(float v) {
#pragma unroll
    for (int o = 1; o < 64; o <<= 1) v += __shfl_xor(v, o);
    return v;
}
#define LDS_WAIT() asm volatile("s_waitcnt lgkmcnt(0)" ::: "memory")
__device__ __forceinline__ unsigned cvt4_fp8(float a, float b, float c, float d) { int p = 0; p = __builtin_amdgcn_cvt_pk_fp8_f32(a, b, p, false); p = __builtin_amdgcn_cvt_pk_fp8_f32(c, d, p, true); return (unsigned)p; }
constexpr float WQ_SCALE = 16.f, WKV_SCALE = 8.f, WKV_INV = 1.f / 8.f;
constexpr float WSCALE = 64.f, WINV = 1.f / 64.f;
__device__ __forceinline__ int opaque(int v) { asm volatile("" : "+v"(v)); return v; }
__device__ __forceinline__ int sopaque(int v) { asm volatile("" : "+s"(v)); return v; }
__device__ __forceinline__ int tid_of(int wv) { return sopaque(wv) * 64 + opaque((int)__builtin_amdgcn_mbcnt_hi(~0u, __builtin_amdgcn_mbcnt_lo(~0u, 0u))); }

#define XB_TMO      128
#define XB_XCNT(j)  (256  + 64 * (j))
#define XB_XSUB(j)  (1280 + 64 * (j))
#define XB_XGEN(j)  (2304 + 64 * (j))
#define XB_TOP      3328
#define XB_TOPGEN   3392
#define XCD_BAR_WORDS 3456
#define XB_SPIN_CAP (1u << 20)
__device__ __forceinline__ unsigned xb_ld(unsigned* p)              { return __hip_atomic_load(p, __ATOMIC_RELAXED, __HIP_MEMORY_SCOPE_AGENT); }
__device__ __forceinline__ unsigned xb_add(unsigned* p, unsigned v) { return __hip_atomic_fetch_add(p, v, __ATOMIC_RELAXED, __HIP_MEMORY_SCOPE_AGENT); }
__device__ __forceinline__ unsigned xb_xcc_id() { return (unsigned)__builtin_amdgcn_s_getreg((3 << 11) | 20) & 0xFu; }
#define XB_SPIN(cond, bar) do { unsigned _sp = 0; while (cond) { __builtin_amdgcn_s_sleep(1); \
    if ((++_sp & 255u) == 0u) { if (xb_ld(&(bar)[XB_TMO])) break; if (_sp > XB_SPIN_CAP) { atomicAdd(&(bar)[XB_TMO], 1u); break; } } } } while (0)
struct XcdBarrier { unsigned* bar; unsigned x; volatile LAS unsigned* st; int wv; };
__device__ __forceinline__ XcdBarrier xcd_barrier_post(unsigned* bar, volatile LAS unsigned* st, int wv) {
    XcdBarrier b; b.bar = bar; b.x = xb_xcc_id(); b.st = st; b.wv = wv;
    if (tid_of(wv) == 0) (void)xb_add(&bar[XB_XCNT(b.x)], 1u);
    return b;
}
__device__ __forceinline__ void xcd_barrier_complete(unsigned* bar, unsigned x, unsigned& nloc, unsigned& nx) {
    const unsigned G = gridDim.x * gridDim.y * gridDim.z;
    unsigned sum, cnt, mine, sp = 0u;
    for (;;) {
        sum = 0u; cnt = 0u; mine = 0u;
#pragma unroll 1
        for (unsigned j = 0; j < 16; ++j) { const unsigned c = xb_ld(&bar[XB_XCNT(j)]); sum += c; cnt += (c > 0u) ? 1u : 0u; mine = (j == x) ? c : mine; }
        if (sum == G) break;
        __builtin_amdgcn_s_sleep(1);
        if ((++sp & 255u) == 0u) { if (xb_ld(&bar[XB_TMO])) break; if (sp > XB_SPIN_CAP) { atomicAdd(&bar[XB_TMO], 1u); break; } }
    }
    nloc = mine > 0u ? mine : 1u; nx = cnt > 0u ? cnt : 1u;
}
__device__ __forceinline__ void xcd_barrier(const XcdBarrier& b) {
    asm volatile("s_waitcnt vmcnt(0)" ::: "memory");
    __syncthreads();
    if (tid_of(b.wv) == 0) {
        unsigned* bar = b.bar; asm volatile("" : "+s"(bar));
        __builtin_amdgcn_s_waitcnt(0);
        unsigned nloc = b.st[0], nx = b.st[1];
        if (nloc == 0u) { xcd_barrier_complete(bar, b.x, nloc, nx); b.st[0] = nloc; b.st[1] = nx; }
        const unsigned old = xb_add(&bar[XB_XSUB(b.x)], 1u);
        const unsigned gen = old / nloc;
        if (old + 1u == (gen + 1u) * nloc) {
            __builtin_amdgcn_fence(__ATOMIC_RELEASE, "agent");
            asm volatile("s_waitcnt vmcnt(0)" ::: "memory");
            const unsigned og = xb_add(&bar[XB_TOP], 1u);
            const unsigned tg = og / nx;
            if (og + 1u == (tg + 1u) * nx) xb_add(&bar[XB_TOPGEN], 1u);
            else XB_SPIN(xb_ld(&bar[XB_TOPGEN]) == tg, bar);
            __builtin_amdgcn_fence(__ATOMIC_ACQUIRE, "agent");
            xb_add(&bar[XB_XGEN(b.x)], 1u);
            asm volatile("s_waitcnt vmcnt(0)" ::: "memory");
        } else {
            XB_SPIN(xb_ld(&bar[XB_XGEN(b.x)]) == gen, bar);
            __builtin_amdgcn_fence(__ATOMIC_ACQUIRE, "agent");
            asm volatile("s_waitcnt vmcnt(0)" ::: "memory");
        }
    }
    __syncthreads();
}

struct Args { const float* in[24]; float* out; unsigned char* ws; int ph_lo, ph_hi; int wv, pad; };
#define CAS __attribute__((address_space(4)))
__device__ __forceinline__ Args load_args() { auto p = __builtin_amdgcn_kernarg_segment_ptr(); asm volatile("" : "+s"(p)); Args r; __builtin_memcpy(&r, p, sizeof(Args)); return r; }
enum { I_X = 0, I_C, I_CTX, I_CCTX, I_GATTN, I_GFFN, I_WADA, I_BADA, I_WIN, I_GQL, I_WQUP, I_GQH, I_GKVL, I_WKVUP, I_GKH, I_DECAY, I_GRET, I_WOUT,
       I_WR, I_BR, I_W1, I_B1, I_W2, I_B2 };

template <int MT, int NT, bool SWAP>
__device__ __forceinline__ void mma_ll(f32x4 (&acc)[MT][NT], const LAS bf16_t* sA, int lda, int m0, const LAS bf16_t* sB, int ldb, int n0, int K, int lane) {
    const int fr = lane & 15, fq = lane >> 4;
    for (int k = 0; k < K; k += 32) {
        bf16x8 a[MT], b[NT];
#pragma unroll
        for (int i = 0; i < MT; ++i) a[i] = *(const LAS bf16x8*)(sA + (m0 + 16 * i + fr) * lda + k + 8 * fq);
#pragma unroll
        for (int j = 0; j < NT; ++j) b[j] = *(const LAS bf16x8*)(sB + (n0 + 16 * j + fr) * ldb + k + 8 * fq);
#pragma unroll
        for (int i = 0; i < MT; ++i)
#pragma unroll
            for (int j = 0; j < NT; ++j)
                acc[i][j] = SWAP ? __builtin_amdgcn_mfma_f32_16x16x32_bf16(b[j], a[i], acc[i][j], 0, 0, 0) : __builtin_amdgcn_mfma_f32_16x16x32_bf16(a[i], b[j], acc[i][j], 0, 0, 0);
    }
}
template <int MT, int NT, bool SWAP>
__device__ __forceinline__ void mma_lg(f32x4 (&acc)[MT][NT], const LAS bf16_t* sA, int lda, int m0, const bf16_t* gB, int ldb, int n0, int K, int lane) {
    const int fr = lane & 15, fq = lane >> 4;
#pragma unroll 2
    for (int k = 0; k < K; k += 32) {
        bf16x8 a[MT], b[NT];
#pragma unroll
        for (int j = 0; j < NT; ++j) b[j] = *(const GAS bf16x8*)(gB + (size_t)(n0 + 16 * j + fr) * ldb + k + 8 * fq);
#pragma unroll
        for (int i = 0; i < MT; ++i) a[i] = *(const LAS bf16x8*)(sA + (m0 + 16 * i + fr) * lda + k + 8 * fq);
#pragma unroll
        for (int i = 0; i < MT; ++i)
#pragma unroll
            for (int j = 0; j < NT; ++j)
                acc[i][j] = SWAP ? __builtin_amdgcn_mfma_f32_16x16x32_bf16(b[j], a[i], acc[i][j], 0, 0, 0) : __builtin_amdgcn_mfma_f32_16x16x32_bf16(a[i], b[j], acc[i][j], 0, 0, 0);
    }
}

__device__ __forceinline__ void phase_mod(const Args& a, LAS unsigned char* lds) {
    const int tid = tid_of(a.wv), lane = tid & 63, wave = tid >> 6;
    LAS float* sv = (LAS float*)lds;
    LAS float* red = sv + 5 * 1024;
    float* mod = (float*)(a.ws + WS_MOD);
    for (int i = tid; i < 5 * 1024; i += 512) { const float v = (i < 4096) ? a.in[I_C][i] : a.in[I_CCTX][i - 4096]; sv[i] = v / (1.f + __expf(-v)); }
    __syncthreads();
    const float* W = a.in[I_WADA]; const float* bb = a.in[I_BADA];
    for (int u = blockIdx.x; u < 96; u += gridDim.x) {
        const int col = u * 64 + lane;
        float acc[5] = {0.f, 0.f, 0.f, 0.f, 0.f};
        for (int k = wave * 128; k < wave * 128 + 128; ++k) {
            const float w = W[(size_t)k * 6144 + col];
#pragma unroll
            for (int v = 0; v < 5; ++v) acc[v] += sv[v * 1024 + k] * w;
        }
#pragma unroll
        for (int v = 0; v < 5; ++v) red[(wave * 5 + v) * 64 + lane] = acc[v];
        __syncthreads();
        if (tid < 320) { const int v = tid >> 6; float s = bb[u * 64 + lane];
#pragma unroll
            for (int w = 0; w < 8; ++w) s += red[(w * 5 + v) * 64 + lane];
            mod[v * 6144 + u * 64 + lane] = s; }
        __syncthreads();
    }
    const int gt = blockIdx.x * 512 + tid;
    if (gt < 192 * 8) { const int pi = gt >> 3, f = gt & 7; const float pos = (float)(pi < 128 ? pi : pi - 128);
        const float inv = exp2f(-(float)f * (13.287712379549449f / 8.f)); const float rev = pos * inv * 0.15915494309189535f;
        float* tm = (float*)(a.ws + WS_TABM); tm[gt * 2] = __builtin_amdgcn_cosf(rev); tm[gt * 2 + 1] = __builtin_amdgcn_sinf(rev); }
    else if (gt < 192 * 8 + 192 * 16) { const int g2 = gt - 192 * 8; const int pi = g2 >> 4, f = g2 & 15; const float pos = (float)(pi < 128 ? pi : pi - 128);
        const float inv = exp2f(-(float)f * (13.287712379549449f / 16.f)); const float rev = pos * inv * 0.15915494309189535f;
        float* tr = (float*)(a.ws + WS_TABR); tr[g2 * 2] = __builtin_amdgcn_cosf(rev); tr[g2 * 2 + 1] = __builtin_amdgcn_sinf(rev); }
}

__device__ __forceinline__ void transpose_item(const float* W, int K, int N, bf16_t* WT, LAS float* scr, int item, int lane) {
    const int nblk = N / 32, kb = item / nblk, nb = item % nblk, k0 = 64 * kb, n0 = 32 * nb;
    float wv_[32];
#pragma unroll
    for (int i = 0; i < 32; ++i) { const int kk = 2 * i + (lane >> 5); wv_[i] = W[(size_t)(k0 + kk) * N + n0 + (lane & 31)]; }
#pragma unroll
    for (int i = 0; i < 32; ++i) { const int kk = 2 * i + (lane >> 5); scr[kk * 33 + (lane & 31)] = wv_[i]; }
    LDS_WAIT();
    const int c = lane & 7;
#pragma unroll
    for (int j = 0; j < 4; ++j) { const int n = (lane >> 3) + 8 * j; const LAS float* s = scr + (8 * c) * 33 + n;
        u32x4 o; o.x = pk2(s[0 * 33], s[1 * 33]); o.y = pk2(s[2 * 33], s[3 * 33]); o.z = pk2(s[4 * 33], s[5 * 33]); o.w = pk2(s[6 * 33], s[7 * 33]);
        *(GAS u32x4*)(WT + (size_t)(n0 + n) * K + k0 + 8 * c) = o; }
    LDS_WAIT();
}
__device__ __forceinline__ void transpose_item8(const float* W, int K, int N, unsigned char* WT, float sc, LAS float* scr, int item, int lane) {
    const int nblk = N / 32, kb = item / nblk, nb = item % nblk, k0 = 64 * kb, n0 = 32 * nb;
    float wv_[32];
#pragma unroll
    for (int i = 0; i < 32; ++i) { const int kk = 2 * i + (lane >> 5); wv_[i] = W[(size_t)(k0 + kk) * N + n0 + (lane & 31)]; }
#pragma unroll
    for (int i = 0; i < 32; ++i) { const int kk = 2 * i + (lane >> 5); scr[kk * 33 + (lane & 31)] = wv_[i]; }
    LDS_WAIT();
    const int c = lane & 7;
#pragma unroll
    for (int j = 0; j < 4; ++j) { const int n = (lane >> 3) + 8 * j; const LAS float* s = scr + (8 * c) * 33 + n;
        u32x2 o; o.x = cvt4_fp8(s[0 * 33] * sc, s[1 * 33] * sc, s[2 * 33] * sc, s[3 * 33] * sc); o.y = cvt4_fp8(s[4 * 33] * sc, s[5 * 33] * sc, s[6 * 33] * sc, s[7 * 33] * sc);
        *(GAS u32x2*)(WT + (size_t)(n0 + n) * K + k0 + 8 * c) = o; }
    LDS_WAIT();
}
__device__ __forceinline__ void phase_prep(const Args& a, LAS unsigned char* lds) {
    const int tid = tid_of(a.wv), lane = tid & 63, wave = tid >> 6;
    LAS float* scr = (LAS float*)(lds + wave * 16384);
    const int gw = blockIdx.x * 8 + wave, NGW = gridDim.x * 8;
    constexpr int I_IN = 16 * 61, I_QU = 4 * 24, I_KVU = 2 * 32, I_O = 16 * 32, I_1 = 16 * 64, I_2 = 16 * 32;
    constexpr int NITEMS = I_IN + I_QU + I_KVU + I_O + 32 * I_1 + 32 * I_2;
    const int nitems = gridDim.x == 256 ? I_IN + I_QU + I_KVU + I_O : NITEMS;
    for (int it = gw; it < nitems; it += NGW) {
        int r = it;
        if (r < I_IN) { transpose_item(a.in[I_WIN], 1024, DIN, (bf16_t*)(a.ws + WS_WIN), scr, r, lane); continue; } r -= I_IN;
        if (r < I_QU) { transpose_item8(a.in[I_WQUP], 256, 768, a.ws + WS_WQ, WQ_SCALE, scr, r, lane); continue; } r -= I_QU;
        if (r < I_KVU) { transpose_item8(a.in[I_WKVUP], 128, 1024, a.ws + WS_WKV, WKV_SCALE, scr, r, lane); continue; } r -= I_KVU;
        if (r < I_O) { transpose_item(a.in[I_WOUT], 1024, 1024, (bf16_t*)(a.ws + WS_WO), scr, r, lane); continue; } r -= I_O;
        if (r < 32 * I_1) { const int e = r / I_1; transpose_item8(a.in[I_W1] + (size_t)e * 1024 * 2048, 1024, 2048, a.ws + WS_W1 + (size_t)e * 2048 * 1024, WSCALE, scr, r % I_1, lane); continue; } r -= 32 * I_1;
        { const int e = r / I_2; transpose_item8(a.in[I_W2] + (size_t)e * 1024 * 1024, 1024, 1024, a.ws + WS_W2 + (size_t)e * 1024 * 1024, WSCALE, scr, r % I_2, lane); }
    }
    const int gt = blockIdx.x * 512 + tid, NGT = gridDim.x * 512;
    for (int i = gt; i < 96 * 1024 / 8; i += NGT) *(GAS u32x4*)((bf16_t*)(a.ws + WS_WIN) + (size_t)DIN * 1024 + (size_t)i * 8) = (u32x4){0u, 0u, 0u, 0u};
    for (int i = gt; i < 32 * 1024; i += NGT) { const int n = i >> 10, k = i & 1023; const float w = a.in[I_WR][k * 32 + n]; const unsigned h = f2bf(w);
        bf16_t* wr = (bf16_t*)(a.ws + WS_WR); wr[i] = (bf16_t)h; wr[32768 + i] = (bf16_t)f2bf(w - bf2f((bf16_t)h)); }
    {
        float* prm = (float*)(a.ws + WS_PRM);
        for (int i = gt; i < PRM_END; i += NGT) {
            float v;
            if (i < PRM_GKVL) v = a.in[I_GQL][i - PRM_GQL]; else if (i < PRM_GQH) v = a.in[I_GKVL][i - PRM_GKVL]; else if (i < PRM_GKH) v = a.in[I_GQH][i - PRM_GQH];
            else if (i < PRM_DECAY) v = a.in[I_GKH][i - PRM_GKH]; else if (i < PRM_GRET) v = a.in[I_DECAY][i - PRM_DECAY]; else if (i < PRM_BR) v = a.in[I_GRET][i - PRM_GRET];
            else if (i < PRM_GFFN) v = a.in[I_BR][i - PRM_BR]; else if (i < PRM_B1) v = a.in[I_GFFN][i - PRM_GFFN]; else if (i < PRM_B2) v = a.in[I_B1][i - PRM_B1]; else v = a.in[I_B2][i - PRM_B2];
            prm[i] = v;
        }
    }
    const float* mod = (const float*)(a.ws + WS_MOD); const float* g = a.in[I_GATTN];
    for (int m = gw; m < TA; m += NGW) {
        const float* xr; int mv;
        if (m < T) { xr = a.in[I_X] + (size_t)m * DM; mv = m >> 13; } else { xr = a.in[I_CTX] + (size_t)(m - T) * DM; mv = 4; }
        const float* sh = mod + mv * 6144; const float* sc = sh + 1024;
        f32x4 v[4]; float ss = 0.f;
#pragma unroll
        for (int j = 0; j < 4; ++j) { v[j] = *(const GAS f32x4*)(xr + j * 256 + lane * 4); ss += (v[j].x * v[j].x + v[j].y * v[j].y) + (v[j].z * v[j].z + v[j].w * v[j].w); }
        const float rstd = rsqrtf(wave_sum(ss) * (1.f / DM) + EPS);
        bf16_t* hr = (bf16_t*)(a.ws + WS_H) + (size_t)m * DM;
#pragma unroll
        for (int j = 0; j < 4; ++j) { const int c = j * 256 + lane * 4; const f32x4 gg = *(const GAS f32x4*)(g + c), s1 = *(const GAS f32x4*)(sc + c), s0 = *(const GAS f32x4*)(sh + c);
            const f32x4 o = (v[j] * rstd * gg) * (s1 + 1.f) + s0; u32x2 w; w.x = pk2(o.x, o.y); w.y = pk2(o.z, o.w); *(GAS u32x2*)(hr + c) = w; }
    }
}

#define MOE_ITEM(it_, P_, D_, N_) do { constexpr int I_1 = 16 * 64, I_2 = 16 * 32; \
    const bool up_ = (it_) < 32 * I_1; const int r_ = up_ ? (it_) : (it_) - 32 * I_1; N_ = up_ ? 2048 : 1024; const int per_ = up_ ? I_1 : I_2, e_ = r_ / per_, item_ = r_ % per_; \
    const int nblk_ = N_ / 32, kb_ = item_ / nblk_, nb_ = item_ % nblk_, k0_ = 64 * kb_, n0_ = 32 * nb_; \
    P_ = (up_ ? a.in[I_W1] : a.in[I_W2]) + (size_t)e_ * 1024 * N_ + (size_t)(k0_ + (lane >> 5)) * N_ + n0_ + (lane & 31); \
    D_ = a.ws + (up_ ? WS_W1 : WS_W2) + (size_t)e_ * N_ * 1024 + (size_t)n0_ * 1024 + k0_; } while (0)
__device__ __forceinline__ void moe_convert(const Args& a, LAS unsigned char* lds, int cu) {
    const int tid = tid_of(a.wv), lane = tid & 63, wave = tid >> 6;
    LAS float* scr = (LAS float*)(lds + wave * 16384);
    constexpr int NIT = 32 * (16 * 64 + 16 * 32);
    __syncthreads();
    float wc[32], wn[32];
    int it = cu * 8 + wave;
    const float* pc; unsigned char* dc; int nc;
    MOE_ITEM(it, pc, dc, nc);
#pragma unroll
    for (int i = 0; i < 32; ++i) wc[i] = pc[(size_t)(2 * i) * nc];
#pragma unroll 1
    while (it < NIT) {
        const int itn = it + 256 * 8; const bool more = itn < NIT;
        const float* pn; unsigned char* dn; int nn; const int itx = more ? itn : it;
        MOE_ITEM(itx, pn, dn, nn);
        if (more) {
#pragma unroll
            for (int i = 0; i < 32; ++i) wn[i] = pn[(size_t)(2 * i) * nn]; }
#pragma unroll
        for (int i = 0; i < 32; ++i) { const int kk = 2 * i + (lane >> 5); scr[kk * 33 + (lane & 31)] = wc[i]; }
        LDS_WAIT();
        const int c = lane & 7;
#pragma unroll
        for (int j = 0; j < 4; ++j) { const int n = (lane >> 3) + 8 * j; const LAS float* s_ = scr + (8 * c) * 33 + n;
            u32x2 o; o.x = cvt4_fp8(s_[0 * 33] * WSCALE, s_[1 * 33] * WSCALE, s_[2 * 33] * WSCALE, s_[3 * 33] * WSCALE); o.y = cvt4_fp8(s_[4 * 33] * WSCALE, s_[5 * 33] * WSCALE, s_[6 * 33] * WSCALE, s_[7 * 33] * WSCALE);
            *(GAS u32x2*)(dc + (size_t)n * 1024 + 8 * c) = o; }
        LDS_WAIT();
#pragma unroll
        for (int i = 0; i < 32; ++i) wc[i] = wn[i];
        dc = dn; it = itn;
    }
    __syncthreads();
}
#undef MOE_ITEM

struct GUnit { const bf16_t* Bt; int m0, n0, nvalid, e; };
template <class RowFn, class Epi>
__device__ __forceinline__ void gemm_tile(LAS unsigned char* lds, const bf16_t* A, int K, const GUnit& u, const RowFn& rowfn, const Epi& epi) {
    LAS bf16_t* sA = (LAS bf16_t*)lds;
    LAS bf16_t* sB = (LAS bf16_t*)(lds + 256 * 72 * 2);
    const int tid = opaque((int)threadIdx.x), lane = tid & 63, wave = tid >> 6, wm = wave >> 1, wn = wave & 1;
    const int ch = tid & 7, r0 = tid >> 3;
    const bf16_t* ap[4]; const bf16_t* bp[2];
#pragma unroll
    for (int i = 0; i < 4; ++i) { const int r = r0 + 64 * i; const int rr = r < u.nvalid ? r : 0; ap[i] = A + (size_t)rowfn(u, rr) * K + ch * 8; }
#pragma unroll
    for (int i = 0; i < 2; ++i) bp[i] = u.Bt + (size_t)(r0 + 64 * i) * K + ch * 8;
    f32x4 acc[4][4];
#pragma unroll
    for (int i = 0; i < 4; ++i)
#pragma unroll
        for (int j = 0; j < 4; ++j) acc[i][j] = (f32x4){0.f, 0.f, 0.f, 0.f};
    u32x4 ra[4], rb[2];
#pragma unroll
    for (int i = 0; i < 4; ++i) ra[i] = *(const GAS u32x4*)(ap[i]);
#pragma unroll
    for (int i = 0; i < 2; ++i) rb[i] = *(const GAS u32x4*)(bp[i]);
    const int nk = K / 64;
    for (int kt = 0; kt < nk; ++kt) {
        __syncthreads();
#pragma unroll
        for (int i = 0; i < 4; ++i) *(LAS u32x4*)(sA + (r0 + 64 * i) * 72 + ch * 8) = ra[i];
#pragma unroll
        for (int i = 0; i < 2; ++i) *(LAS u32x4*)(sB + (r0 + 64 * i) * 72 + ch * 8) = rb[i];
        __syncthreads();
        if (kt + 1 < nk) {
#pragma unroll
            for (int i = 0; i < 4; ++i) ra[i] = *(const GAS u32x4*)(ap[i] + (kt + 1) * 64);
#pragma unroll
            for (int i = 0; i < 2; ++i) rb[i] = *(const GAS u32x4*)(bp[i] + (kt + 1) * 64);
        }
        mma_ll<4, 4, true>(acc, sA, 72, wm * 64, sB, 72, wn * 64, 64, lane);
    }
    epi(acc, u, wm, wn, lane);
}
struct RowDense { __device__ __forceinline__ int operator()(const GUnit& u, int r) const { return u.m0 + r; } };
struct RowPairTok { const unsigned* list; __device__ __forceinline__ int operator()(const GUnit& u, int r) const { return (int)(list[(size_t)u.e * 32768 + u.m0 + r] >> 2); } };
struct RowPair { const unsigned* list; __device__ __forceinline__ int operator()(const GUnit& u, int r) const { return (int)list[(size_t)u.e * 32768 + u.m0 + r]; } };

struct EpiP { bf16_t* P;
    __device__ __forceinline__ void operator()(const f32x4 (&acc)[4][4], const GUnit& u, int wm, int wn, int lane) const {
        const int fr = lane & 15, fq = lane >> 4;
#pragma unroll
        for (int i = 0; i < 4; ++i) { const int row = u.m0 + wm * 64 + 16 * i + fr;
#pragma unroll
            for (int j = 0; j < 4; ++j) { const int col = u.n0 + wn * 64 + 16 * j + 4 * fq; u32x2 w; w.x = pk2(acc[i][j][0], acc[i][j][1]); w.y = pk2(acc[i][j][2], acc[i][j][3]);
                *(GAS u32x2*)(P + (size_t)row * DINP + col) = w; } }
    } };
struct EpiOut { const float* x; const float* mod; float* out;
    __device__ __forceinline__ void operator()(const f32x4 (&acc)[4][4], const GUnit& u, int wm, int wn, int lane) const {
        const int fr = lane & 15, fq = lane >> 4;
#pragma unroll
        for (int i = 0; i < 4; ++i) { const int row = u.m0 + wm * 64 + 16 * i + fr; const float* gate = mod + (row >> 13) * 6144 + 2 * 1024;
#pragma unroll
            for (int j = 0; j < 4; ++j) { const int col = u.n0 + wn * 64 + 16 * j + 4 * fq;
                const f32x4 xv = *(const GAS f32x4*)(x + (size_t)row * DM + col), gv = *(const GAS f32x4*)(gate + col);
                *(GAS f32x4*)(out + (size_t)row * DM + col) = xv + gv * acc[i][j]; } }
    } };
struct EpiM1 { const unsigned* list; const float* b1; bf16_t* act;
    __device__ __forceinline__ void operator()(const f32x4 (&acc)[4][4], const GUnit& u, int wm, int wn, int lane) const {
        const int fr = lane & 15, fq = lane >> 4;
#pragma unroll
        for (int i = 0; i < 4; ++i) { const int r = wm * 64 + 16 * i + fr; if (r >= u.nvalid) continue;
            const unsigned pair = list[(size_t)u.e * 32768 + u.m0 + r];
#pragma unroll
            for (int j = 0; j < 4; ++j) { const int col = u.n0 + wn * 64 + 16 * j + 4 * fq; const f32x4 bv = *(const GAS f32x4*)(b1 + (size_t)u.e * 2048 + col);
                const f32x4 v = acc[i][j] + bv;
                const float g0 = fminf(v[0], 7.f), l0 = fminf(fmaxf(v[1], -7.f), 7.f), g1 = fminf(v[2], 7.f), l1 = fminf(fmaxf(v[3], -7.f), 7.f);
                const float a0 = g0 / (1.f + __expf(-1.702f * g0)) * (l0 + 1.f), a1 = g1 / (1.f + __expf(-1.702f * g1)) * (l1 + 1.f);
                *(GAS unsigned*)(act + (size_t)pair * DFF + (col >> 1)) = pk2(a0, a1); } }
    } };
struct EpiM2 { const unsigned* list; const float* b2; const float* pg; bf16_t* y;
    __device__ __forceinline__ void operator()(const f32x4 (&acc)[4][4], const GUnit& u, int wm, int wn, int lane) const {
        const int fr = lane & 15, fq = lane >> 4;
#pragma unroll
        for (int i = 0; i < 4; ++i) { const int r = wm * 64 + 16 * i + fr; if (r >= u.nvalid) continue;
            const unsigned pair = list[(size_t)u.e * 32768 + u.m0 + r]; const float g = pg[pair];
#pragma unroll
            for (int j = 0; j < 4; ++j) { const int col = u.n0 + wn * 64 + 16 * j + 4 * fq; const f32x4 bv = *(const GAS f32x4*)(b2 + (size_t)u.e * 1024 + col);
                const f32x4 v = (acc[i][j] + bv) * g; u32x2 w; w.x = pk2(v[0], v[1]); w.y = pk2(v[2], v[3]);
                *(GAS u32x2*)(y + (size_t)pair * DM + col) = w; } }
    } };

namespace pg8 {
constexpr int BM = 256, BK = 64, HALF = 128, HTB = HALF * BK * 2, STAGE_BYTES = 8 * HTB, NXCD = 8, WGM = 8;
__host__ __device__ __forceinline__ int lds_byte(int r, int c) { const int st = (r >> 4) * 2 + (c >> 5), rr = r & 15, cc = c & 31, ob = rr * 64 + cc * 2; return st * 1024 + (ob ^ (((ob >> 9) & 1) << 5)); }
__host__ __device__ __forceinline__ void stage_rc(int b, int& R, int& C) { const int st = b / 1024, sb = b % 1024, swz = sb ^ (((sb >> 9) & 1) << 5); R = (st >> 1) * 16 + swz / 64; C = (st & 1) * 32 + (swz % 64) / 2; }
__host__ __device__ __forceinline__ int perm32(int rho) { const int n = rho >> 4, i = rho & 15; return 8 * (i >> 2) + 4 * n + (i & 3); }
struct Unit { int pm, pn; const char* A; const char* B; int e, nvalid, ul; };
struct DenseOrder {
    int nM, nN, nwg, G, c; const char* A; const char* B; size_t tstep;
    __device__ void init(const void* A_, const void* B_, int M, int N, int K, int G_, int c_) { nM = M / BM; nN = N / BM; nwg = nM * nN; G = G_; c = c_; A = (const char*)A_; B = (const char*)B_; tstep = (size_t)BM * K * 2; }
    __device__ bool next(int i, Unit& u) const {
        const long L = (long)i * G + c; if (L >= nwg) return false;
        int wgid = (int)L; { const int q = nwg / NXCD, r = nwg % NXCD, xcd = wgid % NXCD, off = wgid / NXCD; wgid = (xcd < r ? xcd * (q + 1) : r * (q + 1) + (xcd - r) * q) + off; }
        const int nig = WGM * nN, gid = wgid / nig, fm = gid * WGM, gsz = (nM - fm) < WGM ? (nM - fm) : WGM;
        u.pm = fm + ((wgid % nig) % gsz); u.pn = (wgid % nig) / gsz; u.A = A + (size_t)u.pm * tstep; u.B = B + (size_t)u.pn * tstep; u.e = 0; u.nvalid = 256; u.ul = 0; return true;
    }
};
template <int NCT> struct ExpertOrder {
    const LAS int* pre; int G, c; const char* A; const char* W; size_t wstride; int rowbytes;
    __device__ bool next(int i, Unit& u) const {
        const int L = i * G + c; const int nunit = pre[32] * NCT; if (L >= nunit) return false;
        const int ti = L / NCT; u.pn = L % NCT; int e = 0;
        for (int k = 1; k < 32; ++k) if (pre[k] <= ti) e = k;
        u.pm = ti - pre[e]; u.e = e; const int cnt = pre[33 + e]; u.nvalid = (cnt - u.pm * 256) < 256 ? (cnt - u.pm * 256) : 256; u.ul = i;
        u.A = A; u.B = W + (size_t)e * wstride + (size_t)u.pn * 256 * rowbytes; return true;
    }
};
__device__ __forceinline__ unsigned cvt_pk_bf16(float lo, float hi) { unsigned r; asm volatile("v_cvt_pk_bf16_f32 %0, %1, %2" : "=v"(r) : "v"(lo), "v"(hi)); return r; }
typedef int i32x4 __attribute__((ext_vector_type(4))); typedef int i32x8 __attribute__((ext_vector_type(8)));
__device__ __forceinline__ bf16x8 lo8(i32x8 v) { return __builtin_bit_cast(bf16x8, (i32x4)__builtin_shufflevector(v, v, 0, 1, 2, 3)); }
__device__ __forceinline__ bf16x8 hi8(i32x8 v) { return __builtin_bit_cast(bf16x8, (i32x4)__builtin_shufflevector(v, v, 4, 5, 6, 7)); }

template <class Epi, class Sched, bool GATHER, bool FP8 = false>
__device__ __forceinline__ void gemm_phase(LAS unsigned char* lds, const LAS int* tab, const LAS bf16_t* aux, int ashift, int K, const Sched& S, const Epi& E, int wv) {
    const int tid = tid_of(wv), wid = wv, lane = tid & 63, wr = wid >> 2, wc = wid & 3, fr = lane & 15, fq = lane >> 4;
    const int nt = K / BK;
    unsigned voffA[2], voffB[2]; unsigned cb0 = 0; int rg0 = 0;
#pragma unroll
    for (int i = 0; i < 2; ++i) { int R, C; stage_rc(tid * 16 + i * 8192, R, C); const int Rb = (R & ~31) + perm32(R & 31);
        voffA[i] = (unsigned)(R * K + C) * 2u; voffB[i] = (unsigned)(Rb * K + C) * 2u; if (i == 0) { cb0 = (unsigned)C * 2u; rg0 = R; } }
    const size_t kstep = (size_t)(BK * 2);
    const size_t hstep = (size_t)HALF * K * 2;
    const size_t hstepA = GATHER ? 0 : hstep;
    const unsigned ldsw = (unsigned)wid * 1024u;
    const int aoff = lds_byte(wr * 64 + fr, fq * 8), boff = lds_byte(wc * 32 + fr, fq * 8);
    int cul = 0, nul = 0;
#define PG8_SA(b, h) (((b) * 2 + (h)) * HTB)
#define PG8_SB(b, h) ((4 + (b) * 2 + (h)) * HTB)
#define PG8_STAGE(bufoff, gbase, voff) do { _Pragma("unroll") for (int _i = 0; _i < 2; ++_i) \
        __builtin_amdgcn_global_load_lds((const unsigned*)((const char*)(gbase) + (voff)[_i]), (LAS unsigned*)(lds + (bufoff) + ldsw + _i * 8192), 16, 0, 0); } while (0)
#define PG8_STAGE_A(bufoff, gbase, h, usenext) do { const int ulx_ = (usenext) ? nul : cul; _Pragma("unroll") for (int _i = 0; _i < 2; ++_i) { \
        unsigned vo_; if constexpr (GATHER) vo_ = (unsigned)(tab[ulx_ * 256 + (h) * 128 + rg0 + 64 * _i] >> ashift) * (unsigned)(K * 2) + cb0; else vo_ = voffA[_i]; \
        __builtin_amdgcn_global_load_lds((const unsigned*)((const char*)(gbase) + (h) * hstepA + vo_), (LAS unsigned*)(lds + (bufoff) + ldsw + _i * 8192), 16, 0, 0); } } while (0)
#define PG8_LDA(dst, b, h) do { _Pragma("unroll") for (int m = 0; m < 4; ++m) { const i32x4 lo_ = *(const LAS i32x4*)(lds + PG8_SA(b, h) + aoff + m * 2048), hi_ = *(const LAS i32x4*)(lds + PG8_SA(b, h) + aoff + m * 2048 + 1024); \
        dst[m] = __builtin_shufflevector(lo_, hi_, 0, 1, 2, 3, 4, 5, 6, 7); } } while (0)
#define PG8_LDB(dst, b, h) do { _Pragma("unroll") for (int n = 0; n < 2; ++n) { const i32x4 lo_ = *(const LAS i32x4*)(lds + PG8_SB(b, h) + boff + n * 2048), hi_ = *(const LAS i32x4*)(lds + PG8_SB(b, h) + boff + n * 2048 + 1024); \
        dst[n] = __builtin_shufflevector(lo_, hi_, 0, 1, 2, 3, 4, 5, 6, 7); } } while (0)
#define PG8_MMA(ai, bj, At, Bt) do { __builtin_amdgcn_s_setprio(1); _Pragma("unroll") for (int m = 0; m < 4; ++m) _Pragma("unroll") for (int n = 0; n < 2; ++n) { \
        if constexpr (FP8) { asm("v_mfma_f32_16x16x128_f8f6f4 %0, %1, %2, %0" : "+v"(acc[ai][bj][m][n]) : "v"(Bt[n]), "v"(At[m])); } \
        else { acc[ai][bj][m][n] = __builtin_amdgcn_mfma_f32_16x16x32_bf16(lo8(Bt[n]), lo8(At[m]), acc[ai][bj][m][n], 0, 0, 0); \
               acc[ai][bj][m][n] = __builtin_amdgcn_mfma_f32_16x16x32_bf16(hi8(Bt[n]), hi8(At[m]), acc[ai][bj][m][n], 0, 0, 0); } } \
        __builtin_amdgcn_s_setprio(0); } while (0)
#define PG8_WAIT_V(n) asm volatile("s_waitcnt vmcnt(" #n ")" ::: "memory")
#define PG8_WAIT_L(n) asm volatile("s_waitcnt lgkmcnt(" #n ")" ::: "memory")
#define PG8_BAR __builtin_amdgcn_s_barrier()
#define PG8_SCHED __builtin_amdgcn_sched_barrier(0)
    Unit cur, nxt; int ui = 0;
    if (!S.next(0, cur)) return;
    cul = cur.ul; nul = cur.ul;
    f32x4 acc[2][2][4][2];
#pragma unroll
    for (int a = 0; a < 2; ++a)
#pragma unroll
        for (int b = 0; b < 2; ++b)
#pragma unroll
            for (int m = 0; m < 4; ++m)
#pragma unroll
                for (int n = 0; n < 2; ++n) acc[a][b][m][n] = (f32x4){0.f, 0.f, 0.f, 0.f};
    i32x8 At[4], B0[2], B1[2];
    const char* cA = cur.A; const char* cB = cur.B;
    PG8_STAGE(PG8_SB(0, 0), cB, voffB); PG8_STAGE(PG8_SB(0, 1), cB + hstep, voffB); PG8_STAGE_A(PG8_SA(0, 0), cA, 0, false); PG8_STAGE_A(PG8_SA(0, 1), cA, 1, false);
    if (wr == 1) PG8_BAR;
    PG8_WAIT_V(2); PG8_BAR;
    PG8_STAGE(PG8_SB(1, 0), cB + kstep, voffB); PG8_STAGE_A(PG8_SA(1, 0), cA + kstep, 0, false); PG8_STAGE(PG8_SB(1, 1), cB + hstep + kstep, voffB);
    PG8_WAIT_V(6); PG8_BAR;
    for (;;) {
        const bool has_next = S.next(ui + 1, nxt);
        const char* nA = has_next ? nxt.A : cA; const char* nB = has_next ? nxt.B : cB;
        nul = has_next ? nxt.ul : cur.ul;
#if DIAG >= 10
        long long tk0_ = 0; if (DIAG == 10 + Epi::ID && ui == 0) tk0_ = (long long)__builtin_amdgcn_s_memtime();
        if (DIAG == 20 + Epi::ID && ui <= 1) { const long long tn_ = (long long)__builtin_amdgcn_s_memtime();
            if (ui == 0) { if (blockIdx.x == 0 && tid == 0) { ((volatile LAS unsigned*)(lds + 159744))[41] = (unsigned)tn_; } }
            else if (blockIdx.x == 0 && tid == 0) { const unsigned d_ = (unsigned)tn_ - ((volatile LAS unsigned*)(lds + 159744))[41]; const float q = rintf((float)d_ * (1.f / 1000.f));
                ((volatile LAS unsigned*)(lds + 159744))[40] = __float_as_uint(q * 1e-5f); } }
#endif
#pragma unroll 1
        for (int t = 0; t < nt; t += 2) {
            const bool last = (t == nt - 2);
            const char* a1 = cA + (size_t)(t + 1) * kstep;
            const char* a2 = last ? nA : cA + (size_t)(t + 2) * kstep; const char* b2 = last ? nB : cB + (size_t)(t + 2) * kstep;
            const char* a3 = a2 + kstep; const char* b3 = b2 + kstep;
            PG8_LDB(B0, 0, 0); PG8_LDB(B1, 0, 1); PG8_SCHED; PG8_LDA(At, 0, 0); PG8_STAGE_A(PG8_SA(1, 1), a1, 1, false);
            PG8_WAIT_V(8); PG8_WAIT_L(0); PG8_BAR; PG8_MMA(0, 0, At, B0); PG8_MMA(0, 1, At, B1); PG8_BAR; PG8_SCHED;
            PG8_LDA(At, 0, 1); PG8_STAGE(PG8_SB(0, 0), b2, voffB); PG8_STAGE(PG8_SB(0, 1), b2 + hstep, voffB); PG8_STAGE_A(PG8_SA(0, 0), a2, 0, last);
            PG8_WAIT_V(8); PG8_WAIT_L(0); PG8_BAR; PG8_MMA(1, 0, At, B0); PG8_MMA(1, 1, At, B1); PG8_BAR; PG8_SCHED;
            PG8_LDB(B0, 1, 0); PG8_LDB(B1, 1, 1); PG8_SCHED; PG8_LDA(At, 1, 0); PG8_STAGE_A(PG8_SA(0, 1), a2, 1, last);
            PG8_WAIT_V(8); PG8_WAIT_L(0); PG8_BAR; PG8_MMA(0, 0, At, B0); PG8_MMA(0, 1, At, B1); PG8_BAR; PG8_SCHED;
            PG8_LDA(At, 1, 1); PG8_STAGE(PG8_SB(1, 0), b3, voffB); PG8_STAGE(PG8_SB(1, 1), b3 + hstep, voffB); PG8_STAGE_A(PG8_SA(1, 0), a3, 0, last);
            PG8_WAIT_V(8); PG8_WAIT_L(0); PG8_BAR; PG8_MMA(1, 0, At, B0); PG8_MMA(1, 1, At, B1); PG8_BAR; PG8_SCHED;
        }
#if DIAG >= 10
        if (DIAG == 10 + Epi::ID && ui == 0) { const long long tk1_ = (long long)__builtin_amdgcn_s_memtime();
            if (blockIdx.x == 0 && tid == 0) { const float perk = (float)(tk1_ - tk0_) / (float)nt; const float q = rintf(perk * (1.f / 250.f));
                ((volatile LAS unsigned*)(lds + 159744))[40] = __float_as_uint(q * 2e-5f); } }
#endif
        if (wr == 0) PG8_BAR;
        if constexpr (FP8) asm volatile("s_nop 15\n\ts_nop 7" ::: "memory");
        E(acc, cur, tab, aux, wr, wc, fr, fq);
        if (!has_next) break;
#pragma unroll
        for (int a = 0; a < 2; ++a)
#pragma unroll
            for (int b = 0; b < 2; ++b)
#pragma unroll
                for (int m = 0; m < 4; ++m)
#pragma unroll
                    for (int n = 0; n < 2; ++n) acc[a][b][m][n] = (f32x4){0.f, 0.f, 0.f, 0.f};
        cur = nxt; cA = nA; cB = nB; ++ui;
        cul = cur.ul;
        if (wr == 1) PG8_BAR;
    }
    PG8_WAIT_V(0);
    PG8_BAR;
#undef PG8_SA
#undef PG8_SB
#undef PG8_STAGE
#undef PG8_STAGE_A
#undef PG8_LDA
#undef PG8_LDB
#undef PG8_MMA
#undef PG8_WAIT_V
#undef PG8_WAIT_L
#undef PG8_BAR
#undef PG8_SCHED
}

struct EpiP { static constexpr int ID = 2; bf16_t* P;
    __device__ __forceinline__ void operator()(const f32x4 (&acc)[2][2][4][2], const Unit& u, const LAS int*, const LAS bf16_t*, int wr, int wc, int fr, int fq) const {
        const int row0 = u.pm * BM + wr * 64 + fr, col0 = u.pn * BM + wc * 32 + 8 * fq;
#pragma unroll
        for (int ai = 0; ai < 2; ++ai)
#pragma unroll
            for (int m = 0; m < 4; ++m) { bf16_t* rowp = P + (size_t)(row0 + ai * HALF + m * 16) * DINP + col0;
#pragma unroll
                for (int bj = 0; bj < 2; ++bj) { const f32x4 v0 = acc[ai][bj][m][0], v1 = acc[ai][bj][m][1]; u32x4 w;
                    w.x = cvt_pk_bf16(v0[0], v0[1]); w.y = cvt_pk_bf16(v0[2], v0[3]); w.z = cvt_pk_bf16(v1[0], v1[1]); w.w = cvt_pk_bf16(v1[2], v1[3]);
                    *(GAS u32x4*)(rowp + bj * HALF) = w; } }
    } };
struct EpiOut { static constexpr int ID = 6; const float* x; const float* mod; float* out;
    __device__ __forceinline__ void operator()(const f32x4 (&acc)[2][2][4][2], const Unit& u, const LAS int*, const LAS bf16_t*, int wr, int wc, int fr, int fq) const {
        const int row0 = u.pm * BM + wr * 64 + fr, col0 = u.pn * BM + wc * 32 + 8 * fq;
        const float* gate = mod + (row0 >> 13) * 6144 + 2 * 1024;
#pragma unroll
        for (int bj = 0; bj < 2; ++bj) { const f32x4 g0 = *(const GAS f32x4*)(gate + col0 + bj * HALF), g1 = *(const GAS f32x4*)(gate + col0 + bj * HALF + 4);
#pragma unroll
            for (int ai = 0; ai < 2; ++ai)
#pragma unroll
                for (int m = 0; m < 4; ++m) { const size_t off = (size_t)(row0 + ai * HALF + m * 16) * DM + col0 + bj * HALF;
                    const f32x4 x0 = *(const GAS f32x4*)(x + off), x1 = *(const GAS f32x4*)(x + off + 4);
                    *(GAS f32x4*)(out + off) = x0 + g0 * acc[ai][bj][m][0]; *(GAS f32x4*)(out + off + 4) = x1 + g1 * acc[ai][bj][m][1]; } }
    } };
struct EpiM1 { static constexpr int ID = 8; unsigned char* act;
    __device__ __forceinline__ void operator()(const f32x4 (&acc)[2][2][4][2], const Unit& u, const LAS int* tab, const LAS bf16_t* aux, int wr, int wc, int fr, int fq) const {
        const int cl = wc * 32 + 8 * fq, col0 = u.pn * BM + cl;
        f32x4 bv[2][2];
#pragma unroll
        for (int bj = 0; bj < 2; ++bj) { const u32x4 w = *(const LAS u32x4*)(aux + u.ul * 256 + bj * HALF + cl);
            bv[bj][0] = (f32x4){lo16(w[0]), hi16(w[0]), lo16(w[1]), hi16(w[1])}; bv[bj][1] = (f32x4){lo16(w[2]), hi16(w[2]), lo16(w[3]), hi16(w[3])}; }
#pragma unroll
        for (int ai = 0; ai < 2; ++ai)
#pragma unroll
            for (int m = 0; m < 4; ++m) { const int r = ai * HALF + wr * 64 + m * 16 + fr; const bool ok = r < u.nvalid;
                const int pair = tab[u.ul * 256 + r]; unsigned char* rowp = act + (size_t)pair * DFF + (col0 >> 1);
#pragma unroll
                for (int bj = 0; bj < 2; ++bj) { float o[4];
#pragma unroll
                    for (int n = 0; n < 2; ++n) { const f32x4 v = acc[ai][bj][m][n] * WINV + bv[bj][n];
                        const float g0 = fminf(v[0], 7.f), l0 = fminf(fmaxf(v[1], -7.f), 7.f), g1 = fminf(v[2], 7.f), l1 = fminf(fmaxf(v[3], -7.f), 7.f);
                        o[2 * n] = g0 * __builtin_amdgcn_rcpf(1.f + __builtin_amdgcn_exp2f(-2.4554669595930156f * g0)) * (l0 + 1.f);
                        o[2 * n + 1] = g1 * __builtin_amdgcn_rcpf(1.f + __builtin_amdgcn_exp2f(-2.4554669595930156f * g1)) * (l1 + 1.f); }
                    const unsigned w = cvt4_fp8(o[0], o[1], o[2], o[3]); if (ok) *(GAS unsigned*)(rowp + bj * (HALF / 2)) = w; } }
    } };
constexpr float YSCALE = 8.f, YINV = 1.f / 8.f;
struct EpiM2 { static constexpr int ID = 9; unsigned char* y;
    __device__ __forceinline__ void operator()(const f32x4 (&acc)[2][2][4][2], const Unit& u, const LAS int* tab, const LAS bf16_t* aux, int wr, int wc, int fr, int fq) const {
        const int cl = wc * 32 + 8 * fq, col0 = u.pn * BM + cl;
        f32x4 bv[2][2];
#pragma unroll
        for (int bj = 0; bj < 2; ++bj) { const u32x4 w = *(const LAS u32x4*)(aux + u.ul * 256 + bj * HALF + cl);
            bv[bj][0] = (f32x4){lo16(w[0]), hi16(w[0]), lo16(w[1]), hi16(w[1])}; bv[bj][1] = (f32x4){lo16(w[2]), hi16(w[2]), lo16(w[3]), hi16(w[3])}; }
#pragma unroll
        for (int ai = 0; ai < 2; ++ai)
#pragma unroll
            for (int m = 0; m < 4; ++m) { const int r = ai * HALF + wr * 64 + m * 16 + fr; const bool ok = r < u.nvalid;
                const int pair = tab[u.ul * 256 + r]; const float g = bf2f(aux[9 * 256 + u.ul * 256 + r]) * YSCALE; unsigned char* rowp = y + (size_t)pair * DM + col0;
#pragma unroll
                for (int bj = 0; bj < 2; ++bj) { const f32x4 v0 = (acc[ai][bj][m][0] * WINV + bv[bj][0]) * g, v1 = (acc[ai][bj][m][1] * WINV + bv[bj][1]) * g; u32x2 w;
                    w.x = cvt4_fp8(v0[0], v0[1], v0[2], v0[3]); w.y = cvt4_fp8(v1[0], v1[1], v1[2], v1[3]);
                    if (ok) *(GAS u32x2*)(rowp + bj * HALF) = w; } }
    } };
}
constexpr int PG8_TAB_OFF = pg8::STAGE_BYTES;
constexpr int PG8_AUX_OFF = PG8_TAB_OFF + 18 * 1024;
constexpr int PG8_PRE_OFF = PG8_AUX_OFF + 9 * 1024;
static_assert(PG8_PRE_OFF + 512 <= LDS_SCRATCH, "LDS map");

template <int NCT, class Epi>
__device__ __forceinline__ void phase_moe_pg8(const Args& a, LAS unsigned char* lds, const unsigned char* A, int ashift, const unsigned char* Wt, size_t wstride, const float* bias, int nbias, const float* gates, const Epi& E) {
    LAS int* tab = (LAS int*)(lds + PG8_TAB_OFF); LAS int* pre = (LAS int*)(lds + PG8_PRE_OFF); LAS bf16_t* aux = (LAS bf16_t*)(lds + PG8_AUX_OFF);
    const unsigned* cnt = (const unsigned*)(a.ws + WS_CTL) + CW_CNT; const unsigned* list = (const unsigned*)(a.ws + WS_LIST);
    __syncthreads();
    const int tidm = tid_of(a.wv);
    if (tidm < NE) pre[33 + tidm] = (int)__hip_atomic_load(cnt + 64 * tidm, __ATOMIC_RELAXED, __HIP_MEMORY_SCOPE_AGENT);
    __syncthreads();
    if (tidm == 0) { int s = 0;
#pragma unroll 1
        for (int e = 0; e < NE; ++e) { const int c = pre[33 + e]; pre[e] = s; s += (c + 255) >> 8; } pre[32] = s; }
    __syncthreads();
    const int G_ = (int)gridDim.x, bx_ = (int)blockIdx.x, vcu_ = (G_ % 8 == 0) ? (bx_ % 8) * (G_ / 8) + bx_ / 8 : bx_;
    pg8::ExpertOrder<NCT> S{pre, G_, vcu_, (const char*)A, (const char*)Wt, wstride, 1024};
    constexpr int NU = NCT == 8 ? 18 : 9; constexpr bool HASG = NCT == 4;
    const int nunit_ = pre[32] * NCT;
    unsigned val[NU]; float gv[NU];
#pragma unroll
    for (int i = 0; i < NU; ++i) { pg8::Unit u; val[i] = 0u;
        if (S.next(i, u)) { if (tidm < 256) val[i] = list[(size_t)u.e * 32768 + u.pm * 256 + (tidm < u.nvalid ? tidm : 0)]; else val[i] = __float_as_uint(bias[(size_t)u.e * nbias + u.pn * 256 + tidm - 256]); } }
#pragma unroll
    for (int i = 0; i < NU; ++i) { gv[i] = 0.f; if (HASG && tidm < 256 && i * G_ + vcu_ < nunit_) gv[i] = gates[val[i]]; }
#pragma unroll
    for (int i = 0; i < NU; ++i) if (i * G_ + vcu_ < nunit_) {
        if (tidm < 256) { tab[i * 256 + tidm] = (int)val[i]; if (HASG) aux[9 * 256 + i * 256 + tidm] = (bf16_t)f2bf(gv[i]); }
        else aux[i * 256 + tidm - 256] = (bf16_t)f2bf(__uint_as_float(val[i])); }
    __syncthreads();
    pg8::gemm_phase<Epi, pg8::ExpertOrder<NCT>, true, true>(lds, tab, aux, ashift, 512, S, E, a.wv);
}

__device__ __forceinline__ void mla_tile(const Args& a, LAS unsigned char* lds, int tile, int r0 = 0, int nrows = 128) {
    const int tid = tid_of(a.wv), lane = tid & 63, wave = a.wv, fr = lane & 15, fq = lane >> 4;
    const bool lat = tile < 256;
    const int prow0 = tile * 128;
    const int b = lat ? (prow0 >> 13) : ((prow0 - T) >> 8);
    const int tpos0 = lat ? (prow0 & 8191) : ((prow0 - T) & 255);
    const int key0 = lat ? (LC + tpos0) : tpos0;
    LAS unsigned char* Aq = lds;
    LAS unsigned char* Akv = lds + 34816;
    LAS float* kpe = (LAS float*)(lds + 34816 + 18432);
    LAS float* sspe = (LAS float*)(lds + 34816 + 18432 + 16384);
    const bf16_t* P = (const bf16_t*)(a.ws + WS_P);
    const float* tabm = (const float*)(a.ws + WS_TABM);
    __syncthreads();
    if ((tid >> 2) >= r0 && (tid >> 2) < r0 + nrows) {
        const int r = tid >> 2, part = tid & 3;
        const bf16_t* pr = P + (size_t)(prow0 + r) * DINP;
        u32x4 q[8]; float ss = 0.f;
#pragma unroll
        for (int i = 0; i < 8; ++i) { q[i] = *(const GAS u32x4*)(pr + OFF_Q + part * 64 + i * 8);
#pragma unroll
            for (int e = 0; e < 4; ++e) { const float lo = lo16(q[i][e]), hi = hi16(q[i][e]); ss += lo * lo + hi * hi; } }
        ss += __shfl_xor(ss, 1); ss += __shfl_xor(ss, 2);
        float rstd = rsqrtf(ss * (1.f / 256.f) + EPS);
        const float* gq = a.in[I_GQL] + part * 64;
#pragma unroll
        for (int i = 0; i < 8; ++i) { u32x2 o;
#pragma unroll
            for (int e = 0; e < 2; ++e) o[e] = cvt4_fp8(lo16(q[i][2 * e]) * rstd * gq[i * 8 + 4 * e], hi16(q[i][2 * e]) * rstd * gq[i * 8 + 4 * e + 1], lo16(q[i][2 * e + 1]) * rstd * gq[i * 8 + 4 * e + 2], hi16(q[i][2 * e + 1]) * rstd * gq[i * 8 + 4 * e + 3]);
            *(LAS u32x2*)(Aq + r * 272 + part * 64 + i * 8) = o; }
        u32x4 kv[4]; ss = 0.f;
#pragma unroll
        for (int i = 0; i < 4; ++i) { kv[i] = *(const GAS u32x4*)(pr + OFF_KV + part * 32 + i * 8);
#pragma unroll
            for (int e = 0; e < 4; ++e) { const float lo = lo16(kv[i][e]), hi = hi16(kv[i][e]); ss += lo * lo + hi * hi; } }
        ss += __shfl_xor(ss, 1); ss += __shfl_xor(ss, 2);
        rstd = rsqrtf(ss * (1.f / 128.f) + EPS);
        const float* gkv = a.in[I_GKVL] + part * 32;
#pragma unroll
        for (int i = 0; i < 4; ++i) { u32x2 o;
#pragma unroll
            for (int e = 0; e < 2; ++e) o[e] = cvt4_fp8(lo16(kv[i][2 * e]) * rstd * gkv[i * 8 + 4 * e], hi16(kv[i][2 * e]) * rstd * gkv[i * 8 + 4 * e + 1], lo16(kv[i][2 * e + 1]) * rstd * gkv[i * 8 + 4 * e + 2], hi16(kv[i][2 * e + 1]) * rstd * gkv[i * 8 + 4 * e + 3]);
            *(LAS u32x2*)(Akv + r * 144 + part * 32 + i * 8) = o; }
        const u32x4 pe = *(const GAS u32x4*)(pr + OFF_PE + part * 8); ss = 0.f;
#pragma unroll
        for (int e = 0; e < 4; ++e) { const float lo = lo16(pe[e]), hi = hi16(pe[e]); ss += lo * lo + hi * hi; kpe[r * 32 + part * 8 + 2 * e] = lo; kpe[r * 32 + part * 8 + 2 * e + 1] = hi; }
        ss += __shfl_xor(ss, 1); ss += __shfl_xor(ss, 2);
        if (part == 0) sspe[r] = ss;
    }
    __syncthreads();
    const int h = wave, bh = b * NH + h;
    typedef int i32x4m __attribute__((ext_vector_type(4))); typedef int i32x8m __attribute__((ext_vector_type(8)));
#define LD32G(p) __builtin_shufflevector(*(const GAS i32x4m*)(p), *(const GAS i32x4m*)((p) + 16), 0, 1, 2, 3, 4, 5, 6, 7)
#define LD32L(p) __builtin_shufflevector(*(const LAS i32x4m*)(p), *(const LAS i32x4m*)((p) + 16), 0, 1, 2, 3, 4, 5, 6, 7)
    if (lat) {
        const unsigned char* WQ = a.ws + WS_WQ + (size_t)h * QK * 256;
        const float* gqh = a.in[I_GQH];
        unsigned char* Qo = a.ws + WS_Q + ((size_t)bh * SEQ + tpos0) * QK8;
        i32x8m bq[2][6];
#pragma unroll
        for (int s2 = 0; s2 < 2; ++s2)
#pragma unroll
            for (int j = 0; j < 6; ++j) bq[s2][j] = LD32G(WQ + (size_t)(16 * j + fr) * 256 + 128 * s2 + 32 * fq);
        f32x4 gqv[6];
#pragma unroll
        for (int j = 0; j < 6; ++j) gqv[j] = *(const GAS f32x4*)(gqh + 16 * j + 4 * fq);
#pragma unroll 1
        for (int rq = 0; rq < 8; ++rq) {
            const int row = rq * 16 + fr, t = tpos0 + row;
            f32x4 csq[2][2];
#pragma unroll
            for (int ax = 0; ax < 2; ++ax) { const int pi = ax == 0 ? (t >> 6) : 128 + (t & 63); const float* cs = tabm + (pi * 8 + 4 * (fq & 1)) * 2;
                csq[ax][0] = *(const GAS f32x4*)(cs); csq[ax][1] = *(const GAS f32x4*)(cs + 4); }
            f32x4 acc[6];
#pragma unroll
            for (int j = 0; j < 6; ++j) acc[j] = (f32x4){0.f, 0.f, 0.f, 0.f};
#pragma unroll
            for (int s2 = 0; s2 < 2; ++s2) { const i32x8m af = LD32L(Aq + row * 272 + 128 * s2 + 32 * fq);
#pragma unroll
                for (int j = 0; j < 6; ++j) acc[j] = __builtin_amdgcn_mfma_scale_f32_16x16x128_f8f6f4(bq[s2][j], af, acc[j], 0, 0, 0, 0, 0, 0); }
            float ss = 0.f;
#pragma unroll
            for (int j = 0; j < 6; ++j) ss += (acc[j][0] * acc[j][0] + acc[j][1] * acc[j][1]) + (acc[j][2] * acc[j][2] + acc[j][3] * acc[j][3]);
            ss += __shfl_xor(ss, 16); ss += __shfl_xor(ss, 32);
            const float rstd = rsqrtf(ss * (1.f / 96.f) + EPS * (WQ_SCALE * WQ_SCALE)) * QSCALE;
#pragma unroll
            for (int j = 0; j < 6; ++j) {
                const int col = 16 * j + 4 * fq; const f32x4 gv = gqv[j];
                f32x4 v = acc[j] * gv * rstd;
                if (j >= 4) {
                    const int ax = j - 4;
#pragma unroll
                    for (int r = 0; r < 4; ++r) { const float other = __shfl_xor(v[r], 32); const float c = csq[ax][r >> 1][2 * (r & 1)], sn = csq[ax][r >> 1][2 * (r & 1) + 1];
                        v[r] = (fq < 2) ? (v[r] * c - other * sn) : (v[r] * c + other * sn); }
                }
                *(GAS unsigned*)(Qo + (size_t)row * QK8 + col) = cvt4_fp8(v[0], v[1], v[2], v[3]);
            }
            *(GAS u32x2*)(Qo + (size_t)row * QK8 + QK + 8 * fq) = (u32x2){0u, 0u};
        }
    }
    {
        const unsigned char* WKV = a.ws + WS_WKV + (size_t)h * 128 * 128;
        const float* gkh = a.in[I_GKH];
        unsigned char* Ko = a.ws + WS_K + ((size_t)bh * SKV + key0) * QK8;
        unsigned char* Vo = a.ws + WS_VT + (size_t)bh * DV * SKV + key0;
        i32x8m bkv[8];
#pragma unroll
        for (int j = 0; j < 8; ++j) bkv[j] = LD32G(WKV + (size_t)(16 * j + fr) * 128 + 32 * fq);
        f32x4 gkv[4]; float gp0[4], gp1[4];
#pragma unroll
        for (int j = 0; j < 4; ++j) gkv[j] = *(const GAS f32x4*)(gkh + 16 * j + 4 * fq);
#pragma unroll
        for (int r = 0; r < 4; ++r) { const int c0 = (fq >> 1) * 16 + 4 * (fq & 1) + r; gp0[r] = gkh[64 + c0]; gp1[r] = gkh[64 + c0 + 8]; }
#pragma unroll 1
        for (int rq = r0 >> 4; rq < ((r0 + nrows) >> 4); ++rq) {
            f32x4 csk[2];
            { const int t = tpos0 + rq * 16 + fr, ax = fq >> 1, pi = ax == 0 ? (t >> 6) : 128 + (t & 63); const float* cs = tabm + (pi * 8 + 4 * (fq & 1)) * 2;
              csk[0] = *(const GAS f32x4*)(cs); csk[1] = *(const GAS f32x4*)(cs + 4); }
            f32x4 acc[1][8];
#pragma unroll
            for (int i = 0; i < 1; ++i)
#pragma unroll
                for (int j = 0; j < 8; ++j) acc[i][j] = (f32x4){0.f, 0.f, 0.f, 0.f};
            { const i32x8m af = LD32L(Akv + (rq * 16 + fr) * 144 + 32 * fq);
#pragma unroll
              for (int j = 0; j < 8; ++j) acc[0][j] = __builtin_amdgcn_mfma_scale_f32_16x16x128_f8f6f4(bkv[j], af, acc[0][j], 0, 0, 0, 0, 0, 0) ; }
#pragma unroll
            for (int j = 0; j < 8; ++j) acc[0][j] = acc[0][j] * WKV_INV;
#pragma unroll
            for (int i = 0; i < 1; ++i) {
                const int row = rq * 16 + 16 * i + fr, t = tpos0 + row;
                const int kk = row & 63; const int vrow = (row & 64) + 32 * ((kk >> 2) & 1) + (kk & 3) + 4 * ((kk & 31) >> 3) + 16 * (kk >> 5);
                float ss = 0.f;
#pragma unroll
                for (int j = 0; j < 4; ++j) ss += (acc[i][j][0] * acc[i][j][0] + acc[i][j][1] * acc[i][j][1]) + (acc[i][j][2] * acc[i][j][2] + acc[i][j][3] * acc[i][j][3]);
                ss += __shfl_xor(ss, 16); ss += __shfl_xor(ss, 32);
                const float rstd = rsqrtf((ss + sspe[row]) * (1.f / 96.f) + EPS);
#pragma unroll
                for (int j = 0; j < 4; ++j) { const int col = 16 * j + 4 * fq; const f32x4 gv = gkv[j]; const f32x4 v = acc[i][j] * gv * rstd;
                    *(GAS unsigned*)(Ko + (size_t)row * QK8 + col) = cvt4_fp8(v[0], v[1], v[2], v[3]); }
                {
                    const int ax = fq >> 1, f0 = 4 * (fq & 1);
                    float o0[4], o1[4];
#pragma unroll
                    for (int r = 0; r < 4; ++r) { const int c0 = ax * 16 + f0 + r, c1 = c0 + 8;
                        const float x0 = kpe[row * 32 + c0] * rstd * gp0[r], x1 = kpe[row * 32 + c1] * rstd * gp1[r];
                        const float c = lat ? csk[r >> 1][2 * (r & 1)] : 1.f, s = lat ? csk[r >> 1][2 * (r & 1) + 1] : 0.f;
                        o0[r] = x0 * c - x1 * s; o1[r] = x1 * c + x0 * s; }
                    *(GAS unsigned*)(Ko + (size_t)row * QK8 + 64 + ax * 16 + f0) = cvt4_fp8(o0[0], o0[1], o0[2], o0[3]);
                    *(GAS unsigned*)(Ko + (size_t)row * QK8 + 64 + ax * 16 + 8 + f0) = cvt4_fp8(o1[0], o1[1], o1[2], o1[3]);
                    *(GAS u32x2*)(Ko + (size_t)row * QK8 + QK + 8 * fq) = (u32x2){0u, 0u};
                }
#pragma unroll
                for (int j = 4; j < 8; ++j)
#pragma unroll
                    for (int r = 0; r < 4; ++r) { const int d = 16 * (j - 4) + 4 * fq + r; Vo[(size_t)d * SKV + vrow] = (unsigned char)(cvt4_fp8(acc[i][j][r], 0.f, 0.f, 0.f) & 0xffu); }
            }
        }
    }
}

__device__ __forceinline__ float log_gamma(const float* logit) { const float x = *logit; return -log1pf(__expf(-x)); }

__device__ __forceinline__ void rope16(float (&out)[16], const bf16_t* rowp  , int part, const float* cs  , float scale) {
    const u32x4 a0 = *(const GAS u32x4*)(rowp + part * 16), a1 = *(const GAS u32x4*)(rowp + part * 16 + 8);
    const u32x4 b0 = *(const GAS u32x4*)(rowp + (part ^ 1) * 16), b1 = *(const GAS u32x4*)(rowp + (part ^ 1) * 16 + 8);
    float xs[16], xo[16];
#pragma unroll
    for (int e = 0; e < 4; ++e) { xs[2 * e] = lo16(a0[e]); xs[2 * e + 1] = hi16(a0[e]); xs[8 + 2 * e] = lo16(a1[e]); xs[8 + 2 * e + 1] = hi16(a1[e]);
        xo[2 * e] = lo16(b0[e]); xo[2 * e + 1] = hi16(b0[e]); xo[8 + 2 * e] = lo16(b1[e]); xo[8 + 2 * e + 1] = hi16(b1[e]); }
    if (cs) {
        const float sg = (part & 1) ? 1.f : -1.f;
#pragma unroll
        for (int q = 0; q < 8; ++q) { const f32x4 t = *(const GAS f32x4*)(cs + 4 * q);
            out[2 * q] = (xs[2 * q] * t[0] + sg * xo[2 * q] * t[1]) * scale; out[2 * q + 1] = (xs[2 * q + 1] * t[2] + sg * xo[2 * q + 1] * t[3]) * scale; }
    } else {
#pragma unroll
        for (int f = 0; f < 16; ++f) out[f] = xs[f] * scale;
    }
}

__device__ __forceinline__ void ret_local_unit(const Args& a, LAS unsigned char* lds, int unit) {
    const int tid = tid_of(a.wv), lane = tid & 63, wave = a.wv, fr = lane & 15, fq = lane >> 4;
    const int bh = unit / NSLOT, slot = unit % NSLOT, b = bh >> 2, h = bh & 3;
    const bool lat = slot >= 2;
    const int prow0 = lat ? b * SEQ + (slot - 2) * RC : T + b * LC + slot * RC;
    const int tpos0 = lat ? (slot - 2) * RC : 0;
    LAS bf16_t* KfT = (LAS bf16_t*)lds;
    LAS bf16_t* KbT = (LAS bf16_t*)(lds + 17408);
    LAS bf16_t* VT = (LAS bf16_t*)(lds + 34816);
    const bf16_t* P = (const bf16_t*)(a.ws + WS_P);
    const float* tabr = (const float*)(a.ws + WS_TABR);
    const float lgf = log_gamma(a.in[I_DECAY] + h), lgb = log_gamma(a.in[I_DECAY] + 4 + h);
    __syncthreads();
    {
        const int j = tid >> 2, part = tid & 3, t = tpos0 + j, ax = part >> 1;
        const int pi = ax == 0 ? (t >> 6) : 128 + (t & 63);
        float o[16]; rope16(o, P + (size_t)(prow0 + j) * DINP + OFF_RK + h * 64, part, lat ? tabr + pi * 32 : nullptr, 0.125f);
        const float wf = __expf(lgf * (float)(127 - j)), wb = __expf(lgb * (float)j);
#pragma unroll
        for (int f = 0; f < 16; ++f) { const int d = part * 16 + f; KfT[d * 136 + j] = (bf16_t)f2bf(o[f] * wf); KbT[d * 136 + j] = (bf16_t)f2bf(o[f] * wb); }
    }
    for (int idx = tid; idx < 128 * 16; idx += 512) {
        const int j = idx >> 4, c = idx & 15;
        const u32x4 v = *(const GAS u32x4*)(P + (size_t)(prow0 + j) * DINP + OFF_RV + h * 128 + c * 8);
#pragma unroll
        for (int e = 0; e < 4; ++e) { VT[(c * 8 + 2 * e) * 136 + j] = (bf16_t)(v[e] & 0xffffu); VT[(c * 8 + 2 * e + 1) * 136 + j] = (bf16_t)(v[e] >> 16); }
    }
    __syncthreads();
    const int dir = wave >> 2, mi = wave & 3;
    f32x4 acc[1][8];
#pragma unroll
    for (int j = 0; j < 8; ++j) acc[0][j] = (f32x4){0.f, 0.f, 0.f, 0.f};
    mma_ll<1, 8, false>(acc, dir ? KbT : KfT, 136, 16 * mi, VT, 136, 0, 128, lane);
    float* out = (float*)(a.ws + WS_LST) + ((size_t)(bh * 2 + dir) * NSLOT + slot) * 8192;
#pragma unroll
    for (int j = 0; j < 8; ++j) *(GAS f32x4*)(out + (size_t)(16 * j + fr) * 64 + 16 * mi + 4 * fq) = acc[0][j];
}

__device__ __forceinline__ void phase_ret_scan(const Args& a) {
    const int gt = blockIdx.x * 512 + tid_of(a.wv);
    if (gt >= 32 * 2048) return;
    const int bd = gt >> 11, v4 = gt & 2047, dir = bd & 1, h = (bd >> 1) & 3;
    const float lg = log_gamma(a.in[I_DECAY] + dir * 4 + h);
    const float g = __expf(lg * 128.f);
    float* base = (float*)(a.ws + WS_LST) + (size_t)bd * NSLOT * 8192 + v4 * 4;
    f32x4 S = (f32x4){0.f, 0.f, 0.f, 0.f};
#pragma unroll 1
    for (int bt = 0; bt < 5; ++bt) {
        f32x4 L[13];
#pragma unroll
        for (int q = 0; q < 13; ++q) { const int n = bt * 13 + q; const int slot = dir == 0 ? n : (n == 0 ? 1 : (n == 1 ? 0 : 67 - n)); L[q] = *(const GAS f32x4*)(base + (size_t)slot * 8192); }
#pragma unroll
        for (int q = 0; q < 13; ++q) { const int n = bt * 13 + q; const int slot = dir == 0 ? n : (n == 0 ? 1 : (n == 1 ? 0 : 67 - n)); S = S * g + L[q]; *(GAS f32x4*)(base + (size_t)slot * 8192) = S; }
    }
}

__device__ __forceinline__ void ret_out_unit(const Args& a, LAS unsigned char* lds, int unit) {
    const int tid = tid_of(a.wv), lane = tid & 63, wave = a.wv, fr = lane & 15, fq = lane >> 4;
    const int bh = unit >> 6, c = unit & 63, b = bh >> 2, h = bh & 3;
    const int prow0 = b * SEQ + c * RC, tpos0 = c * RC;
    LAS bf16_t* Qs = (LAS bf16_t*)lds;
    LAS bf16_t* Ks = (LAS bf16_t*)(lds + 18432);
    LAS bf16_t* VT = (LAS bf16_t*)(lds + 36864);
    LAS bf16_t* SfT = (LAS bf16_t*)(lds + 71680);
    LAS bf16_t* SbT = (LAS bf16_t*)(lds + 90112);
    LAS bf16_t* Ws = (LAS bf16_t*)(lds + 108544);
    const bf16_t* P = (const bf16_t*)(a.ws + WS_P);
    const float* tabr = (const float*)(a.ws + WS_TABR);
    const float lgf = log_gamma(a.in[I_DECAY] + h), lgb = log_gamma(a.in[I_DECAY] + 4 + h);
    __syncthreads();
    {
        const int j = tid >> 2, part = tid & 3, t = tpos0 + j, ax = part >> 1;
        const int pi = ax == 0 ? (t >> 6) : 128 + (t & 63);
        float oq[16], ok[16];
        rope16(oq, P + (size_t)(prow0 + j) * DINP + OFF_RQ + h * 64, part, tabr + pi * 32, 1.f);
        rope16(ok, P + (size_t)(prow0 + j) * DINP + OFF_RK + h * 64, part, tabr + pi * 32, 0.125f);
        u32x4 w0, w1;
        w0 = (u32x4){pk2(oq[0], oq[1]), pk2(oq[2], oq[3]), pk2(oq[4], oq[5]), pk2(oq[6], oq[7])}; w1 = (u32x4){pk2(oq[8], oq[9]), pk2(oq[10], oq[11]), pk2(oq[12], oq[13]), pk2(oq[14], oq[15])};
        *(LAS u32x4*)(Qs + j * 72 + part * 16) = w0; *(LAS u32x4*)(Qs + j * 72 + part * 16 + 8) = w1;
        w0 = (u32x4){pk2(ok[0], ok[1]), pk2(ok[2], ok[3]), pk2(ok[4], ok[5]), pk2(ok[6], ok[7])}; w1 = (u32x4){pk2(ok[8], ok[9]), pk2(ok[10], ok[11]), pk2(ok[12], ok[13]), pk2(ok[14], ok[15])};
        *(LAS u32x4*)(Ks + j * 72 + part * 16) = w0; *(LAS u32x4*)(Ks + j * 72 + part * 16 + 8) = w1;
    }
    for (int idx = tid; idx < 128 * 16; idx += 512) {
        const int j = idx >> 4, cch = idx & 15;
        const u32x4 v = *(const GAS u32x4*)(P + (size_t)(prow0 + j) * DINP + OFF_RV + h * 128 + cch * 8);
#pragma unroll
        for (int e = 0; e < 4; ++e) { VT[(cch * 8 + 2 * e) * 136 + j] = (bf16_t)(v[e] & 0xffffu); VT[(cch * 8 + 2 * e + 1) * 136 + j] = (bf16_t)(v[e] >> 16); }
    }
    {
        const float* sf = (const float*)(a.ws + WS_LST) + ((size_t)(bh * 2 + 0) * NSLOT + (c + 1)) * 8192;
        const float* sb = (const float*)(a.ws + WS_LST) + ((size_t)(bh * 2 + 1) * NSLOT + (c == 63 ? 0 : c + 3)) * 8192;
        for (int idx = tid; idx < 2048; idx += 512) {
            const int e = idx >> 4, d = (idx & 15) * 4;
            const f32x4 x = *(const GAS f32x4*)(sf + idx * 4), y = *(const GAS f32x4*)(sb + idx * 4);
            u32x2 w; w.x = pk2(x[0], x[1]); w.y = pk2(x[2], x[3]); *(LAS u32x2*)(SfT + e * 72 + d) = w;
            w.x = pk2(y[0], y[1]); w.y = pk2(y[2], y[3]); *(LAS u32x2*)(SbT + e * 72 + d) = w;
        }
    }
    __syncthreads();
    const int i0 = 16 * wave, irow = i0 + fr;
    f32x4 accS[1][8], accF[1][8], accB[1][8], accO[1][8];
#pragma unroll
    for (int j = 0; j < 8; ++j) { accS[0][j] = (f32x4){0.f, 0.f, 0.f, 0.f}; accF[0][j] = accS[0][j]; accB[0][j] = accS[0][j]; accO[0][j] = accS[0][j]; }
    mma_ll<1, 8, true>(accS, Qs, 72, i0, Ks, 72, 0, 64, lane);
    mma_ll<1, 8, true>(accF, Qs, 72, i0, SfT, 72, 0, 64, lane);
    mma_ll<1, 8, true>(accB, Qs, 72, i0, SbT, 72, 0, 64, lane);
#pragma unroll
    for (int j = 0; j < 8; ++j) {
        float w[4];
#pragma unroll
        for (int r = 0; r < 4; ++r) { const int jj = 16 * j + 4 * fq + r; const int df = irow - jj;
            const float dec = df > 0 ? __expf(lgf * (float)df) : (df < 0 ? __expf(lgb * (float)(-df)) : 2.f);
            w[r] = accS[0][j][r] * dec; }
        u32x2 pw; pw.x = pk2(w[0], w[1]); pw.y = pk2(w[2], w[3]);
        *(LAS u32x2*)(Ws + irow * 136 + 16 * j + 4 * fq) = pw;
    }
    LDS_WAIT(); __builtin_amdgcn_wave_barrier();
    mma_ll<1, 8, true>(accO, Ws, 136, i0, VT, 136, 0, 128, lane);
    const float wf = __expf(lgf * (float)(irow + 1)), wb = __expf(lgb * (float)(128 - irow));
    float ss = 0.f;
#pragma unroll
    for (int j = 0; j < 8; ++j) { accO[0][j] = accO[0][j] + accF[0][j] * wf + accB[0][j] * wb;
        ss += (accO[0][j][0] * accO[0][j][0] + accO[0][j][1] * accO[0][j][1]) + (accO[0][j][2] * accO[0][j][2] + accO[0][j][3] * accO[0][j][3]); }
    ss += __shfl_xor(ss, 16); ss += __shfl_xor(ss, 32);
    const float rstd = rsqrtf(ss * (1.f / 128.f) + EPS);
    const float* gro = a.in[I_GRET] + h * 128;
    const bf16_t* pg = P + (size_t)(prow0 + irow) * DINP + OFF_RG + h * 128;
    bf16_t* mix = (bf16_t*)(a.ws + WS_MIX) + (size_t)(prow0 + irow) * DM + 512 + h * 128;
#pragma unroll
    for (int j = 0; j < 8; ++j) { const int e = 16 * j + 4 * fq; const f32x4 gv = *(const GAS f32x4*)(gro + e); const u32x2 gw = *(const GAS u32x2*)(pg + e);
        const float g0 = lo16(gw.x), g1 = hi16(gw.x), g2 = lo16(gw.y), g3 = hi16(gw.y);
        f32x4 v = accO[0][j] * gv * rstd;
        v[0] *= g0 / (1.f + __expf(-g0)); v[1] *= g1 / (1.f + __expf(-g1)); v[2] *= g2 / (1.f + __expf(-g2)); v[3] *= g3 / (1.f + __expf(-g3));
        u32x2 w; w.x = pk2(v[0], v[1]); w.y = pk2(v[2], v[3]); *(GAS u32x2*)(mix + e) = w; }
}

namespace att {
constexpr int KLD8 = 144  , VLD8 = 80  , KBUF = 64 * KLD8, VBUF = 64 * VLD8, NKB = 3, NVB = 4;
constexpr int L_K = 0, L_V = NKB * KBUF, L_WS = NKB * KBUF + NVB * VBUF;
__device__ __forceinline__ int crow(int r, int hi) { return (r & 3) + 8 * (r >> 2) + 4 * hi; }
typedef __bf16 bf16x2_t __attribute__((ext_vector_type(2))); typedef float f32x2_t __attribute__((ext_vector_type(2)));
__device__ __forceinline__ unsigned cvtpk(float lo, float hi) { f32x2_t v = {lo, hi}; bf16x2_t b = __builtin_convertvector(v, bf16x2_t); return __builtin_bit_cast(unsigned, b); }
#define SBAR() __builtin_amdgcn_sched_barrier(0)
typedef int i32x4 __attribute__((ext_vector_type(4))); typedef int i32x8 __attribute__((ext_vector_type(8)));
constexpr float PSHIFT = 2.f;
template <bool SHIFT>
__device__ __forceinline__ i32x8 softmax_pack8(f32x16& p0, f32x16& p1, float negm) {
    const float sh = negm + 8.f - PSHIFT;
#pragma unroll
    for (int r = 0; r < 16; ++r) { p0[r] = __builtin_amdgcn_exp2f(SHIFT ? p0[r] + sh : p0[r]); p1[r] = __builtin_amdgcn_exp2f(SHIFT ? p1[r] + sh : p1[r]); }
    i32x8 w;
#pragma unroll
    for (int q = 0; q < 4; ++q) { w[q] = (int)cvt4_fp8(p0[4 * q], p0[4 * q + 1], p0[4 * q + 2], p0[4 * q + 3]); w[4 + q] = (int)cvt4_fp8(p1[4 * q], p1[4 * q + 1], p1[4 * q + 2], p1[4 * q + 3]); }
    return w;
}
template <bool SHIFT>
__device__ __forceinline__ void unit64(const Args& a, LAS unsigned char* lds, int bh, int qb, float negm) {
    const int wid = sopaque(a.wv), tid = tid_of(wid), lane = tid & 63, r32 = lane & 31, hi = lane >> 5;
    const unsigned char* QwA = a.ws + WS_Q + ((size_t)bh * SEQ + qb * 512 + wid * 64 + r32) * QK8 + hi * 32;
    const unsigned char* Kh = a.ws + WS_K + (size_t)bh * SKV * QK8;
    const unsigned char* Vh = a.ws + WS_VT + (size_t)bh * DV * SKV;
    LAS unsigned char* Kl = lds + L_K; LAS unsigned char* Vl = lds + L_V;
    LAS float* wsf = (LAS float*)(lds + L_WS) + wid * 64;
    i32x8 qA8[2], qB8[2];
#pragma unroll
    for (int s2 = 0; s2 < 2; ++s2) { const i32x4 a0_ = *(const GAS i32x4*)(QwA + 64 * s2), a1_ = *(const GAS i32x4*)(QwA + 64 * s2 + 16), b0_ = *(const GAS i32x4*)(QwA + 32 * QK8 + 64 * s2), b1_ = *(const GAS i32x4*)(QwA + 32 * QK8 + 64 * s2 + 16);
        qA8[s2] = __builtin_shufflevector(a0_, a1_, 0, 1, 2, 3, 4, 5, 6, 7); qB8[s2] = __builtin_shufflevector(b0_, b1_, 0, 1, 2, 3, 4, 5, 6, 7); }
    unsigned soff[2]; int dsto[2];
#pragma unroll
    for (int m = 0; m < 2; ++m) { const int j = (wid + 8 * m) < 14 ? wid + 8 * m : wid + 8 * m - 8;
        if (j < 9) { const int p = j * 64 + lane, row = p / 9, c = p % 9; soff[m] = (unsigned)(row * QK8 + (c < 8 ? c : 7) * 16); dsto[m] = L_K + j * 1024; }
        else { const int jv = j - 9, p = jv * 64 + lane, d = p / 5, c = p % 5; soff[m] = (unsigned)(d * SKV + (c < 4 ? c : 3) * 16); dsto[m] = L_V + jv * 1024; } }
    const char* Kb = (const char*)Kh; const char* Vb = (const char*)Vh;
#define DMA(t, kslot, vslot) do { _Pragma("unroll") for (int pm_ = 0; pm_ < 2; ++pm_) { const int j_ = (wid + 8 * pm_) < 14 ? wid + 8 * pm_ : wid + 8 * pm_ - 8; { \
        const char* src_ = (j_ < 9 ? Kb + (size_t)(t) * (64 * QK8) : Vb + (size_t)(t) * 64) + soff[pm_]; \
        __builtin_amdgcn_global_load_lds((const unsigned*)src_, (LAS unsigned*)(lds + dsto[pm_] + (j_ < 9 ? (kslot) * KBUF : (vslot) * VBUF)), 16, 0, 0); } } } while (0)
    i32x8 ones8;
#pragma unroll
    for (int q = 0; q < 8; ++q) ones8[q] = r32 == 0 ? 0x38383838 : 0;
    f32x16 oA[2], oB[2], sA, sB;
#pragma unroll
    for (int r = 0; r < 16; ++r) { oA[0][r] = 0.f; oA[1][r] = 0.f; oB[0][r] = 0.f; oB[1][r] = 0.f; sA[r] = 0.f; sB[r] = 0.f; }
    constexpr int NT = SKV / 64;
    __syncthreads();
    DMA(0, 0, 0); DMA(1, 1, 1); __syncthreads();
#ifndef ATT_STAGGER
#define ATT_STAGGER 0
#endif
    const bool late = ATT_STAGGER && wid >= 4;
#define TILE_BAR(more) do { if (more) asm volatile("s_waitcnt vmcnt(2) lgkmcnt(0)\n\ts_barrier" ::: "memory"); else asm volatile("s_waitcnt vmcnt(0) lgkmcnt(0)\n\ts_barrier" ::: "memory"); } while (0)
    int ks = 0, vs = 0;
    for (int i = 0; i < NT; ++i) {
        const bool more = i + 2 < NT;
        if (more) DMA(i + 2, (ks == 0 ? 2 : ks - 1), ((vs + 2) & 3));
        SBAR();
        f32x16 pA0, pA1, pB0, pB1;
#pragma unroll
        for (int r = 0; r < 16; ++r) { pA0[r] = PSHIFT; pA1[r] = PSHIFT; pB0[r] = PSHIFT; pB1[r] = PSHIFT; }
        const LAS unsigned char* Ks = Kl + ks * KBUF + r32 * KLD8 + 32 * hi;
#pragma unroll
        for (int s2 = 0; s2 < 2; ++s2) {
            const i32x4 c0_ = *(const LAS i32x4*)(Ks + 64 * s2), c1_ = *(const LAS i32x4*)(Ks + 64 * s2 + 16), d0_ = *(const LAS i32x4*)(Ks + 32 * KLD8 + 64 * s2), d1_ = *(const LAS i32x4*)(Ks + 32 * KLD8 + 64 * s2 + 16);
            const i32x8 k0 = __builtin_shufflevector(c0_, c1_, 0, 1, 2, 3, 4, 5, 6, 7), k1 = __builtin_shufflevector(d0_, d1_, 0, 1, 2, 3, 4, 5, 6, 7);
            pA0 = __builtin_amdgcn_mfma_scale_f32_32x32x64_f8f6f4(k0, qA8[s2], pA0, 0, 0, 0, 0, 0, 0); pB0 = __builtin_amdgcn_mfma_scale_f32_32x32x64_f8f6f4(k0, qB8[s2], pB0, 0, 0, 0, 0, 0, 0);
            pA1 = __builtin_amdgcn_mfma_scale_f32_32x32x64_f8f6f4(k1, qA8[s2], pA1, 0, 0, 0, 0, 0, 0); pB1 = __builtin_amdgcn_mfma_scale_f32_32x32x64_f8f6f4(k1, qB8[s2], pB1, 0, 0, 0, 0, 0, 0);
        }
        SBAR();
        if (late) TILE_BAR(more);
        const LAS unsigned char* Vs = Vl + vs * VBUF + r32 * VLD8 + 32 * hi;
        const i32x4 e0_ = *(const LAS i32x4*)(Vs), e1_ = *(const LAS i32x4*)(Vs + 16), f0_ = *(const LAS i32x4*)(Vs + 32 * VLD8), f1_ = *(const LAS i32x4*)(Vs + 32 * VLD8 + 16);
        const i32x8 v0 = __builtin_shufflevector(e0_, e1_, 0, 1, 2, 3, 4, 5, 6, 7), v1 = __builtin_shufflevector(f0_, f1_, 0, 1, 2, 3, 4, 5, 6, 7);
        { const i32x8 pa = softmax_pack8<SHIFT>(pA0, pA1, negm);
          oA[0] = __builtin_amdgcn_mfma_scale_f32_32x32x64_f8f6f4(pa, v0, oA[0], 0, 0, 0, 0, 0, 0); oA[1] = __builtin_amdgcn_mfma_scale_f32_32x32x64_f8f6f4(pa, v1, oA[1], 0, 0, 0, 0, 0, 0);
          sA = __builtin_amdgcn_mfma_scale_f32_32x32x64_f8f6f4(pa, ones8, sA, 0, 0, 0, 0, 0, 0); }
        { const i32x8 pa = softmax_pack8<SHIFT>(pB0, pB1, negm);
          oB[0] = __builtin_amdgcn_mfma_scale_f32_32x32x64_f8f6f4(pa, v0, oB[0], 0, 0, 0, 0, 0, 0); oB[1] = __builtin_amdgcn_mfma_scale_f32_32x32x64_f8f6f4(pa, v1, oB[1], 0, 0, 0, 0, 0, 0);
          sB = __builtin_amdgcn_mfma_scale_f32_32x32x64_f8f6f4(pa, ones8, sB, 0, 0, 0, 0, 0, 0); }
        SBAR();
        if (!late) TILE_BAR(more);
        ks = ks == 2 ? 0 : ks + 1; vs = (vs + 1) & 3;
    }
#undef DMA
#undef TILE_BAR
    if (r32 == 0) {
#pragma unroll
        for (int r = 0; r < 16; ++r) { wsf[crow(r, hi)] = sA[r]; wsf[32 + crow(r, hi)] = sB[r]; } }
    LDS_WAIT(); __builtin_amdgcn_wave_barrier();
    const int b = bh >> 3, h = bh & 7;
    const int lz = opaque(lane), r32z = lz & 31, hiz = lz >> 5;
    bf16_t* Ow = (bf16_t*)(a.ws + WS_MIX) + ((size_t)b * SEQ + qb * 512 + wid * 64) * DM + h * DV;
    const unsigned ooff = (unsigned)(4 * hiz * DM + r32z);
#pragma unroll
    for (int r = 0; r < 16; ++r) { const int orow = crow(r, hiz); const float rlA = 1.f / wsf[orow], rlB = 1.f / wsf[32 + orow];
        const unsigned off = ooff + (unsigned)(((r & 3) + 8 * (r >> 2)) * DM);
        Ow[off] = (bf16_t)f2bf(oA[0][r] * rlA); Ow[off + 32] = (bf16_t)f2bf(oA[1][r] * rlA);
        Ow[off + 32 * DM] = (bf16_t)f2bf(oB[0][r] * rlB); Ow[off + 32 * DM + 32] = (bf16_t)f2bf(oB[1][r] * rlB); }
}
#undef SBAR
}


#if DIAG == 5
__device__ __forceinline__ void attn_selfcheck(const Args& a, LAS unsigned char* lds) {
    const int tid = tid_of(a.wv);
    LAS float* red = (LAS float*)lds;
    __syncthreads();
    if (blockIdx.x == 0) {
        const int row = tid >> 3, ds = (tid & 7) * 8;
        const unsigned char* q = a.ws + WS_Q + (size_t)row * QK8; const unsigned char* K = a.ws + WS_K; const unsigned char* V = a.ws + WS_VT;
        float qf[96];
        float acc[8] = {0.f, 0.f, 0.f, 0.f, 0.f, 0.f, 0.f, 0.f}; float l = 0.f;
        for (int key = 0; key < SKV; ++key) {
            float s = 0.f;
            for (int c = 0; c < 96; c += 4) { const int kw = *(const GAS int*)(K + (size_t)key * QK8 + c), qw = *(const GAS int*)(q + c);
                s += __builtin_amdgcn_cvt_f32_fp8(kw, 0) * __builtin_amdgcn_cvt_f32_fp8(qw, 0) + __builtin_amdgcn_cvt_f32_fp8(kw, 1) * __builtin_amdgcn_cvt_f32_fp8(qw, 1)
                   + __builtin_amdgcn_cvt_f32_fp8(kw, 2) * __builtin_amdgcn_cvt_f32_fp8(qw, 2) + __builtin_amdgcn_cvt_f32_fp8(kw, 3) * __builtin_amdgcn_cvt_f32_fp8(qw, 3); }
            const float p = exp2f(s);
            const int kk = key & 63, pos = (key & ~63) + 32 * ((kk >> 2) & 1) + (kk & 3) + 4 * ((kk & 31) >> 3) + 16 * (kk >> 5);
            l += p;
#pragma unroll
            for (int e = 0; e < 8; ++e) { const int w = V[(size_t)(ds + e) * SKV + pos]; acc[e] += p * __builtin_amdgcn_cvt_f32_fp8(w, 0); }
        }
        (void)qf;
        float emax = 0.f, omax = 0.f;
        const bf16_t* mix = (const bf16_t*)(a.ws + WS_MIX) + (size_t)row * DM + ds;
#pragma unroll
        for (int e = 0; e < 8; ++e) { const float o = acc[e] / l; emax = fmaxf(emax, fabsf(o - bf2f(mix[e]))); omax = fmaxf(omax, fabsf(o)); }
        red[tid] = emax; red[512 + tid] = omax;
        __syncthreads();
        if (tid == 0) { float e = 0.f, o = 0.f; for (int i = 0; i < 512; ++i) { e = fmaxf(e, red[i]); o = fmaxf(o, red[512 + i]); }
            ((unsigned*)(a.ws + WS_CTL))[CW_DIAG] = __float_as_uint(e / o * 0.1f); }
    }
    __syncthreads();
}
#endif

__device__ __forceinline__ void phase_router(const Args& a, LAS unsigned char* lds) {
    const int tid = tid_of(a.wv), lane = tid & 63, wave = a.wv, fr = lane & 15, fq = lane >> 4;
    LAS bf16_t* Ah = (LAS bf16_t*)lds;
    LAS bf16_t* Al = (LAS bf16_t*)(lds + 33024);
    LAS float* red = (LAS float*)(lds + 66048);
    LAS int* hist = (LAS int*)(lds + 66048 + 16384);
    LAS int* base = hist + 32;
    LAS int* pk_e = base + 32;
    LAS int* pk_r = pk_e + 512;
    LAS int* pk_p = pk_r + 512;
    const float* mod = (const float*)(a.ws + WS_MOD); const float* g = a.in[I_GFFN];
    const bf16_t* WR = (const bf16_t*)(a.ws + WS_WR);
    unsigned char* HF = a.ws + WS_HF;
    float* PG = (float*)(a.ws + WS_PG);
    unsigned* cnt = (unsigned*)(a.ws + WS_CTL) + CW_CNT;
    unsigned* list = (unsigned*)(a.ws + WS_LIST);
    LAS float* lg = (LAS float*)(pk_p + 512);
    bf16x8 bh[4][2], bl[4][2];
#pragma unroll
    for (int ks = 0; ks < 4; ++ks)
#pragma unroll
        for (int j = 0; j < 2; ++j) { bh[ks][j] = *(const GAS bf16x8*)(WR + (size_t)(16 * j + fr) * 1024 + wave * 128 + 32 * ks + 8 * fq); bl[ks][j] = *(const GAS bf16x8*)(WR + 32768 + (size_t)(16 * j + fr) * 1024 + wave * 128 + 32 * ks + 8 * fq); }
    for (int tile = blockIdx.x; tile < T / 128; tile += gridDim.x) {
        __syncthreads();
        if (tid < 32) hist[tid] = 0;
        f32x4 v[2][4];
#pragma unroll
        for (int rr = 0; rr < 2; ++rr) { const float* xr = a.out + (size_t)(tile * 128 + wave * 2 + rr) * DM;
#pragma unroll
            for (int j = 0; j < 4; ++j) v[rr][j] = *(const GAS f32x4*)(xr + j * 256 + lane * 4); }
#pragma unroll 1
        for (int it = 0; it < 8; ++it) {
            const int tok0 = tile * 128 + it * 16;
#pragma unroll
            for (int rr = 0; rr < 2; ++rr) {
                const int row = wave * 2 + rr, tok = tok0 + row;
                const float* sh = mod + (tok >> 13) * 6144 + 3 * 1024; const float* sc = sh + 1024;
                float ss = 0.f;
#pragma unroll
                for (int j = 0; j < 4; ++j) ss += (v[rr][j].x * v[rr][j].x + v[rr][j].y * v[rr][j].y) + (v[rr][j].z * v[rr][j].z + v[rr][j].w * v[rr][j].w);
                const float rstd = rsqrtf(wave_sum(ss) * (1.f / DM) + EPS);
#pragma unroll
                for (int j = 0; j < 4; ++j) { const int c = j * 256 + lane * 4; const f32x4 gg = *(const GAS f32x4*)(g + c), s1 = *(const GAS f32x4*)(sc + c), s0 = *(const GAS f32x4*)(sh + c);
                    const f32x4 o = (v[rr][j] * rstd * gg) * (s1 + 1.f) + s0;
                    const unsigned h0 = f2bf(o.x), h1 = f2bf(o.y), h2 = f2bf(o.z), h3 = f2bf(o.w);
                    u32x2 wh; wh.x = h0 | (h1 << 16); wh.y = h2 | (h3 << 16);
                    u32x2 wl; wl.x = pk2(o.x - bf2f((bf16_t)h0), o.y - bf2f((bf16_t)h1)); wl.y = pk2(o.z - bf2f((bf16_t)h2), o.w - bf2f((bf16_t)h3));
                    *(GAS unsigned*)(HF + (size_t)tok * DM + c) = cvt4_fp8(o.x, o.y, o.z, o.w);
                    *(LAS u32x2*)(Ah + row * 1032 + c) = wh; *(LAS u32x2*)(Al + row * 1032 + c) = wl; }
            }
            if (it < 7) {
#pragma unroll
                for (int rr = 0; rr < 2; ++rr) { const float* xr = a.out + (size_t)(tok0 + 16 + wave * 2 + rr) * DM;
#pragma unroll
                    for (int j = 0; j < 4; ++j) v[rr][j] = *(const GAS f32x4*)(xr + j * 256 + lane * 4); } }
            __syncthreads();
            {
                f32x4 acc[2]; acc[0] = (f32x4){0.f, 0.f, 0.f, 0.f}; acc[1] = acc[0];
#pragma unroll
                for (int ks = 0; ks < 4; ++ks) { const bf16x8 ah = *(const LAS bf16x8*)(Ah + fr * 1032 + wave * 128 + 32 * ks + 8 * fq), al = *(const LAS bf16x8*)(Al + fr * 1032 + wave * 128 + 32 * ks + 8 * fq);
#pragma unroll
                    for (int j = 0; j < 2; ++j) { acc[j] = __builtin_amdgcn_mfma_f32_16x16x32_bf16(ah, bh[ks][j], acc[j], 0, 0, 0); acc[j] = __builtin_amdgcn_mfma_f32_16x16x32_bf16(al, bh[ks][j], acc[j], 0, 0, 0);
                        acc[j] = __builtin_amdgcn_mfma_f32_16x16x32_bf16(ah, bl[ks][j], acc[j], 0, 0, 0); } }
#pragma unroll
                for (int j = 0; j < 2; ++j)
#pragma unroll
                    for (int r = 0; r < 4; ++r) red[(wave * 16 + 4 * fq + r) * 32 + 16 * j + fr] = acc[j][r];
            }
            __syncthreads();
            { const int tk = tid >> 5, e = tid & 31; float sl = a.in[I_BR][e];
#pragma unroll
              for (int w = 0; w < 8; ++w) sl += red[(w * 16 + tk) * 32 + e];
              lg[tk * 32 + e] = sl; }
            __syncthreads();
            if (tid < 16) {
                const int tok = tok0 + tid;
                float best[4]; int bi[4];
#pragma unroll
                for (int k = 0; k < 4; ++k) { best[k] = -3.0e38f; bi[k] = 0; }
                for (int e = 0; e < 32; ++e) {
                    const float s = lg[tid * 32 + e];
                    if (s > best[3]) {
                        if (s > best[0]) { best[3] = best[2]; bi[3] = bi[2]; best[2] = best[1]; bi[2] = bi[1]; best[1] = best[0]; bi[1] = bi[0]; best[0] = s; bi[0] = e; }
                        else if (s > best[1]) { best[3] = best[2]; bi[3] = bi[2]; best[2] = best[1]; bi[2] = bi[1]; best[1] = s; bi[1] = e; }
                        else if (s > best[2]) { best[3] = best[2]; bi[3] = bi[2]; best[2] = s; bi[2] = e; }
                        else { best[3] = s; bi[3] = e; }
                    }
                }
                const float e1 = __expf(best[1] - best[0]), e2 = __expf(best[2] - best[0]), e3 = __expf(best[3] - best[0]);
                const float inv = 1.f / (1.f + e1 + e2 + e3);
                const float gk[4] = {inv, e1 * inv, e2 * inv, e3 * inv};
#pragma unroll
                for (int k = 0; k < 4; ++k) { const int slot = (it * 16 + tid) * 4 + k; const int rk = __hip_atomic_fetch_add(hist + bi[k], 1, __ATOMIC_RELAXED, __HIP_MEMORY_SCOPE_WORKGROUP);
                    pk_e[slot] = bi[k]; pk_r[slot] = rk; pk_p[slot] = tok * 4 + k; PG[tok * 4 + k] = gk[k]; }
            }
        }
        __syncthreads();
        if (tid < 32) base[tid] = (int)__hip_atomic_fetch_add(cnt + 64 * tid, (unsigned)hist[tid], __ATOMIC_RELAXED, __HIP_MEMORY_SCOPE_AGENT);
        __syncthreads();
        { const int e = pk_e[tid]; list[(size_t)e * 32768 + base[e] + pk_r[tid]] = (unsigned)pk_p[tid]; }
    }
}

__device__ __forceinline__ void phase_combine(const Args& a) {
    const int tid = tid_of(a.wv), lane = tid & 63, wave = tid >> 6;
    const int gw = blockIdx.x * 8 + wave, NGW = gridDim.x * 8;
    const float* mod = (const float*)(a.ws + WS_MOD);
    const unsigned char* Y = a.ws + WS_Y;
#if DIAG == 1
    const float dz = 0.1f;
#elif DIAG >= 2
    const float dz = sqrtf(__uint_as_float(__hip_atomic_load((unsigned*)(a.ws + WS_CTL) + CW_DIAG, __ATOMIC_RELAXED, __HIP_MEMORY_SCOPE_AGENT)));
#else
    const float dz = 0.f;
#endif
    for (int tok = gw; tok < T; tok += NGW) {
        const float* gate = mod + (tok >> 13) * 6144 + 5 * 1024;
        float* orow = a.out + (size_t)tok * DM;
#pragma unroll
        for (int j = 0; j < 4; ++j) { const int c = j * 256 + lane * 4;
            f32x4 s = (f32x4){0.f, 0.f, 0.f, 0.f};
#pragma unroll
            for (int k = 0; k < 4; ++k) { const int w = *(const GAS int*)(Y + ((size_t)tok * 4 + k) * DM + c);
                s[0] += __builtin_amdgcn_cvt_f32_fp8(w, 0); s[1] += __builtin_amdgcn_cvt_f32_fp8(w, 1); s[2] += __builtin_amdgcn_cvt_f32_fp8(w, 2); s[3] += __builtin_amdgcn_cvt_f32_fp8(w, 3); }
            s = s * pg8::YINV;
            const f32x4 xv = *(const GAS f32x4*)(orow + c), gv = *(const GAS f32x4*)(gate + c);
            *(GAS f32x4*)(orow + c) = xv + gv * s + dz; }
    }
}

constexpr int N_PHASES = 11;
__global__ void __launch_bounds__(512, 2) fwd_kernel(Args a0) {
    Args a;
    extern __shared__ __attribute__((aligned(16))) unsigned char lds_raw[];
    LAS unsigned char* lds = (LAS unsigned char*)lds_raw;
    volatile LAS unsigned* MISC = (volatile LAS unsigned*)(lds + LDS_MISC);
    const int wv0 = __builtin_amdgcn_readfirstlane((int)threadIdx.x >> 6);
    const int tid = threadIdx.x;
    if (tid < 64) MISC[tid] = 0u;
    __syncthreads();
    const int lo = sopaque(a0.ph_lo), hi = sopaque(a0.ph_hi);
#define use_bar ((hi - lo) > 1)
    XcdBarrier bar; bar.bar = (unsigned*)(a0.ws + WS_CTL) + CW_BAR; bar.x = 0; bar.st = MISC + 8;
    bar.wv = wv0;
    if (use_bar) bar = xcd_barrier_post((unsigned*)(a0.ws + WS_CTL) + CW_BAR, MISC + 8, wv0);
    const int G = sopaque((int)gridDim.x), bx = sopaque((int)blockIdx.x);
    const int vcu = (G % 8 == 0) ? (bx % 8) * (G / 8) + bx / 8 : bx;
#ifndef ONLY_PHASE
#define ONLY_PHASE -1
#endif
#ifndef PHASE_MASK
#define PHASE_MASK 0x7ff
#endif
#define IN(k) (lo <= (k) && (k) < hi && (ONLY_PHASE < 0 || ONLY_PHASE == (k)) && ((PHASE_MASK >> (k)) & 1))
#if DIAG >= 40
    unsigned long long tprev_ = __builtin_amdgcn_s_memrealtime();
#define TSTAMP(k) do { const unsigned long long tn_ = __builtin_amdgcn_s_memrealtime(); if (DIAG - 40 == (k) && blockIdx.x == 0 && tid == 0) MISC[40] = __float_as_uint(rintf((float)(tn_ - tprev_) * (1.f / 1000.f)) * 1e-5f); tprev_ = tn_; } while (0)
#else
#define TSTAMP(k) do { } while (0)
#endif
#define SEAM(k) do { if ((k) == 9) TSTAMP(k); if ((k) == 9 && DIAG >= 10 && blockIdx.x == 0 && tid == 0) __hip_atomic_store((unsigned*)(a0.ws + WS_CTL) + CW_DIAG, MISC[40], __ATOMIC_RELAXED, __HIP_MEMORY_SCOPE_AGENT); \
        if (use_bar && (k) + 1 < hi) xcd_barrier(bar); if ((k) != 9) TSTAMP(k); } while (0)
#ifndef REPEAT_MASK
#define REPEAT_MASK 0
#endif
#define REP(k) for (int rep_ = 0; rep_ <= ((REPEAT_MASK >> (k)) & 1); ++rep_)
    a = a0; a.wv = wv0;
    if (IN(0)) { phase_mod(a, lds); SEAM(0); }
    REP(1) if (IN(1)) { phase_prep(a, lds); SEAM(1); }
    {
        float* prm = (float*)(a0.ws + WS_PRM);
        a.ws = a0.ws; a.out = a0.out; a.in[I_X] = a0.in[I_X]; a.wv = wv0;
        a.in[I_GQL] = prm + PRM_GQL; a.in[I_GKVL] = prm + PRM_GKVL; a.in[I_GQH] = prm + PRM_GQH; a.in[I_GKH] = prm + PRM_GKH; a.in[I_DECAY] = prm + PRM_DECAY;
        a.in[I_GRET] = prm + PRM_GRET; a.in[I_BR] = prm + PRM_BR; a.in[I_GFFN] = prm + PRM_GFFN; a.in[I_B1] = prm + PRM_B1; a.in[I_B2] = prm + PRM_B2;
    }
    REP(2) if (IN(2)) {
        pg8::DenseOrder S; S.init(a.ws + WS_H, a.ws + WS_WIN, TA, DINP, 1024, G, bx);
        pg8::EpiP E{(bf16_t*)(a.ws + WS_P)};
        pg8::gemm_phase<pg8::EpiP, pg8::DenseOrder, false>(lds, nullptr, nullptr, 0, 1024, S, E, a.wv);
        SEAM(2);
    }
    REP(3) if (IN(3)) {
        if (G == 256) {
            int u0, nu;
            if (bx < 32) { u0 = 3 * bx; nu = 3; }
            else { const int c = bx - 32; u0 = 96 + 4 * c + (c < 64 ? c : 64); nu = 4 + (c < 64 ? 1 : 0); }
            for (int k2 = 0; k2 < (bx < 32 ? 2 : 1); ++k2) mla_tile(a, lds, k2 ? 256 + (bx >> 2) : bx, k2 ? 32 * (bx & 3) : 0, k2 ? 32 : 128);
            for (int u = u0; u < u0 + nu; ++u) ret_local_unit(a, lds, u);
        } else { for (int t = bx; t < TA / 128; t += G) mla_tile(a, lds, t); for (int u = bx; u < 16 * NSLOT; u += G) ret_local_unit(a, lds, u); }
        SEAM(3);
    }
    if (IN(4)) { phase_ret_scan(a); SEAM(4); }
    REP(5) if (IN(5)) {
        float negm;
        { float gq = 0.f, gk = 0.f; for (int i = 0; i < QK; ++i) { gq = fmaxf(gq, fabsf(a.in[I_GQH][i])); gk = fmaxf(gk, fabsf(a.in[I_GKH][i])); }
          negm = -(gq * gk * 96.f * QSCALE * 1.03f + 0.5f); negm = __uint_as_float(__builtin_amdgcn_readfirstlane(__float_as_uint(negm))); }
        const bool shift = negm < -64.f;
        __builtin_amdgcn_s_setreg((0 << 11) | (23 << 6) | 1, 1);
#ifndef REP5A
#define REP5A 0
#endif
#ifndef REP5B
#define REP5B 0
#endif
        if (G == 256) {
            const int xg = vcu >> 5, c = vcu & 31, cg = vcu & 3;
#pragma unroll 1
            for (int step = 0; step < 4; ++step) {
                if (step == cg) moe_convert(a, lds, vcu);
                if (step < 2) { const int bh = xg * 4 + 2 * step + (c >> 4), qb = c & 15; if (shift) att::unit64<true>(a, lds, bh, qb, negm); else att::unit64<false>(a, lds, bh, qb, negm); }
                else if (step == 2) { for (int u = bx; u < 16 * 64; u += G) ret_out_unit(a, lds, u); }
            }
        } else {
            for (int w = bx; w < 512; w += G) { if (shift) att::unit64<true>(a, lds, w >> 4, w & 15, negm); else att::unit64<false>(a, lds, w >> 4, w & 15, negm); }
            for (int u = bx; u < 16 * 64; u += G) ret_out_unit(a, lds, u);
        }
        SEAM(5);
    }
    REP(6) if (IN(6)) {
        pg8::DenseOrder S; S.init(a.ws + WS_MIX, a.ws + WS_WO, T, DM, 1024, G, bx);
        pg8::EpiOut E{a.in[I_X], (const float*)(a.ws + WS_MOD), a.out};
        pg8::gemm_phase<pg8::EpiOut, pg8::DenseOrder, false>(lds, nullptr, nullptr, 0, 1024, S, E, a.wv);
        SEAM(6);
    }
    if (IN(7)) { phase_router(a, lds); SEAM(7); }
    REP(8) if (IN(8)) {
        pg8::EpiM1 E{a.ws + WS_ACT};
        phase_moe_pg8<8>(a, lds, a.ws + WS_HF, 2, a.ws + WS_W1, (size_t)2048 * 1024, a.in[I_B1], 2048, nullptr, E);
        SEAM(8);
    }
    REP(9) if (IN(9)) {
        pg8::EpiM2 E{a.ws + WS_Y};
        phase_moe_pg8<4>(a, lds, a.ws + WS_ACT, 0, a.ws + WS_W2, (size_t)1024 * 1024, a.in[I_B2], 1024, (const float*)(a.ws + WS_PG), E);
        SEAM(9);
    }
    if (IN(10)) { phase_combine(a); }
#undef IN
#undef SEAM
#undef use_bar
}

extern "C" void kernel_launch(void* const* d_in, const int* in_sizes, int n_in, void* d_out, int out_size, void* d_ws, size_t ws_size, hipStream_t stream) {
    static int grid = 0;
    if (grid == 0) {
        if (n_in != 24 || out_size != T * DM || ws_size < WS_END) { fprintf(stderr, "kernel_launch: unexpected shapes (n_in %d out %d ws %zu)\n", n_in, out_size, ws_size); grid = -1; return; }
        int dev = 0, cus = 0, per_cu = 0;
        if (hipGetDevice(&dev) != hipSuccess || hipDeviceGetAttribute(&cus, hipDeviceAttributeMultiprocessorCount, dev) != hipSuccess) { grid = -1; return; }
        if (hipFuncSetAttribute((const void*)fwd_kernel, hipFuncAttributeMaxDynamicSharedMemorySize, LDS_BYTES) != hipSuccess) { fprintf(stderr, "kernel_launch: hipFuncSetAttribute failed\n"); grid = -1; return; }
        if (hipOccupancyMaxActiveBlocksPerMultiprocessor(&per_cu, (const void*)fwd_kernel, 512, LDS_BYTES) != hipSuccess || per_cu < 1) { fprintf(stderr, "kernel_launch: occupancy query says %d\n", per_cu); per_cu = 1; }
        (void)hipGetLastError();
        grid = cus;
    }
    if (grid < 0) return;
    (void)hipMemsetAsync((char*)d_ws + WS_CTL, 0, CTL_BYTES, stream);
    Args a{};
    for (int i = 0; i < 24; ++i) a.in[i] = (const float*)d_in[i];
    a.out = (float*)d_out; a.ws = (unsigned char*)d_ws;
#if MK_N_LAUNCHES == 1
    a.ph_lo = 0; a.ph_hi = N_PHASES;
    void* params[] = {&a};
    hipError_t e = hipLaunchCooperativeKernel((const void*)fwd_kernel, dim3(grid), dim3(512), params, LDS_BYTES, stream);
    if (e != hipSuccess) fprintf(stderr, "kernel_launch: cooperative launch failed: %s (grid %d)\n", hipGetErrorString(e), grid);
#else
    for (int p = 0; p < N_PHASES; ++p) { a.ph_lo = p; a.ph_hi = p + 1; hipLaunchKernelGGL(fwd_kernel, dim3(grid), dim3(512), LDS_BYTES, stream, a); }
#endif
}
```

```cpp
#include <hip/hip_runtime.h>
#include <cstdio>
#include <cstdint>

#ifndef MK_N_LAUNCHES
#define MK_N_LAUNCHES 1
#endif

#define LAS __attribute__((address_space(3)))
#define GAS __attribute__((address_space(1)))
typedef unsigned short bf16_t;
typedef short bf16x8 __attribute__((ext_vector_type(8)));
typedef short s16x4 __attribute__((ext_vector_type(4)));
typedef float f32x4 __attribute__((ext_vector_type(4)));
typedef float f32x16 __attribute__((ext_vector_type(16)));
typedef unsigned u32x4 __attribute__((ext_vector_type(4)));
typedef unsigned u32x2 __attribute__((ext_vector_type(2)));

constexpr int DM = 1024, NB = 4, SEQ = 8192, LC = 256;
constexpr int T = NB * SEQ;
constexpr int TC = NB * LC;
constexpr int TA = T + TC;
constexpr int DIN = 1952, DINP = 2048;
constexpr int OFF_Q = 0, OFF_KV = 256, OFF_PE = 384, OFF_RQ = 416, OFF_RK = 672, OFF_RV = 928, OFF_RG = 1440;
constexpr int NH = 8, QK = 96, QK8 = 128, DV = 64, SKV = LC + SEQ;
constexpr int RH = 4, RDK = 64, RDV = 128, RC = 128, NSLOT = 66;
constexpr int NE = 32, DFF = 1024, NPAIR = T * 4;
constexpr float EPS = 1e-6f;
constexpr float QSCALE = 0.10206207261596577f * 1.4426950408889634f;

constexpr size_t MiB = 1ull << 20;
constexpr size_t WS_CTL = 0, CTL_BYTES = 1 * MiB;
constexpr size_t WS_MOD = 1 * MiB;
constexpr size_t WS_TABM = WS_MOD + 128 * 1024;
constexpr size_t WS_TABR = WS_TABM + 16 * 1024;
constexpr size_t WS_WIN = 2 * MiB;
constexpr size_t WS_WQ = 6 * MiB;
constexpr size_t WS_WKV = 6 * MiB + 512 * 1024;
constexpr size_t WS_WO = 7 * MiB;
constexpr size_t WS_WR = 9 * MiB;
constexpr size_t WS_W1 = 10 * MiB;
constexpr size_t WS_W2 = 138 * MiB;
constexpr size_t WS_HF = 202 * MiB;
constexpr size_t WS_PG = 266 * MiB;
constexpr size_t WS_LIST = 267 * MiB;
constexpr size_t WS_H = 272 * MiB;
constexpr size_t WS_P = 338 * MiB;
constexpr size_t WS_Q = 470 * MiB;
constexpr size_t WS_K = 518 * MiB;
constexpr size_t WS_VT = 568 * MiB;
constexpr size_t WS_LST = 601 * MiB;
constexpr size_t WS_MIX = 667 * MiB;
constexpr size_t WS_ACT = 272 * MiB;
constexpr size_t WS_Y = 528 * MiB;
constexpr size_t WS_END = 784 * MiB;
constexpr size_t WS_PRM = WS_MOD + 256 * 1024;
constexpr int PRM_GQL = 0, PRM_GKVL = 256, PRM_GQH = 384, PRM_GKH = 480, PRM_DECAY = 576, PRM_GRET = 584, PRM_BR = 1096, PRM_GFFN = 1128, PRM_B1 = 2152, PRM_B2 = 67688, PRM_END = 100456;
constexpr int CW_BAR = 4096;
constexpr int CW_CNT = 16384;
constexpr int CW_DIAG = 20480;
#ifndef DIAG
#define DIAG 0
#endif

constexpr int LDS_SCRATCH = 159744;
constexpr int LDS_MISC = LDS_SCRATCH;
constexpr int LDS_BYTES = LDS_SCRATCH + 256;

__device__ __forceinline__ float bf2f(bf16_t h) { return __uint_as_float((unsigned)h << 16); }
__device__ __forceinline__ unsigned f2bf(float f) { unsigned u = __float_as_uint(f); return (u + 0x7fffu + ((u >> 16) & 1u)) >> 16; }
__device__ __forceinline__ unsigned pk2(float lo, float hi) { return f2bf(lo) | (f2bf(hi) << 16); }
__device__ __forceinline__ float lo16(unsigned w) { return __uint_as_float(w << 16); }
__device__ __forceinline__ float hi16(unsigned w) { return __uint_as_float(w & 0xffff0000u); }
__device__ __forceinline__ float wave_sum(float v) {
#pragma unroll
    for (int o = 1; o < 64; o <<= 1) v += __shfl_xor(v, o);
    return v;
}
#define LDS_WAIT() asm volatile("s_waitcnt lgkmcnt(0)" ::: "memory")
__device__ __forceinline__ unsigned cvt4_fp8(float a, float b, float c, float d) { int p = 0; p = __builtin_amdgcn_cvt_pk_fp8_f32(a, b, p, false); p = __builtin_amdgcn_cvt_pk_fp8_f32(c, d, p, true); return (unsigned)p; }
constexpr float WQ_SCALE = 16.f, WKV_SCALE = 8.f, WKV_INV = 1.f / 8.f;
constexpr float WSCALE = 64.f, WINV = 1.f / 64.f;
__device__ __forceinline__ int opaque(int v) { asm volatile("" : "+v"(v)); return v; }
__device__ __forceinline__ int sopaque(int v) { asm volatile("" : "+s"(v)); return v; }
__device__ __forceinline__ int tid_of(int wv) { return sopaque(wv) * 64 + opaque((int)__builtin_amdgcn_mbcnt_hi(~0u, __builtin_amdgcn_mbcnt_lo(~0u, 0u))); }

#define XB_TMO      128
#define XB_XCNT(j)  (256  + 64 * (j))
#define XB_XSUB(j)  (1280 + 64 * (j))
#define XB_XGEN(j)  (2304 + 64 * (j))
#define XB_TOP      3328
#define XB_TOPGEN   3392
#define XCD_BAR_WORDS 3456
#define XB_SPIN_CAP (1u << 20)
__device__ __forceinline__ unsigned xb_ld(unsigned* p)              { return __hip_atomic_load(p, __ATOMIC_RELAXED, __HIP_MEMORY_SCOPE_AGENT); }
__device__ __forceinline__ unsigned xb_add(unsigned* p, unsigned v) { return __hip_atomic_fetch_add(p, v, __ATOMIC_RELAXED, __HIP_MEMORY_SCOPE_AGENT); }
__device__ __forceinline__ unsigned xb_xcc_id() { return (unsigned)__builtin_amdgcn_s_getreg((3 << 11) | 20) & 0xFu; }
#define XB_SPIN(cond, bar) do { unsigned _sp = 0; while (cond) { __builtin_amdgcn_s_sleep(1); \
    if ((++_sp & 255u) == 0u) { if (xb_ld(&(bar)[XB_TMO])) break; if (_sp > XB_SPIN_CAP) { atomicAdd(&(bar)[XB_TMO], 1u); break; } } } } while (0)
struct XcdBarrier { unsigned* bar; unsigned x; volatile LAS unsigned* st; int wv; };
__device__ __forceinline__ XcdBarrier xcd_barrier_post(unsigned* bar, volatile LAS unsigned* st, int wv) {
    XcdBarrier b; b.bar = bar; b.x = xb_xcc_id(); b.st = st; b.wv = wv;
    if (tid_of(wv) == 0) (void)xb_add(&bar[XB_XCNT(b.x)], 1u);
    return b;
}
__device__ __forceinline__ void xcd_barrier_complete(unsigned* bar, unsigned x, unsigned& nloc, unsigned& nx) {
    const unsigned G = gridDim.x * gridDim.y * gridDim.z;
    unsigned sum, cnt, mine, sp = 0u;
    for (;;) {
        sum = 0u; cnt = 0u; mine = 0u;
#pragma unroll 1
        for (unsigned j = 0; j < 16; ++j) { const unsigned c = xb_ld(&bar[XB_XCNT(j)]); sum += c; cnt += (c > 0u) ? 1u : 0u; mine = (j == x) ? c : mine; }
        if (sum == G) break;
        __builtin_amdgcn_s_sleep(1);
        if ((++sp & 255u) == 0u) { if (xb_ld(&bar[XB_TMO])) break; if (sp > XB_SPIN_CAP) { atomicAdd(&bar[XB_TMO], 1u); break; } }
    }
    nloc = mine > 0u ? mine : 1u; nx = cnt > 0u ? cnt : 1u;
}
__device__ __forceinline__ void xcd_barrier(const XcdBarrier& b) {
    asm volatile("s_waitcnt vmcnt(0)" ::: "memory");
    __syncthreads();
    if (tid_of(b.wv) == 0) {
        unsigned* bar = b.bar; asm volatile("" : "+s"(bar));
        __builtin_amdgcn_s_waitcnt(0);
        unsigned nloc = b.st[0], nx = b.st[1];
        if (nloc == 0u) { xcd_barrier_complete(bar, b.x, nloc, nx); b.st[0] = nloc; b.st[1] = nx; }
        const unsigned old = xb_add(&bar[XB_XSUB(b.x)], 1u);
        const unsigned gen = old / nloc;
        if (old + 1u == (gen + 1u) * nloc) {
            __builtin_amdgcn_fence(__ATOMIC_RELEASE, "agent");
            asm volatile("s_waitcnt vmcnt(0)" ::: "memory");
            const unsigned og = xb_add(&bar[XB_TOP], 1u);
            const unsigned tg = og / nx;
            if (og + 1u == (tg + 1u) * nx) xb_add(&bar[XB_TOPGEN], 1u);
            else XB_SPIN(xb_ld(&bar[XB_TOPGEN]) == tg, bar);
            __builtin_amdgcn_fence(__ATOMIC_ACQUIRE, "agent");
            xb_add(&bar[XB_XGEN(b.x)], 1u);
            asm volatile("s_waitcnt vmcnt(0)" ::: "memory");
        } else {
            XB_SPIN(xb_ld(&bar[XB_XGEN(b.x)]) == gen, bar);
            __builtin_amdgcn_fence(__ATOMIC_ACQUIRE, "agent");
            asm volatile("s_waitcnt vmcnt(0)" ::: "memory");
        }
    }
    __syncthreads();
}

struct Args { const float* in[24]; float* out; unsigned char* ws; int ph_lo, ph_hi; int wv, pad; };
#define CAS __attribute__((address_space(4)))
__device__ __forceinline__ Args load_args() { auto p = __builtin_amdgcn_kernarg_segment_ptr(); asm volatile("" : "+s"(p)); Args r; __builtin_memcpy(&r, p, sizeof(Args)); return r; }
enum { I_X = 0, I_C, I_CTX, I_CCTX, I_GATTN, I_GFFN, I_WADA, I_BADA, I_WIN, I_GQL, I_WQUP, I_GQH, I_GKVL, I_WKVUP, I_GKH, I_DECAY, I_GRET, I_WOUT,
       I_WR, I_BR, I_W1, I_B1, I_W2, I_B2 };

template <int MT, int NT, bool SWAP>
__device__ __forceinline__ void mma_ll(f32x4 (&acc)[MT][NT], const LAS bf16_t* sA, int lda, int m0, const LAS bf16_t* sB, int ldb, int n0, int K, int lane) {
    const int fr = lane & 15, fq = lane >> 4;
    for (int k = 0; k < K; k += 32) {
        bf16x8 a[MT], b[NT];
#pragma unroll
        for (int i = 0; i < MT; ++i) a[i] = *(const LAS bf16x8*)(sA + (m0 + 16 * i + fr) * lda + k + 8 * fq);
#pragma unroll
        for (int j = 0; j < NT; ++j) b[j] = *(const LAS bf16x8*)(sB + (n0 + 16 * j + fr) * ldb + k + 8 * fq);
#pragma unroll
        for (int i = 0; i < MT; ++i)
#pragma unroll
            for (int j = 0; j < NT; ++j)
                acc[i][j] = SWAP ? __builtin_amdgcn_mfma_f32_16x16x32_bf16(b[j], a[i], acc[i][j], 0, 0, 0) : __builtin_amdgcn_mfma_f32_16x16x32_bf16(a[i], b[j], acc[i][j], 0, 0, 0);
    }
}
template <int MT, int NT, bool SWAP>
__device__ __forceinline__ void mma_lg(f32x4 (&acc)[MT][NT], const LAS bf16_t* sA, int lda, int m0, const bf16_t* gB, int ldb, int n0, int K, int lane) {
    const int fr = lane & 15, fq = lane >> 4;
#pragma unroll 2
    for (int k = 0; k < K; k += 32) {
        bf16x8 a[MT], b[NT];
#pragma unroll
        for (int j = 0; j < NT; ++j) b[j] = *(const GAS bf16x8*)(gB + (size_t)(n0 + 16 * j + fr) * ldb + k + 8 * fq);
#pragma unroll
        for (int i = 0; i < MT; ++i) a[i] = *(const LAS bf16x8*)(sA + (m0 + 16 * i + fr) * lda + k + 8 * fq);
#pragma unroll
        for (int i = 0; i < MT; ++i)
#pragma unroll
            for (int j = 0; j < NT; ++j)
                acc[i][j] = SWAP ? __builtin_amdgcn_mfma_f32_16x16x32_bf16(b[j], a[i], acc[i][j], 0, 0, 0) : __builtin_amdgcn_mfma_f32_16x16x32_bf16(a[i], b[j], acc[i][j], 0, 0, 0);
    }
}

__device__ __forceinline__ void phase_mod(const Args& a, LAS unsigned char* lds) {
    const int tid = tid_of(a.wv), lane = tid & 63, wave = tid >> 6;
    LAS float* sv = (LAS float*)lds;
    LAS float* red = sv + 5 * 1024;
    float* mod = (float*)(a.ws + WS_MOD);
    for (int i = tid; i < 5 * 1024; i += 512) { const float v = (i < 4096) ? a.in[I_C][i] : a.in[I_CCTX][i - 4096]; sv[i] = v / (1.f + __expf(-v)); }
    __syncthreads();
    const float* W = a.in[I_WADA]; const float* bb = a.in[I_BADA];
    for (int u = blockIdx.x; u < 96; u += gridDim.x) {
        const int col = u * 64 + lane;
        float acc[5] = {0.f, 0.f, 0.f, 0.f, 0.f};
        for (int k = wave * 128; k < wave * 128 + 128; ++k) {
            const float w = W[(size_t)k * 6144 + col];
#pragma unroll
            for (int v = 0; v < 5; ++v) acc[v] += sv[v * 1024 + k] * w;
        }
#pragma unroll
        for (int v = 0; v < 5; ++v) red[(wave * 5 + v) * 64 + lane] = acc[v];
        __syncthreads();
        if (tid < 320) { const int v = tid >> 6; float s = bb[u * 64 + lane];
#pragma unroll
            for (int w = 0; w < 8; ++w) s += red[(w * 5 + v) * 64 + lane];
            mod[v * 6144 + u * 64 + lane] = s; }
        __syncthreads();
    }
    const int gt = blockIdx.x * 512 + tid;
    if (gt < 192 * 8) { const int pi = gt >> 3, f = gt & 7; const float pos = (float)(pi < 128 ? pi : pi - 128);
        const float inv = exp2f(-(float)f * (13.287712379549449f / 8.f)); const float rev = pos * inv * 0.15915494309189535f;
        float* tm = (float*)(a.ws + WS_TABM); tm[gt * 2] = __builtin_amdgcn_cosf(rev); tm[gt * 2 + 1] = __builtin_amdgcn_sinf(rev); }
    else if (gt < 192 * 8 + 192 * 16) { const int g2 = gt - 192 * 8; const int pi = g2 >> 4, f = g2 & 15; const float pos = (float)(pi < 128 ? pi : pi - 128);
        const float inv = exp2f(-(float)f * (13.287712379549449f / 16.f)); const float rev = pos * inv * 0.15915494309189535f;
        float* tr = (float*)(a.ws + WS_TABR); tr[g2 * 2] = __builtin_amdgcn_cosf(rev); tr[g2 * 2 + 1] = __builtin_amdgcn_sinf(rev); }
}

__device__ __forceinline__ void transpose_item(const float* W, int K, int N, bf16_t* WT, LAS float* scr, int item, int lane) {
    const int nblk = N / 32, kb = item / nblk, nb = item % nblk, k0 = 64 * kb, n0 = 32 * nb;
    float wv_[32];
#pragma unroll
    for (int i = 0; i < 32; ++i) { const int kk = 2 * i + (lane >> 5); wv_[i] = W[(size_t)(k0 + kk) * N + n0 + (lane & 31)]; }
#pragma unroll
    for (int i = 0; i < 32; ++i) { const int kk = 2 * i + (lane >> 5); scr[kk * 33 + (lane & 31)] = wv_[i]; }
    LDS_WAIT();
    const int c = lane & 7;
#pragma unroll
    for (int j = 0; j < 4; ++j) { const int n = (lane >> 3) + 8 * j; const LAS float* s = scr + (8 * c) * 33 + n;
        u32x4 o; o.x = pk2(s[0 * 33], s[1 * 33]); o.y = pk2(s[2 * 33], s[3 * 33]); o.z = pk2(s[4 * 33], s[5 * 33]); o.w = pk2(s[6 * 33], s[7 * 33]);
        *(GAS u32x4*)(WT + (size_t)(n0 + n) * K + k0 + 8 * c) = o; }
    LDS_WAIT();
}
__device__ __forceinline__ void transpose_item8(const float* W, int K, int N, unsigned char* WT, float sc, LAS float* scr, int item, int lane) {
    const int nblk = N / 32, kb = item / nblk, nb = item % nblk, k0 = 64 * kb, n0 = 32 * nb;
    float wv_[32];
#pragma unroll
    for (int i = 0; i < 32; ++i) { const int kk = 2 * i + (lane >> 5); wv_[i] = W[(size_t)(k0 + kk) * N + n0 + (lane & 31)]; }
#pragma unroll
    for (int i = 0; i < 32; ++i) { const int kk = 2 * i + (lane >> 5); scr[kk * 33 + (lane & 31)] = wv_[i]; }
    LDS_WAIT();
    const int c = lane & 7;
#pragma unroll
    for (int j = 0; j < 4; ++j) { const int n = (lane >> 3) + 8 * j; const LAS float* s = scr + (8 * c) * 33 + n;
        u32x2 o; o.x = cvt4_fp8(s[0 * 33] * sc, s[1 * 33] * sc, s[2 * 33] * sc, s[3 * 33] * sc); o.y = cvt4_fp8(s[4 * 33] * sc, s[5 * 33] * sc, s[6 * 33] * sc, s[7 * 33] * sc);
        *(GAS u32x2*)(WT + (size_t)(n0 + n) * K + k0 + 8 * c) = o; }
    LDS_WAIT();
}
__device__ __forceinline__ void phase_prep(const Args& a, LAS unsigned char* lds) {
    const int tid = tid_of(a.wv), lane = tid & 63, wave = tid >> 6;
    LAS float* scr = (LAS float*)(lds + wave * 16384);
    const int gw = blockIdx.x * 8 + wave, NGW = gridDim.x * 8;
    constexpr int I_IN = 16 * 61, I_QU = 4 * 24, I_KVU = 2 * 32, I_O = 16 * 32, I_1 = 16 * 64, I_2 = 16 * 32;
    constexpr int NITEMS = I_IN + I_QU + I_KVU + I_O + 32 * I_1 + 32 * I_2;
    const int nitems = gridDim.x == 256 ? I_IN + I_QU + I_KVU + I_O : NITEMS;
    for (int it = gw; it < nitems; it += NGW) {
        int r = it;
        if (r < I_IN) { transpose_item(a.in[I_WIN], 1024, DIN, (bf16_t*)(a.ws + WS_WIN), scr, r, lane); continue; } r -= I_IN;
        if (r < I_QU) { transpose_item8(a.in[I_WQUP], 256, 768, a.ws + WS_WQ, WQ_SCALE, scr, r, lane); continue; } r -= I_QU;
        if (r < I_KVU) { transpose_item8(a.in[I_WKVUP], 128, 1024, a.ws + WS_WKV, WKV_SCALE, scr, r, lane); continue; } r -= I_KVU;
        if (r < I_O) { transpose_item(a.in[I_WOUT], 1024, 1024, (bf16_t*)(a.ws + WS_WO), scr, r, lane); continue; } r -= I_O;
        if (r < 32 * I_1) { const int e = r / I_1; transpose_item8(a.in[I_W1] + (size_t)e * 1024 * 2048, 1024, 2048, a.ws + WS_W1 + (size_t)e * 2048 * 1024, WSCALE, scr, r % I_1, lane); continue; } r -= 32 * I_1;
        { const int e = r / I_2; transpose_item8(a.in[I_W2] + (size_t)e * 1024 * 1024, 1024, 1024, a.ws + WS_W2 + (size_t)e * 1024 * 1024, WSCALE, scr, r % I_2, lane); }
    }
    const int gt = blockIdx.x * 512 + tid, NGT = gridDim.x * 512;
    for (int i = gt; i < 96 * 1024 / 8; i += NGT) *(GAS u32x4*)((bf16_t*)(a.ws + WS_WIN) + (size_t)DIN * 1024 + (size_t)i * 8) = (u32x4){0u, 0u, 0u, 0u};
    for (int i = gt; i < 32 * 1024; i += NGT) { const int n = i >> 10, k = i & 1023; const float w = a.in[I_WR][k * 32 + n]; const unsigned h = f2bf(w);
        bf16_t* wr = (bf16_t*)(a.ws + WS_WR); wr[i] = (bf16_t)h; wr[32768 + i] = (bf16_t)f2bf(w - bf2f((bf16_t)h)); }
    {
        float* prm = (float*)(a.ws + WS_PRM);
        for (int i = gt; i < PRM_END; i += NGT) {
            float v;
            if (i < PRM_GKVL) v = a.in[I_GQL][i - PRM_GQL]; else if (i < PRM_GQH) v = a.in[I_GKVL][i - PRM_GKVL]; else if (i < PRM_GKH) v = a.in[I_GQH][i - PRM_GQH];
            else if (i < PRM_DECAY) v = a.in[I_GKH][i - PRM_GKH]; else if (i < PRM_GRET) v = a.in[I_DECAY][i - PRM_DECAY]; else if (i < PRM_BR) v = a.in[I_GRET][i - PRM_GRET];
            else if (i < PRM_GFFN) v = a.in[I_BR][i - PRM_BR]; else if (i < PRM_B1) v = a.in[I_GFFN][i - PRM_GFFN]; else if (i < PRM_B2) v = a.in[I_B1][i - PRM_B1]; else v = a.in[I_B2][i - PRM_B2];
            prm[i] = v;
        }
    }
    const float* mod = (const float*)(a.ws + WS_MOD); const float* g = a.in[I_GATTN];
    for (int m = gw; m < TA; m += NGW) {
        const float* xr; int mv;
        if (m < T) { xr = a.in[I_X] + (size_t)m * DM; mv = m >> 13; } else { xr = a.in[I_CTX] + (size_t)(m - T) * DM; mv = 4; }
        const float* sh = mod + mv * 6144; const float* sc = sh + 1024;
        f32x4 v[4]; float ss = 0.f;
#pragma unroll
        for (int j = 0; j < 4; ++j) { v[j] = *(const GAS f32x4*)(xr + j * 256 + lane * 4); ss += (v[j].x * v[j].x + v[j].y * v[j].y) + (v[j].z * v[j].z + v[j].w * v[j].w); }
        const float rstd = rsqrtf(wave_sum(ss) * (1.f / DM) + EPS);
        bf16_t* hr = (bf16_t*)(a.ws + WS_H) + (size_t)m * DM;
#pragma unroll
        for (int j = 0; j < 4; ++j) { const int c = j * 256 + lane * 4; const f32x4 gg = *(const GAS f32x4*)(g + c), s1 = *(const GAS f32x4*)(sc + c), s0 = *(const GAS f32x4*)(sh + c);
            const f32x4 o = (v[j] * rstd * gg) * (s1 + 1.f) + s0; u32x2 w; w.x = pk2(o.x, o.y); w.y = pk2(o.z, o.w); *(GAS u32x2*)(hr + c) = w; }
    }
}

#define MOE_ITEM(it_, P_, D_, N_) do { constexpr int I_1 = 16 * 64, I_2 = 16 * 32; \
    const bool up_ = (it_) < 32 * I_1; const int r_ = up_ ? (it_) : (it_) - 32 * I_1; N_ = up_ ? 2048 : 1024; const int per_ = up_ ? I_1 : I_2, e_ = r_ / per_, item_ = r_ % per_; \
    const int nblk_ = N_ / 32, kb_ = item_ / nblk_, nb_ = item_ % nblk_, k0_ = 64 * kb_, n0_ = 32 * nb_; \
    P_ = (up_ ? a.in[I_W1] : a.in[I_W2]) + (size_t)e_ * 1024 * N_ + (size_t)(k0_ + (lane >> 5)) * N_ + n0_ + (lane & 31); \
    D_ = a.ws + (up_ ? WS_W1 : WS_W2) + (size_t)e_ * N_ * 1024 + (size_t)n0_ * 1024 + k0_; } while (0)
__device__ __forceinline__ void moe_convert(const Args& a, LAS unsigned char* lds, int cu) {
    const int tid = tid_of(a.wv), lane = tid & 63, wave = tid >> 6;
    LAS float* scr = (LAS float*)(lds + wave * 16384);
    constexpr int NIT = 32 * (16 * 64 + 16 * 32);
    __syncthreads();
    float wc[32], wn[32];
    int it = cu * 8 + wave;
    const float* pc; unsigned char* dc; int nc;
    MOE_ITEM(it, pc, dc, nc);
#pragma unroll
    for (int i = 0; i < 32; ++i) wc[i] = pc[(size_t)(2 * i) * nc];
#pragma unroll 1
    while (it < NIT) {
        const int itn = it + 256 * 8; const bool more = itn < NIT;
        const float* pn; unsigned char* dn; int nn; const int itx = more ? itn : it;
        MOE_ITEM(itx, pn, dn, nn);
        if (more) {
#pragma unroll
            for (int i = 0; i < 32; ++i) wn[i] = pn[(size_t)(2 * i) * nn]; }
#pragma unroll
        for (int i = 0; i < 32; ++i) { const int kk = 2 * i + (lane >> 5); scr[kk * 33 + (lane & 31)] = wc[i]; }
        LDS_WAIT();
        const int c = lane & 7;
#pragma unroll
        for (int j = 0; j < 4; ++j) { const int n = (lane >> 3) + 8 * j; const LAS float* s_ = scr + (8 * c) * 33 + n;
            u32x2 o; o.x = cvt4_fp8(s_[0 * 33] * WSCALE, s_[1 * 33] * WSCALE, s_[2 * 33] * WSCALE, s_[3 * 33] * WSCALE); o.y = cvt4_fp8(s_[4 * 33] * WSCALE, s_[5 * 33] * WSCALE, s_[6 * 33] * WSCALE, s_[7 * 33] * WSCALE);
            *(GAS u32x2*)(dc + (size_t)n * 1024 + 8 * c) = o; }
        LDS_WAIT();
#pragma unroll
        for (int i = 0; i < 32; ++i) wc[i] = wn[i];
        dc = dn; it = itn;
    }
    __syncthreads();
}
#undef MOE_ITEM

struct GUnit { const bf16_t* Bt; int m0, n0, nvalid, e; };
template <class RowFn, class Epi>
__device__ __forceinline__ void gemm_tile(LAS unsigned char* lds, const bf16_t* A, int K, const GUnit& u, const RowFn& rowfn, const Epi& epi) {
    LAS bf16_t* sA = (LAS bf16_t*)lds;
    LAS bf16_t* sB = (LAS bf16_t*)(lds + 256 * 72 * 2);
    const int tid = opaque((int)threadIdx.x), lane = tid & 63, wave = tid >> 6, wm = wave >> 1, wn = wave & 1;
    const int ch = tid & 7, r0 = tid >> 3;
    const bf16_t* ap[4]; const bf16_t* bp[2];
#pragma unroll
    for (int i = 0; i < 4; ++i) { const int r = r0 + 64 * i; const int rr = r < u.nvalid ? r : 0; ap[i] = A + (size_t)rowfn(u, rr) * K + ch * 8; }
#pragma unroll
    for (int i = 0; i < 2; ++i) bp[i] = u.Bt + (size_t)(r0 + 64 * i) * K + ch * 8;
    f32x4 acc[4][4];
#pragma unroll
    for (int i = 0; i < 4; ++i)
#pragma unroll
        for (int j = 0; j < 4; ++j) acc[i][j] = (f32x4){0.f, 0.f, 0.f, 0.f};
    u32x4 ra[4], rb[2];
#pragma unroll
    for (int i = 0; i < 4; ++i) ra[i] = *(const GAS u32x4*)(ap[i]);
#pragma unroll
    for (int i = 0; i < 2; ++i) rb[i] = *(const GAS u32x4*)(bp[i]);
    const int nk = K / 64;
    for (int kt = 0; kt < nk; ++kt) {
        __syncthreads();
#pragma unroll
        for (int i = 0; i < 4; ++i) *(LAS u32x4*)(sA + (r0 + 64 * i) * 72 + ch * 8) = ra[i];
#pragma unroll
        for (int i = 0; i < 2; ++i) *(LAS u32x4*)(sB + (r0 + 64 * i) * 72 + ch * 8) = rb[i];
        __syncthreads();
        if (kt + 1 < nk) {
#pragma unroll
            for (int i = 0; i < 4; ++i) ra[i] = *(const GAS u32x4*)(ap[i] + (kt + 1) * 64);
#pragma unroll
            for (int i = 0; i < 2; ++i) rb[i] = *(const GAS u32x4*)(bp[i] + (kt + 1) * 64);
        }
        mma_ll<4, 4, true>(acc, sA, 72, wm * 64, sB, 72, wn * 64, 64, lane);
    }
    epi(acc, u, wm, wn, lane);
}
struct RowDense { __device__ __forceinline__ int operator()(const GUnit& u, int r) const { return u.m0 + r; } };
struct RowPairTok { const unsigned* list; __device__ __forceinline__ int operator()(const GUnit& u, int r) const { return (int)(list[(size_t)u.e * 32768 + u.m0 + r] >> 2); } };
struct RowPair { const unsigned* list; __device__ __forceinline__ int operator()(const GUnit& u, int r) const { return (int)list[(size_t)u.e * 32768 + u.m0 + r]; } };

struct EpiP { bf16_t* P;
    __device__ __forceinline__ void operator()(const f32x4 (&acc)[4][4], const GUnit& u, int wm, int wn, int lane) const {
        const int fr = lane & 15, fq = lane >> 4;
#pragma unroll
        for (int i = 0; i < 4; ++i) { const int row = u.m0 + wm * 64 + 16 * i + fr;
#pragma unroll
            for (int j = 0; j < 4; ++j) { const int col = u.n0 + wn * 64 + 16 * j + 4 * fq; u32x2 w; w.x = pk2(acc[i][j][0], acc[i][j][1]); w.y = pk2(acc[i][j][2], acc[i][j][3]);
                *(GAS u32x2*)(P + (size_t)row * DINP + col) = w; } }
    } };
struct EpiOut { const float* x; const float* mod; float* out;
    __device__ __forceinline__ void operator()(const f32x4 (&acc)[4][4], const GUnit& u, int wm, int wn, int lane) const {
        const int fr = lane & 15, fq = lane >> 4;
#pragma unroll
        for (int i = 0; i < 4; ++i) { const int row = u.m0 + wm * 64 + 16 * i + fr; const float* gate = mod + (row >> 13) * 6144 + 2 * 1024;
#pragma unroll
            for (int j = 0; j < 4; ++j) { const int col = u.n0 + wn * 64 + 16 * j + 4 * fq;
                const f32x4 xv = *(const GAS f32x4*)(x + (size_t)row * DM + col), gv = *(const GAS f32x4*)(gate + col);
                *(GAS f32x4*)(out + (size_t)row * DM + col) = xv + gv * acc[i][j]; } }
    } };
struct EpiM1 { const unsigned* list; const float* b1; bf16_t* act;
    __device__ __forceinline__ void operator()(const f32x4 (&acc)[4][4], const GUnit& u, int wm, int wn, int lane) const {
        const int fr = lane & 15, fq = lane >> 4;
#pragma unroll
        for (int i = 0; i < 4; ++i) { const int r = wm * 64 + 16 * i + fr; if (r >= u.nvalid) continue;
            const unsigned pair = list[(size_t)u.e * 32768 + u.m0 + r];
#pragma unroll
            for (int j = 0; j < 4; ++j) { const int col = u.n0 + wn * 64 + 16 * j + 4 * fq; const f32x4 bv = *(const GAS f32x4*)(b1 + (size_t)u.e * 2048 + col);
                const f32x4 v = acc[i][j] + bv;
                const float g0 = fminf(v[0], 7.f), l0 = fminf(fmaxf(v[1], -7.f), 7.f), g1 = fminf(v[2], 7.f), l1 = fminf(fmaxf(v[3], -7.f), 7.f);
                const float a0 = g0 / (1.f + __expf(-1.702f * g0)) * (l0 + 1.f), a1 = g1 / (1.f + __expf(-1.702f * g1)) * (l1 + 1.f);
                *(GAS unsigned*)(act + (size_t)pair * DFF + (col >> 1)) = pk2(a0, a1); } }
    } };
struct EpiM2 { const unsigned* list; const float* b2; const float* pg; bf16_t* y;
    __device__ __forceinline__ void operator()(const f32x4 (&acc)[4][4], const GUnit& u, int wm, int wn, int lane) const {
        const int fr = lane & 15, fq = lane >> 4;
#pragma unroll
        for (int i = 0; i < 4; ++i) { const int r = wm * 64 + 16 * i + fr; if (r >= u.nvalid) continue;
            const unsigned pair = list[(size_t)u.e * 32768 + u.m0 + r]; const float g = pg[pair];
#pragma unroll
            for (int j = 0; j < 4; ++j) { const int col = u.n0 + wn * 64 + 16 * j + 4 * fq; const f32x4 bv = *(const GAS f32x4*)(b2 + (size_t)u.e * 1024 + col);
                const f32x4 v = (acc[i][j] + bv) * g; u32x2 w; w.x = pk2(v[0], v[1]); w.y = pk2(v[2], v[3]);
                *(GAS u32x2*)(y + (size_t)pair * DM + col) = w; } }
    } };

namespace pg8 {
constexpr int BM = 256, BK = 64, HALF = 128, HTB = HALF * BK * 2, STAGE_BYTES = 8 * HTB, NXCD = 8, WGM = 8;
__host__ __device__ __forceinline__ int lds_byte(int r, int c) { const int st = (r >> 4) * 2 + (c >> 5), rr = r & 15, cc = c & 31, ob = rr * 64 + cc * 2; return st * 1024 + (ob ^ (((ob >> 9) & 1) << 5)); }
__host__ __device__ __forceinline__ void stage_rc(int b, int& R, int& C) { const int st = b / 1024, sb = b % 1024, swz = sb ^ (((sb >> 9) & 1) << 5); R = (st >> 1) * 16 + swz / 64; C = (st & 1) * 32 + (swz % 64) / 2; }
__host__ __device__ __forceinline__ int perm32(int rho) { const int n = rho >> 4, i = rho & 15; return 8 * (i >> 2) + 4 * n + (i & 3); }
struct Unit { int pm, pn; const char* A; const char* B; int e, nvalid, ul; };
struct DenseOrder {
    int nM, nN, nwg, G, c; const char* A; const char* B; size_t tstep;
    __device__ void init(const void* A_, const void* B_, int M, int N, int K, int G_, int c_) { nM = M / BM; nN = N / BM; nwg = nM * nN; G = G_; c = c_; A = (const char*)A_; B = (const char*)B_; tstep = (size_t)BM * K * 2; }
    __device__ bool next(int i, Unit& u) const {
        const long L = (long)i * G + c; if (L >= nwg) return false;
        int wgid = (int)L; { const int q = nwg / NXCD, r = nwg % NXCD, xcd = wgid % NXCD, off = wgid / NXCD; wgid = (xcd < r ? xcd * (q + 1) : r * (q + 1) + (xcd - r) * q) + off; }
        const int nig = WGM * nN, gid = wgid / nig, fm = gid * WGM, gsz = (nM - fm) < WGM ? (nM - fm) : WGM;
        u.pm = fm + ((wgid % nig) % gsz); u.pn = (wgid % nig) / gsz; u.A = A + (size_t)u.pm * tstep; u.B = B + (size_t)u.pn * tstep; u.e = 0; u.nvalid = 256; u.ul = 0; return true;
    }
};
template <int NCT> struct ExpertOrder {
    const LAS int* pre; int G, c; const char* A; const char* W; size_t wstride; int rowbytes;
    __device__ bool next(int i, Unit& u) const {
        const int L = i * G + c; const int nunit = pre[32] * NCT; if (L >= nunit) return false;
        const int ti = L / NCT; u.pn = L % NCT; int e = 0;
        for (int k = 1; k < 32; ++k) if (pre[k] <= ti) e = k;
        u.pm = ti - pre[e]; u.e = e; const int cnt = pre[33 + e]; u.nvalid = (cnt - u.pm * 256) < 256 ? (cnt - u.pm * 256) : 256; u.ul = i;
        u.A = A; u.B = W + (size_t)e * wstride + (size_t)u.pn * 256 * rowbytes; return true;
    }
};
__device__ __forceinline__ unsigned cvt_pk_bf16(float lo, float hi) { unsigned r; asm volatile("v_cvt_pk_bf16_f32 %0, %1, %2" : "=v"(r) : "v"(lo), "v"(hi)); return r; }
typedef int i32x4 __attribute__((ext_vector_type(4))); typedef int i32x8 __attribute__((ext_vector_type(8)));
__device__ __forceinline__ bf16x8 lo8(i32x8 v) { return __builtin_bit_cast(bf16x8, (i32x4)__builtin_shufflevector(v, v, 0, 1, 2, 3)); }
__device__ __forceinline__ bf16x8 hi8(i32x8 v) { return __builtin_bit_cast(bf16x8, (i32x4)__builtin_shufflevector(v, v, 4, 5, 6, 7)); }

template <class Epi, class Sched, bool GATHER, bool FP8 = false>
__device__ __forceinline__ void gemm_phase(LAS unsigned char* lds, const LAS int* tab, const LAS bf16_t* aux, int ashift, int K, const Sched& S, const Epi& E, int wv) {
    const int tid = tid_of(wv), wid = wv, lane = tid & 63, wr = wid >> 2, wc = wid & 3, fr = lane & 15, fq = lane >> 4;
    const int nt = K / BK;
    unsigned voffA[2], voffB[2]; unsigned cb0 = 0; int rg0 = 0;
#pragma unroll
    for (int i = 0; i < 2; ++i) { int R, C; stage_rc(tid * 16 + i * 8192, R, C); const int Rb = (R & ~31) + perm32(R & 31);
        voffA[i] = (unsigned)(R * K + C) * 2u; voffB[i] = (unsigned)(Rb * K + C) * 2u; if (i == 0) { cb0 = (unsigned)C * 2u; rg0 = R; } }
    const size_t kstep = (size_t)(BK * 2);
    const size_t hstep = (size_t)HALF * K * 2;
    const size_t hstepA = GATHER ? 0 : hstep;
    const unsigned ldsw = (unsigned)wid * 1024u;
    const int aoff = lds_byte(wr * 64 + fr, fq * 8), boff = lds_byte(wc * 32 + fr, fq * 8);
    int cul = 0, nul = 0;
#define PG8_SA(b, h) (((b) * 2 + (h)) * HTB)
#define PG8_SB(b, h) ((4 + (b) * 2 + (h)) * HTB)
#define PG8_STAGE(bufoff, gbase, voff) do { _Pragma("unroll") for (int _i = 0; _i < 2; ++_i) \
        __builtin_amdgcn_global_load_lds((const unsigned*)((const char*)(gbase) + (voff)[_i]), (LAS unsigned*)(lds + (bufoff) + ldsw + _i * 8192), 16, 0, 0); } while (0)
#define PG8_STAGE_A(bufoff, gbase, h, usenext) do { const int ulx_ = (usenext) ? nul : cul; _Pragma("unroll") for (int _i = 0; _i < 2; ++_i) { \
        unsigned vo_; if constexpr (GATHER) vo_ = (unsigned)(tab[ulx_ * 256 + (h) * 128 + rg0 + 64 * _i] >> ashift) * (unsigned)(K * 2) + cb0; else vo_ = voffA[_i]; \
        __builtin_amdgcn_global_load_lds((const unsigned*)((const char*)(gbase) + (h) * hstepA + vo_), (LAS unsigned*)(lds + (bufoff) + ldsw + _i * 8192), 16, 0, 0); } } while (0)
#define PG8_LDA(dst, b, h) do { _Pragma("unroll") for (int m = 0; m < 4; ++m) { const i32x4 lo_ = *(const LAS i32x4*)(lds + PG8_SA(b, h) + aoff + m * 2048), hi_ = *(const LAS i32x4*)(lds + PG8_SA(b, h) + aoff + m * 2048 + 1024); \
        dst[m] = __builtin_shufflevector(lo_, hi_, 0, 1, 2, 3, 4, 5, 6, 7); } } while (0)
#define PG8_LDB(dst, b, h) do { _Pragma("unroll") for (int n = 0; n < 2; ++n) { const i32x4 lo_ = *(const LAS i32x4*)(lds + PG8_SB(b, h) + boff + n * 2048), hi_ = *(const LAS i32x4*)(lds + PG8_SB(b, h) + boff + n * 2048 + 1024); \
        dst[n] = __builtin_shufflevector(lo_, hi_, 0, 1, 2, 3, 4, 5, 6, 7); } } while (0)
#define PG8_MMA(ai, bj, At, Bt) do { __builtin_amdgcn_s_setprio(1); _Pragma("unroll") for (int m = 0; m < 4; ++m) _Pragma("unroll") for (int n = 0; n < 2; ++n) { \
        if constexpr (FP8) { asm("v_mfma_f32_16x16x128_f8f6f4 %0, %1, %2, %0" : "+v"(acc[ai][bj][m][n]) : "v"(Bt[n]), "v"(At[m])); } \
        else { acc[ai][bj][m][n] = __builtin_amdgcn_mfma_f32_16x16x32_bf16(lo8(Bt[n]), lo8(At[m]), acc[ai][bj][m][n], 0, 0, 0); \
               acc[ai][bj][m][n] = __builtin_amdgcn_mfma_f32_16x16x32_bf16(hi8(Bt[n]), hi8(At[m]), acc[ai][bj][m][n], 0, 0, 0); } } \
        __builtin_amdgcn_s_setprio(0); } while (0)
#define PG8_WAIT_V(n) asm volatile("s_waitcnt vmcnt(" #n ")" ::: "memory")
#define PG8_WAIT_L(n) asm volatile("s_waitcnt lgkmcnt(" #n ")" ::: "memory")
#define PG8_BAR __builtin_amdgcn_s_barrier()
#define PG8_SCHED __builtin_amdgcn_sched_barrier(0)
    Unit cur, nxt; int ui = 0;
    if (!S.next(0, cur)) return;
    cul = cur.ul; nul = cur.ul;
    f32x4 acc[2][2][4][2];
#pragma unroll
    for (int a = 0; a < 2; ++a)
#pragma unroll
        for (int b = 0; b < 2; ++b)
#pragma unroll
            for (int m = 0; m < 4; ++m)
#pragma unroll
                for (int n = 0; n < 2; ++n) acc[a][b][m][n] = (f32x4){0.f, 0.f, 0.f, 0.f};
    i32x8 At[4], B0[2], B1[2];
    const char* cA = cur.A; const char* cB = cur.B;
    PG8_STAGE(PG8_SB(0, 0), cB, voffB); PG8_STAGE(PG8_SB(0, 1), cB + hstep, voffB); PG8_STAGE_A(PG8_SA(0, 0), cA, 0, false); PG8_STAGE_A(PG8_SA(0, 1), cA, 1, false);
    if (wr == 1) PG8_BAR;
    PG8_WAIT_V(2); PG8_BAR;
    PG8_STAGE(PG8_SB(1, 0), cB + kstep, voffB); PG8_STAGE_A(PG8_SA(1, 0), cA + kstep, 0, false); PG8_STAGE(PG8_SB(1, 1), cB + hstep + kstep, voffB);
    PG8_WAIT_V(6); PG8_BAR;
    for (;;) {
        const bool has_next = S.next(ui + 1, nxt);
        const char* nA = has_next ? nxt.A : cA; const char* nB = has_next ? nxt.B : cB;
        nul = has_next ? nxt.ul : cur.ul;
#if DIAG >= 10
        long long tk0_ = 0; if (DIAG == 10 + Epi::ID && ui == 0) tk0_ = (long long)__builtin_amdgcn_s_memtime();
        if (DIAG == 20 + Epi::ID && ui <= 1) { const long long tn_ = (long long)__builtin_amdgcn_s_memtime();
            if (ui == 0) { if (blockIdx.x == 0 && tid == 0) { ((volatile LAS unsigned*)(lds + 159744))[41] = (unsigned)tn_; } }
            else if (blockIdx.x == 0 && tid == 0) { const unsigned d_ = (unsigned)tn_ - ((volatile LAS unsigned*)(lds + 159744))[41]; const float q = rintf((float)d_ * (1.f / 1000.f));
                ((volatile LAS unsigned*)(lds + 159744))[40] = __float_as_uint(q * 1e-5f); } }
#endif
#pragma unroll 1
        for (int t = 0; t < nt; t += 2) {
            const bool last = (t == nt - 2);
            const char* a1 = cA + (size_t)(t + 1) * kstep;
            const char* a2 = last ? nA : cA + (size_t)(t + 2) * kstep; const char* b2 = last ? nB : cB + (size_t)(t + 2) * kstep;
            const char* a3 = a2 + kstep; const char* b3 = b2 + kstep;
            PG8_LDB(B0, 0, 0); PG8_LDB(B1, 0, 1); PG8_SCHED; PG8_LDA(At, 0, 0); PG8_STAGE_A(PG8_SA(1, 1), a1, 1, false);
            PG8_WAIT_V(8); PG8_WAIT_L(0); PG8_BAR; PG8_MMA(0, 0, At, B0); PG8_MMA(0, 1, At, B1); PG8_BAR; PG8_SCHED;
            PG8_LDA(At, 0, 1); PG8_STAGE(PG8_SB(0, 0), b2, voffB); PG8_STAGE(PG8_SB(0, 1), b2 + hstep, voffB); PG8_STAGE_A(PG8_SA(0, 0), a2, 0, last);
            PG8_WAIT_V(8); PG8_WAIT_L(0); PG8_BAR; PG8_MMA(1, 0, At, B0); PG8_MMA(1, 1, At, B1); PG8_BAR; PG8_SCHED;
            PG8_LDB(B0, 1, 0); PG8_LDB(B1, 1, 1); PG8_SCHED; PG8_LDA(At, 1, 0); PG8_STAGE_A(PG8_SA(0, 1), a2, 1, last);
            PG8_WAIT_V(8); PG8_WAIT_L(0); PG8_BAR; PG8_MMA(0, 0, At, B0); PG8_MMA(0, 1, At, B1); PG8_BAR; PG8_SCHED;
            PG8_LDA(At, 1, 1); PG8_STAGE(PG8_SB(1, 0), b3, voffB); PG8_STAGE(PG8_SB(1, 1), b3 + hstep, voffB); PG8_STAGE_A(PG8_SA(1, 0), a3, 0, last);
            PG8_WAIT_V(8); PG8_WAIT_L(0); PG8_BAR; PG8_MMA(1, 0, At, B0); PG8_MMA(1, 1, At, B1); PG8_BAR; PG8_SCHED;
        }
#if DIAG >= 10
        if (DIAG == 10 + Epi::ID && ui == 0) { const long long tk1_ = (long long)__builtin_amdgcn_s_memtime();
            if (blockIdx.x == 0 && tid == 0) { const float perk = (float)(tk1_ - tk0_) / (float)nt; const float q = rintf(perk * (1.f / 250.f));
                ((volatile LAS unsigned*)(lds + 159744))[40] = __float_as_uint(q * 2e-5f); } }
#endif
        if (wr == 0) PG8_BAR;
        if constexpr (FP8) asm volatile("s_nop 15\n\ts_nop 7" ::: "memory");
        E(acc, cur, tab, aux, wr, wc, fr, fq);
        if (!has_next) break;
#pragma unroll
        for (int a = 0; a < 2; ++a)
#pragma unroll
            for (int b = 0; b < 2; ++b)
#pragma unroll
                for (int m = 0; m < 4; ++m)
#pragma unroll
                    for (int n = 0; n < 2; ++n) acc[a][b][m][n] = (f32x4){0.f, 0.f, 0.f, 0.f};
        cur = nxt; cA = nA; cB = nB; ++ui;
        cul = cur.ul;
        if (wr == 1) PG8_BAR;
    }
    PG8_WAIT_V(0);
    PG8_BAR;
#undef PG8_SA
#undef PG8_SB
#undef PG8_STAGE
#undef PG8_STAGE_A
#undef PG8_LDA
#undef PG8_LDB
#undef PG8_MMA
#undef PG8_WAIT_V
#undef PG8_WAIT_L
#undef PG8_BAR
#undef PG8_SCHED
}

struct EpiP { static constexpr int ID = 2; bf16_t* P;
    __device__ __forceinline__ void operator()(const f32x4 (&acc)[2][2][4][2], const Unit& u, const LAS int*, const LAS bf16_t*, int wr, int wc, int fr, int fq) const {
        const int row0 = u.pm * BM + wr * 64 + fr, col0 = u.pn * BM + wc * 32 + 8 * fq;
#pragma unroll
        for (int ai = 0; ai < 2; ++ai)
#pragma unroll
            for (int m = 0; m < 4; ++m) { bf16_t* rowp = P + (size_t)(row0 + ai * HALF + m * 16) * DINP + col0;
#pragma unroll
                for (int bj = 0; bj < 2; ++bj) { const f32x4 v0 = acc[ai][bj][m][0], v1 = acc[ai][bj][m][1]; u32x4 w;
                    w.x = cvt_pk_bf16(v0[0], v0[1]); w.y = cvt_pk_bf16(v0[2], v0[3]); w.z = cvt_pk_bf16(v1[0], v1[1]); w.w = cvt_pk_bf16(v1[2], v1[3]);
                    *(GAS u32x4*)(rowp + bj * HALF) = w; } }
    } };
struct EpiOut { static constexpr int ID = 6; const float* x; const float* mod; float* out;
    __device__ __forceinline__ void operator()(const f32x4 (&acc)[2][2][4][2], const Unit& u, const LAS int*, const LAS bf16_t*, int wr, int wc, int fr, int fq) const {
        const int row0 = u.pm * BM + wr * 64 + fr, col0 = u.pn * BM + wc * 32 + 8 * fq;
        const float* gate = mod + (row0 >> 13) * 6144 + 2 * 1024;
#pragma unroll
        for (int bj = 0; bj < 2; ++bj) { const f32x4 g0 = *(const GAS f32x4*)(gate + col0 + bj * HALF), g1 = *(const GAS f32x4*)(gate + col0 + bj * HALF + 4);
#pragma unroll
            for (int ai = 0; ai < 2; ++ai)
#pragma unroll
                for (int m = 0; m < 4; ++m) { const size_t off = (size_t)(row0 + ai * HALF + m * 16) * DM + col0 + bj * HALF;
                    const f32x4 x0 = *(const GAS f32x4*)(x + off), x1 = *(const GAS f32x4*)(x + off + 4);
                    *(GAS f32x4*)(out + off) = x0 + g0 * acc[ai][bj][m][0]; *(GAS f32x4*)(out + off + 4) = x1 + g1 * acc[ai][bj][m][1]; } }
    } };
typedef _Float16 h2_t __attribute__((ext_vector_type(2))); typedef short s2_t __attribute__((ext_vector_type(2)));
struct EpiM1 { static constexpr int ID = 8; unsigned char* act;
    __device__ __forceinline__ void operator()(const f32x4 (&acc)[2][2][4][2], const Unit& u, const LAS int* tab, const LAS bf16_t* aux, int wr, int wc, int fr, int fq) const {
        const int cl = wc * 32 + 8 * fq, col0 = u.pn * BM + cl;
        h2_t bg[2][2], bl[2][2];
#pragma unroll
        for (int bj = 0; bj < 2; ++bj) { const u32x4 w = *(const LAS u32x4*)(aux + u.ul * 256 + bj * HALF + cl);
#pragma unroll
            for (int n = 0; n < 2; ++n) { bg[bj][n] = (h2_t){(_Float16)lo16(w[2 * n]), (_Float16)lo16(w[2 * n + 1])}; bl[bj][n] = (h2_t){(_Float16)hi16(w[2 * n]), (_Float16)hi16(w[2 * n + 1])}; } }
        const h2_t winv = {(_Float16)WINV, (_Float16)WINV}, seven = {(_Float16)7.f, (_Float16)7.f}, one = {(_Float16)1.f, (_Float16)1.f}, cexp = {(_Float16)-2.4554669595930156f, (_Float16)-2.4554669595930156f};
#pragma unroll
        for (int ai = 0; ai < 2; ++ai)
#pragma unroll
            for (int m = 0; m < 4; ++m) { const int r = ai * HALF + wr * 64 + m * 16 + fr; const bool ok = r < u.nvalid;
                const int pair = tab[u.ul * 256 + r]; unsigned char* rowp = act + (size_t)pair * DFF + (col0 >> 1);
#pragma unroll
                for (int bj = 0; bj < 2; ++bj) { s2_t pk = {0, 0};
#pragma unroll
                    for (int n = 0; n < 2; ++n) { const f32x4 v = acc[ai][bj][m][n];
                        h2_t g = __builtin_bit_cast(h2_t, __builtin_amdgcn_cvt_pkrtz(v[0], v[2])), l = __builtin_bit_cast(h2_t, __builtin_amdgcn_cvt_pkrtz(v[1], v[3]));
                        g = g * winv + bg[bj][n]; l = l * winv + bl[bj][n];
                        g = __builtin_elementwise_min(g, seven); l = __builtin_elementwise_min(__builtin_elementwise_max(l, -seven), seven);
                        const h2_t e = __builtin_elementwise_exp2(g * cexp);
                        const h2_t d = e + one; const h2_t rc = {(_Float16)__builtin_amdgcn_rcph(d[0]), (_Float16)__builtin_amdgcn_rcph(d[1])};
                        const h2_t o = (g * rc) * (l + one);
                        pk = n == 0 ? __builtin_amdgcn_cvt_scalef32_pk_fp8_f16(pk, o, 1.0f, false) : __builtin_amdgcn_cvt_scalef32_pk_fp8_f16(pk, o, 1.0f, true); }
                    if (ok) *(GAS unsigned*)(rowp + bj * (HALF / 2)) = __builtin_bit_cast(unsigned, pk); } }
    } };
constexpr float YSCALE = 8.f, YINV = 1.f / 8.f;
struct EpiM2 { static constexpr int ID = 9; unsigned char* y;
    __device__ __forceinline__ void operator()(const f32x4 (&acc)[2][2][4][2], const Unit& u, const LAS int* tab, const LAS bf16_t* aux, int wr, int wc, int fr, int fq) const {
        const int cl = wc * 32 + 8 * fq, col0 = u.pn * BM + cl;
        f32x4 bv[2][2];
#pragma unroll
        for (int bj = 0; bj < 2; ++bj) { const u32x4 w = *(const LAS u32x4*)(aux + u.ul * 256 + bj * HALF + cl);
            bv[bj][0] = (f32x4){lo16(w[0]), hi16(w[0]), lo16(w[1]), hi16(w[1])}; bv[bj][1] = (f32x4){lo16(w[2]), hi16(w[2]), lo16(w[3]), hi16(w[3])}; }
#pragma unroll
        for (int ai = 0; ai < 2; ++ai)
#pragma unroll
            for (int m = 0; m < 4; ++m) { const int r = ai * HALF + wr * 64 + m * 16 + fr; const bool ok = r < u.nvalid;
                const int pair = tab[u.ul * 256 + r]; const float g = bf2f(aux[9 * 256 + u.ul * 256 + r]) * YSCALE; unsigned char* rowp = y + (size_t)pair * DM + col0;
#pragma unroll
                for (int bj = 0; bj < 2; ++bj) { const f32x4 v0 = (acc[ai][bj][m][0] * WINV + bv[bj][0]) * g, v1 = (acc[ai][bj][m][1] * WINV + bv[bj][1]) * g; u32x2 w;
                    w.x = cvt4_fp8(v0[0], v0[1], v0[2], v0[3]); w.y = cvt4_fp8(v1[0], v1[1], v1[2], v1[3]);
                    if (ok) *(GAS u32x2*)(rowp + bj * HALF) = w; } }
    } };
}
constexpr int PG8_TAB_OFF = pg8::STAGE_BYTES;
constexpr int PG8_AUX_OFF = PG8_TAB_OFF + 18 * 1024;
constexpr int PG8_PRE_OFF = PG8_AUX_OFF + 9 * 1024;
static_assert(PG8_PRE_OFF + 512 <= LDS_SCRATCH, "LDS map");

template <int NCT, class Epi>
__device__ __forceinline__ void phase_moe_pg8(const Args& a, LAS unsigned char* lds, const unsigned char* A, int ashift, const unsigned char* Wt, size_t wstride, const float* bias, int nbias, const float* gates, const Epi& E) {
    LAS int* tab = (LAS int*)(lds + PG8_TAB_OFF); LAS int* pre = (LAS int*)(lds + PG8_PRE_OFF); LAS bf16_t* aux = (LAS bf16_t*)(lds + PG8_AUX_OFF);
    const unsigned* cnt = (const unsigned*)(a.ws + WS_CTL) + CW_CNT; const unsigned* list = (const unsigned*)(a.ws + WS_LIST);
    __syncthreads();
    const int tidm = tid_of(a.wv);
    if (tidm < NE) pre[33 + tidm] = (int)__hip_atomic_load(cnt + 64 * tidm, __ATOMIC_RELAXED, __HIP_MEMORY_SCOPE_AGENT);
    __syncthreads();
    if (tidm == 0) { int s = 0;
#pragma unroll 1
        for (int e = 0; e < NE; ++e) { const int c = pre[33 + e]; pre[e] = s; s += (c + 255) >> 8; } pre[32] = s; }
    __syncthreads();
    const int G_ = (int)gridDim.x, bx_ = (int)blockIdx.x, vcu_ = (G_ % 8 == 0) ? (bx_ % 8) * (G_ / 8) + bx_ / 8 : bx_;
    pg8::ExpertOrder<NCT> S{pre, G_, vcu_, (const char*)A, (const char*)Wt, wstride, 1024};
    constexpr int NU = NCT == 8 ? 18 : 9; constexpr bool HASG = NCT == 4;
    const int nunit_ = pre[32] * NCT;
    unsigned val[NU]; float gv[NU];
#pragma unroll
    for (int i = 0; i < NU; ++i) { pg8::Unit u; val[i] = 0u;
        if (S.next(i, u)) { if (tidm < 256) val[i] = list[(size_t)u.e * 32768 + u.pm * 256 + (tidm < u.nvalid ? tidm : 0)]; else val[i] = __float_as_uint(bias[(size_t)u.e * nbias + u.pn * 256 + tidm - 256]); } }
#pragma unroll
    for (int i = 0; i < NU; ++i) { gv[i] = 0.f; if (HASG && tidm < 256 && i * G_ + vcu_ < nunit_) gv[i] = gates[val[i]]; }
#pragma unroll
    for (int i = 0; i < NU; ++i) if (i * G_ + vcu_ < nunit_) {
        if (tidm < 256) { tab[i * 256 + tidm] = (int)val[i]; if (HASG) aux[9 * 256 + i * 256 + tidm] = (bf16_t)f2bf(gv[i]); }
        else aux[i * 256 + tidm - 256] = (bf16_t)f2bf(__uint_as_float(val[i])); }
    __syncthreads();
    pg8::gemm_phase<Epi, pg8::ExpertOrder<NCT>, true, true>(lds, tab, aux, ashift, 512, S, E, a.wv);
}

__device__ __forceinline__ void mla_tile(const Args& a, LAS unsigned char* lds, int tile, int r0 = 0, int nrows = 128) {
    const int tid = tid_of(a.wv), lane = tid & 63, wave = a.wv, fr = lane & 15, fq = lane >> 4;
    const bool lat = tile < 256;
    const int prow0 = tile * 128;
    const int b = lat ? (prow0 >> 13) : ((prow0 - T) >> 8);
    const int tpos0 = lat ? (prow0 & 8191) : ((prow0 - T) & 255);
    const int key0 = lat ? (LC + tpos0) : tpos0;
    LAS unsigned char* Aq = lds;
    LAS unsigned char* Akv = lds + 34816;
    LAS float* kpe = (LAS float*)(lds + 34816 + 18432);
    LAS float* sspe = (LAS float*)(lds + 34816 + 18432 + 16384);
    const bf16_t* P = (const bf16_t*)(a.ws + WS_P);
    const float* tabm = (const float*)(a.ws + WS_TABM);
    __syncthreads();
    if ((tid >> 2) >= r0 && (tid >> 2) < r0 + nrows) {
        const int r = tid >> 2, part = tid & 3;
        const bf16_t* pr = P + (size_t)(prow0 + r) * DINP;
        u32x4 q[8]; float ss = 0.f;
#pragma unroll
        for (int i = 0; i < 8; ++i) { q[i] = *(const GAS u32x4*)(pr + OFF_Q + part * 64 + i * 8);
#pragma unroll
            for (int e = 0; e < 4; ++e) { const float lo = lo16(q[i][e]), hi = hi16(q[i][e]); ss += lo * lo + hi * hi; } }
        ss += __shfl_xor(ss, 1); ss += __shfl_xor(ss, 2);
        float rstd = rsqrtf(ss * (1.f / 256.f) + EPS);
        const float* gq = a.in[I_GQL] + part * 64;
#pragma unroll
        for (int i = 0; i < 8; ++i) { u32x2 o;
#pragma unroll
            for (int e = 0; e < 2; ++e) o[e] = cvt4_fp8(lo16(q[i][2 * e]) * rstd * gq[i * 8 + 4 * e], hi16(q[i][2 * e]) * rstd * gq[i * 8 + 4 * e + 1], lo16(q[i][2 * e + 1]) * rstd * gq[i * 8 + 4 * e + 2], hi16(q[i][2 * e + 1]) * rstd * gq[i * 8 + 4 * e + 3]);
            *(LAS u32x2*)(Aq + r * 272 + part * 64 + i * 8) = o; }
        u32x4 kv[4]; ss = 0.f;
#pragma unroll
        for (int i = 0; i < 4; ++i) { kv[i] = *(const GAS u32x4*)(pr + OFF_KV + part * 32 + i * 8);
#pragma unroll
            for (int e = 0; e < 4; ++e) { const float lo = lo16(kv[i][e]), hi = hi16(kv[i][e]); ss += lo * lo + hi * hi; } }
        ss += __shfl_xor(ss, 1); ss += __shfl_xor(ss, 2);
        rstd = rsqrtf(ss * (1.f / 128.f) + EPS);
        const float* gkv = a.in[I_GKVL] + part * 32;
#pragma unroll
        for (int i = 0; i < 4; ++i) { u32x2 o;
#pragma unroll
            for (int e = 0; e < 2; ++e) o[e] = cvt4_fp8(lo16(kv[i][2 * e]) * rstd * gkv[i * 8 + 4 * e], hi16(kv[i][2 * e]) * rstd * gkv[i * 8 + 4 * e + 1], lo16(kv[i][2 * e + 1]) * rstd * gkv[i * 8 + 4 * e + 2], hi16(kv[i][2 * e + 1]) * rstd * gkv[i * 8 + 4 * e + 3]);
            *(LAS u32x2*)(Akv + r * 144 + part * 32 + i * 8) = o; }
        const u32x4 pe = *(const GAS u32x4*)(pr + OFF_PE + part * 8); ss = 0.f;
#pragma unroll
        for (int e = 0; e < 4; ++e) { const float lo = lo16(pe[e]), hi = hi16(pe[e]); ss += lo * lo + hi * hi; kpe[r * 32 + part * 8 + 2 * e] = lo; kpe[r * 32 + part * 8 + 2 * e + 1] = hi; }
        ss += __shfl_xor(ss, 1); ss += __shfl_xor(ss, 2);
        if (part == 0) sspe[r] = ss;
    }
    __syncthreads();
    const int h = wave, bh = b * NH + h;
    typedef int i32x4m __attribute__((ext_vector_type(4))); typedef int i32x8m __attribute__((ext_vector_type(8)));
#define LD32G(p) __builtin_shufflevector(*(const GAS i32x4m*)(p), *(const GAS i32x4m*)((p) + 16), 0, 1, 2, 3, 4, 5, 6, 7)
#define LD32L(p) __builtin_shufflevector(*(const LAS i32x4m*)(p), *(const LAS i32x4m*)((p) + 16), 0, 1, 2, 3, 4, 5, 6, 7)
    if (lat) {
        const unsigned char* WQ = a.ws + WS_WQ + (size_t)h * QK * 256;
        const float* gqh = a.in[I_GQH];
        unsigned char* Qo = a.ws + WS_Q + ((size_t)bh * SEQ + tpos0) * QK8;
        i32x8m bq[2][6];
#pragma unroll
        for (int s2 = 0; s2 < 2; ++s2)
#pragma unroll
            for (int j = 0; j < 6; ++j) bq[s2][j] = LD32G(WQ + (size_t)(16 * j + fr) * 256 + 128 * s2 + 32 * fq);
        f32x4 gqv[6];
#pragma unroll
        for (int j = 0; j < 6; ++j) gqv[j] = *(const GAS f32x4*)(gqh + 16 * j + 4 * fq);
#pragma unroll 1
        for (int rq = 0; rq < 8; ++rq) {
            const int row = rq * 16 + fr, t = tpos0 + row;
            f32x4 csq[2][2];
#pragma unroll
            for (int ax = 0; ax < 2; ++ax) { const int pi = ax == 0 ? (t >> 6) : 128 + (t & 63); const float* cs = tabm + (pi * 8 + 4 * (fq & 1)) * 2;
                csq[ax][0] = *(const GAS f32x4*)(cs); csq[ax][1] = *(const GAS f32x4*)(cs + 4); }
            f32x4 acc[6];
#pragma unroll
            for (int j = 0; j < 6; ++j) acc[j] = (f32x4){0.f, 0.f, 0.f, 0.f};
#pragma unroll
            for (int s2 = 0; s2 < 2; ++s2) { const i32x8m af = LD32L(Aq + row * 272 + 128 * s2 + 32 * fq);
#pragma unroll
                for (int j = 0; j < 6; ++j) acc[j] = __builtin_amdgcn_mfma_scale_f32_16x16x128_f8f6f4(bq[s2][j], af, acc[j], 0, 0, 0, 0, 0, 0); }
            float ss = 0.f;
#pragma unroll
            for (int j = 0; j < 6; ++j) ss += (acc[j][0] * acc[j][0] + acc[j][1] * acc[j][1]) + (acc[j][2] * acc[j][2] + acc[j][3] * acc[j][3]);
            ss += __shfl_xor(ss, 16); ss += __shfl_xor(ss, 32);
            const float rstd = rsqrtf(ss * (1.f / 96.f) + EPS * (WQ_SCALE * WQ_SCALE)) * QSCALE;
#pragma unroll
            for (int j = 0; j < 6; ++j) {
                const int col = 16 * j + 4 * fq; const f32x4 gv = gqv[j];
                f32x4 v = acc[j] * gv * rstd;
                if (j >= 4) {
                    const int ax = j - 4;
#pragma unroll
                    for (int r = 0; r < 4; ++r) { const float other = __shfl_xor(v[r], 32); const float c = csq[ax][r >> 1][2 * (r & 1)], sn = csq[ax][r >> 1][2 * (r & 1) + 1];
                        v[r] = (fq < 2) ? (v[r] * c - other * sn) : (v[r] * c + other * sn); }
                }
                *(GAS unsigned*)(Qo + (size_t)row * QK8 + col) = cvt4_fp8(v[0], v[1], v[2], v[3]);
            }
            *(GAS u32x2*)(Qo + (size_t)row * QK8 + QK + 8 * fq) = (u32x2){0u, 0u};
        }
    }
    {
        const unsigned char* WKV = a.ws + WS_WKV + (size_t)h * 128 * 128;
        const float* gkh = a.in[I_GKH];
        unsigned char* Ko = a.ws + WS_K + ((size_t)bh * SKV + key0) * QK8;
        unsigned char* Vo = a.ws + WS_VT + (size_t)bh * DV * SKV + key0;
        i32x8m bkv[8];
#pragma unroll
        for (int j = 0; j < 8; ++j) bkv[j] = LD32G(WKV + (size_t)(16 * j + fr) * 128 + 32 * fq);
        f32x4 gkv[4]; float gp0[4], gp1[4];
#pragma unroll
        for (int j = 0; j < 4; ++j) gkv[j] = *(const GAS f32x4*)(gkh + 16 * j + 4 * fq);
#pragma unroll
        for (int r = 0; r < 4; ++r) { const int c0 = (fq >> 1) * 16 + 4 * (fq & 1) + r; gp0[r] = gkh[64 + c0]; gp1[r] = gkh[64 + c0 + 8]; }
#pragma unroll 1
        for (int rq = r0 >> 4; rq < ((r0 + nrows) >> 4); ++rq) {
            f32x4 csk[2];
            { const int t = tpos0 + rq * 16 + fr, ax = fq >> 1, pi = ax == 0 ? (t >> 6) : 128 + (t & 63); const float* cs = tabm + (pi * 8 + 4 * (fq & 1)) * 2;
              csk[0] = *(const GAS f32x4*)(cs); csk[1] = *(const GAS f32x4*)(cs + 4); }
            f32x4 acc[1][8];
#pragma unroll
            for (int i = 0; i < 1; ++i)
#pragma unroll
                for (int j = 0; j < 8; ++j) acc[i][j] = (f32x4){0.f, 0.f, 0.f, 0.f};
            { const i32x8m af = LD32L(Akv + (rq * 16 + fr) * 144 + 32 * fq);
#pragma unroll
              for (int j = 0; j < 8; ++j) acc[0][j] = __builtin_amdgcn_mfma_scale_f32_16x16x128_f8f6f4(bkv[j], af, acc[0][j], 0, 0, 0, 0, 0, 0) ; }
#pragma unroll
            for (int j = 0; j < 8; ++j) acc[0][j] = acc[0][j] * WKV_INV;
#pragma unroll
            for (int i = 0; i < 1; ++i) {
                const int row = rq * 16 + 16 * i + fr, t = tpos0 + row;
                const int kk = row & 63; const int vrow = (row & 64) + 32 * ((kk >> 2) & 1) + (kk & 3) + 4 * ((kk & 31) >> 3) + 16 * (kk >> 5);
                float ss = 0.f;
#pragma unroll
                for (int j = 0; j < 4; ++j) ss += (acc[i][j][0] * acc[i][j][0] + acc[i][j][1] * acc[i][j][1]) + (acc[i][j][2] * acc[i][j][2] + acc[i][j][3] * acc[i][j][3]);
                ss += __shfl_xor(ss, 16); ss += __shfl_xor(ss, 32);
                const float rstd = rsqrtf((ss + sspe[row]) * (1.f / 96.f) + EPS);
#pragma unroll
                for (int j = 0; j < 4; ++j) { const int col = 16 * j + 4 * fq; const f32x4 gv = gkv[j]; const f32x4 v = acc[i][j] * gv * rstd;
                    *(GAS unsigned*)(Ko + (size_t)row * QK8 + col) = cvt4_fp8(v[0], v[1], v[2], v[3]); }
                {
                    const int ax = fq >> 1, f0 = 4 * (fq & 1);
                    float o0[4], o1[4];
#pragma unroll
                    for (int r = 0; r < 4; ++r) { const int c0 = ax * 16 + f0 + r, c1 = c0 + 8;
                        const float x0 = kpe[row * 32 + c0] * rstd * gp0[r], x1 = kpe[row * 32 + c1] * rstd * gp1[r];
                        const float c = lat ? csk[r >> 1][2 * (r & 1)] : 1.f, s = lat ? csk[r >> 1][2 * (r & 1) + 1] : 0.f;
                        o0[r] = x0 * c - x1 * s; o1[r] = x1 * c + x0 * s; }
                    *(GAS unsigned*)(Ko + (size_t)row * QK8 + 64 + ax * 16 + f0) = cvt4_fp8(o0[0], o0[1], o0[2], o0[3]);
                    *(GAS unsigned*)(Ko + (size_t)row * QK8 + 64 + ax * 16 + 8 + f0) = cvt4_fp8(o1[0], o1[1], o1[2], o1[3]);
                    *(GAS u32x2*)(Ko + (size_t)row * QK8 + QK + 8 * fq) = (u32x2){0u, 0u};
                }
#pragma unroll
                for (int j = 4; j < 8; ++j)
#pragma unroll
                    for (int r = 0; r < 4; ++r) { const int d = 16 * (j - 4) + 4 * fq + r; Vo[(size_t)d * SKV + vrow] = (unsigned char)(cvt4_fp8(acc[i][j][r], 0.f, 0.f, 0.f) & 0xffu); }
            }
        }
    }
}

__device__ __forceinline__ float log_gamma(const float* logit) { const float x = *logit; return -log1pf(__expf(-x)); }

__device__ __forceinline__ void rope16(float (&out)[16], const bf16_t* rowp  , int part, const float* cs  , float scale) {
    const u32x4 a0 = *(const GAS u32x4*)(rowp + part * 16), a1 = *(const GAS u32x4*)(rowp + part * 16 + 8);
    const u32x4 b0 = *(const GAS u32x4*)(rowp + (part ^ 1) * 16), b1 = *(const GAS u32x4*)(rowp + (part ^ 1) * 16 + 8);
    float xs[16], xo[16];
#pragma unroll
    for (int e = 0; e < 4; ++e) { xs[2 * e] = lo16(a0[e]); xs[2 * e + 1] = hi16(a0[e]); xs[8 + 2 * e] = lo16(a1[e]); xs[8 + 2 * e + 1] = hi16(a1[e]);
        xo[2 * e] = lo16(b0[e]); xo[2 * e + 1] = hi16(b0[e]); xo[8 + 2 * e] = lo16(b1[e]); xo[8 + 2 * e + 1] = hi16(b1[e]); }
    if (cs) {
        const float sg = (part & 1) ? 1.f : -1.f;
#pragma unroll
        for (int q = 0; q < 8; ++q) { const f32x4 t = *(const GAS f32x4*)(cs + 4 * q);
            out[2 * q] = (xs[2 * q] * t[0] + sg * xo[2 * q] * t[1]) * scale; out[2 * q + 1] = (xs[2 * q + 1] * t[2] + sg * xo[2 * q + 1] * t[3]) * scale; }
    } else {
#pragma unroll
        for (int f = 0; f < 16; ++f) out[f] = xs[f] * scale;
    }
}

__device__ __forceinline__ void ret_local_unit(const Args& a, LAS unsigned char* lds, int unit) {
    const int tid = tid_of(a.wv), lane = tid & 63, wave = a.wv, fr = lane & 15, fq = lane >> 4;
    const int bh = unit / NSLOT, slot = unit % NSLOT, b = bh >> 2, h = bh & 3;
    const bool lat = slot >= 2;
    const int prow0 = lat ? b * SEQ + (slot - 2) * RC : T + b * LC + slot * RC;
    const int tpos0 = lat ? (slot - 2) * RC : 0;
    LAS bf16_t* KfT = (LAS bf16_t*)lds;
    LAS bf16_t* KbT = (LAS bf16_t*)(lds + 17408);
    LAS bf16_t* VT = (LAS bf16_t*)(lds + 34816);
    const bf16_t* P = (const bf16_t*)(a.ws + WS_P);
    const float* tabr = (const float*)(a.ws + WS_TABR);
    const float lgf = log_gamma(a.in[I_DECAY] + h), lgb = log_gamma(a.in[I_DECAY] + 4 + h);
    __syncthreads();
    {
        const int j = tid >> 2, part = tid & 3, t = tpos0 + j, ax = part >> 1;
        const int pi = ax == 0 ? (t >> 6) : 128 + (t & 63);
        float o[16]; rope16(o, P + (size_t)(prow0 + j) * DINP + OFF_RK + h * 64, part, lat ? tabr + pi * 32 : nullptr, 0.125f);
        const float wf = __expf(lgf * (float)(127 - j)), wb = __expf(lgb * (float)j);
#pragma unroll
        for (int f = 0; f < 16; ++f) { const int d = part * 16 + f; KfT[d * 136 + j] = (bf16_t)f2bf(o[f] * wf); KbT[d * 136 + j] = (bf16_t)f2bf(o[f] * wb); }
    }
    for (int idx = tid; idx < 128 * 16; idx += 512) {
        const int j = idx >> 4, c = idx & 15;
        const u32x4 v = *(const GAS u32x4*)(P + (size_t)(prow0 + j) * DINP + OFF_RV + h * 128 + c * 8);
#pragma unroll
        for (int e = 0; e < 4; ++e) { VT[(c * 8 + 2 * e) * 136 + j] = (bf16_t)(v[e] & 0xffffu); VT[(c * 8 + 2 * e + 1) * 136 + j] = (bf16_t)(v[e] >> 16); }
    }
    __syncthreads();
    const int dir = wave >> 2, mi = wave & 3;
    f32x4 acc[1][8];
#pragma unroll
    for (int j = 0; j < 8; ++j) acc[0][j] = (f32x4){0.f, 0.f, 0.f, 0.f};
    mma_ll<1, 8, false>(acc, dir ? KbT : KfT, 136, 16 * mi, VT, 136, 0, 128, lane);
    float* out = (float*)(a.ws + WS_LST) + ((size_t)(bh * 2 + dir) * NSLOT + slot) * 8192;
#pragma unroll
    for (int j = 0; j < 8; ++j) *(GAS f32x4*)(out + (size_t)(16 * j + fr) * 64 + 16 * mi + 4 * fq) = acc[0][j];
}

__device__ __forceinline__ void phase_ret_scan(const Args& a) {
    const int gt = blockIdx.x * 512 + tid_of(a.wv);
    if (gt >= 32 * 2048) return;
    const int bd = gt >> 11, v4 = gt & 2047, dir = bd & 1, h = (bd >> 1) & 3;
    const float lg = log_gamma(a.in[I_DECAY] + dir * 4 + h);
    const float g = __expf(lg * 128.f);
    float* base = (float*)(a.ws + WS_LST) + (size_t)bd * NSLOT * 8192 + v4 * 4;
    f32x4 S = (f32x4){0.f, 0.f, 0.f, 0.f};
#pragma unroll 1
    for (int bt = 0; bt < 5; ++bt) {
        f32x4 L[13];
#pragma unroll
        for (int q = 0; q < 13; ++q) { const int n = bt * 13 + q; const int slot = dir == 0 ? n : (n == 0 ? 1 : (n == 1 ? 0 : 67 - n)); L[q] = *(const GAS f32x4*)(base + (size_t)slot * 8192); }
#pragma unroll
        for (int q = 0; q < 13; ++q) { const int n = bt * 13 + q; const int slot = dir == 0 ? n : (n == 0 ? 1 : (n == 1 ? 0 : 67 - n)); S = S * g + L[q]; *(GAS f32x4*)(base + (size_t)slot * 8192) = S; }
    }
}

__device__ __forceinline__ void ret_out_unit(const Args& a, LAS unsigned char* lds, int unit) {
    const int tid = tid_of(a.wv), lane = tid & 63, wave = a.wv, fr = lane & 15, fq = lane >> 4;
    const int bh = unit >> 6, c = unit & 63, b = bh >> 2, h = bh & 3;
    const int prow0 = b * SEQ + c * RC, tpos0 = c * RC;
    LAS bf16_t* Qs = (LAS bf16_t*)lds;
    LAS bf16_t* Ks = (LAS bf16_t*)(lds + 18432);
    LAS bf16_t* VT = (LAS bf16_t*)(lds + 36864);
    LAS bf16_t* SfT = (LAS bf16_t*)(lds + 71680);
    LAS bf16_t* SbT = (LAS bf16_t*)(lds + 90112);
    LAS bf16_t* Ws = (LAS bf16_t*)(lds + 108544);
    const bf16_t* P = (const bf16_t*)(a.ws + WS_P);
    const float* tabr = (const float*)(a.ws + WS_TABR);
    const float lgf = log_gamma(a.in[I_DECAY] + h), lgb = log_gamma(a.in[I_DECAY] + 4 + h);
    __syncthreads();
    {
        const int j = tid >> 2, part = tid & 3, t = tpos0 + j, ax = part >> 1;
        const int pi = ax == 0 ? (t >> 6) : 128 + (t & 63);
        float oq[16], ok[16];
        rope16(oq, P + (size_t)(prow0 + j) * DINP + OFF_RQ + h * 64, part, tabr + pi * 32, 1.f);
        rope16(ok, P + (size_t)(prow0 + j) * DINP + OFF_RK + h * 64, part, tabr + pi * 32, 0.125f);
        u32x4 w0, w1;
        w0 = (u32x4){pk2(oq[0], oq[1]), pk2(oq[2], oq[3]), pk2(oq[4], oq[5]), pk2(oq[6], oq[7])}; w1 = (u32x4){pk2(oq[8], oq[9]), pk2(oq[10], oq[11]), pk2(oq[12], oq[13]), pk2(oq[14], oq[15])};
        *(LAS u32x4*)(Qs + j * 72 + part * 16) = w0; *(LAS u32x4*)(Qs + j * 72 + part * 16 + 8) = w1;
        w0 = (u32x4){pk2(ok[0], ok[1]), pk2(ok[2], ok[3]), pk2(ok[4], ok[5]), pk2(ok[6], ok[7])}; w1 = (u32x4){pk2(ok[8], ok[9]), pk2(ok[10], ok[11]), pk2(ok[12], ok[13]), pk2(ok[14], ok[15])};
        *(LAS u32x4*)(Ks + j * 72 + part * 16) = w0; *(LAS u32x4*)(Ks + j * 72 + part * 16 + 8) = w1;
    }
    for (int idx = tid; idx < 128 * 16; idx += 512) {
        const int j = idx >> 4, cch = idx & 15;
        const u32x4 v = *(const GAS u32x4*)(P + (size_t)(prow0 + j) * DINP + OFF_RV + h * 128 + cch * 8);
#pragma unroll
        for (int e = 0; e < 4; ++e) { VT[(cch * 8 + 2 * e) * 136 + j] = (bf16_t)(v[e] & 0xffffu); VT[(cch * 8 + 2 * e + 1) * 136 + j] = (bf16_t)(v[e] >> 16); }
    }
    {
        const float* sf = (const float*)(a.ws + WS_LST) + ((size_t)(bh * 2 + 0) * NSLOT + (c + 1)) * 8192;
        const float* sb = (const float*)(a.ws + WS_LST) + ((size_t)(bh * 2 + 1) * NSLOT + (c == 63 ? 0 : c + 3)) * 8192;
        for (int idx = tid; idx < 2048; idx += 512) {
            const int e = idx >> 4, d = (idx & 15) * 4;
            const f32x4 x = *(const GAS f32x4*)(sf + idx * 4), y = *(const GAS f32x4*)(sb + idx * 4);
            u32x2 w; w.x = pk2(x[0], x[1]); w.y = pk2(x[2], x[3]); *(LAS u32x2*)(SfT + e * 72 + d) = w;
            w.x = pk2(y[0], y[1]); w.y = pk2(y[2], y[3]); *(LAS u32x2*)(SbT + e * 72 + d) = w;
        }
    }
    __syncthreads();
    const int i0 = 16 * wave, irow = i0 + fr;
    f32x4 accS[1][8], accF[1][8], accB[1][8], accO[1][8];
#pragma unroll
    for (int j = 0; j < 8; ++j) { accS[0][j] = (f32x4){0.f, 0.f, 0.f, 0.f}; accF[0][j] = accS[0][j]; accB[0][j] = accS[0][j]; accO[0][j] = accS[0][j]; }
    mma_ll<1, 8, true>(accS, Qs, 72, i0, Ks, 72, 0, 64, lane);
    mma_ll<1, 8, true>(accF, Qs, 72, i0, SfT, 72, 0, 64, lane);
    mma_ll<1, 8, true>(accB, Qs, 72, i0, SbT, 72, 0, 64, lane);
#pragma unroll
    for (int j = 0; j < 8; ++j) {
        float w[4];
#pragma unroll
        for (int r = 0; r < 4; ++r) { const int jj = 16 * j + 4 * fq + r; const int df = irow - jj;
            const float dec = df > 0 ? __expf(lgf * (float)df) : (df < 0 ? __expf(lgb * (float)(-df)) : 2.f);
            w[r] = accS[0][j][r] * dec; }
        u32x2 pw; pw.x = pk2(w[0], w[1]); pw.y = pk2(w[2], w[3]);
        *(LAS u32x2*)(Ws + irow * 136 + 16 * j + 4 * fq) = pw;
    }
    LDS_WAIT(); __builtin_amdgcn_wave_barrier();
    mma_ll<1, 8, true>(accO, Ws, 136, i0, VT, 136, 0, 128, lane);
    const float wf = __expf(lgf * (float)(irow + 1)), wb = __expf(lgb * (float)(128 - irow));
    float ss = 0.f;
#pragma unroll
    for (int j = 0; j < 8; ++j) { accO[0][j] = accO[0][j] + accF[0][j] * wf + accB[0][j] * wb;
        ss += (accO[0][j][0] * accO[0][j][0] + accO[0][j][1] * accO[0][j][1]) + (accO[0][j][2] * accO[0][j][2] + accO[0][j][3] * accO[0][j][3]); }
    ss += __shfl_xor(ss, 16); ss += __shfl_xor(ss, 32);
    const float rstd = rsqrtf(ss * (1.f / 128.f) + EPS);
    const float* gro = a.in[I_GRET] + h * 128;
    const bf16_t* pg = P + (size_t)(prow0 + irow) * DINP + OFF_RG + h * 128;
    bf16_t* mix = (bf16_t*)(a.ws + WS_MIX) + (size_t)(prow0 + irow) * DM + 512 + h * 128;
#pragma unroll
    for (int j = 0; j < 8; ++j) { const int e = 16 * j + 4 * fq; const f32x4 gv = *(const GAS f32x4*)(gro + e); const u32x2 gw = *(const GAS u32x2*)(pg + e);
        const float g0 = lo16(gw.x), g1 = hi16(gw.x), g2 = lo16(gw.y), g3 = hi16(gw.y);
        f32x4 v = accO[0][j] * gv * rstd;
        v[0] *= g0 / (1.f + __expf(-g0)); v[1] *= g1 / (1.f + __expf(-g1)); v[2] *= g2 / (1.f + __expf(-g2)); v[3] *= g3 / (1.f + __expf(-g3));
        u32x2 w; w.x = pk2(v[0], v[1]); w.y = pk2(v[2], v[3]); *(GAS u32x2*)(mix + e) = w; }
}

namespace att {
constexpr int KLD8 = 144  , VLD8 = 80  , KBUF = 64 * KLD8, VBUF = 64 * VLD8, NKB = 3, NVB = 4;
constexpr int L_K = 0, L_V = NKB * KBUF, L_WS = NKB * KBUF + NVB * VBUF;
__device__ __forceinline__ int crow(int r, int hi) { return (r & 3) + 8 * (r >> 2) + 4 * hi; }
typedef __bf16 bf16x2_t __attribute__((ext_vector_type(2))); typedef float f32x2_t __attribute__((ext_vector_type(2)));
__device__ __forceinline__ unsigned cvtpk(float lo, float hi) { f32x2_t v = {lo, hi}; bf16x2_t b = __builtin_convertvector(v, bf16x2_t); return __builtin_bit_cast(unsigned, b); }
#define SBAR() __builtin_amdgcn_sched_barrier(0)
typedef int i32x4 __attribute__((ext_vector_type(4))); typedef int i32x8 __attribute__((ext_vector_type(8)));
constexpr float PSHIFT = 2.f;
template <bool SHIFT>
__device__ __forceinline__ i32x8 softmax_pack8(f32x16& p0, f32x16& p1, float negm) {
    const float sh = negm + 8.f - PSHIFT;
#pragma unroll
    for (int r = 0; r < 16; ++r) { p0[r] = __builtin_amdgcn_exp2f(SHIFT ? p0[r] + sh : p0[r]); p1[r] = __builtin_amdgcn_exp2f(SHIFT ? p1[r] + sh : p1[r]); }
    i32x8 w;
#pragma unroll
    for (int q = 0; q < 4; ++q) { w[q] = (int)cvt4_fp8(p0[4 * q], p0[4 * q + 1], p0[4 * q + 2], p0[4 * q + 3]); w[4 + q] = (int)cvt4_fp8(p1[4 * q], p1[4 * q + 1], p1[4 * q + 2], p1[4 * q + 3]); }
    return w;
}
template <bool SHIFT>
__device__ __forceinline__ void unit64(const Args& a, LAS unsigned char* lds, int bh, int qb, float negm) {
    const int wid = sopaque(a.wv), tid = tid_of(wid), lane = tid & 63, r32 = lane & 31, hi = lane >> 5;
    const unsigned char* QwA = a.ws + WS_Q + ((size_t)bh * SEQ + qb * 512 + wid * 64 + r32) * QK8 + hi * 32;
    const unsigned char* Kh = a.ws + WS_K + (size_t)bh * SKV * QK8;
    const unsigned char* Vh = a.ws + WS_VT + (size_t)bh * DV * SKV;
    LAS unsigned char* Kl = lds + L_K; LAS unsigned char* Vl = lds + L_V;
    LAS float* wsf = (LAS float*)(lds + L_WS) + wid * 64;
    i32x8 qA8[2], qB8[2];
#pragma unroll
    for (int s2 = 0; s2 < 2; ++s2) { const i32x4 a0_ = *(const GAS i32x4*)(QwA + 64 * s2), a1_ = *(const GAS i32x4*)(QwA + 64 * s2 + 16), b0_ = *(const GAS i32x4*)(QwA + 32 * QK8 + 64 * s2), b1_ = *(const GAS i32x4*)(QwA + 32 * QK8 + 64 * s2 + 16);
        qA8[s2] = __builtin_shufflevector(a0_, a1_, 0, 1, 2, 3, 4, 5, 6, 7); qB8[s2] = __builtin_shufflevector(b0_, b1_, 0, 1, 2, 3, 4, 5, 6, 7); }
    unsigned soff[2]; int dsto[2];
#pragma unroll
    for (int m = 0; m < 2; ++m) { const int j = (wid + 8 * m) < 14 ? wid + 8 * m : wid + 8 * m - 8;
        if (j < 9) { const int p = j * 64 + lane, row = p / 9, c = p % 9; soff[m] = (unsigned)(row * QK8 + (c < 8 ? c : 7) * 16); dsto[m] = L_K + j * 1024; }
        else { const int jv = j - 9, p = jv * 64 + lane, d = p / 5, c = p % 5; soff[m] = (unsigned)(d * SKV + (c < 4 ? c : 3) * 16); dsto[m] = L_V + jv * 1024; } }
    const char* Kb = (const char*)Kh; const char* Vb = (const char*)Vh;
#define DMA(t, kslot, vslot) do { _Pragma("unroll") for (int pm_ = 0; pm_ < 2; ++pm_) { const int j_ = (wid + 8 * pm_) < 14 ? wid + 8 * pm_ : wid + 8 * pm_ - 8; { \
        const char* src_ = (j_ < 9 ? Kb + (size_t)(t) * (64 * QK8) : Vb + (size_t)(t) * 64) + soff[pm_]; \
        __builtin_amdgcn_global_load_lds((const unsigned*)src_, (LAS unsigned*)(lds + dsto[pm_] + (j_ < 9 ? (kslot) * KBUF : (vslot) * VBUF)), 16, 0, 0); } } } while (0)
    i32x8 ones8;
#pragma unroll
    for (int q = 0; q < 8; ++q) ones8[q] = r32 == 0 ? 0x38383838 : 0;
    f32x16 oA[2], oB[2], sA, sB;
#pragma unroll
    for (int r = 0; r < 16; ++r) { oA[0][r] = 0.f; oA[1][r] = 0.f; oB[0][r] = 0.f; oB[1][r] = 0.f; sA[r] = 0.f; sB[r] = 0.f; }
    constexpr int NT = SKV / 64;
    __syncthreads();
    DMA(0, 0, 0); DMA(1, 1, 1); __syncthreads();
#ifndef ATT_STAGGER
#define ATT_STAGGER 0
#endif
    const bool late = ATT_STAGGER && wid >= 4;
#define TILE_BAR(more) do { if (more) asm volatile("s_waitcnt vmcnt(2) lgkmcnt(0)\n\ts_barrier" ::: "memory"); else asm volatile("s_waitcnt vmcnt(0) lgkmcnt(0)\n\ts_barrier" ::: "memory"); } while (0)
    int ks = 0, vs = 0;
    for (int i = 0; i < NT; ++i) {
        const bool more = i + 2 < NT;
        if (more) DMA(i + 2, (ks == 0 ? 2 : ks - 1), ((vs + 2) & 3));
        SBAR();
        f32x16 pA0, pA1, pB0, pB1;
#pragma unroll
        for (int r = 0; r < 16; ++r) { pA0[r] = PSHIFT; pA1[r] = PSHIFT; pB0[r] = PSHIFT; pB1[r] = PSHIFT; }
        const LAS unsigned char* Ks = Kl + ks * KBUF + r32 * KLD8 + 32 * hi;
#pragma unroll
        for (int s2 = 0; s2 < 2; ++s2) {
            const i32x4 c0_ = *(const LAS i32x4*)(Ks + 64 * s2), c1_ = *(const LAS i32x4*)(Ks + 64 * s2 + 16), d0_ = *(const LAS i32x4*)(Ks + 32 * KLD8 + 64 * s2), d1_ = *(const LAS i32x4*)(Ks + 32 * KLD8 + 64 * s2 + 16);
            const i32x8 k0 = __builtin_shufflevector(c0_, c1_, 0, 1, 2, 3, 4, 5, 6, 7), k1 = __builtin_shufflevector(d0_, d1_, 0, 1, 2, 3, 4, 5, 6, 7);
            pA0 = __builtin_amdgcn_mfma_scale_f32_32x32x64_f8f6f4(k0, qA8[s2], pA0, 0, 0, 0, 0, 0, 0); pB0 = __builtin_amdgcn_mfma_scale_f32_32x32x64_f8f6f4(k0, qB8[s2], pB0, 0, 0, 0, 0, 0, 0);
            pA1 = __builtin_amdgcn_mfma_scale_f32_32x32x64_f8f6f4(k1, qA8[s2], pA1, 0, 0, 0, 0, 0, 0); pB1 = __builtin_amdgcn_mfma_scale_f32_32x32x64_f8f6f4(k1, qB8[s2], pB1, 0, 0, 0, 0, 0, 0);
        }
        SBAR();
        if (late) TILE_BAR(more);
        const LAS unsigned char* Vs = Vl + vs * VBUF + r32 * VLD8 + 32 * hi;
        const i32x4 e0_ = *(const LAS i32x4*)(Vs), e1_ = *(const LAS i32x4*)(Vs + 16), f0_ = *(const LAS i32x4*)(Vs + 32 * VLD8), f1_ = *(const LAS i32x4*)(Vs + 32 * VLD8 + 16);
        const i32x8 v0 = __builtin_shufflevector(e0_, e1_, 0, 1, 2, 3, 4, 5, 6, 7), v1 = __builtin_shufflevector(f0_, f1_, 0, 1, 2, 3, 4, 5, 6, 7);
        { const i32x8 pa = softmax_pack8<SHIFT>(pA0, pA1, negm);
          oA[0] = __builtin_amdgcn_mfma_scale_f32_32x32x64_f8f6f4(pa, v0, oA[0], 0, 0, 0, 0, 0, 0); oA[1] = __builtin_amdgcn_mfma_scale_f32_32x32x64_f8f6f4(pa, v1, oA[1], 0, 0, 0, 0, 0, 0);
          sA = __builtin_amdgcn_mfma_scale_f32_32x32x64_f8f6f4(pa, ones8, sA, 0, 0, 0, 0, 0, 0); }
        { const i32x8 pa = softmax_pack8<SHIFT>(pB0, pB1, negm);
          oB[0] = __builtin_amdgcn_mfma_scale_f32_32x32x64_f8f6f4(pa, v0, oB[0], 0, 0, 0, 0, 0, 0); oB[1] = __builtin_amdgcn_mfma_scale_f32_32x32x64_f8f6f4(pa, v1, oB[1], 0, 0, 0, 0, 0, 0);
          sB = __builtin_amdgcn_mfma_scale_f32_32x32x64_f8f6f4(pa, ones8, sB, 0, 0, 0, 0, 0, 0); }
        SBAR();
        if (!late) TILE_BAR(more);
        ks = ks == 2 ? 0 : ks + 1; vs = (vs + 1) & 3;
    }
#undef DMA
#undef TILE_BAR
    if (r32 == 0) {
#pragma unroll
        for (int r = 0; r < 16; ++r) { wsf[crow(r, hi)] = sA[r]; wsf[32 + crow(r, hi)] = sB[r]; } }
    LDS_WAIT(); __builtin_amdgcn_wave_barrier();
    const int b = bh >> 3, h = bh & 7;
    const int lz = opaque(lane), r32z = lz & 31, hiz = lz >> 5;
    bf16_t* Ow = (bf16_t*)(a.ws + WS_MIX) + ((size_t)b * SEQ + qb * 512 + wid * 64) * DM + h * DV;
    const unsigned ooff = (unsigned)(4 * hiz * DM + r32z);
#pragma unroll
    for (int r = 0; r < 16; ++r) { const int orow = crow(r, hiz); const float rlA = 1.f / wsf[orow], rlB = 1.f / wsf[32 + orow];
        const unsigned off = ooff + (unsigned)(((r & 3) + 8 * (r >> 2)) * DM);
        Ow[off] = (bf16_t)f2bf(oA[0][r] * rlA); Ow[off + 32] = (bf16_t)f2bf(oA[1][r] * rlA);
        Ow[off + 32 * DM] = (bf16_t)f2bf(oB[0][r] * rlB); Ow[off + 32 * DM + 32] = (bf16_t)f2bf(oB[1][r] * rlB); }
}
#undef SBAR
}


#if DIAG == 5
__device__ __forceinline__ void attn_selfcheck(const Args& a, LAS unsigned char* lds) {
    const int tid = tid_of(a.wv);
    LAS float* red = (LAS float*)lds;
    __syncthreads();
    if (blockIdx.x == 0) {
        const int row = tid >> 3, ds = (tid & 7) * 8;
        const unsigned char* q = a.ws + WS_Q + (size_t)row * QK8; const unsigned char* K = a.ws + WS_K; const unsigned char* V = a.ws + WS_VT;
        float qf[96];
        float acc[8] = {0.f, 0.f, 0.f, 0.f, 0.f, 0.f, 0.f, 0.f}; float l = 0.f;
        for (int key = 0; key < SKV; ++key) {
            float s = 0.f;
            for (int c = 0; c < 96; c += 4) { const int kw = *(const GAS int*)(K + (size_t)key * QK8 + c), qw = *(const GAS int*)(q + c);
                s += __builtin_amdgcn_cvt_f32_fp8(kw, 0) * __builtin_amdgcn_cvt_f32_fp8(qw, 0) + __builtin_amdgcn_cvt_f32_fp8(kw, 1) * __builtin_amdgcn_cvt_f32_fp8(qw, 1)
                   + __builtin_amdgcn_cvt_f32_fp8(kw, 2) * __builtin_amdgcn_cvt_f32_fp8(qw, 2) + __builtin_amdgcn_cvt_f32_fp8(kw, 3) * __builtin_amdgcn_cvt_f32_fp8(qw, 3); }
            const float p = exp2f(s);
            const int kk = key & 63, pos = (key & ~63) + 32 * ((kk >> 2) & 1) + (kk & 3) + 4 * ((kk & 31) >> 3) + 16 * (kk >> 5);
            l += p;
#pragma unroll
            for (int e = 0; e < 8; ++e) { const int w = V[(size_t)(ds + e) * SKV + pos]; acc[e] += p * __builtin_amdgcn_cvt_f32_fp8(w, 0); }
        }
        (void)qf;
        float emax = 0.f, omax = 0.f;
        const bf16_t* mix = (const bf16_t*)(a.ws + WS_MIX) + (size_t)row * DM + ds;
#pragma unroll
        for (int e = 0; e < 8; ++e) { const float o = acc[e] / l; emax = fmaxf(emax, fabsf(o - bf2f(mix[e]))); omax = fmaxf(omax, fabsf(o)); }
        red[tid] = emax; red[512 + tid] = omax;
        __syncthreads();
        if (tid == 0) { float e = 0.f, o = 0.f; for (int i = 0; i < 512; ++i) { e = fmaxf(e, red[i]); o = fmaxf(o, red[512 + i]); }
            ((unsigned*)(a.ws + WS_CTL))[CW_DIAG] = __float_as_uint(e / o * 0.1f); }
    }
    __syncthreads();
}
#endif

__device__ __forceinline__ void phase_router(const Args& a, LAS unsigned char* lds) {
    const int tid = tid_of(a.wv), lane = tid & 63, wave = a.wv, fr = lane & 15, fq = lane >> 4;
    LAS bf16_t* Ah = (LAS bf16_t*)lds;
    LAS bf16_t* Al = (LAS bf16_t*)(lds + 33024);
    LAS float* red = (LAS float*)(lds + 66048);
    LAS int* hist = (LAS int*)(lds + 66048 + 16384);
    LAS int* base = hist + 32;
    LAS int* pk_e = base + 32;
    LAS int* pk_r = pk_e + 512;
    LAS int* pk_p = pk_r + 512;
    const float* mod = (const float*)(a.ws + WS_MOD); const float* g = a.in[I_GFFN];
    const bf16_t* WR = (const bf16_t*)(a.ws + WS_WR);
    unsigned char* HF = a.ws + WS_HF;
    float* PG = (float*)(a.ws + WS_PG);
    unsigned* cnt = (unsigned*)(a.ws + WS_CTL) + CW_CNT;
    unsigned* list = (unsigned*)(a.ws + WS_LIST);
    LAS float* lg = (LAS float*)(pk_p + 512);
    bf16x8 bh[4][2], bl[4][2];
#pragma unroll
    for (int ks = 0; ks < 4; ++ks)
#pragma unroll
        for (int j = 0; j < 2; ++j) { bh[ks][j] = *(const GAS bf16x8*)(WR + (size_t)(16 * j + fr) * 1024 + wave * 128 + 32 * ks + 8 * fq); bl[ks][j] = *(const GAS bf16x8*)(WR + 32768 + (size_t)(16 * j + fr) * 1024 + wave * 128 + 32 * ks + 8 * fq); }
    for (int tile = blockIdx.x; tile < T / 128; tile += gridDim.x) {
        __syncthreads();
        if (tid < 32) hist[tid] = 0;
        f32x4 v[2][4];
#pragma unroll
        for (int rr = 0; rr < 2; ++rr) { const float* xr = a.out + (size_t)(tile * 128 + wave * 2 + rr) * DM;
#pragma unroll
            for (int j = 0; j < 4; ++j) v[rr][j] = *(const GAS f32x4*)(xr + j * 256 + lane * 4); }
#pragma unroll 1
        for (int it = 0; it < 8; ++it) {
            const int tok0 = tile * 128 + it * 16;
#pragma unroll
            for (int rr = 0; rr < 2; ++rr) {
                const int row = wave * 2 + rr, tok = tok0 + row;
                const float* sh = mod + (tok >> 13) * 6144 + 3 * 1024; const float* sc = sh + 1024;
                float ss = 0.f;
#pragma unroll
                for (int j = 0; j < 4; ++j) ss += (v[rr][j].x * v[rr][j].x + v[rr][j].y * v[rr][j].y) + (v[rr][j].z * v[rr][j].z + v[rr][j].w * v[rr][j].w);
                const float rstd = rsqrtf(wave_sum(ss) * (1.f / DM) + EPS);
#pragma unroll
                for (int j = 0; j < 4; ++j) { const int c = j * 256 + lane * 4; const f32x4 gg = *(const GAS f32x4*)(g + c), s1 = *(const GAS f32x4*)(sc + c), s0 = *(const GAS f32x4*)(sh + c);
                    const f32x4 o = (v[rr][j] * rstd * gg) * (s1 + 1.f) + s0;
                    const unsigned h0 = f2bf(o.x), h1 = f2bf(o.y), h2 = f2bf(o.z), h3 = f2bf(o.w);
                    u32x2 wh; wh.x = h0 | (h1 << 16); wh.y = h2 | (h3 << 16);
                    u32x2 wl; wl.x = pk2(o.x - bf2f((bf16_t)h0), o.y - bf2f((bf16_t)h1)); wl.y = pk2(o.z - bf2f((bf16_t)h2), o.w - bf2f((bf16_t)h3));
                    *(GAS unsigned*)(HF + (size_t)tok * DM + c) = cvt4_fp8(o.x, o.y, o.z, o.w);
                    *(LAS u32x2*)(Ah + row * 1032 + c) = wh; *(LAS u32x2*)(Al + row * 1032 + c) = wl; }
            }
            if (it < 7) {
#pragma unroll
                for (int rr = 0; rr < 2; ++rr) { const float* xr = a.out + (size_t)(tok0 + 16 + wave * 2 + rr) * DM;
#pragma unroll
                    for (int j = 0; j < 4; ++j) v[rr][j] = *(const GAS f32x4*)(xr + j * 256 + lane * 4); } }
            __syncthreads();
            {
                f32x4 acc[2]; acc[0] = (f32x4){0.f, 0.f, 0.f, 0.f}; acc[1] = acc[0];
#pragma unroll
                for (int ks = 0; ks < 4; ++ks) { const bf16x8 ah = *(const LAS bf16x8*)(Ah + fr * 1032 + wave * 128 + 32 * ks + 8 * fq), al = *(const LAS bf16x8*)(Al + fr * 1032 + wave * 128 + 32 * ks + 8 * fq);
#pragma unroll
                    for (int j = 0; j < 2; ++j) { acc[j] = __builtin_amdgcn_mfma_f32_16x16x32_bf16(ah, bh[ks][j], acc[j], 0, 0, 0); acc[j] = __builtin_amdgcn_mfma_f32_16x16x32_bf16(al, bh[ks][j], acc[j], 0, 0, 0);
                        acc[j] = __builtin_amdgcn_mfma_f32_16x16x32_bf16(ah, bl[ks][j], acc[j], 0, 0, 0); } }
#pragma unroll
                for (int j = 0; j < 2; ++j)
#pragma unroll
                    for (int r = 0; r < 4; ++r) red[(wave * 16 + 4 * fq + r) * 32 + 16 * j + fr] = acc[j][r];
            }
            __syncthreads();
            { const int tk = tid >> 5, e = tid & 31; float sl = a.in[I_BR][e];
#pragma unroll
              for (int w = 0; w < 8; ++w) sl += red[(w * 16 + tk) * 32 + e];
              lg[tk * 32 + e] = sl; }
            __syncthreads();
            if (tid < 16) {
                const int tok = tok0 + tid;
                float best[4]; int bi[4];
#pragma unroll
                for (int k = 0; k < 4; ++k) { best[k] = -3.0e38f; bi[k] = 0; }
                for (int e = 0; e < 32; ++e) {
                    const float s = lg[tid * 32 + e];
                    if (s > best[3]) {
                        if (s > best[0]) { best[3] = best[2]; bi[3] = bi[2]; best[2] = best[1]; bi[2] = bi[1]; best[1] = best[0]; bi[1] = bi[0]; best[0] = s; bi[0] = e; }
                        else if (s > best[1]) { best[3] = best[2]; bi[3] = bi[2]; best[2] = best[1]; bi[2] = bi[1]; best[1] = s; bi[1] = e; }
                        else if (s > best[2]) { best[3] = best[2]; bi[3] = bi[2]; best[2] = s; bi[2] = e; }
                        else { best[3] = s; bi[3] = e; }
                    }
                }
                const float e1 = __expf(best[1] - best[0]), e2 = __expf(best[2] - best[0]), e3 = __expf(best[3] - best[0]);
                const float inv = 1.f / (1.f + e1 + e2 + e3);
                const float gk[4] = {inv, e1 * inv, e2 * inv, e3 * inv};
#pragma unroll
                for (int k = 0; k < 4; ++k) { const int slot = (it * 16 + tid) * 4 + k; const int rk = __hip_atomic_fetch_add(hist + bi[k], 1, __ATOMIC_RELAXED, __HIP_MEMORY_SCOPE_WORKGROUP);
                    pk_e[slot] = bi[k]; pk_r[slot] = rk; pk_p[slot] = tok * 4 + k; PG[tok * 4 + k] = gk[k]; }
            }
        }
        __syncthreads();
        if (tid < 32) base[tid] = (int)__hip_atomic_fetch_add(cnt + 64 * tid, (unsigned)hist[tid], __ATOMIC_RELAXED, __HIP_MEMORY_SCOPE_AGENT);
        __syncthreads();
        { const int e = pk_e[tid]; list[(size_t)e * 32768 + base[e] + pk_r[tid]] = (unsigned)pk_p[tid]; }
    }
}

__device__ __forceinline__ void phase_combine(const Args& a) {
    const int tid = tid_of(a.wv), lane = tid & 63, wave = tid >> 6;
    const int gw = blockIdx.x * 8 + wave, NGW = gridDim.x * 8;
    const float* mod = (const float*)(a.ws + WS_MOD);
    const unsigned char* Y = a.ws + WS_Y;
#if DIAG == 1
    const float dz = 0.1f;
#elif DIAG >= 2
    const float dz = sqrtf(__uint_as_float(__hip_atomic_load((unsigned*)(a.ws + WS_CTL) + CW_DIAG, __ATOMIC_RELAXED, __HIP_MEMORY_SCOPE_AGENT)));
#else
    const float dz = 0.f;
#endif
    for (int tok = gw; tok < T; tok += NGW) {
        const float* gate = mod + (tok >> 13) * 6144 + 5 * 1024;
        float* orow = a.out + (size_t)tok * DM;
#pragma unroll
        for (int j = 0; j < 4; ++j) { const int c = j * 256 + lane * 4;
            f32x4 s = (f32x4){0.f, 0.f, 0.f, 0.f};
#pragma unroll
            for (int k = 0; k < 4; ++k) { const int w = *(const GAS int*)(Y + ((size_t)tok * 4 + k) * DM + c);
                s[0] += __builtin_amdgcn_cvt_f32_fp8(w, 0); s[1] += __builtin_amdgcn_cvt_f32_fp8(w, 1); s[2] += __builtin_amdgcn_cvt_f32_fp8(w, 2); s[3] += __builtin_amdgcn_cvt_f32_fp8(w, 3); }
            s = s * pg8::YINV;
            const f32x4 xv = *(const GAS f32x4*)(orow + c), gv = *(const GAS f32x4*)(gate + c);
            *(GAS f32x4*)(orow + c) = xv + gv * s + dz; }
    }
}

constexpr int N_PHASES = 11;
__global__ void __launch_bounds__(512, 2) fwd_kernel(Args a0) {
    Args a;
    extern __shared__ __attribute__((aligned(16))) unsigned char lds_raw[];
    LAS unsigned char* lds = (LAS unsigned char*)lds_raw;
    volatile LAS unsigned* MISC = (volatile LAS unsigned*)(lds + LDS_MISC);
    const int wv0 = __builtin_amdgcn_readfirstlane((int)threadIdx.x >> 6);
    const int tid = threadIdx.x;
    if (tid < 64) MISC[tid] = 0u;
    __syncthreads();
    const int lo = sopaque(a0.ph_lo), hi = sopaque(a0.ph_hi);
#define use_bar ((hi - lo) > 1)
    XcdBarrier bar; bar.bar = (unsigned*)(a0.ws + WS_CTL) + CW_BAR; bar.x = 0; bar.st = MISC + 8;
    bar.wv = wv0;
    if (use_bar) bar = xcd_barrier_post((unsigned*)(a0.ws + WS_CTL) + CW_BAR, MISC + 8, wv0);
    const int G = sopaque((int)gridDim.x), bx = sopaque((int)blockIdx.x);
    const int vcu = (G % 8 == 0) ? (bx % 8) * (G / 8) + bx / 8 : bx;
#ifndef ONLY_PHASE
#define ONLY_PHASE -1
#endif
#ifndef PHASE_MASK
#define PHASE_MASK 0x7ff
#endif
#define IN(k) (lo <= (k) && (k) < hi && (ONLY_PHASE < 0 || ONLY_PHASE == (k)) && ((PHASE_MASK >> (k)) & 1))
#if DIAG >= 40
    unsigned long long tprev_ = __builtin_amdgcn_s_memrealtime();
#define TSTAMP(k) do { const unsigned long long tn_ = __builtin_amdgcn_s_memrealtime(); if (DIAG - 40 == (k) && blockIdx.x == 0 && tid == 0) MISC[40] = __float_as_uint(rintf((float)(tn_ - tprev_) * (1.f / 1000.f)) * 1e-5f); tprev_ = tn_; } while (0)
#else
#define TSTAMP(k) do { } while (0)
#endif
#define SEAM(k) do { if ((k) == 9) TSTAMP(k); if ((k) == 9 && DIAG >= 10 && blockIdx.x == 0 && tid == 0) __hip_atomic_store((unsigned*)(a0.ws + WS_CTL) + CW_DIAG, MISC[40], __ATOMIC_RELAXED, __HIP_MEMORY_SCOPE_AGENT); \
        if (use_bar && (k) + 1 < hi) xcd_barrier(bar); if ((k) != 9) TSTAMP(k); } while (0)
#ifndef REPEAT_MASK
#define REPEAT_MASK 0
#endif
#define REP(k) for (int rep_ = 0; rep_ <= ((REPEAT_MASK >> (k)) & 1); ++rep_)
    a = a0; a.wv = wv0;
    if (IN(0)) { phase_mod(a, lds); SEAM(0); }
    REP(1) if (IN(1)) { phase_prep(a, lds); SEAM(1); }
    {
        float* prm = (float*)(a0.ws + WS_PRM);
        a.ws = a0.ws; a.out = a0.out; a.in[I_X] = a0.in[I_X]; a.wv = wv0;
        a.in[I_GQL] = prm + PRM_GQL; a.in[I_GKVL] = prm + PRM_GKVL; a.in[I_GQH] = prm + PRM_GQH; a.in[I_GKH] = prm + PRM_GKH; a.in[I_DECAY] = prm + PRM_DECAY;
        a.in[I_GRET] = prm + PRM_GRET; a.in[I_BR] = prm + PRM_BR; a.in[I_GFFN] = prm + PRM_GFFN; a.in[I_B1] = prm + PRM_B1; a.in[I_B2] = prm + PRM_B2;
    }
    REP(2) if (IN(2)) {
        pg8::DenseOrder S; S.init(a.ws + WS_H, a.ws + WS_WIN, TA, DINP, 1024, G, bx);
        pg8::EpiP E{(bf16_t*)(a.ws + WS_P)};
        pg8::gemm_phase<pg8::EpiP, pg8::DenseOrder, false>(lds, nullptr, nullptr, 0, 1024, S, E, a.wv);
        SEAM(2);
    }
    REP(3) if (IN(3)) {
        if (G == 256) {
            int u0, nu;
            if (bx < 32) { u0 = 3 * bx; nu = 3; }
            else { const int c = bx - 32; u0 = 96 + 4 * c + (c < 64 ? c : 64); nu = 4 + (c < 64 ? 1 : 0); }
            for (int k2 = 0; k2 < (bx < 32 ? 2 : 1); ++k2) mla_tile(a, lds, k2 ? 256 + (bx >> 2) : bx, k2 ? 32 * (bx & 3) : 0, k2 ? 32 : 128);
            for (int u = u0; u < u0 + nu; ++u) ret_local_unit(a, lds, u);
        } else { for (int t = bx; t < TA / 128; t += G) mla_tile(a, lds, t); for (int u = bx; u < 16 * NSLOT; u += G) ret_local_unit(a, lds, u); }
        SEAM(3);
    }
    if (IN(4)) { phase_ret_scan(a); SEAM(4); }
    REP(5) if (IN(5)) {
        float negm;
        { float gq = 0.f, gk = 0.f; for (int i = 0; i < QK; ++i) { gq = fmaxf(gq, fabsf(a.in[I_GQH][i])); gk = fmaxf(gk, fabsf(a.in[I_GKH][i])); }
          negm = -(gq * gk * 96.f * QSCALE * 1.03f + 0.5f); negm = __uint_as_float(__builtin_amdgcn_readfirstlane(__float_as_uint(negm))); }
        const bool shift = negm < -64.f;
        __builtin_amdgcn_s_setreg((0 << 11) | (23 << 6) | 1, 1);
#ifndef REP5A
#define REP5A 0
#endif
#ifndef REP5B
#define REP5B 0
#endif
        if (G == 256) {
            const int xg = vcu >> 5, c = vcu & 31, cg = vcu & 3;
#pragma unroll 1
            for (int step = 0; step < 4; ++step) {
                if (step == cg) moe_convert(a, lds, vcu);
                if (step < 2) { const int bh = xg * 4 + 2 * step + (c >> 4), qb = c & 15; if (shift) att::unit64<true>(a, lds, bh, qb, negm); else att::unit64<false>(a, lds, bh, qb, negm); }
                else if (step == 2) { for (int u = bx; u < 16 * 64; u += G) ret_out_unit(a, lds, u); }
            }
        } else {
            for (int w = bx; w < 512; w += G) { if (shift) att::unit64<true>(a, lds, w >> 4, w & 15, negm); else att::unit64<false>(a, lds, w >> 4, w & 15, negm); }
            for (int u = bx; u < 16 * 64; u += G) ret_out_unit(a, lds, u);
        }
        SEAM(5);
    }
    REP(6) if (IN(6)) {
        pg8::DenseOrder S; S.init(a.ws + WS_MIX, a.ws + WS_WO, T, DM, 1024, G, bx);
        pg8::EpiOut E{a.in[I_X], (const float*)(a.ws + WS_MOD), a.out};
        pg8::gemm_phase<pg8::EpiOut, pg8::DenseOrder, false>(lds, nullptr, nullptr, 0, 1024, S, E, a.wv);
        SEAM(6);
    }
    if (IN(7)) { phase_router(a, lds); SEAM(7); }
    REP(8) if (IN(8)) {
        pg8::EpiM1 E{a.ws + WS_ACT};
        phase_moe_pg8<8>(a, lds, a.ws + WS_HF, 2, a.ws + WS_W1, (size_t)2048 * 1024, a.in[I_B1], 2048, nullptr, E);
        SEAM(8);
    }
    REP(9) if (IN(9)) {
        pg8::EpiM2 E{a.ws + WS_Y};
        phase_moe_pg8<4>(a, lds, a.ws + WS_ACT, 0, a.ws + WS_W2, (size_t)1024 * 1024, a.in[I_B2], 1024, (const float*)(a.ws + WS_PG), E);
        SEAM(9);
    }
    if (IN(10)) { phase_combine(a); }
#undef IN
#undef SEAM
#undef use_bar
}

extern "C" void kernel_launch(void* const* d_in, const int* in_sizes, int n_in, void* d_out, int out_size, void* d_ws, size_t ws_size, hipStream_t stream) {
    static int grid = 0;
    if (grid == 0) {
        if (n_in != 24 || out_size != T * DM || ws_size < WS_END) { fprintf(stderr, "kernel_launch: unexpected shapes (n_in %d out %d ws %zu)\n", n_in, out_size, ws_size); grid = -1; return; }
        int dev = 0, cus = 0, per_cu = 0;
        if (hipGetDevice(&dev) != hipSuccess || hipDeviceGetAttribute(&cus, hipDeviceAttributeMultiprocessorCount, dev) != hipSuccess) { grid = -1; return; }
        if (hipFuncSetAttribute((const void*)fwd_kernel, hipFuncAttributeMaxDynamicSharedMemorySize, LDS_BYTES) != hipSuccess) { fprintf(stderr, "kernel_launch: hipFuncSetAttribute failed\n"); grid = -1; return; }
        if (hipOccupancyMaxActiveBlocksPerMultiprocessor(&per_cu, (const void*)fwd_kernel, 512, LDS_BYTES) != hipSuccess || per_cu < 1) { fprintf(stderr, "kernel_launch: occupancy query says %d\n", per_cu); per_cu = 1; }
        (void)hipGetLastError();
        grid = cus;
    }
    if (grid < 0) return;
    (void)hipMemsetAsync((char*)d_ws + WS_CTL, 0, CTL_BYTES, stream);
    Args a{};
    for (int i = 0; i < 24; ++i) a.in[i] = (const float*)d_in[i];
    a.out = (float*)d_out; a.ws = (unsigned char*)d_ws;
#if MK_N_LAUNCHES == 1
    a.ph_lo = 0; a.ph_hi = N_PHASES;
    void* params[] = {&a};
    hipError_t e = hipLaunchCooperativeKernel((const void*)fwd_kernel, dim3(grid), dim3(512), params, LDS_BYTES, stream);
    if (e != hipSuccess) fprintf(stderr, "kernel_launch: cooperative launch failed: %s (grid %d)\n", hipGetErrorString(e), grid);
#else
    for (int p = 0; p < N_PHASES; ++p) { a.ph_lo = p; a.ph_hi = p + 1; hipLaunchKernelGGL(fwd_kernel, dim3(grid), dim3(512), LDS_BYTES, stream, a); }
#endif
}
```

```cpp
#include <hip/hip_runtime.h>
#include <cstdio>
#include <cstdint>

#ifndef MK_N_LAUNCHES
#define MK_N_LAUNCHES 1
#endif

#define LAS __attribute__((address_space(3)))
#define GAS __attribute__((address_space(1)))
typedef unsigned short bf16_t;
typedef short bf16x8 __attribute__((ext_vector_type(8)));
typedef short s16x4 __attribute__((ext_vector_type(4)));
typedef float f32x4 __attribute__((ext_vector_type(4)));
typedef float f32x16 __attribute__((ext_vector_type(16)));
typedef unsigned u32x4 __attribute__((ext_vector_type(4)));
typedef unsigned u32x2 __attribute__((ext_vector_type(2)));

constexpr int DM = 1024, NB = 4, SEQ = 8192, LC = 256;
constexpr int T = NB * SEQ;
constexpr int TC = NB * LC;
constexpr int TA = T + TC;
constexpr int DIN = 1952, DINP = 2048;
constexpr int OFF_Q = 0, OFF_KV = 256, OFF_PE = 384, OFF_RQ = 416, OFF_RK = 672, OFF_RV = 928, OFF_RG = 1440;
constexpr int NH = 8, QK = 96, QK8 = 128, DV = 64, SKV = LC + SEQ;
constexpr int RH = 4, RDK = 64, RDV = 128, RC = 128, NSLOT = 66;
constexpr int NE = 32, DFF = 1024, NPAIR = T * 4;
constexpr float EPS = 1e-6f;
constexpr float QSCALE = 0.10206207261596577f * 1.4426950408889634f;

constexpr size_t MiB = 1ull << 20;
constexpr size_t WS_CTL = 0, CTL_BYTES = 1 * MiB;
constexpr size_t WS_MOD = 1 * MiB;
constexpr size_t WS_TABM = WS_MOD + 128 * 1024;
constexpr size_t WS_TABR = WS_TABM + 16 * 1024;
constexpr size_t WS_WIN = 2 * MiB;
constexpr size_t WS_WQ = 6 * MiB;
constexpr size_t WS_WKV = 6 * MiB + 512 * 1024;
constexpr size_t WS_WO = 7 * MiB;
constexpr size_t WS_WR = 9 * MiB;
constexpr size_t WS_W1 = 10 * MiB;
constexpr size_t WS_W2 = 138 * MiB;
constexpr size_t WS_HF = 202 * MiB;
constexpr size_t WS_PG = 266 * MiB;
constexpr size_t WS_LIST = 267 * MiB;
constexpr size_t WS_H = 272 * MiB;
constexpr size_t WS_P = 338 * MiB;
constexpr size_t WS_Q = 470 * MiB;
constexpr size_t WS_K = 518 * MiB;
constexpr size_t WS_VT = 568 * MiB;
constexpr size_t WS_LST = 601 * MiB;
constexpr size_t WS_MIX = 667 * MiB;
constexpr size_t WS_ACT = 272 * MiB;
constexpr size_t WS_Y = 528 * MiB;
constexpr size_t WS_END = 784 * MiB;
constexpr size_t WS_PRM = WS_MOD + 256 * 1024;
constexpr int PRM_GQL = 0, PRM_GKVL = 256, PRM_GQH = 384, PRM_GKH = 480, PRM_DECAY = 576, PRM_GRET = 584, PRM_BR = 1096, PRM_GFFN = 1128, PRM_B1 = 2152, PRM_B2 = 67688, PRM_END = 100456;
constexpr int CW_BAR = 4096;
constexpr int CW_CNT = 16384;
constexpr int CW_DIAG = 20480;
#ifndef DIAG
#define DIAG 0
#endif

constexpr int LDS_SCRATCH = 159744;
constexpr int LDS_MISC = LDS_SCRATCH;
constexpr int LDS_BYTES = LDS_SCRATCH + 256;

__device__ __forceinline__ float bf2f(bf16_t h) { return __uint_as_float((unsigned)h << 16); }
__device__ __forceinline__ unsigned f2bf(float f) { unsigned u = __float_as_uint(f); return (u + 0x7fffu + ((u >> 16) & 1u)) >> 16; }
__device__ __forceinline__ unsigned pk2(float lo, float hi) { return f2bf(lo) | (f2bf(hi) << 16); }
__device__ __forceinline__ float lo16(unsigned w) { return __uint_as_float(w << 16); }
__device__ __forceinline__ float hi16(unsigned w) { return __uint_as_float(w & 0xffff0000u); }
__device__ __forceinline__ float wave_sum(float v) {
#pragma unroll
    for (int o = 1; o < 64; o <<= 1) v += __shfl_xor(v, o);
    return v;
}
#define LDS_WAIT() asm volatile("s_waitcnt lgkmcnt(0)" ::: "memory")
__device__ __forceinline__ unsigned cvt4_fp8(float a, float b, float c, float d) { int p = 0; p = __builtin_amdgcn_cvt_pk_fp8_f32(a, b, p, false); p = __builtin_amdgcn_cvt_pk_fp8_f32(c, d, p, true); return (unsigned)p; }
constexpr float WQ_SCALE = 16.f, WKV_SCALE = 8.f, WKV_INV = 1.f / 8.f;
constexpr float WSCALE = 64.f, WINV = 1.f / 64.f;
__device__ __forceinline__ int opaque(int v) { asm volatile("" : "+v"(v)); return v; }
__device__ __forceinline__ int sopaque(int v) { asm volatile("" : "+s"(v)); return v; }
__device__ __forceinline__ int tid_of(int wv) { return sopaque(wv) * 64 + opaque((int)__builtin_amdgcn_mbcnt_hi(~0u, __builtin_amdgcn_mbcnt_lo(~0u, 0u))); }

#define XB_TMO      128
#define XB_XCNT(j)  (256  + 64 * (j))
#define XB_XSUB(j)  (1280 + 64 * (j))
#define XB_XGEN(j)  (2304 + 64 * (j))
#define XB_TOP      3328
#define XB_TOPGEN   3392
#define XCD_BAR_WORDS 3456
#define XB_SPIN_CAP (1u << 20)
__device__ __forceinline__ unsigned xb_ld(unsigned* p)              { return __hip_atomic_load(p, __ATOMIC_RELAXED, __HIP_MEMORY_SCOPE_AGENT); }
__device__ __forceinline__ unsigned xb_add(unsigned* p, unsigned v) { return __hip_atomic_fetch_add(p, v, __ATOMIC_RELAXED, __HIP_MEMORY_SCOPE_AGENT); }
__device__ __forceinline__ unsigned xb_xcc_id() { return (unsigned)__builtin_amdgcn_s_getreg((3 << 11) | 20) & 0xFu; }
#define XB_SPIN(cond, bar) do { unsigned _sp = 0; while (cond) { __builtin_amdgcn_s_sleep(1); \
    if ((++_sp & 255u) == 0u) { if (xb_ld(&(bar)[XB_TMO])) break; if (_sp > XB_SPIN_CAP) { atomicAdd(&(bar)[XB_TMO], 1u); break; } } } } while (0)
struct XcdBarrier { unsigned* bar; unsigned x; volatile LAS unsigned* st; int wv; };
__device__ __forceinline__ XcdBarrier xcd_barrier_post(unsigned* bar, volatile LAS unsigned* st, int wv) {
    XcdBarrier b; b.bar = bar; b.x = xb_xcc_id(); b.st = st; b.wv = wv;
    if (tid_of(wv) == 0) (void)xb_add(&bar[XB_XCNT(b.x)], 1u);
    return b;
}
__device__ __forceinline__ void xcd_barrier_complete(unsigned* bar, unsigned x, unsigned& nloc, unsigned& nx) {
    const unsigned G = gridDim.x * gridDim.y * gridDim.z;
    unsigned sum, cnt, mine, sp = 0u;
    for (;;) {
        sum = 0u; cnt = 0u; mine = 0u;
#pragma unroll 1
        for (unsigned j = 0; j < 16; ++j) { const unsigned c = xb_ld(&bar[XB_XCNT(j)]); sum += c; cnt += (c > 0u) ? 1u : 0u; mine = (j == x) ? c : mine; }
        if (sum == G) break;
        __builtin_amdgcn_s_sleep(1);
        if ((++sp & 255u) == 0u) { if (xb_ld(&bar[XB_TMO])) break; if (sp > XB_SPIN_CAP) { atomicAdd(&bar[XB_TMO], 1u); break; } }
    }
    nloc = mine > 0u ? mine : 1u; nx = cnt > 0u ? cnt : 1u;
}
__device__ __forceinline__ void xcd_barrier(const XcdBarrier& b) {
    asm volatile("s_waitcnt vmcnt(0)" ::: "memory");
    __syncthreads();
    if (tid_of(b.wv) == 0) {
        unsigned* bar = b.bar; asm volatile("" : "+s"(bar));
        __builtin_amdgcn_s_waitcnt(0);
        unsigned nloc = b.st[0], nx = b.st[1];
        if (nloc == 0u) { xcd_barrier_complete(bar, b.x, nloc, nx); b.st[0] = nloc; b.st[1] = nx; }
        const unsigned old = xb_add(&bar[XB_XSUB(b.x)], 1u);
        const unsigned gen = old / nloc;
        if (old + 1u == (gen + 1u) * nloc) {
            __builtin_amdgcn_fence(__ATOMIC_RELEASE, "agent");
            asm volatile("s_waitcnt vmcnt(0)" ::: "memory");
            const unsigned og = xb_add(&bar[XB_TOP], 1u);
            const unsigned tg = og / nx;
            if (og + 1u == (tg + 1u) * nx) xb_add(&bar[XB_TOPGEN], 1u);
            else XB_SPIN(xb_ld(&bar[XB_TOPGEN]) == tg, bar);
            __builtin_amdgcn_fence(__ATOMIC_ACQUIRE, "agent");
            xb_add(&bar[XB_XGEN(b.x)], 1u);
            asm volatile("s_waitcnt vmcnt(0)" ::: "memory");
        } else {
            XB_SPIN(xb_ld(&bar[XB_XGEN(b.x)]) == gen, bar);
            __builtin_amdgcn_fence(__ATOMIC_ACQUIRE, "agent");
            asm volatile("s_waitcnt vmcnt(0)" ::: "memory");
        }
    }
    __syncthreads();
}

struct Args { const float* in[24]; float* out; unsigned char* ws; int ph_lo, ph_hi; int wv, pad; };
#define CAS __attribute__((address_space(4)))
__device__ __forceinline__ Args load_args() { auto p = __builtin_amdgcn_kernarg_segment_ptr(); asm volatile("" : "+s"(p)); Args r; __builtin_memcpy(&r, p, sizeof(Args)); return r; }
enum { I_X = 0, I_C, I_CTX, I_CCTX, I_GATTN, I_GFFN, I_WADA, I_BADA, I_WIN, I_GQL, I_WQUP, I_GQH, I_GKVL, I_WKVUP, I_GKH, I_DECAY, I_GRET, I_WOUT,
       I_WR, I_BR, I_W1, I_B1, I_W2, I_B2 };

template <int MT, int NT, bool SWAP>
__device__ __forceinline__ void mma_ll(f32x4 (&acc)[MT][NT], const LAS bf16_t* sA, int lda, int m0, const LAS bf16_t* sB, int ldb, int n0, int K, int lane) {
    const int fr = lane & 15, fq = lane >> 4;
    for (int k = 0; k < K; k += 32) {
        bf16x8 a[MT], b[NT];
#pragma unroll
        for (int i = 0; i < MT; ++i) a[i] = *(const LAS bf16x8*)(sA + (m0 + 16 * i + fr) * lda + k + 8 * fq);
#pragma unroll
        for (int j = 0; j < NT; ++j) b[j] = *(const LAS bf16x8*)(sB + (n0 + 16 * j + fr) * ldb + k + 8 * fq);
#pragma unroll
        for (int i = 0; i < MT; ++i)
#pragma unroll
            for (int j = 0; j < NT; ++j)
                acc[i][j] = SWAP ? __builtin_amdgcn_mfma_f32_16x16x32_bf16(b[j], a[i], acc[i][j], 0, 0, 0) : __builtin_amdgcn_mfma_f32_16x16x32_bf16(a[i], b[j], acc[i][j], 0, 0, 0);
    }
}
template <int MT, int NT, bool SWAP>
__device__ __forceinline__ void mma_lg(f32x4 (&acc)[MT][NT], const LAS bf16_t* sA, int lda, int m0, const bf16_t* gB, int ldb, int n0, int K, int lane) {
    const int fr = lane & 15, fq = lane >> 4;
#pragma unroll 2
    for (int k = 0; k < K; k += 32) {
        bf16x8 a[MT], b[NT];
#pragma unroll
        for (int j = 0; j < NT; ++j) b[j] = *(const GAS bf16x8*)(gB + (size_t)(n0 + 16 * j + fr) * ldb + k + 8 * fq);
#pragma unroll
        for (int i = 0; i < MT; ++i) a[i] = *(const LAS bf16x8*)(sA + (m0 + 16 * i + fr) * lda + k + 8 * fq);
#pragma unroll
        for (int i = 0; i < MT; ++i)
#pragma unroll
            for (int j = 0; j < NT; ++j)
                acc[i][j] = SWAP ? __builtin_amdgcn_mfma_f32_16x16x32_bf16(b[j], a[i], acc[i][j], 0, 0, 0) : __builtin_amdgcn_mfma_f32_16x16x32_bf16(a[i], b[j], acc[i][j], 0, 0, 0);
    }
}

__device__ __forceinline__ void phase_mod(const Args& a, LAS unsigned char* lds) {
    const int tid = tid_of(a.wv), lane = tid & 63, wave = tid >> 6;
    LAS float* sv = (LAS float*)lds;
    LAS float* red = sv + 5 * 1024;
    float* mod = (float*)(a.ws + WS_MOD);
    for (int i = tid; i < 5 * 1024; i += 512) { const float v = (i < 4096) ? a.in[I_C][i] : a.in[I_CCTX][i - 4096]; sv[i] = v / (1.f + __expf(-v)); }
    __syncthreads();
    const float* W = a.in[I_WADA]; const float* bb = a.in[I_BADA];
    for (int u = blockIdx.x; u < 96; u += gridDim.x) {
        const int col = u * 64 + lane;
        float acc[5] = {0.f, 0.f, 0.f, 0.f, 0.f};
        for (int k = wave * 128; k < wave * 128 + 128; ++k) {
            const float w = W[(size_t)k * 6144 + col];
#pragma unroll
            for (int v = 0; v < 5; ++v) acc[v] += sv[v * 1024 + k] * w;
        }
#pragma unroll
        for (int v = 0; v < 5; ++v) red[(wave * 5 + v) * 64 + lane] = acc[v];
        __syncthreads();
        if (tid < 320) { const int v = tid >> 6; float s = bb[u * 64 + lane];
#pragma unroll
            for (int w = 0; w < 8; ++w) s += red[(w * 5 + v) * 64 + lane];
            mod[v * 6144 + u * 64 + lane] = s; }
        __syncthreads();
    }
    const int gt = blockIdx.x * 512 + tid;
    if (gt < 192 * 8) { const int pi = gt >> 3, f = gt & 7; const float pos = (float)(pi < 128 ? pi : pi - 128);
        const float inv = exp2f(-(float)f * (13.287712379549449f / 8.f)); const float rev = pos * inv * 0.15915494309189535f;
        float* tm = (float*)(a.ws + WS_TABM); tm[gt * 2] = __builtin_amdgcn_cosf(rev); tm[gt * 2 + 1] = __builtin_amdgcn_sinf(rev); }
    else if (gt < 192 * 8 + 192 * 16) { const int g2 = gt - 192 * 8; const int pi = g2 >> 4, f = g2 & 15; const float pos = (float)(pi < 128 ? pi : pi - 128);
        const float inv = exp2f(-(float)f * (13.287712379549449f / 16.f)); const float rev = pos * inv * 0.15915494309189535f;
        float* tr = (float*)(a.ws + WS_TABR); tr[g2 * 2] = __builtin_amdgcn_cosf(rev); tr[g2 * 2 + 1] = __builtin_amdgcn_sinf(rev); }
}

__device__ __forceinline__ void transpose_item(const float* W, int K, int N, bf16_t* WT, LAS float* scr, int item, int lane) {
    const int nblk = N / 32, kb = item / nblk, nb = item % nblk, k0 = 64 * kb, n0 = 32 * nb;
    float wv_[32];
#pragma unroll
    for (int i = 0; i < 32; ++i) { const int kk = 2 * i + (lane >> 5); wv_[i] = W[(size_t)(k0 + kk) * N + n0 + (lane & 31)]; }
#pragma unroll
    for (int i = 0; i < 32; ++i) { const int kk = 2 * i + (lane >> 5); scr[kk * 33 + (lane & 31)] = wv_[i]; }
    LDS_WAIT();
    const int c = lane & 7;
#pragma unroll
    for (int j = 0; j < 4; ++j) { const int n = (lane >> 3) + 8 * j; const LAS float* s = scr + (8 * c) * 33 + n;
        u32x4 o; o.x = pk2(s[0 * 33], s[1 * 33]); o.y = pk2(s[2 * 33], s[3 * 33]); o.z = pk2(s[4 * 33], s[5 * 33]); o.w = pk2(s[6 * 33], s[7 * 33]);
        *(GAS u32x4*)(WT + (size_t)(n0 + n) * K + k0 + 8 * c) = o; }
    LDS_WAIT();
}
__device__ __forceinline__ void transpose_item8(const float* W, int K, int N, unsigned char* WT, float sc, LAS float* scr, int item, int lane) {
    const int nblk = N / 32, kb = item / nblk, nb = item % nblk, k0 = 64 * kb, n0 = 32 * nb;
    float wv_[32];
#pragma unroll
    for (int i = 0; i < 32; ++i) { const int kk = 2 * i + (lane >> 5); wv_[i] = W[(size_t)(k0 + kk) * N + n0 + (lane & 31)]; }
#pragma unroll
    for (int i = 0; i < 32; ++i) { const int kk = 2 * i + (lane >> 5); scr[kk * 33 + (lane & 31)] = wv_[i]; }
    LDS_WAIT();
    const int c = lane & 7;
#pragma unroll
    for (int j = 0; j < 4; ++j) { const int n = (lane >> 3) + 8 * j; const LAS float* s = scr + (8 * c) * 33 + n;
        u32x2 o; o.x = cvt4_fp8(s[0 * 33] * sc, s[1 * 33] * sc, s[2 * 33] * sc, s[3 * 33] * sc); o.y = cvt4_fp8(s[4 * 33] * sc, s[5 * 33] * sc, s[6 * 33] * sc, s[7 * 33] * sc);
        *(GAS u32x2*)(WT + (size_t)(n0 + n) * K + k0 + 8 * c) = o; }
    LDS_WAIT();
}
__device__ __forceinline__ void phase_prep(const Args& a, LAS unsigned char* lds) {
    const int tid = tid_of(a.wv), lane = tid & 63, wave = tid >> 6;
    LAS float* scr = (LAS float*)(lds + wave * 16384);
    const int gw = blockIdx.x * 8 + wave, NGW = gridDim.x * 8;
    constexpr int I_IN = 16 * 61, I_QU = 4 * 24, I_KVU = 2 * 32, I_O = 16 * 32, I_1 = 16 * 64, I_2 = 16 * 32;
    constexpr int NITEMS = I_IN + I_QU + I_KVU + I_O + 32 * I_1 + 32 * I_2;
    const int nitems = gridDim.x == 256 ? I_IN + I_QU + I_KVU + I_O : NITEMS;
    for (int it = gw; it < nitems; it += NGW) {
        int r = it;
        if (r < I_IN) { transpose_item(a.in[I_WIN], 1024, DIN, (bf16_t*)(a.ws + WS_WIN), scr, r, lane); continue; } r -= I_IN;
        if (r < I_QU) { transpose_item8(a.in[I_WQUP], 256, 768, a.ws + WS_WQ, WQ_SCALE, scr, r, lane); continue; } r -= I_QU;
        if (r < I_KVU) { transpose_item8(a.in[I_WKVUP], 128, 1024, a.ws + WS_WKV, WKV_SCALE, scr, r, lane); continue; } r -= I_KVU;
        if (r < I_O) { transpose_item(a.in[I_WOUT], 1024, 1024, (bf16_t*)(a.ws + WS_WO), scr, r, lane); continue; } r -= I_O;
        if (r < 32 * I_1) { const int e = r / I_1; transpose_item8(a.in[I_W1] + (size_t)e * 1024 * 2048, 1024, 2048, a.ws + WS_W1 + (size_t)e * 2048 * 1024, WSCALE, scr, r % I_1, lane); continue; } r -= 32 * I_1;
        { const int e = r / I_2; transpose_item8(a.in[I_W2] + (size_t)e * 1024 * 1024, 1024, 1024, a.ws + WS_W2 + (size_t)e * 1024 * 1024, WSCALE, scr, r % I_2, lane); }
    }
    const int gt = blockIdx.x * 512 + tid, NGT = gridDim.x * 512;
    for (int i = gt; i < 96 * 1024 / 8; i += NGT) *(GAS u32x4*)((bf16_t*)(a.ws + WS_WIN) + (size_t)DIN * 1024 + (size_t)i * 8) = (u32x4){0u, 0u, 0u, 0u};
    for (int i = gt; i < 32 * 1024; i += NGT) { const int n = i >> 10, k = i & 1023; const float w = a.in[I_WR][k * 32 + n]; const unsigned h = f2bf(w);
        bf16_t* wr = (bf16_t*)(a.ws + WS_WR); wr[i] = (bf16_t)h; wr[32768 + i] = (bf16_t)f2bf(w - bf2f((bf16_t)h)); }
    {
        float* prm = (float*)(a.ws + WS_PRM);
        for (int i = gt; i < PRM_END; i += NGT) {
            float v;
            if (i < PRM_GKVL) v = a.in[I_GQL][i - PRM_GQL]; else if (i < PRM_GQH) v = a.in[I_GKVL][i - PRM_GKVL]; else if (i < PRM_GKH) v = a.in[I_GQH][i - PRM_GQH];
            else if (i < PRM_DECAY) v = a.in[I_GKH][i - PRM_GKH]; else if (i < PRM_GRET) v = a.in[I_DECAY][i - PRM_DECAY]; else if (i < PRM_BR) v = a.in[I_GRET][i - PRM_GRET];
            else if (i < PRM_GFFN) v = a.in[I_BR][i - PRM_BR]; else if (i < PRM_B1) v = a.in[I_GFFN][i - PRM_GFFN]; else if (i < PRM_B2) v = a.in[I_B1][i - PRM_B1]; else v = a.in[I_B2][i - PRM_B2];
            prm[i] = v;
        }
    }
    const float* mod = (const float*)(a.ws + WS_MOD); const float* g = a.in[I_GATTN];
    for (int m = gw; m < TA; m += NGW) {
        const float* xr; int mv;
        if (m < T) { xr = a.in[I_X] + (size_t)m * DM; mv = m >> 13; } else { xr = a.in[I_CTX] + (size_t)(m - T) * DM; mv = 4; }
        const float* sh = mod + mv * 6144; const float* sc = sh + 1024;
        f32x4 v[4]; float ss = 0.f;
#pragma unroll
        for (int j = 0; j < 4; ++j) { v[j] = *(const GAS f32x4*)(xr + j * 256 + lane * 4); ss += (v[j].x * v[j].x + v[j].y * v[j].y) + (v[j].z * v[j].z + v[j].w * v[j].w); }
        const float rstd = rsqrtf(wave_sum(ss) * (1.f / DM) + EPS);
        bf16_t* hr = (bf16_t*)(a.ws + WS_H) + (size_t)m * DM;
#pragma unroll
        for (int j = 0; j < 4; ++j) { const int c = j * 256 + lane * 4; const f32x4 gg = *(const GAS f32x4*)(g + c), s1 = *(const GAS f32x4*)(sc + c), s0 = *(const GAS f32x4*)(sh + c);
            const f32x4 o = (v[j] * rstd * gg) * (s1 + 1.f) + s0; u32x2 w; w.x = pk2(o.x, o.y); w.y = pk2(o.z, o.w); *(GAS u32x2*)(hr + c) = w; }
    }
}

#define MOE_ITEM(it_, P_, D_, N_) do { constexpr int I_1 = 16 * 64, I_2 = 16 * 32; \
    const bool up_ = (it_) < 32 * I_1; const int r_ = up_ ? (it_) : (it_) - 32 * I_1; N_ = up_ ? 2048 : 1024; const int per_ = up_ ? I_1 : I_2, e_ = r_ / per_, item_ = r_ % per_; \
    const int nblk_ = N_ / 32, kb_ = item_ / nblk_, nb_ = item_ % nblk_, k0_ = 64 * kb_, n0_ = 32 * nb_; \
    P_ = (up_ ? a.in[I_W1] : a.in[I_W2]) + (size_t)e_ * 1024 * N_ + (size_t)(k0_ + (lane >> 5)) * N_ + n0_ + (lane & 31); \
    D_ = a.ws + (up_ ? WS_W1 : WS_W2) + (size_t)e_ * N_ * 1024 + (size_t)n0_ * 1024 + k0_; } while (0)
__device__ __forceinline__ void moe_convert(const Args& a, LAS unsigned char* lds, int it0, int itstep, int itend) {
    const int tid = tid_of(a.wv), lane = tid & 63, wave = tid >> 6;
    LAS float* scr = (LAS float*)(lds + wave * 16384);
    const int NIT = itend;
    __syncthreads();
    float wc[32], wn[32];
    int it = it0 + wave;
    if (it >= NIT) { __syncthreads(); return; }
    const float* pc; unsigned char* dc; int nc;
    MOE_ITEM(it, pc, dc, nc);
#pragma unroll
    for (int i = 0; i < 32; ++i) wc[i] = pc[(size_t)(2 * i) * nc];
#pragma unroll 1
    while (it < NIT) {
        const int itn = it + itstep; const bool more = itn < NIT;
        const float* pn; unsigned char* dn; int nn; const int itx = more ? itn : it;
        MOE_ITEM(itx, pn, dn, nn);
        if (more) {
#pragma unroll
            for (int i = 0; i < 32; ++i) wn[i] = pn[(size_t)(2 * i) * nn]; }
#pragma unroll
        for (int i = 0; i < 32; ++i) { const int kk = 2 * i + (lane >> 5); scr[kk * 33 + (lane & 31)] = wc[i]; }
        LDS_WAIT();
        const int c = lane & 7;
#pragma unroll
        for (int j = 0; j < 4; ++j) { const int n = (lane >> 3) + 8 * j; const LAS float* s_ = scr + (8 * c) * 33 + n;
            u32x2 o; o.x = cvt4_fp8(s_[0 * 33] * WSCALE, s_[1 * 33] * WSCALE, s_[2 * 33] * WSCALE, s_[3 * 33] * WSCALE); o.y = cvt4_fp8(s_[4 * 33] * WSCALE, s_[5 * 33] * WSCALE, s_[6 * 33] * WSCALE, s_[7 * 33] * WSCALE);
            *(GAS u32x2*)(dc + (size_t)n * 1024 + 8 * c) = o; }
        LDS_WAIT();
#pragma unroll
        for (int i = 0; i < 32; ++i) wc[i] = wn[i];
        dc = dn; it = itn;
    }
    __syncthreads();
}
#undef MOE_ITEM

struct GUnit { const bf16_t* Bt; int m0, n0, nvalid, e; };
template <class RowFn, class Epi>
__device__ __forceinline__ void gemm_tile(LAS unsigned char* lds, const bf16_t* A, int K, const GUnit& u, const RowFn& rowfn, const Epi& epi) {
    LAS bf16_t* sA = (LAS bf16_t*)lds;
    LAS bf16_t* sB = (LAS bf16_t*)(lds + 256 * 72 * 2);
    const int tid = opaque((int)threadIdx.x), lane = tid & 63, wave = tid >> 6, wm = wave >> 1, wn = wave & 1;
    const int ch = tid & 7, r0 = tid >> 3;
    const bf16_t* ap[4]; const bf16_t* bp[2];
#pragma unroll
    for (int i = 0; i < 4; ++i) { const int r = r0 + 64 * i; const int rr = r < u.nvalid ? r : 0; ap[i] = A + (size_t)rowfn(u, rr) * K + ch * 8; }
#pragma unroll
    for (int i = 0; i < 2; ++i) bp[i] = u.Bt + (size_t)(r0 + 64 * i) * K + ch * 8;
    f32x4 acc[4][4];
#pragma unroll
    for (int i = 0; i < 4; ++i)
#pragma unroll
        for (int j = 0; j < 4; ++j) acc[i][j] = (f32x4){0.f, 0.f, 0.f, 0.f};
    u32x4 ra[4], rb[2];
#pragma unroll
    for (int i = 0; i < 4; ++i) ra[i] = *(const GAS u32x4*)(ap[i]);
#pragma unroll
    for (int i = 0; i < 2; ++i) rb[i] = *(const GAS u32x4*)(bp[i]);
    const int nk = K / 64;
    for (int kt = 0; kt < nk; ++kt) {
        __syncthreads();
#pragma unroll
        for (int i = 0; i < 4; ++i) *(LAS u32x4*)(sA + (r0 + 64 * i) * 72 + ch * 8) = ra[i];
#pragma unroll
        for (int i = 0; i < 2; ++i) *(LAS u32x4*)(sB + (r0 + 64 * i) * 72 + ch * 8) = rb[i];
        __syncthreads();
        if (kt + 1 < nk) {
#pragma unroll
            for (int i = 0; i < 4; ++i) ra[i] = *(const GAS u32x4*)(ap[i] + (kt + 1) * 64);
#pragma unroll
            for (int i = 0; i < 2; ++i) rb[i] = *(const GAS u32x4*)(bp[i] + (kt + 1) * 64);
        }
        mma_ll<4, 4, true>(acc, sA, 72, wm * 64, sB, 72, wn * 64, 64, lane);
    }
    epi(acc, u, wm, wn, lane);
}
struct RowDense { __device__ __forceinline__ int operator()(const GUnit& u, int r) const { return u.m0 + r; } };
struct RowPairTok { const unsigned* list; __device__ __forceinline__ int operator()(const GUnit& u, int r) const { return (int)(list[(size_t)u.e * 32768 + u.m0 + r] >> 2); } };
struct RowPair { const unsigned* list; __device__ __forceinline__ int operator()(const GUnit& u, int r) const { return (int)list[(size_t)u.e * 32768 + u.m0 + r]; } };

struct EpiP { bf16_t* P;
    __device__ __forceinline__ void operator()(const f32x4 (&acc)[4][4], const GUnit& u, int wm, int wn, int lane) const {
        const int fr = lane & 15, fq = lane >> 4;
#pragma unroll
        for (int i = 0; i < 4; ++i) { const int row = u.m0 + wm * 64 + 16 * i + fr;
#pragma unroll
            for (int j = 0; j < 4; ++j) { const int col = u.n0 + wn * 64 + 16 * j + 4 * fq; u32x2 w; w.x = pk2(acc[i][j][0], acc[i][j][1]); w.y = pk2(acc[i][j][2], acc[i][j][3]);
                *(GAS u32x2*)(P + (size_t)row * DINP + col) = w; } }
    } };
struct EpiOut { const float* x; const float* mod; float* out;
    __device__ __forceinline__ void operator()(const f32x4 (&acc)[4][4], const GUnit& u, int wm, int wn, int lane) const {
        const int fr = lane & 15, fq = lane >> 4;
#pragma unroll
        for (int i = 0; i < 4; ++i) { const int row = u.m0 + wm * 64 + 16 * i + fr; const float* gate = mod + (row >> 13) * 6144 + 2 * 1024;
#pragma unroll
            for (int j = 0; j < 4; ++j) { const int col = u.n0 + wn * 64 + 16 * j + 4 * fq;
                const f32x4 xv = *(const GAS f32x4*)(x + (size_t)row * DM + col), gv = *(const GAS f32x4*)(gate + col);
                *(GAS f32x4*)(out + (size_t)row * DM + col) = xv + gv * acc[i][j]; } }
    } };
struct EpiM1 { const unsigned* list; const float* b1; bf16_t* act;
    __device__ __forceinline__ void operator()(const f32x4 (&acc)[4][4], const GUnit& u, int wm, int wn, int lane) const {
        const int fr = lane & 15, fq = lane >> 4;
#pragma unroll
        for (int i = 0; i < 4; ++i) { const int r = wm * 64 + 16 * i + fr; if (r >= u.nvalid) continue;
            const unsigned pair = list[(size_t)u.e * 32768 + u.m0 + r];
#pragma unroll
            for (int j = 0; j < 4; ++j) { const int col = u.n0 + wn * 64 + 16 * j + 4 * fq; const f32x4 bv = *(const GAS f32x4*)(b1 + (size_t)u.e * 2048 + col);
                const f32x4 v = acc[i][j] + bv;
                const float g0 = fminf(v[0], 7.f), l0 = fminf(fmaxf(v[1], -7.f), 7.f), g1 = fminf(v[2], 7.f), l1 = fminf(fmaxf(v[3], -7.f), 7.f);
                const float a0 = g0 / (1.f + __expf(-1.702f * g0)) * (l0 + 1.f), a1 = g1 / (1.f + __expf(-1.702f * g1)) * (l1 + 1.f);
                *(GAS unsigned*)(act + (size_t)pair * DFF + (col >> 1)) = pk2(a0, a1); } }
    } };
struct EpiM2 { const unsigned* list; const float* b2; const float* pg; bf16_t* y;
    __device__ __forceinline__ void operator()(const f32x4 (&acc)[4][4], const GUnit& u, int wm, int wn, int lane) const {
        const int fr = lane & 15, fq = lane >> 4;
#pragma unroll
        for (int i = 0; i < 4; ++i) { const int r = wm * 64 + 16 * i + fr; if (r >= u.nvalid) continue;
            const unsigned pair = list[(size_t)u.e * 32768 + u.m0 + r]; const float g = pg[pair];
#pragma unroll
            for (int j = 0; j < 4; ++j) { const int col = u.n0 + wn * 64 + 16 * j + 4 * fq; const f32x4 bv = *(const GAS f32x4*)(b2 + (size_t)u.e * 1024 + col);
                const f32x4 v = (acc[i][j] + bv) * g; u32x2 w; w.x = pk2(v[0], v[1]); w.y = pk2(v[2], v[3]);
                *(GAS u32x2*)(y + (size_t)pair * DM + col) = w; } }
    } };

namespace pg8 {
constexpr int BM = 256, BK = 64, HALF = 128, HTB = HALF * BK * 2, STAGE_BYTES = 8 * HTB, NXCD = 8, WGM = 8;
__host__ __device__ __forceinline__ int lds_byte(int r, int c) { const int st = (r >> 4) * 2 + (c >> 5), rr = r & 15, cc = c & 31, ob = rr * 64 + cc * 2; return st * 1024 + (ob ^ (((ob >> 9) & 1) << 5)); }
__host__ __device__ __forceinline__ void stage_rc(int b, int& R, int& C) { const int st = b / 1024, sb = b % 1024, swz = sb ^ (((sb >> 9) & 1) << 5); R = (st >> 1) * 16 + swz / 64; C = (st & 1) * 32 + (swz % 64) / 2; }
__host__ __device__ __forceinline__ int perm32(int rho) { const int n = rho >> 4, i = rho & 15; return 8 * (i >> 2) + 4 * n + (i & 3); }
struct Unit { int pm, pn; const char* A; const char* B; int e, nvalid, ul; };
struct DenseOrder {
    int nM, nN, nwg, G, c; const char* A; const char* B; size_t tstep;
    __device__ void init(const void* A_, const void* B_, int M, int N, int K, int G_, int c_) { nM = M / BM; nN = N / BM; nwg = nM * nN; G = G_; c = c_; A = (const char*)A_; B = (const char*)B_; tstep = (size_t)BM * K * 2; }
    __device__ bool next(int i, Unit& u) const {
        const long L = (long)i * G + c; if (L >= nwg) return false;
        int wgid = (int)L; { const int q = nwg / NXCD, r = nwg % NXCD, xcd = wgid % NXCD, off = wgid / NXCD; wgid = (xcd < r ? xcd * (q + 1) : r * (q + 1) + (xcd - r) * q) + off; }
        const int nig = WGM * nN, gid = wgid / nig, fm = gid * WGM, gsz = (nM - fm) < WGM ? (nM - fm) : WGM;
        u.pm = fm + ((wgid % nig) % gsz); u.pn = (wgid % nig) / gsz; u.A = A + (size_t)u.pm * tstep; u.B = B + (size_t)u.pn * tstep; u.e = 0; u.nvalid = 256; u.ul = 0; return true;
    }
};
template <int NCT> struct ExpertOrder {
    const LAS int* pre; int G, c; const char* A; const char* W; size_t wstride; int rowbytes;
    __device__ bool next(int i, Unit& u) const {
        const int L = i * G + c; const int nunit = pre[32] * NCT; if (L >= nunit) return false;
        const int ti = L / NCT; u.pn = L % NCT; int e = 0;
        for (int k = 1; k < 32; ++k) if (pre[k] <= ti) e = k;
        u.pm = ti - pre[e]; u.e = e; const int cnt = pre[33 + e]; u.nvalid = (cnt - u.pm * 256) < 256 ? (cnt - u.pm * 256) : 256; u.ul = i;
        u.A = A; u.B = W + (size_t)e * wstride + (size_t)u.pn * 256 * rowbytes; return true;
    }
};
__device__ __forceinline__ unsigned cvt_pk_bf16(float lo, float hi) { unsigned r; asm volatile("v_cvt_pk_bf16_f32 %0, %1, %2" : "=v"(r) : "v"(lo), "v"(hi)); return r; }
typedef int i32x4 __attribute__((ext_vector_type(4))); typedef int i32x8 __attribute__((ext_vector_type(8)));
__device__ __forceinline__ bf16x8 lo8(i32x8 v) { return __builtin_bit_cast(bf16x8, (i32x4)__builtin_shufflevector(v, v, 0, 1, 2, 3)); }
__device__ __forceinline__ bf16x8 hi8(i32x8 v) { return __builtin_bit_cast(bf16x8, (i32x4)__builtin_shufflevector(v, v, 4, 5, 6, 7)); }

template <class Epi, class Sched, bool GATHER, bool FP8 = false>
__device__ __forceinline__ void gemm_phase(LAS unsigned char* lds, const LAS int* tab, const LAS bf16_t* aux, int ashift, int K, const Sched& S, const Epi& E, int wv) {
    const int tid = tid_of(wv), wid = wv, lane = tid & 63, wr = wid >> 2, wc = wid & 3, fr = lane & 15, fq = lane >> 4;
    const int nt = K / BK;
    unsigned voffA[2], voffB[2]; unsigned cb0 = 0; int rg0 = 0;
#pragma unroll
    for (int i = 0; i < 2; ++i) { int R, C; stage_rc(tid * 16 + i * 8192, R, C); const int Rb = (R & ~31) + perm32(R & 31);
        voffA[i] = (unsigned)(R * K + C) * 2u; voffB[i] = (unsigned)(Rb * K + C) * 2u; if (i == 0) { cb0 = (unsigned)C * 2u; rg0 = R; } }
    const size_t kstep = (size_t)(BK * 2);
    const size_t hstep = (size_t)HALF * K * 2;
    const size_t hstepA = GATHER ? 0 : hstep;
    const unsigned ldsw = (unsigned)wid * 1024u;
    const int aoff = lds_byte(wr * 64 + fr, fq * 8), boff = lds_byte(wc * 32 + fr, fq * 8);
    int cul = 0, nul = 0;
#define PG8_SA(b, h) (((b) * 2 + (h)) * HTB)
#define PG8_SB(b, h) ((4 + (b) * 2 + (h)) * HTB)
#define PG8_STAGE(bufoff, gbase, voff) do { _Pragma("unroll") for (int _i = 0; _i < 2; ++_i) \
        __builtin_amdgcn_global_load_lds((const unsigned*)((const char*)(gbase) + (voff)[_i]), (LAS unsigned*)(lds + (bufoff) + ldsw + _i * 8192), 16, 0, 0); } while (0)
#define PG8_STAGE_A(bufoff, gbase, h, usenext) do { const int ulx_ = (usenext) ? nul : cul; _Pragma("unroll") for (int _i = 0; _i < 2; ++_i) { \
        unsigned vo_; if constexpr (GATHER) vo_ = (unsigned)(tab[ulx_ * 256 + (h) * 128 + rg0 + 64 * _i] >> ashift) * (unsigned)(K * 2) + cb0; else vo_ = voffA[_i]; \
        __builtin_amdgcn_global_load_lds((const unsigned*)((const char*)(gbase) + (h) * hstepA + vo_), (LAS unsigned*)(lds + (bufoff) + ldsw + _i * 8192), 16, 0, 0); } } while (0)
#define PG8_LDA(dst, b, h) do { _Pragma("unroll") for (int m = 0; m < 4; ++m) { const i32x4 lo_ = *(const LAS i32x4*)(lds + PG8_SA(b, h) + aoff + m * 2048), hi_ = *(const LAS i32x4*)(lds + PG8_SA(b, h) + aoff + m * 2048 + 1024); \
        dst[m] = __builtin_shufflevector(lo_, hi_, 0, 1, 2, 3, 4, 5, 6, 7); } } while (0)
#define PG8_LDB(dst, b, h) do { _Pragma("unroll") for (int n = 0; n < 2; ++n) { const i32x4 lo_ = *(const LAS i32x4*)(lds + PG8_SB(b, h) + boff + n * 2048), hi_ = *(const LAS i32x4*)(lds + PG8_SB(b, h) + boff + n * 2048 + 1024); \
        dst[n] = __builtin_shufflevector(lo_, hi_, 0, 1, 2, 3, 4, 5, 6, 7); } } while (0)
#define PG8_MMA(ai, bj, At, Bt) do { __builtin_amdgcn_s_setprio(1); _Pragma("unroll") for (int m = 0; m < 4; ++m) _Pragma("unroll") for (int n = 0; n < 2; ++n) { \
        if constexpr (FP8) { asm("v_mfma_f32_16x16x128_f8f6f4 %0, %1, %2, %0" : "+v"(acc[ai][bj][m][n]) : "v"(Bt[n]), "v"(At[m])); } \
        else { acc[ai][bj][m][n] = __builtin_amdgcn_mfma_f32_16x16x32_bf16(lo8(Bt[n]), lo8(At[m]), acc[ai][bj][m][n], 0, 0, 0); \
               acc[ai][bj][m][n] = __builtin_amdgcn_mfma_f32_16x16x32_bf16(hi8(Bt[n]), hi8(At[m]), acc[ai][bj][m][n], 0, 0, 0); } } \
        __builtin_amdgcn_s_setprio(0); } while (0)
#define PG8_WAIT_V(n) asm volatile("s_waitcnt vmcnt(" #n ")" ::: "memory")
#define PG8_WAIT_L(n) asm volatile("s_waitcnt lgkmcnt(" #n ")" ::: "memory")
#define PG8_BAR __builtin_amdgcn_s_barrier()
#define PG8_SCHED __builtin_amdgcn_sched_barrier(0)
    Unit cur, nxt; int ui = 0;
    if (!S.next(0, cur)) return;
    cul = cur.ul; nul = cur.ul;
    f32x4 acc[2][2][4][2];
#pragma unroll
    for (int a = 0; a < 2; ++a)
#pragma unroll
        for (int b = 0; b < 2; ++b)
#pragma unroll
            for (int m = 0; m < 4; ++m)
#pragma unroll
                for (int n = 0; n < 2; ++n) acc[a][b][m][n] = (f32x4){0.f, 0.f, 0.f, 0.f};
    i32x8 At[4], B0[2], B1[2];
    const char* cA = cur.A; const char* cB = cur.B;
    PG8_STAGE(PG8_SB(0, 0), cB, voffB); PG8_STAGE(PG8_SB(0, 1), cB + hstep, voffB); PG8_STAGE_A(PG8_SA(0, 0), cA, 0, false); PG8_STAGE_A(PG8_SA(0, 1), cA, 1, false);
    if (wr == 1) PG8_BAR;
    PG8_WAIT_V(2); PG8_BAR;
    PG8_STAGE(PG8_SB(1, 0), cB + kstep, voffB); PG8_STAGE_A(PG8_SA(1, 0), cA + kstep, 0, false); PG8_STAGE(PG8_SB(1, 1), cB + hstep + kstep, voffB);
    PG8_WAIT_V(6); PG8_BAR;
    for (;;) {
        const bool has_next = S.next(ui + 1, nxt);
        const char* nA = has_next ? nxt.A : cA; const char* nB = has_next ? nxt.B : cB;
        nul = has_next ? nxt.ul : cur.ul;
#if DIAG >= 10
        long long tk0_ = 0; if (DIAG == 10 + Epi::ID && ui == 0) tk0_ = (long long)__builtin_amdgcn_s_memtime();
        if (DIAG == 20 + Epi::ID && ui <= 1) { const long long tn_ = (long long)__builtin_amdgcn_s_memtime();
            if (ui == 0) { if (blockIdx.x == 0 && tid == 0) { ((volatile LAS unsigned*)(lds + 159744))[41] = (unsigned)tn_; } }
            else if (blockIdx.x == 0 && tid == 0) { const unsigned d_ = (unsigned)tn_ - ((volatile LAS unsigned*)(lds + 159744))[41]; const float q = rintf((float)d_ * (1.f / 1000.f));
                ((volatile LAS unsigned*)(lds + 159744))[40] = __float_as_uint(q * 1e-5f); } }
#endif
#pragma unroll 1
        for (int t = 0; t < nt; t += 2) {
            const bool last = (t == nt - 2);
            const char* a1 = cA + (size_t)(t + 1) * kstep;
            const char* a2 = last ? nA : cA + (size_t)(t + 2) * kstep; const char* b2 = last ? nB : cB + (size_t)(t + 2) * kstep;
            const char* a3 = a2 + kstep; const char* b3 = b2 + kstep;
            PG8_LDB(B0, 0, 0); PG8_LDB(B1, 0, 1); PG8_SCHED; PG8_LDA(At, 0, 0); PG8_STAGE_A(PG8_SA(1, 1), a1, 1, false);
            PG8_WAIT_V(8); PG8_WAIT_L(0); PG8_BAR; PG8_MMA(0, 0, At, B0); PG8_MMA(0, 1, At, B1); PG8_BAR; PG8_SCHED;
            PG8_LDA(At, 0, 1); PG8_STAGE(PG8_SB(0, 0), b2, voffB); PG8_STAGE(PG8_SB(0, 1), b2 + hstep, voffB); PG8_STAGE_A(PG8_SA(0, 0), a2, 0, last);
            PG8_WAIT_V(8); PG8_WAIT_L(0); PG8_BAR; PG8_MMA(1, 0, At, B0); PG8_MMA(1, 1, At, B1); PG8_BAR; PG8_SCHED;
            PG8_LDB(B0, 1, 0); PG8_LDB(B1, 1, 1); PG8_SCHED; PG8_LDA(At, 1, 0); PG8_STAGE_A(PG8_SA(0, 1), a2, 1, last);
            PG8_WAIT_V(8); PG8_WAIT_L(0); PG8_BAR; PG8_MMA(0, 0, At, B0); PG8_MMA(0, 1, At, B1); PG8_BAR; PG8_SCHED;
            PG8_LDA(At, 1, 1); PG8_STAGE(PG8_SB(1, 0), b3, voffB); PG8_STAGE(PG8_SB(1, 1), b3 + hstep, voffB); PG8_STAGE_A(PG8_SA(1, 0), a3, 0, last);
            PG8_WAIT_V(8); PG8_WAIT_L(0); PG8_BAR; PG8_MMA(1, 0, At, B0); PG8_MMA(1, 1, At, B1); PG8_BAR; PG8_SCHED;
        }
#if DIAG >= 10
        if (DIAG == 10 + Epi::ID && ui == 0) { const long long tk1_ = (long long)__builtin_amdgcn_s_memtime();
            if (blockIdx.x == 0 && tid == 0) { const float perk = (float)(tk1_ - tk0_) / (float)nt; const float q = rintf(perk * (1.f / 250.f));
                ((volatile LAS unsigned*)(lds + 159744))[40] = __float_as_uint(q * 2e-5f); } }
#endif
        if (wr == 0) PG8_BAR;
        if constexpr (FP8) asm volatile("s_nop 15\n\ts_nop 7" ::: "memory");
        E(acc, cur, tab, aux, wr, wc, fr, fq);
        if (!has_next) break;
#pragma unroll
        for (int a = 0; a < 2; ++a)
#pragma unroll
            for (int b = 0; b < 2; ++b)
#pragma unroll
                for (int m = 0; m < 4; ++m)
#pragma unroll
                    for (int n = 0; n < 2; ++n) acc[a][b][m][n] = (f32x4){0.f, 0.f, 0.f, 0.f};
        cur = nxt; cA = nA; cB = nB; ++ui;
        cul = cur.ul;
        if (wr == 1) PG8_BAR;
    }
    PG8_WAIT_V(0);
    PG8_BAR;
#undef PG8_SA
#undef PG8_SB
#undef PG8_STAGE
#undef PG8_STAGE_A
#undef PG8_LDA
#undef PG8_LDB
#undef PG8_MMA
#undef PG8_WAIT_V
#undef PG8_WAIT_L
#undef PG8_BAR
#undef PG8_SCHED
}

struct EpiP { static constexpr int ID = 2; bf16_t* P;
    __device__ __forceinline__ void operator()(const f32x4 (&acc)[2][2][4][2], const Unit& u, const LAS int*, const LAS bf16_t*, int wr, int wc, int fr, int fq) const {
        const int row0 = u.pm * BM + wr * 64 + fr, col0 = u.pn * BM + wc * 32 + 8 * fq;
#pragma unroll
        for (int ai = 0; ai < 2; ++ai)
#pragma unroll
            for (int m = 0; m < 4; ++m) { bf16_t* rowp = P + (size_t)(row0 + ai * HALF + m * 16) * DINP + col0;
#pragma unroll
                for (int bj = 0; bj < 2; ++bj) { const f32x4 v0 = acc[ai][bj][m][0], v1 = acc[ai][bj][m][1]; u32x4 w;
                    w.x = cvt_pk_bf16(v0[0], v0[1]); w.y = cvt_pk_bf16(v0[2], v0[3]); w.z = cvt_pk_bf16(v1[0], v1[1]); w.w = cvt_pk_bf16(v1[2], v1[3]);
                    *(GAS u32x4*)(rowp + bj * HALF) = w; } }
    } };
struct EpiOut { static constexpr int ID = 6; const float* x; const float* mod; float* out;
    __device__ __forceinline__ void operator()(const f32x4 (&acc)[2][2][4][2], const Unit& u, const LAS int*, const LAS bf16_t*, int wr, int wc, int fr, int fq) const {
        const int row0 = u.pm * BM + wr * 64 + fr, col0 = u.pn * BM + wc * 32 + 8 * fq;
        const float* gate = mod + (row0 >> 13) * 6144 + 2 * 1024;
#pragma unroll
        for (int bj = 0; bj < 2; ++bj) { const f32x4 g0 = *(const GAS f32x4*)(gate + col0 + bj * HALF), g1 = *(const GAS f32x4*)(gate + col0 + bj * HALF + 4);
#pragma unroll
            for (int ai = 0; ai < 2; ++ai)
#pragma unroll
                for (int m = 0; m < 4; ++m) { const size_t off = (size_t)(row0 + ai * HALF + m * 16) * DM + col0 + bj * HALF;
                    const f32x4 x0 = *(const GAS f32x4*)(x + off), x1 = *(const GAS f32x4*)(x + off + 4);
                    *(GAS f32x4*)(out + off) = x0 + g0 * acc[ai][bj][m][0]; *(GAS f32x4*)(out + off + 4) = x1 + g1 * acc[ai][bj][m][1]; } }
    } };
typedef _Float16 h2_t __attribute__((ext_vector_type(2))); typedef short s2_t __attribute__((ext_vector_type(2)));
struct EpiM1 { static constexpr int ID = 8; unsigned char* act;
    __device__ __forceinline__ void operator()(const f32x4 (&acc)[2][2][4][2], const Unit& u, const LAS int* tab, const LAS bf16_t* aux, int wr, int wc, int fr, int fq) const {
        const int cl = wc * 32 + 8 * fq, col0 = u.pn * BM + cl;
        h2_t bg[2][2], bl[2][2];
#pragma unroll
        for (int bj = 0; bj < 2; ++bj) { const u32x4 w = *(const LAS u32x4*)(aux + u.ul * 256 + bj * HALF + cl);
#pragma unroll
            for (int n = 0; n < 2; ++n) { bg[bj][n] = (h2_t){(_Float16)lo16(w[2 * n]), (_Float16)lo16(w[2 * n + 1])}; bl[bj][n] = (h2_t){(_Float16)hi16(w[2 * n]), (_Float16)hi16(w[2 * n + 1])}; } }
        const h2_t winv = {(_Float16)WINV, (_Float16)WINV}, seven = {(_Float16)7.f, (_Float16)7.f}, one = {(_Float16)1.f, (_Float16)1.f}, cexp = {(_Float16)-2.4554669595930156f, (_Float16)-2.4554669595930156f};
#pragma unroll
        for (int ai = 0; ai < 2; ++ai)
#pragma unroll
            for (int m = 0; m < 4; ++m) { const int r = ai * HALF + wr * 64 + m * 16 + fr; const bool ok = r < u.nvalid;
                const int pair = tab[u.ul * 256 + r]; unsigned char* rowp = act + (size_t)pair * DFF + (col0 >> 1);
#pragma unroll
                for (int bj = 0; bj < 2; ++bj) { s2_t pk = {0, 0};
#pragma unroll
                    for (int n = 0; n < 2; ++n) { const f32x4 v = acc[ai][bj][m][n];
                        h2_t g = __builtin_bit_cast(h2_t, __builtin_amdgcn_cvt_pkrtz(v[0], v[2])), l = __builtin_bit_cast(h2_t, __builtin_amdgcn_cvt_pkrtz(v[1], v[3]));
                        g = g * winv + bg[bj][n]; l = l * winv + bl[bj][n];
                        g = __builtin_elementwise_min(g, seven); l = __builtin_elementwise_min(__builtin_elementwise_max(l, -seven), seven);
                        const h2_t e = __builtin_elementwise_exp2(g * cexp);
                        const h2_t d = e + one; const h2_t rc = {(_Float16)__builtin_amdgcn_rcph(d[0]), (_Float16)__builtin_amdgcn_rcph(d[1])};
                        const h2_t o = (g * rc) * (l + one);
                        pk = n == 0 ? __builtin_amdgcn_cvt_scalef32_pk_fp8_f16(pk, o, 1.0f, false) : __builtin_amdgcn_cvt_scalef32_pk_fp8_f16(pk, o, 1.0f, true); }
                    if (ok) *(GAS unsigned*)(rowp + bj * (HALF / 2)) = __builtin_bit_cast(unsigned, pk); } }
    } };
constexpr float YSCALE = 8.f, YINV = 1.f / 8.f;
struct EpiM2 { static constexpr int ID = 9; unsigned char* y;
    __device__ __forceinline__ void operator()(const f32x4 (&acc)[2][2][4][2], const Unit& u, const LAS int* tab, const LAS bf16_t* aux, int wr, int wc, int fr, int fq) const {
        const int cl = wc * 32 + 8 * fq, col0 = u.pn * BM + cl;
        f32x4 bv[2][2];
#pragma unroll
        for (int bj = 0; bj < 2; ++bj) { const u32x4 w = *(const LAS u32x4*)(aux + u.ul * 256 + bj * HALF + cl);
            bv[bj][0] = (f32x4){lo16(w[0]), hi16(w[0]), lo16(w[1]), hi16(w[1])}; bv[bj][1] = (f32x4){lo16(w[2]), hi16(w[2]), lo16(w[3]), hi16(w[3])}; }
#pragma unroll
        for (int ai = 0; ai < 2; ++ai)
#pragma unroll
            for (int m = 0; m < 4; ++m) { const int r = ai * HALF + wr * 64 + m * 16 + fr; const bool ok = r < u.nvalid;
                const int pair = tab[u.ul * 256 + r]; const float g = bf2f(aux[9 * 256 + u.ul * 256 + r]) * YSCALE; unsigned char* rowp = y + (size_t)pair * DM + col0;
#pragma unroll
                for (int bj = 0; bj < 2; ++bj) { const f32x4 v0 = (acc[ai][bj][m][0] * WINV + bv[bj][0]) * g, v1 = (acc[ai][bj][m][1] * WINV + bv[bj][1]) * g; u32x2 w;
                    w.x = cvt4_fp8(v0[0], v0[1], v0[2], v0[3]); w.y = cvt4_fp8(v1[0], v1[1], v1[2], v1[3]);
                    if (ok) *(GAS u32x2*)(rowp + bj * HALF) = w; } }
    } };
}
constexpr int PG8_TAB_OFF = pg8::STAGE_BYTES;
constexpr int PG8_AUX_OFF = PG8_TAB_OFF + 18 * 1024;
constexpr int PG8_PRE_OFF = PG8_AUX_OFF + 9 * 1024;
static_assert(PG8_PRE_OFF + 512 <= LDS_SCRATCH, "LDS map");

template <int NCT, class Epi>
__device__ __forceinline__ void phase_moe_pg8(const Args& a, LAS unsigned char* lds, const unsigned char* A, int ashift, const unsigned char* Wt, size_t wstride, const float* bias, int nbias, const float* gates, const Epi& E) {
    LAS int* tab = (LAS int*)(lds + PG8_TAB_OFF); LAS int* pre = (LAS int*)(lds + PG8_PRE_OFF); LAS bf16_t* aux = (LAS bf16_t*)(lds + PG8_AUX_OFF);
    const unsigned* cnt = (const unsigned*)(a.ws + WS_CTL) + CW_CNT; const unsigned* list = (const unsigned*)(a.ws + WS_LIST);
    __syncthreads();
    const int tidm = tid_of(a.wv);
    if (tidm < NE) pre[33 + tidm] = (int)__hip_atomic_load(cnt + 64 * tidm, __ATOMIC_RELAXED, __HIP_MEMORY_SCOPE_AGENT);
    __syncthreads();
    if (tidm == 0) { int s = 0;
#pragma unroll 1
        for (int e = 0; e < NE; ++e) { const int c = pre[33 + e]; pre[e] = s; s += (c + 255) >> 8; } pre[32] = s; }
    __syncthreads();
    const int G_ = (int)gridDim.x, bx_ = (int)blockIdx.x, vcu_ = (G_ % 8 == 0) ? (bx_ % 8) * (G_ / 8) + bx_ / 8 : bx_;
    pg8::ExpertOrder<NCT> S{pre, G_, vcu_, (const char*)A, (const char*)Wt, wstride, 1024};
    constexpr int NU = NCT == 8 ? 18 : 9; constexpr bool HASG = NCT == 4;
    const int nunit_ = pre[32] * NCT;
    unsigned val[NU]; float gv[NU];
#pragma unroll
    for (int i = 0; i < NU; ++i) { pg8::Unit u; val[i] = 0u;
        if (S.next(i, u)) { if (tidm < 256) val[i] = list[(size_t)u.e * 32768 + u.pm * 256 + (tidm < u.nvalid ? tidm : 0)]; else val[i] = __float_as_uint(bias[(size_t)u.e * nbias + u.pn * 256 + tidm - 256]); } }
#pragma unroll
    for (int i = 0; i < NU; ++i) { gv[i] = 0.f; if (HASG && tidm < 256 && i * G_ + vcu_ < nunit_) gv[i] = gates[val[i]]; }
#pragma unroll
    for (int i = 0; i < NU; ++i) if (i * G_ + vcu_ < nunit_) {
        if (tidm < 256) { tab[i * 256 + tidm] = (int)val[i]; if (HASG) aux[9 * 256 + i * 256 + tidm] = (bf16_t)f2bf(gv[i]); }
        else aux[i * 256 + tidm - 256] = (bf16_t)f2bf(__uint_as_float(val[i])); }
    __syncthreads();
    pg8::gemm_phase<Epi, pg8::ExpertOrder<NCT>, true, true>(lds, tab, aux, ashift, 512, S, E, a.wv);
}

__device__ __forceinline__ void mla_tile(const Args& a, LAS unsigned char* lds, int tile, int r0 = 0, int nrows = 128) {
    const int tid = tid_of(a.wv), lane = tid & 63, wave = a.wv, fr = lane & 15, fq = lane >> 4;
    const bool lat = tile < 256;
    const int prow0 = tile * 128;
    const int b = lat ? (prow0 >> 13) : ((prow0 - T) >> 8);
    const int tpos0 = lat ? (prow0 & 8191) : ((prow0 - T) & 255);
    const int key0 = lat ? (LC + tpos0) : tpos0;
    LAS unsigned char* Aq = lds;
    LAS unsigned char* Akv = lds + 34816;
    LAS float* kpe = (LAS float*)(lds + 34816 + 18432);
    LAS float* sspe = (LAS float*)(lds + 34816 + 18432 + 16384);
    const bf16_t* P = (const bf16_t*)(a.ws + WS_P);
    const float* tabm = (const float*)(a.ws + WS_TABM);
    __syncthreads();
    if ((tid >> 2) >= r0 && (tid >> 2) < r0 + nrows) {
        const int r = tid >> 2, part = tid & 3;
        const bf16_t* pr = P + (size_t)(prow0 + r) * DINP;
        u32x4 q[8]; float ss = 0.f;
#pragma unroll
        for (int i = 0; i < 8; ++i) { q[i] = *(const GAS u32x4*)(pr + OFF_Q + part * 64 + i * 8);
#pragma unroll
            for (int e = 0; e < 4; ++e) { const float lo = lo16(q[i][e]), hi = hi16(q[i][e]); ss += lo * lo + hi * hi; } }
        ss += __shfl_xor(ss, 1); ss += __shfl_xor(ss, 2);
        float rstd = rsqrtf(ss * (1.f / 256.f) + EPS);
        const float* gq = a.in[I_GQL] + part * 64;
#pragma unroll
        for (int i = 0; i < 8; ++i) { u32x2 o;
#pragma unroll
            for (int e = 0; e < 2; ++e) o[e] = cvt4_fp8(lo16(q[i][2 * e]) * rstd * gq[i * 8 + 4 * e], hi16(q[i][2 * e]) * rstd * gq[i * 8 + 4 * e + 1], lo16(q[i][2 * e + 1]) * rstd * gq[i * 8 + 4 * e + 2], hi16(q[i][2 * e + 1]) * rstd * gq[i * 8 + 4 * e + 3]);
            *(LAS u32x2*)(Aq + r * 272 + part * 64 + i * 8) = o; }
        u32x4 kv[4]; ss = 0.f;
#pragma unroll
        for (int i = 0; i < 4; ++i) { kv[i] = *(const GAS u32x4*)(pr + OFF_KV + part * 32 + i * 8);
#pragma unroll
            for (int e = 0; e < 4; ++e) { const float lo = lo16(kv[i][e]), hi = hi16(kv[i][e]); ss += lo * lo + hi * hi; } }
        ss += __shfl_xor(ss, 1); ss += __shfl_xor(ss, 2);
        rstd = rsqrtf(ss * (1.f / 128.f) + EPS);
        const float* gkv = a.in[I_GKVL] + part * 32;
#pragma unroll
        for (int i = 0; i < 4; ++i) { u32x2 o;
#pragma unroll
            for (int e = 0; e < 2; ++e) o[e] = cvt4_fp8(lo16(kv[i][2 * e]) * rstd * gkv[i * 8 + 4 * e], hi16(kv[i][2 * e]) * rstd * gkv[i * 8 + 4 * e + 1], lo16(kv[i][2 * e + 1]) * rstd * gkv[i * 8 + 4 * e + 2], hi16(kv[i][2 * e + 1]) * rstd * gkv[i * 8 + 4 * e + 3]);
            *(LAS u32x2*)(Akv + r * 144 + part * 32 + i * 8) = o; }
        const u32x4 pe = *(const GAS u32x4*)(pr + OFF_PE + part * 8); ss = 0.f;
#pragma unroll
        for (int e = 0; e < 4; ++e) { const float lo = lo16(pe[e]), hi = hi16(pe[e]); ss += lo * lo + hi * hi; kpe[r * 32 + part * 8 + 2 * e] = lo; kpe[r * 32 + part * 8 + 2 * e + 1] = hi; }
        ss += __shfl_xor(ss, 1); ss += __shfl_xor(ss, 2);
        if (part == 0) sspe[r] = ss;
    }
    __syncthreads();
    const int h = wave, bh = b * NH + h;
    typedef int i32x4m __attribute__((ext_vector_type(4))); typedef int i32x8m __attribute__((ext_vector_type(8)));
#define LD32G(p) __builtin_shufflevector(*(const GAS i32x4m*)(p), *(const GAS i32x4m*)((p) + 16), 0, 1, 2, 3, 4, 5, 6, 7)
#define LD32L(p) __builtin_shufflevector(*(const LAS i32x4m*)(p), *(const LAS i32x4m*)((p) + 16), 0, 1, 2, 3, 4, 5, 6, 7)
    if (lat) {
        const unsigned char* WQ = a.ws + WS_WQ + (size_t)h * QK * 256;
        const float* gqh = a.in[I_GQH];
        unsigned char* Qo = a.ws + WS_Q + ((size_t)bh * SEQ + tpos0) * QK8;
        i32x8m bq[2][6];
#pragma unroll
        for (int s2 = 0; s2 < 2; ++s2)
#pragma unroll
            for (int j = 0; j < 6; ++j) bq[s2][j] = LD32G(WQ + (size_t)(16 * j + fr) * 256 + 128 * s2 + 32 * fq);
        f32x4 gqv[6];
#pragma unroll
        for (int j = 0; j < 6; ++j) gqv[j] = *(const GAS f32x4*)(gqh + 16 * j + 4 * fq);
#pragma unroll 1
        for (int rq = 0; rq < 8; ++rq) {
            const int row = rq * 16 + fr, t = tpos0 + row;
            f32x4 csq[2][2];
#pragma unroll
            for (int ax = 0; ax < 2; ++ax) { const int pi = ax == 0 ? (t >> 6) : 128 + (t & 63); const float* cs = tabm + (pi * 8 + 4 * (fq & 1)) * 2;
                csq[ax][0] = *(const GAS f32x4*)(cs); csq[ax][1] = *(const GAS f32x4*)(cs + 4); }
            f32x4 acc[6];
#pragma unroll
            for (int j = 0; j < 6; ++j) acc[j] = (f32x4){0.f, 0.f, 0.f, 0.f};
#pragma unroll
            for (int s2 = 0; s2 < 2; ++s2) { const i32x8m af = LD32L(Aq + row * 272 + 128 * s2 + 32 * fq);
#pragma unroll
                for (int j = 0; j < 6; ++j) acc[j] = __builtin_amdgcn_mfma_scale_f32_16x16x128_f8f6f4(bq[s2][j], af, acc[j], 0, 0, 0, 0, 0, 0); }
            float ss = 0.f;
#pragma unroll
            for (int j = 0; j < 6; ++j) ss += (acc[j][0] * acc[j][0] + acc[j][1] * acc[j][1]) + (acc[j][2] * acc[j][2] + acc[j][3] * acc[j][3]);
            ss += __shfl_xor(ss, 16); ss += __shfl_xor(ss, 32);
            const float rstd = rsqrtf(ss * (1.f / 96.f) + EPS * (WQ_SCALE * WQ_SCALE)) * QSCALE;
#pragma unroll
            for (int j = 0; j < 6; ++j) {
                const int col = 16 * j + 4 * fq; const f32x4 gv = gqv[j];
                f32x4 v = acc[j] * gv * rstd;
                if (j >= 4) {
                    const int ax = j - 4;
#pragma unroll
                    for (int r = 0; r < 4; ++r) { const float other = __shfl_xor(v[r], 32); const float c = csq[ax][r >> 1][2 * (r & 1)], sn = csq[ax][r >> 1][2 * (r & 1) + 1];
                        v[r] = (fq < 2) ? (v[r] * c - other * sn) : (v[r] * c + other * sn); }
                }
                *(GAS unsigned*)(Qo + (size_t)row * QK8 + col) = cvt4_fp8(v[0], v[1], v[2], v[3]);
            }
            *(GAS u32x2*)(Qo + (size_t)row * QK8 + QK + 8 * fq) = (u32x2){0u, 0u};
        }
    }
    {
        const unsigned char* WKV = a.ws + WS_WKV + (size_t)h * 128 * 128;
        const float* gkh = a.in[I_GKH];
        unsigned char* Ko = a.ws + WS_K + ((size_t)bh * SKV + key0) * QK8;
        unsigned char* Vo = a.ws + WS_VT + (size_t)bh * DV * SKV + key0;
        i32x8m bkv[8];
#pragma unroll
        for (int j = 0; j < 8; ++j) bkv[j] = LD32G(WKV + (size_t)(16 * j + fr) * 128 + 32 * fq);
        f32x4 gkv[4]; float gp0[4], gp1[4];
#pragma unroll
        for (int j = 0; j < 4; ++j) gkv[j] = *(const GAS f32x4*)(gkh + 16 * j + 4 * fq);
#pragma unroll
        for (int r = 0; r < 4; ++r) { const int c0 = (fq >> 1) * 16 + 4 * (fq & 1) + r; gp0[r] = gkh[64 + c0]; gp1[r] = gkh[64 + c0 + 8]; }
#pragma unroll 1
        for (int rq = r0 >> 4; rq < ((r0 + nrows) >> 4); ++rq) {
            f32x4 csk[2];
            { const int t = tpos0 + rq * 16 + fr, ax = fq >> 1, pi = ax == 0 ? (t >> 6) : 128 + (t & 63); const float* cs = tabm + (pi * 8 + 4 * (fq & 1)) * 2;
              csk[0] = *(const GAS f32x4*)(cs); csk[1] = *(const GAS f32x4*)(cs + 4); }
            f32x4 acc[1][8];
#pragma unroll
            for (int i = 0; i < 1; ++i)
#pragma unroll
                for (int j = 0; j < 8; ++j) acc[i][j] = (f32x4){0.f, 0.f, 0.f, 0.f};
            { const i32x8m af = LD32L(Akv + (rq * 16 + fr) * 144 + 32 * fq);
#pragma unroll
              for (int j = 0; j < 8; ++j) acc[0][j] = __builtin_amdgcn_mfma_scale_f32_16x16x128_f8f6f4(bkv[j], af, acc[0][j], 0, 0, 0, 0, 0, 0) ; }
#pragma unroll
            for (int j = 0; j < 8; ++j) acc[0][j] = acc[0][j] * WKV_INV;
#pragma unroll
            for (int i = 0; i < 1; ++i) {
                const int row = rq * 16 + 16 * i + fr, t = tpos0 + row;
                const int kk = row & 63; const int vrow = (row & 64) + 32 * ((kk >> 2) & 1) + (kk & 3) + 4 * ((kk & 31) >> 3) + 16 * (kk >> 5);
                float ss = 0.f;
#pragma unroll
                for (int j = 0; j < 4; ++j) ss += (acc[i][j][0] * acc[i][j][0] + acc[i][j][1] * acc[i][j][1]) + (acc[i][j][2] * acc[i][j][2] + acc[i][j][3] * acc[i][j][3]);
                ss += __shfl_xor(ss, 16); ss += __shfl_xor(ss, 32);
                const float rstd = rsqrtf((ss + sspe[row]) * (1.f / 96.f) + EPS);
#pragma unroll
                for (int j = 0; j < 4; ++j) { const int col = 16 * j + 4 * fq; const f32x4 gv = gkv[j]; const f32x4 v = acc[i][j] * gv * rstd;
                    *(GAS unsigned*)(Ko + (size_t)row * QK8 + col) = cvt4_fp8(v[0], v[1], v[2], v[3]); }
                {
                    const int ax = fq >> 1, f0 = 4 * (fq & 1);
                    float o0[4], o1[4];
#pragma unroll
                    for (int r = 0; r < 4; ++r) { const int c0 = ax * 16 + f0 + r, c1 = c0 + 8;
                        const float x0 = kpe[row * 32 + c0] * rstd * gp0[r], x1 = kpe[row * 32 + c1] * rstd * gp1[r];
                        const float c = lat ? csk[r >> 1][2 * (r & 1)] : 1.f, s = lat ? csk[r >> 1][2 * (r & 1) + 1] : 0.f;
                        o0[r] = x0 * c - x1 * s; o1[r] = x1 * c + x0 * s; }
                    *(GAS unsigned*)(Ko + (size_t)row * QK8 + 64 + ax * 16 + f0) = cvt4_fp8(o0[0], o0[1], o0[2], o0[3]);
                    *(GAS unsigned*)(Ko + (size_t)row * QK8 + 64 + ax * 16 + 8 + f0) = cvt4_fp8(o1[0], o1[1], o1[2], o1[3]);
                    *(GAS u32x2*)(Ko + (size_t)row * QK8 + QK + 8 * fq) = (u32x2){0u, 0u};
                }
#pragma unroll
                for (int j = 4; j < 8; ++j)
#pragma unroll
                    for (int r = 0; r < 4; ++r) { const int d = 16 * (j - 4) + 4 * fq + r; Vo[(size_t)d * SKV + vrow] = (unsigned char)(cvt4_fp8(acc[i][j][r], 0.f, 0.f, 0.f) & 0xffu); }
            }
        }
    }
}

__device__ __forceinline__ float log_gamma(const float* logit) { const float x = *logit; return -log1pf(__expf(-x)); }

__device__ __forceinline__ void rope16(float (&out)[16], const bf16_t* rowp  , int part, const float* cs  , float scale) {
    const u32x4 a0 = *(const GAS u32x4*)(rowp + part * 16), a1 = *(const GAS u32x4*)(rowp + part * 16 + 8);
    const u32x4 b0 = *(const GAS u32x4*)(rowp + (part ^ 1) * 16), b1 = *(const GAS u32x4*)(rowp + (part ^ 1) * 16 + 8);
    float xs[16], xo[16];
#pragma unroll
    for (int e = 0; e < 4; ++e) { xs[2 * e] = lo16(a0[e]); xs[2 * e + 1] = hi16(a0[e]); xs[8 + 2 * e] = lo16(a1[e]); xs[8 + 2 * e + 1] = hi16(a1[e]);
        xo[2 * e] = lo16(b0[e]); xo[2 * e + 1] = hi16(b0[e]); xo[8 + 2 * e] = lo16(b1[e]); xo[8 + 2 * e + 1] = hi16(b1[e]); }
    if (cs) {
        const float sg = (part & 1) ? 1.f : -1.f;
#pragma unroll
        for (int q = 0; q < 8; ++q) { const f32x4 t = *(const GAS f32x4*)(cs + 4 * q);
            out[2 * q] = (xs[2 * q] * t[0] + sg * xo[2 * q] * t[1]) * scale; out[2 * q + 1] = (xs[2 * q + 1] * t[2] + sg * xo[2 * q + 1] * t[3]) * scale; }
    } else {
#pragma unroll
        for (int f = 0; f < 16; ++f) out[f] = xs[f] * scale;
    }
}

__device__ __forceinline__ void ret_local_unit(const Args& a, LAS unsigned char* lds, int unit) {
    const int tid = tid_of(a.wv), lane = tid & 63, wave = a.wv, fr = lane & 15, fq = lane >> 4;
    const int bh = unit / NSLOT, slot = unit % NSLOT, b = bh >> 2, h = bh & 3;
    const bool lat = slot >= 2;
    const int prow0 = lat ? b * SEQ + (slot - 2) * RC : T + b * LC + slot * RC;
    const int tpos0 = lat ? (slot - 2) * RC : 0;
    LAS bf16_t* KfT = (LAS bf16_t*)lds;
    LAS bf16_t* KbT = (LAS bf16_t*)(lds + 17408);
    LAS bf16_t* VT = (LAS bf16_t*)(lds + 34816);
    const bf16_t* P = (const bf16_t*)(a.ws + WS_P);
    const float* tabr = (const float*)(a.ws + WS_TABR);
    const float lgf = log_gamma(a.in[I_DECAY] + h), lgb = log_gamma(a.in[I_DECAY] + 4 + h);
    __syncthreads();
    {
        const int j = tid >> 2, part = tid & 3, t = tpos0 + j, ax = part >> 1;
        const int pi = ax == 0 ? (t >> 6) : 128 + (t & 63);
        float o[16]; rope16(o, P + (size_t)(prow0 + j) * DINP + OFF_RK + h * 64, part, lat ? tabr + pi * 32 : nullptr, 0.125f);
        const float wf = __expf(lgf * (float)(127 - j)), wb = __expf(lgb * (float)j);
#pragma unroll
        for (int f = 0; f < 16; ++f) { const int d = part * 16 + f; KfT[d * 136 + j] = (bf16_t)f2bf(o[f] * wf); KbT[d * 136 + j] = (bf16_t)f2bf(o[f] * wb); }
    }
    for (int idx = tid; idx < 128 * 16; idx += 512) {
        const int j = idx >> 4, c = idx & 15;
        const u32x4 v = *(const GAS u32x4*)(P + (size_t)(prow0 + j) * DINP + OFF_RV + h * 128 + c * 8);
#pragma unroll
        for (int e = 0; e < 4; ++e) { VT[(c * 8 + 2 * e) * 136 + j] = (bf16_t)(v[e] & 0xffffu); VT[(c * 8 + 2 * e + 1) * 136 + j] = (bf16_t)(v[e] >> 16); }
    }
    __syncthreads();
    const int dir = wave >> 2, mi = wave & 3;
    f32x4 acc[1][8];
#pragma unroll
    for (int j = 0; j < 8; ++j) acc[0][j] = (f32x4){0.f, 0.f, 0.f, 0.f};
    mma_ll<1, 8, false>(acc, dir ? KbT : KfT, 136, 16 * mi, VT, 136, 0, 128, lane);
    float* out = (float*)(a.ws + WS_LST) + ((size_t)(bh * 2 + dir) * NSLOT + slot) * 8192;
#pragma unroll
    for (int j = 0; j < 8; ++j) *(GAS f32x4*)(out + (size_t)(16 * j + fr) * 64 + 16 * mi + 4 * fq) = acc[0][j];
}

__device__ __forceinline__ void phase_ret_scan(const Args& a) {
    const int gt = blockIdx.x * 512 + tid_of(a.wv);
    if (gt >= 32 * 2048) return;
    const int bd = gt >> 11, v4 = gt & 2047, dir = bd & 1, h = (bd >> 1) & 3;
    const float lg = log_gamma(a.in[I_DECAY] + dir * 4 + h);
    const float g = __expf(lg * 128.f);
    float* base = (float*)(a.ws + WS_LST) + (size_t)bd * NSLOT * 8192 + v4 * 4;
    f32x4 S = (f32x4){0.f, 0.f, 0.f, 0.f};
#pragma unroll 1
    for (int bt = 0; bt < 5; ++bt) {
        f32x4 L[13];
#pragma unroll
        for (int q = 0; q < 13; ++q) { const int n = bt * 13 + q; const int slot = dir == 0 ? n : (n == 0 ? 1 : (n == 1 ? 0 : 67 - n)); L[q] = *(const GAS f32x4*)(base + (size_t)slot * 8192); }
#pragma unroll
        for (int q = 0; q < 13; ++q) { const int n = bt * 13 + q; const int slot = dir == 0 ? n : (n == 0 ? 1 : (n == 1 ? 0 : 67 - n)); S = S * g + L[q]; *(GAS f32x4*)(base + (size_t)slot * 8192) = S; }
    }
}

__device__ __forceinline__ void ret_out_unit(const Args& a, LAS unsigned char* lds, int unit) {
    const int tid = tid_of(a.wv), lane = tid & 63, wave = a.wv, fr = lane & 15, fq = lane >> 4;
    const int bh = unit >> 6, c = unit & 63, b = bh >> 2, h = bh & 3;
    const int prow0 = b * SEQ + c * RC, tpos0 = c * RC;
    LAS bf16_t* Qs = (LAS bf16_t*)lds;
    LAS bf16_t* Ks = (LAS bf16_t*)(lds + 18432);
    LAS bf16_t* VT = (LAS bf16_t*)(lds + 36864);
    LAS bf16_t* SfT = (LAS bf16_t*)(lds + 71680);
    LAS bf16_t* SbT = (LAS bf16_t*)(lds + 90112);
    LAS bf16_t* Ws = (LAS bf16_t*)(lds + 108544);
    const bf16_t* P = (const bf16_t*)(a.ws + WS_P);
    const float* tabr = (const float*)(a.ws + WS_TABR);
    const float lgf = log_gamma(a.in[I_DECAY] + h), lgb = log_gamma(a.in[I_DECAY] + 4 + h);
    __syncthreads();
    {
        const int j = tid >> 2, part = tid & 3, t = tpos0 + j, ax = part >> 1;
        const int pi = ax == 0 ? (t >> 6) : 128 + (t & 63);
        float oq[16], ok[16];
        rope16(oq, P + (size_t)(prow0 + j) * DINP + OFF_RQ + h * 64, part, tabr + pi * 32, 1.f);
        rope16(ok, P + (size_t)(prow0 + j) * DINP + OFF_RK + h * 64, part, tabr + pi * 32, 0.125f);
        u32x4 w0, w1;
        w0 = (u32x4){pk2(oq[0], oq[1]), pk2(oq[2], oq[3]), pk2(oq[4], oq[5]), pk2(oq[6], oq[7])}; w1 = (u32x4){pk2(oq[8], oq[9]), pk2(oq[10], oq[11]), pk2(oq[12], oq[13]), pk2(oq[14], oq[15])};
        *(LAS u32x4*)(Qs + j * 72 + part * 16) = w0; *(LAS u32x4*)(Qs + j * 72 + part * 16 + 8) = w1;
        w0 = (u32x4){pk2(ok[0], ok[1]), pk2(ok[2], ok[3]), pk2(ok[4], ok[5]), pk2(ok[6], ok[7])}; w1 = (u32x4){pk2(ok[8], ok[9]), pk2(ok[10], ok[11]), pk2(ok[12], ok[13]), pk2(ok[14], ok[15])};
        *(LAS u32x4*)(Ks + j * 72 + part * 16) = w0; *(LAS u32x4*)(Ks + j * 72 + part * 16 + 8) = w1;
    }
    for (int idx = tid; idx < 128 * 16; idx += 512) {
        const int j = idx >> 4, cch = idx & 15;
        const u32x4 v = *(const GAS u32x4*)(P + (size_t)(prow0 + j) * DINP + OFF_RV + h * 128 + cch * 8);
#pragma unroll
        for (int e = 0; e < 4; ++e) { VT[(cch * 8 + 2 * e) * 136 + j] = (bf16_t)(v[e] & 0xffffu); VT[(cch * 8 + 2 * e + 1) * 136 + j] = (bf16_t)(v[e] >> 16); }
    }
    {
        const float* sf = (const float*)(a.ws + WS_LST) + ((size_t)(bh * 2 + 0) * NSLOT + (c + 1)) * 8192;
        const float* sb = (const float*)(a.ws + WS_LST) + ((size_t)(bh * 2 + 1) * NSLOT + (c == 63 ? 0 : c + 3)) * 8192;
        for (int idx = tid; idx < 2048; idx += 512) {
            const int e = idx >> 4, d = (idx & 15) * 4;
            const f32x4 x = *(const GAS f32x4*)(sf + idx * 4), y = *(const GAS f32x4*)(sb + idx * 4);
            u32x2 w; w.x = pk2(x[0], x[1]); w.y = pk2(x[2], x[3]); *(LAS u32x2*)(SfT + e * 72 + d) = w;
            w.x = pk2(y[0], y[1]); w.y = pk2(y[2], y[3]); *(LAS u32x2*)(SbT + e * 72 + d) = w;
        }
    }
    __syncthreads();
    const int i0 = 16 * wave, irow = i0 + fr;
    f32x4 accS[1][8], accF[1][8], accB[1][8], accO[1][8];
#pragma unroll
    for (int j = 0; j < 8; ++j) { accS[0][j] = (f32x4){0.f, 0.f, 0.f, 0.f}; accF[0][j] = accS[0][j]; accB[0][j] = accS[0][j]; accO[0][j] = accS[0][j]; }
    mma_ll<1, 8, true>(accS, Qs, 72, i0, Ks, 72, 0, 64, lane);
    mma_ll<1, 8, true>(accF, Qs, 72, i0, SfT, 72, 0, 64, lane);
    mma_ll<1, 8, true>(accB, Qs, 72, i0, SbT, 72, 0, 64, lane);
#pragma unroll
    for (int j = 0; j < 8; ++j) {
        float w[4];
#pragma unroll
        for (int r = 0; r < 4; ++r) { const int jj = 16 * j + 4 * fq + r; const int df = irow - jj;
            const float dec = df > 0 ? __expf(lgf * (float)df) : (df < 0 ? __expf(lgb * (float)(-df)) : 2.f);
            w[r] = accS[0][j][r] * dec; }
        u32x2 pw; pw.x = pk2(w[0], w[1]); pw.y = pk2(w[2], w[3]);
        *(LAS u32x2*)(Ws + irow * 136 + 16 * j + 4 * fq) = pw;
    }
    LDS_WAIT(); __builtin_amdgcn_wave_barrier();
    mma_ll<1, 8, true>(accO, Ws, 136, i0, VT, 136, 0, 128, lane);
    const float wf = __expf(lgf * (float)(irow + 1)), wb = __expf(lgb * (float)(128 - irow));
    float ss = 0.f;
#pragma unroll
    for (int j = 0; j < 8; ++j) { accO[0][j] = accO[0][j] + accF[0][j] * wf + accB[0][j] * wb;
        ss += (accO[0][j][0] * accO[0][j][0] + accO[0][j][1] * accO[0][j][1]) + (accO[0][j][2] * accO[0][j][2] + accO[0][j][3] * accO[0][j][3]); }
    ss += __shfl_xor(ss, 16); ss += __shfl_xor(ss, 32);
    const float rstd = rsqrtf(ss * (1.f / 128.f) + EPS);
    const float* gro = a.in[I_GRET] + h * 128;
    const bf16_t* pg = P + (size_t)(prow0 + irow) * DINP + OFF_RG + h * 128;
    bf16_t* mix = (bf16_t*)(a.ws + WS_MIX) + (size_t)(prow0 + irow) * DM + 512 + h * 128;
#pragma unroll
    for (int j = 0; j < 8; ++j) { const int e = 16 * j + 4 * fq; const f32x4 gv = *(const GAS f32x4*)(gro + e); const u32x2 gw = *(const GAS u32x2*)(pg + e);
        const float g0 = lo16(gw.x), g1 = hi16(gw.x), g2 = lo16(gw.y), g3 = hi16(gw.y);
        f32x4 v = accO[0][j] * gv * rstd;
        v[0] *= g0 / (1.f + __expf(-g0)); v[1] *= g1 / (1.f + __expf(-g1)); v[2] *= g2 / (1.f + __expf(-g2)); v[3] *= g3 / (1.f + __expf(-g3));
        u32x2 w; w.x = pk2(v[0], v[1]); w.y = pk2(v[2], v[3]); *(GAS u32x2*)(mix + e) = w; }
}

namespace att {
constexpr int KLD8 = 144  , VLD8 = 80  , KBUF = 64 * KLD8, VBUF = 64 * VLD8, NKB = 3, NVB = 4;
constexpr int L_K = 0, L_V = NKB * KBUF, L_WS = NKB * KBUF + NVB * VBUF;
__device__ __forceinline__ int crow(int r, int hi) { return (r & 3) + 8 * (r >> 2) + 4 * hi; }
typedef __bf16 bf16x2_t __attribute__((ext_vector_type(2))); typedef float f32x2_t __attribute__((ext_vector_type(2)));
__device__ __forceinline__ unsigned cvtpk(float lo, float hi) { f32x2_t v = {lo, hi}; bf16x2_t b = __builtin_convertvector(v, bf16x2_t); return __builtin_bit_cast(unsigned, b); }
#define SBAR() __builtin_amdgcn_sched_barrier(0)
typedef int i32x4 __attribute__((ext_vector_type(4))); typedef int i32x8 __attribute__((ext_vector_type(8)));
constexpr float PSHIFT = 2.f;
template <bool SHIFT>
__device__ __forceinline__ i32x8 softmax_pack8(f32x16& p0, f32x16& p1, float negm) {
    const float sh = negm + 8.f - PSHIFT;
#pragma unroll
    for (int r = 0; r < 16; ++r) { p0[r] = __builtin_amdgcn_exp2f(SHIFT ? p0[r] + sh : p0[r]); p1[r] = __builtin_amdgcn_exp2f(SHIFT ? p1[r] + sh : p1[r]); }
    i32x8 w;
#pragma unroll
    for (int q = 0; q < 4; ++q) { w[q] = (int)cvt4_fp8(p0[4 * q], p0[4 * q + 1], p0[4 * q + 2], p0[4 * q + 3]); w[4 + q] = (int)cvt4_fp8(p1[4 * q], p1[4 * q + 1], p1[4 * q + 2], p1[4 * q + 3]); }
    return w;
}
template <bool SHIFT>
__device__ __forceinline__ void unit64(const Args& a, LAS unsigned char* lds, int bh, int qb, float negm) {
    const int wid = sopaque(a.wv), tid = tid_of(wid), lane = tid & 63, r32 = lane & 31, hi = lane >> 5;
    const unsigned char* QwA = a.ws + WS_Q + ((size_t)bh * SEQ + qb * 512 + wid * 64 + r32) * QK8 + hi * 32;
    const unsigned char* Kh = a.ws + WS_K + (size_t)bh * SKV * QK8;
    const unsigned char* Vh = a.ws + WS_VT + (size_t)bh * DV * SKV;
    LAS unsigned char* Kl = lds + L_K; LAS unsigned char* Vl = lds + L_V;
    LAS float* wsf = (LAS float*)(lds + L_WS) + wid * 64;
    i32x8 qA8[2], qB8[2];
#pragma unroll
    for (int s2 = 0; s2 < 2; ++s2) { const i32x4 a0_ = *(const GAS i32x4*)(QwA + 64 * s2), a1_ = *(const GAS i32x4*)(QwA + 64 * s2 + 16), b0_ = *(const GAS i32x4*)(QwA + 32 * QK8 + 64 * s2), b1_ = *(const GAS i32x4*)(QwA + 32 * QK8 + 64 * s2 + 16);
        qA8[s2] = __builtin_shufflevector(a0_, a1_, 0, 1, 2, 3, 4, 5, 6, 7); qB8[s2] = __builtin_shufflevector(b0_, b1_, 0, 1, 2, 3, 4, 5, 6, 7); }
    unsigned soff[2]; int dsto[2];
#pragma unroll
    for (int m = 0; m < 2; ++m) { const int j = (wid + 8 * m) < 14 ? wid + 8 * m : wid + 8 * m - 8;
        if (j < 9) { const int p = j * 64 + lane, row = p / 9, c = p % 9; soff[m] = (unsigned)(row * QK8 + (c < 8 ? c : 7) * 16); dsto[m] = L_K + j * 1024; }
        else { const int jv = j - 9, p = jv * 64 + lane, d = p / 5, c = p % 5; soff[m] = (unsigned)(d * SKV + (c < 4 ? c : 3) * 16); dsto[m] = L_V + jv * 1024; } }
    const char* Kb = (const char*)Kh; const char* Vb = (const char*)Vh;
#define DMA(t, kslot, vslot) do { _Pragma("unroll") for (int pm_ = 0; pm_ < 2; ++pm_) { const int j_ = (wid + 8 * pm_) < 14 ? wid + 8 * pm_ : wid + 8 * pm_ - 8; { \
        const char* src_ = (j_ < 9 ? Kb + (size_t)(t) * (64 * QK8) : Vb + (size_t)(t) * 64) + soff[pm_]; \
        __builtin_amdgcn_global_load_lds((const unsigned*)src_, (LAS unsigned*)(lds + dsto[pm_] + (j_ < 9 ? (kslot) * KBUF : (vslot) * VBUF)), 16, 0, 0); } } } while (0)
    i32x8 ones8;
#pragma unroll
    for (int q = 0; q < 8; ++q) ones8[q] = r32 == 0 ? 0x38383838 : 0;
    f32x16 oA[2], oB[2], sA, sB;
#pragma unroll
    for (int r = 0; r < 16; ++r) { oA[0][r] = 0.f; oA[1][r] = 0.f; oB[0][r] = 0.f; oB[1][r] = 0.f; sA[r] = 0.f; sB[r] = 0.f; }
    constexpr int NT = SKV / 64;
    __syncthreads();
    DMA(0, 0, 0); DMA(1, 1, 1); __syncthreads();
#ifndef ATT_STAGGER
#define ATT_STAGGER 0
#endif
    const bool late = ATT_STAGGER && wid >= 4;
#define TILE_BAR(more) do { if (more) asm volatile("s_waitcnt vmcnt(2) lgkmcnt(0)\n\ts_barrier" ::: "memory"); else asm volatile("s_waitcnt vmcnt(0) lgkmcnt(0)\n\ts_barrier" ::: "memory"); } while (0)
    int ks = 0, vs = 0;
    for (int i = 0; i < NT; ++i) {
        const bool more = i + 2 < NT;
        if (more) DMA(i + 2, (ks == 0 ? 2 : ks - 1), ((vs + 2) & 3));
        SBAR();
        f32x16 pA0, pA1, pB0, pB1;
#pragma unroll
        for (int r = 0; r < 16; ++r) { pA0[r] = PSHIFT; pA1[r] = PSHIFT; pB0[r] = PSHIFT; pB1[r] = PSHIFT; }
        const LAS unsigned char* Ks = Kl + ks * KBUF + r32 * KLD8 + 32 * hi;
#pragma unroll
        for (int s2 = 0; s2 < 2; ++s2) {
            const i32x4 c0_ = *(const LAS i32x4*)(Ks + 64 * s2), c1_ = *(const LAS i32x4*)(Ks + 64 * s2 + 16), d0_ = *(const LAS i32x4*)(Ks + 32 * KLD8 + 64 * s2), d1_ = *(const LAS i32x4*)(Ks + 32 * KLD8 + 64 * s2 + 16);
            const i32x8 k0 = __builtin_shufflevector(c0_, c1_, 0, 1, 2, 3, 4, 5, 6, 7), k1 = __builtin_shufflevector(d0_, d1_, 0, 1, 2, 3, 4, 5, 6, 7);
            pA0 = __builtin_amdgcn_mfma_scale_f32_32x32x64_f8f6f4(k0, qA8[s2], pA0, 0, 0, 0, 0, 0, 0); pB0 = __builtin_amdgcn_mfma_scale_f32_32x32x64_f8f6f4(k0, qB8[s2], pB0, 0, 0, 0, 0, 0, 0);
            pA1 = __builtin_amdgcn_mfma_scale_f32_32x32x64_f8f6f4(k1, qA8[s2], pA1, 0, 0, 0, 0, 0, 0); pB1 = __builtin_amdgcn_mfma_scale_f32_32x32x64_f8f6f4(k1, qB8[s2], pB1, 0, 0, 0, 0, 0, 0);
        }
        SBAR();
        if (late) TILE_BAR(more);
        const LAS unsigned char* Vs = Vl + vs * VBUF + r32 * VLD8 + 32 * hi;
        const i32x4 e0_ = *(const LAS i32x4*)(Vs), e1_ = *(const LAS i32x4*)(Vs + 16), f0_ = *(const LAS i32x4*)(Vs + 32 * VLD8), f1_ = *(const LAS i32x4*)(Vs + 32 * VLD8 + 16);
        const i32x8 v0 = __builtin_shufflevector(e0_, e1_, 0, 1, 2, 3, 4, 5, 6, 7), v1 = __builtin_shufflevector(f0_, f1_, 0, 1, 2, 3, 4, 5, 6, 7);
        { const i32x8 pa = softmax_pack8<SHIFT>(pA0, pA1, negm);
          oA[0] = __builtin_amdgcn_mfma_scale_f32_32x32x64_f8f6f4(pa, v0, oA[0], 0, 0, 0, 0, 0, 0); oA[1] = __builtin_amdgcn_mfma_scale_f32_32x32x64_f8f6f4(pa, v1, oA[1], 0, 0, 0, 0, 0, 0);
          sA = __builtin_amdgcn_mfma_scale_f32_32x32x64_f8f6f4(pa, ones8, sA, 0, 0, 0, 0, 0, 0); }
        { const i32x8 pa = softmax_pack8<SHIFT>(pB0, pB1, negm);
          oB[0] = __builtin_amdgcn_mfma_scale_f32_32x32x64_f8f6f4(pa, v0, oB[0], 0, 0, 0, 0, 0, 0); oB[1] = __builtin_amdgcn_mfma_scale_f32_32x32x64_f8f6f4(pa, v1, oB[1], 0, 0, 0, 0, 0, 0);
          sB = __builtin_amdgcn_mfma_scale_f32_32x32x64_f8f6f4(pa, ones8, sB, 0, 0, 0, 0, 0, 0); }
        SBAR();
        if (!late) TILE_BAR(more);
        ks = ks == 2 ? 0 : ks + 1; vs = (vs + 1) & 3;
    }
#undef DMA
#undef TILE_BAR
    if (r32 == 0) {
#pragma unroll
        for (int r = 0; r < 16; ++r) { wsf[crow(r, hi)] = sA[r]; wsf[32 + crow(r, hi)] = sB[r]; } }
    LDS_WAIT(); __builtin_amdgcn_wave_barrier();
    const int b = bh >> 3, h = bh & 7;
    const int lz = opaque(lane), r32z = lz & 31, hiz = lz >> 5;
    bf16_t* Ow = (bf16_t*)(a.ws + WS_MIX) + ((size_t)b * SEQ + qb * 512 + wid * 64) * DM + h * DV;
    const unsigned ooff = (unsigned)(4 * hiz * DM + r32z);
#pragma unroll
    for (int r = 0; r < 16; ++r) { const int orow = crow(r, hiz); const float rlA = 1.f / wsf[orow], rlB = 1.f / wsf[32 + orow];
        const unsigned off = ooff + (unsigned)(((r & 3) + 8 * (r >> 2)) * DM);
        Ow[off] = (bf16_t)f2bf(oA[0][r] * rlA); Ow[off + 32] = (bf16_t)f2bf(oA[1][r] * rlA);
        Ow[off + 32 * DM] = (bf16_t)f2bf(oB[0][r] * rlB); Ow[off + 32 * DM + 32] = (bf16_t)f2bf(oB[1][r] * rlB); }
}
#undef SBAR
}


#if DIAG == 5
__device__ __forceinline__ void attn_selfcheck(const Args& a, LAS unsigned char* lds) {
    const int tid = tid_of(a.wv);
    LAS float* red = (LAS float*)lds;
    __syncthreads();
    if (blockIdx.x == 0) {
        const int row = tid >> 3, ds = (tid & 7) * 8;
        const unsigned char* q = a.ws + WS_Q + (size_t)row * QK8; const unsigned char* K = a.ws + WS_K; const unsigned char* V = a.ws + WS_VT;
        float qf[96];
        float acc[8] = {0.f, 0.f, 0.f, 0.f, 0.f, 0.f, 0.f, 0.f}; float l = 0.f;
        for (int key = 0; key < SKV; ++key) {
            float s = 0.f;
            for (int c = 0; c < 96; c += 4) { const int kw = *(const GAS int*)(K + (size_t)key * QK8 + c), qw = *(const GAS int*)(q + c);
                s += __builtin_amdgcn_cvt_f32_fp8(kw, 0) * __builtin_amdgcn_cvt_f32_fp8(qw, 0) + __builtin_amdgcn_cvt_f32_fp8(kw, 1) * __builtin_amdgcn_cvt_f32_fp8(qw, 1)
                   + __builtin_amdgcn_cvt_f32_fp8(kw, 2) * __builtin_amdgcn_cvt_f32_fp8(qw, 2) + __builtin_amdgcn_cvt_f32_fp8(kw, 3) * __builtin_amdgcn_cvt_f32_fp8(qw, 3); }
            const float p = exp2f(s);
            const int kk = key & 63, pos = (key & ~63) + 32 * ((kk >> 2) & 1) + (kk & 3) + 4 * ((kk & 31) >> 3) + 16 * (kk >> 5);
            l += p;
#pragma unroll
            for (int e = 0; e < 8; ++e) { const int w = V[(size_t)(ds + e) * SKV + pos]; acc[e] += p * __builtin_amdgcn_cvt_f32_fp8(w, 0); }
        }
        (void)qf;
        float emax = 0.f, omax = 0.f;
        const bf16_t* mix = (const bf16_t*)(a.ws + WS_MIX) + (size_t)row * DM + ds;
#pragma unroll
        for (int e = 0; e < 8; ++e) { const float o = acc[e] / l; emax = fmaxf(emax, fabsf(o - bf2f(mix[e]))); omax = fmaxf(omax, fabsf(o)); }
        red[tid] = emax; red[512 + tid] = omax;
        __syncthreads();
        if (tid == 0) { float e = 0.f, o = 0.f; for (int i = 0; i < 512; ++i) { e = fmaxf(e, red[i]); o = fmaxf(o, red[512 + i]); }
            ((unsigned*)(a.ws + WS_CTL))[CW_DIAG] = __float_as_uint(e / o * 0.1f); }
    }
    __syncthreads();
}
#endif

__device__ __forceinline__ void phase_router(const Args& a, LAS unsigned char* lds) {
    const int tid = tid_of(a.wv), lane = tid & 63, wave = a.wv, fr = lane & 15, fq = lane >> 4;
    LAS bf16_t* Ah = (LAS bf16_t*)lds;
    LAS bf16_t* Al = (LAS bf16_t*)(lds + 33024);
    LAS float* red = (LAS float*)(lds + 66048);
    LAS int* hist = (LAS int*)(lds + 66048 + 16384);
    LAS int* base = hist + 32;
    LAS int* pk_e = base + 32;
    LAS int* pk_r = pk_e + 512;
    LAS int* pk_p = pk_r + 512;
    const float* mod = (const float*)(a.ws + WS_MOD); const float* g = a.in[I_GFFN];
    const bf16_t* WR = (const bf16_t*)(a.ws + WS_WR);
    unsigned char* HF = a.ws + WS_HF;
    float* PG = (float*)(a.ws + WS_PG);
    unsigned* cnt = (unsigned*)(a.ws + WS_CTL) + CW_CNT;
    unsigned* list = (unsigned*)(a.ws + WS_LIST);
    LAS float* lg = (LAS float*)(pk_p + 512);
    bf16x8 bh[4][2], bl[4][2];
#pragma unroll
    for (int ks = 0; ks < 4; ++ks)
#pragma unroll
        for (int j = 0; j < 2; ++j) { bh[ks][j] = *(const GAS bf16x8*)(WR + (size_t)(16 * j + fr) * 1024 + wave * 128 + 32 * ks + 8 * fq); bl[ks][j] = *(const GAS bf16x8*)(WR + 32768 + (size_t)(16 * j + fr) * 1024 + wave * 128 + 32 * ks + 8 * fq); }
    for (int tile = blockIdx.x; tile < T / 128; tile += gridDim.x) {
        __syncthreads();
        if (tid < 32) hist[tid] = 0;
        f32x4 v[2][4];
#pragma unroll
        for (int rr = 0; rr < 2; ++rr) { const float* xr = a.out + (size_t)(tile * 128 + wave * 2 + rr) * DM;
#pragma unroll
            for (int j = 0; j < 4; ++j) v[rr][j] = *(const GAS f32x4*)(xr + j * 256 + lane * 4); }
#pragma unroll 1
        for (int it = 0; it < 8; ++it) {
            const int tok0 = tile * 128 + it * 16;
#pragma unroll
            for (int rr = 0; rr < 2; ++rr) {
                const int row = wave * 2 + rr, tok = tok0 + row;
                const float* sh = mod + (tok >> 13) * 6144 + 3 * 1024; const float* sc = sh + 1024;
                float ss = 0.f;
#pragma unroll
                for (int j = 0; j < 4; ++j) ss += (v[rr][j].x * v[rr][j].x + v[rr][j].y * v[rr][j].y) + (v[rr][j].z * v[rr][j].z + v[rr][j].w * v[rr][j].w);
                const float rstd = rsqrtf(wave_sum(ss) * (1.f / DM) + EPS);
#pragma unroll
                for (int j = 0; j < 4; ++j) { const int c = j * 256 + lane * 4; const f32x4 gg = *(const GAS f32x4*)(g + c), s1 = *(const GAS f32x4*)(sc + c), s0 = *(const GAS f32x4*)(sh + c);
                    const f32x4 o = (v[rr][j] * rstd * gg) * (s1 + 1.f) + s0;
                    const unsigned h0 = f2bf(o.x), h1 = f2bf(o.y), h2 = f2bf(o.z), h3 = f2bf(o.w);
                    u32x2 wh; wh.x = h0 | (h1 << 16); wh.y = h2 | (h3 << 16);
                    u32x2 wl; wl.x = pk2(o.x - bf2f((bf16_t)h0), o.y - bf2f((bf16_t)h1)); wl.y = pk2(o.z - bf2f((bf16_t)h2), o.w - bf2f((bf16_t)h3));
                    *(GAS unsigned*)(HF + (size_t)tok * DM + c) = cvt4_fp8(o.x, o.y, o.z, o.w);
                    *(LAS u32x2*)(Ah + row * 1032 + c) = wh; *(LAS u32x2*)(Al + row * 1032 + c) = wl; }
            }
            if (it < 7) {
#pragma unroll
                for (int rr = 0; rr < 2; ++rr) { const float* xr = a.out + (size_t)(tok0 + 16 + wave * 2 + rr) * DM;
#pragma unroll
                    for (int j = 0; j < 4; ++j) v[rr][j] = *(const GAS f32x4*)(xr + j * 256 + lane * 4); } }
            __syncthreads();
            {
                f32x4 acc[2]; acc[0] = (f32x4){0.f, 0.f, 0.f, 0.f}; acc[1] = acc[0];
#pragma unroll
                for (int ks = 0; ks < 4; ++ks) { const bf16x8 ah = *(const LAS bf16x8*)(Ah + fr * 1032 + wave * 128 + 32 * ks + 8 * fq), al = *(const LAS bf16x8*)(Al + fr * 1032 + wave * 128 + 32 * ks + 8 * fq);
#pragma unroll
                    for (int j = 0; j < 2; ++j) { acc[j] = __builtin_amdgcn_mfma_f32_16x16x32_bf16(ah, bh[ks][j], acc[j], 0, 0, 0); acc[j] = __builtin_amdgcn_mfma_f32_16x16x32_bf16(al, bh[ks][j], acc[j], 0, 0, 0);
                        acc[j] = __builtin_amdgcn_mfma_f32_16x16x32_bf16(ah, bl[ks][j], acc[j], 0, 0, 0); } }
#pragma unroll
                for (int j = 0; j < 2; ++j)
#pragma unroll
                    for (int r = 0; r < 4; ++r) red[(wave * 16 + 4 * fq + r) * 32 + 16 * j + fr] = acc[j][r];
            }
            __syncthreads();
            { const int tk = tid >> 5, e = tid & 31; float sl = a.in[I_BR][e];
#pragma unroll
              for (int w = 0; w < 8; ++w) sl += red[(w * 16 + tk) * 32 + e];
              lg[tk * 32 + e] = sl; }
            __syncthreads();
            if (tid < 16) {
                const int tok = tok0 + tid;
                float best[4]; int bi[4];
#pragma unroll
                for (int k = 0; k < 4; ++k) { best[k] = -3.0e38f; bi[k] = 0; }
                for (int e = 0; e < 32; ++e) {
                    const float s = lg[tid * 32 + e];
                    if (s > best[3]) {
                        if (s > best[0]) { best[3] = best[2]; bi[3] = bi[2]; best[2] = best[1]; bi[2] = bi[1]; best[1] = best[0]; bi[1] = bi[0]; best[0] = s; bi[0] = e; }
                        else if (s > best[1]) { best[3] = best[2]; bi[3] = bi[2]; best[2] = best[1]; bi[2] = bi[1]; best[1] = s; bi[1] = e; }
                        else if (s > best[2]) { best[3] = best[2]; bi[3] = bi[2]; best[2] = s; bi[2] = e; }
                        else { best[3] = s; bi[3] = e; }
                    }
                }
                const float e1 = __expf(best[1] - best[0]), e2 = __expf(best[2] - best[0]), e3 = __expf(best[3] - best[0]);
                const float inv = 1.f / (1.f + e1 + e2 + e3);
                const float gk[4] = {inv, e1 * inv, e2 * inv, e3 * inv};
#pragma unroll
                for (int k = 0; k < 4; ++k) { const int slot = (it * 16 + tid) * 4 + k; const int rk = __hip_atomic_fetch_add(hist + bi[k], 1, __ATOMIC_RELAXED, __HIP_MEMORY_SCOPE_WORKGROUP);
                    pk_e[slot] = bi[k]; pk_r[slot] = rk; pk_p[slot] = tok * 4 + k; PG[tok * 4 + k] = gk[k]; }
            }
        }
        __syncthreads();
        if (tid < 32) base[tid] = (int)__hip_atomic_fetch_add(cnt + 64 * tid, (unsigned)hist[tid], __ATOMIC_RELAXED, __HIP_MEMORY_SCOPE_AGENT);
        __syncthreads();
        { const int e = pk_e[tid]; list[(size_t)e * 32768 + base[e] + pk_r[tid]] = (unsigned)pk_p[tid]; }
    }
}

__device__ __forceinline__ void phase_combine(const Args& a) {
    const int tid = tid_of(a.wv), lane = tid & 63, wave = tid >> 6;
    const int gw = blockIdx.x * 8 + wave, NGW = gridDim.x * 8;
    const float* mod = (const float*)(a.ws + WS_MOD);
    const unsigned char* Y = a.ws + WS_Y;
#if DIAG == 1
    const float dz = 0.1f;
#elif DIAG >= 2
    const float dz = sqrtf(__uint_as_float(__hip_atomic_load((unsigned*)(a.ws + WS_CTL) + CW_DIAG, __ATOMIC_RELAXED, __HIP_MEMORY_SCOPE_AGENT)));
#else
    const float dz = 0.f;
#endif
    for (int tok = gw; tok < T; tok += NGW) {
        const float* gate = mod + (tok >> 13) * 6144 + 5 * 1024;
        float* orow = a.out + (size_t)tok * DM;
#pragma unroll
        for (int j = 0; j < 4; ++j) { const int c = j * 256 + lane * 4;
            f32x4 s = (f32x4){0.f, 0.f, 0.f, 0.f};
#pragma unroll
            for (int k = 0; k < 4; ++k) { const int w = *(const GAS int*)(Y + ((size_t)tok * 4 + k) * DM + c);
                s[0] += __builtin_amdgcn_cvt_f32_fp8(w, 0); s[1] += __builtin_amdgcn_cvt_f32_fp8(w, 1); s[2] += __builtin_amdgcn_cvt_f32_fp8(w, 2); s[3] += __builtin_amdgcn_cvt_f32_fp8(w, 3); }
            s = s * pg8::YINV;
            const f32x4 xv = *(const GAS f32x4*)(orow + c), gv = *(const GAS f32x4*)(gate + c);
            *(GAS f32x4*)(orow + c) = xv + gv * s + dz; }
    }
}

constexpr int N_PHASES = 11;
constexpr int MOE_IT_ALL = 32 * (16 * 64 + 16 * 32), MOE_IT_P2 = 224 * 8 * 6;
__global__ void __launch_bounds__(512, 2) fwd_kernel(Args a0) {
    Args a;
    extern __shared__ __attribute__((aligned(16))) unsigned char lds_raw[];
    LAS unsigned char* lds = (LAS unsigned char*)lds_raw;
    volatile LAS unsigned* MISC = (volatile LAS unsigned*)(lds + LDS_MISC);
    const int wv0 = __builtin_amdgcn_readfirstlane((int)threadIdx.x >> 6);
    const int tid = threadIdx.x;
    if (tid < 64) MISC[tid] = 0u;
    __syncthreads();
    const int lo = sopaque(a0.ph_lo), hi = sopaque(a0.ph_hi);
#define use_bar ((hi - lo) > 1)
    XcdBarrier bar; bar.bar = (unsigned*)(a0.ws + WS_CTL) + CW_BAR; bar.x = 0; bar.st = MISC + 8;
    bar.wv = wv0;
    if (use_bar) bar = xcd_barrier_post((unsigned*)(a0.ws + WS_CTL) + CW_BAR, MISC + 8, wv0);
    const int G = sopaque((int)gridDim.x), bx = sopaque((int)blockIdx.x);
    const int vcu = (G % 8 == 0) ? (bx % 8) * (G / 8) + bx / 8 : bx;
#ifndef ONLY_PHASE
#define ONLY_PHASE -1
#endif
#ifndef PHASE_MASK
#define PHASE_MASK 0x7ff
#endif
#define IN(k) (lo <= (k) && (k) < hi && (ONLY_PHASE < 0 || ONLY_PHASE == (k)) && ((PHASE_MASK >> (k)) & 1))
#if DIAG >= 40
    unsigned long long tprev_ = __builtin_amdgcn_s_memrealtime();
#define TSTAMP(k) do { const unsigned long long tn_ = __builtin_amdgcn_s_memrealtime(); if (DIAG - 40 == (k) && blockIdx.x == 0 && tid == 0) MISC[40] = __float_as_uint(rintf((float)(tn_ - tprev_) * (1.f / 1000.f)) * 1e-5f); tprev_ = tn_; } while (0)
#else
#define TSTAMP(k) do { } while (0)
#endif
#define SEAM(k) do { if ((k) == 9) TSTAMP(k); if ((k) == 9 && DIAG >= 10 && blockIdx.x == 0 && tid == 0) __hip_atomic_store((unsigned*)(a0.ws + WS_CTL) + CW_DIAG, MISC[40], __ATOMIC_RELAXED, __HIP_MEMORY_SCOPE_AGENT); \
        if (use_bar && (k) + 1 < hi) xcd_barrier(bar); if ((k) != 9) TSTAMP(k); } while (0)
#ifndef REPEAT_MASK
#define REPEAT_MASK 0
#endif
#define REP(k) for (int rep_ = 0; rep_ <= ((REPEAT_MASK >> (k)) & 1); ++rep_)
    a = a0; a.wv = wv0;
    if (IN(0)) { phase_mod(a, lds); SEAM(0); }
    REP(1) if (IN(1)) { phase_prep(a, lds); SEAM(1); }
    {
        float* prm = (float*)(a0.ws + WS_PRM);
        a.ws = a0.ws; a.out = a0.out; a.in[I_X] = a0.in[I_X]; a.wv = wv0;
        a.in[I_GQL] = prm + PRM_GQL; a.in[I_GKVL] = prm + PRM_GKVL; a.in[I_GQH] = prm + PRM_GQH; a.in[I_GKH] = prm + PRM_GKH; a.in[I_DECAY] = prm + PRM_DECAY;
        a.in[I_GRET] = prm + PRM_GRET; a.in[I_BR] = prm + PRM_BR; a.in[I_GFFN] = prm + PRM_GFFN; a.in[I_B1] = prm + PRM_B1; a.in[I_B2] = prm + PRM_B2;
    }
    REP(2) if (IN(2)) {
        pg8::DenseOrder S; S.init(a.ws + WS_H, a.ws + WS_WIN, TA, DINP, 1024, G, bx);
        pg8::EpiP E{(bf16_t*)(a.ws + WS_P)};
        pg8::gemm_phase<pg8::EpiP, pg8::DenseOrder, false>(lds, nullptr, nullptr, 0, 1024, S, E, a.wv);
        if (G == 256 && bx >= 32) moe_convert(a, lds, (bx - 32) * 8, 224 * 8, MOE_IT_P2);
        SEAM(2);
    }
    REP(3) if (IN(3)) {
        if (G == 256) {
            int u0, nu;
            if (bx < 32) { u0 = 3 * bx; nu = 3; }
            else { const int c = bx - 32; u0 = 96 + 4 * c + (c < 64 ? c : 64); nu = 4 + (c < 64 ? 1 : 0); }
            for (int k2 = 0; k2 < (bx < 32 ? 2 : 1); ++k2) mla_tile(a, lds, k2 ? 256 + (bx >> 2) : bx, k2 ? 32 * (bx & 3) : 0, k2 ? 32 : 128);
            for (int u = u0; u < u0 + nu; ++u) ret_local_unit(a, lds, u);
        } else { for (int t = bx; t < TA / 128; t += G) mla_tile(a, lds, t); for (int u = bx; u < 16 * NSLOT; u += G) ret_local_unit(a, lds, u); }
        SEAM(3);
    }
    if (IN(4)) { phase_ret_scan(a); SEAM(4); }
    REP(5) if (IN(5)) {
        float negm;
        { float gq = 0.f, gk = 0.f; for (int i = 0; i < QK; ++i) { gq = fmaxf(gq, fabsf(a.in[I_GQH][i])); gk = fmaxf(gk, fabsf(a.in[I_GKH][i])); }
          negm = -(gq * gk * 96.f * QSCALE * 1.03f + 0.5f); negm = __uint_as_float(__builtin_amdgcn_readfirstlane(__float_as_uint(negm))); }
        const bool shift = negm < -64.f;
        __builtin_amdgcn_s_setreg((0 << 11) | (23 << 6) | 1, 1);
#ifndef REP5A
#define REP5A 0
#endif
#ifndef REP5B
#define REP5B 0
#endif
        if (G == 256) {
            const int xg = vcu >> 5, c = vcu & 31, cg = vcu & 3;
#pragma unroll 1
            for (int step = 0; step < 4; ++step) {
                if (step == cg) moe_convert(a, lds, MOE_IT_P2 + vcu * 8, 256 * 8, MOE_IT_ALL);
                if (step < 2) { const int bh = xg * 4 + 2 * step + (c >> 4), qb = c & 15; if (shift) att::unit64<true>(a, lds, bh, qb, negm); else att::unit64<false>(a, lds, bh, qb, negm); }
                else if (step == 2) { for (int u = bx; u < 16 * 64; u += G) ret_out_unit(a, lds, u); }
            }
        } else {
            for (int w = bx; w < 512; w += G) { if (shift) att::unit64<true>(a, lds, w >> 4, w & 15, negm); else att::unit64<false>(a, lds, w >> 4, w & 15, negm); }
            for (int u = bx; u < 16 * 64; u += G) ret_out_unit(a, lds, u);
        }
        SEAM(5);
    }
    REP(6) if (IN(6)) {
        pg8::DenseOrder S; S.init(a.ws + WS_MIX, a.ws + WS_WO, T, DM, 1024, G, bx);
        pg8::EpiOut E{a.in[I_X], (const float*)(a.ws + WS_MOD), a.out};
        pg8::gemm_phase<pg8::EpiOut, pg8::DenseOrder, false>(lds, nullptr, nullptr, 0, 1024, S, E, a.wv);
        SEAM(6);
    }
    if (IN(7)) { phase_router(a, lds); SEAM(7); }
    REP(8) if (IN(8)) {
        pg8::EpiM1 E{a.ws + WS_ACT};
        phase_moe_pg8<8>(a, lds, a.ws + WS_HF, 2, a.ws + WS_W1, (size_t)2048 * 1024, a.in[I_B1], 2048, nullptr, E);
        SEAM(8);
    }
    REP(9) if (IN(9)) {
        pg8::EpiM2 E{a.ws + WS_Y};
        phase_moe_pg8<4>(a, lds, a.ws + WS_ACT, 0, a.ws + WS_W2, (size_t)1024 * 1024, a.in[I_B2], 1024, (const float*)(a.ws + WS_PG), E);
        SEAM(9);
    }
    if (IN(10)) { phase_combine(a); }
#undef IN
#undef SEAM
#undef use_bar
}

extern "C" void kernel_launch(void* const* d_in, const int* in_sizes, int n_in, void* d_out, int out_size, void* d_ws, size_t ws_size, hipStream_t stream) {
    static int grid = 0;
    if (grid == 0) {
        if (n_in != 24 || out_size != T * DM || ws_size < WS_END) { fprintf(stderr, "kernel_launch: unexpected shapes (n_in %d out %d ws %zu)\n", n_in, out_size, ws_size); grid = -1; return; }
        int dev = 0, cus = 0, per_cu = 0;
        if (hipGetDevice(&dev) != hipSuccess || hipDeviceGetAttribute(&cus, hipDeviceAttributeMultiprocessorCount, dev) != hipSuccess) { grid = -1; return; }
        if (hipFuncSetAttribute((const void*)fwd_kernel, hipFuncAttributeMaxDynamicSharedMemorySize, LDS_BYTES) != hipSuccess) { fprintf(stderr, "kernel_launch: hipFuncSetAttribute failed\n"); grid = -1; return; }
        if (hipOccupancyMaxActiveBlocksPerMultiprocessor(&per_cu, (const void*)fwd_kernel, 512, LDS_BYTES) != hipSuccess || per_cu < 1) { fprintf(stderr, "kernel_launch: occupancy query says %d\n", per_cu); per_cu = 1; }
        (void)hipGetLastError();
        grid = cus;
    }
    if (grid < 0) return;
    (void)hipMemsetAsync((char*)d_ws + WS_CTL, 0, 128 * 1024, stream);
    Args a{};
    for (int i = 0; i < 24; ++i) a.in[i] = (const float*)d_in[i];
    a.out = (float*)d_out; a.ws = (unsigned char*)d_ws;
#if MK_N_LAUNCHES == 1
    a.ph_lo = 0; a.ph_hi = N_PHASES;
    void* params[] = {&a};
    hipError_t e = hipLaunchCooperativeKernel((const void*)fwd_kernel, dim3(grid), dim3(512), params, LDS_BYTES, stream);
    if (e != hipSuccess) fprintf(stderr, "kernel_launch: cooperative launch failed: %s (grid %d)\n", hipGetErrorString(e), grid);
#else
    for (int p = 0; p < N_PHASES; ++p) { a.ph_lo = p; a.ph_hi = p + 1; hipLaunchKernelGGL(fwd_kernel, dim3(grid), dim3(512), LDS_BYTES, stream, a); }
#endif
}
```

```cpp
#include <hip/hip_runtime.h>
#include <cstdio>
#include <cstdint>

#ifndef MK_N_LAUNCHES
#define MK_N_LAUNCHES 1
#endif

#define LAS __attribute__((address_space(3)))
#define GAS __attribute__((address_space(1)))
typedef unsigned short bf16_t;
typedef short bf16x8 __attribute__((ext_vector_type(8)));
typedef short s16x4 __attribute__((ext_vector_type(4)));
typedef float f32x4 __attribute__((ext_vector_type(4)));
typedef float f32x16 __attribute__((ext_vector_type(16)));
typedef unsigned u32x4 __attribute__((ext_vector_type(4)));
typedef unsigned u32x2 __attribute__((ext_vector_type(2)));

constexpr int DM = 1024, NB = 4, SEQ = 8192, LC = 256;
constexpr int T = NB * SEQ;
constexpr int TC = NB * LC;
constexpr int TA = T + TC;
constexpr int DIN = 1952, DINP = 2048;
constexpr int OFF_Q = 0, OFF_KV = 256, OFF_PE = 384, OFF_RQ = 416, OFF_RK = 672, OFF_RV = 928, OFF_RG = 1440;
constexpr int NH = 8, QK = 96, QK8 = 128, DV = 64, SKV = LC + SEQ;
constexpr int RH = 4, RDK = 64, RDV = 128, RC = 128, NSLOT = 66;
constexpr int NE = 32, DFF = 1024, NPAIR = T * 4;
constexpr float EPS = 1e-6f;
constexpr float QSCALE = 0.10206207261596577f * 1.4426950408889634f;

constexpr size_t MiB = 1ull << 20;
constexpr size_t WS_CTL = 0, CTL_BYTES = 1 * MiB;
constexpr size_t WS_MOD = 1 * MiB;
constexpr size_t WS_TABM = WS_MOD + 128 * 1024;
constexpr size_t WS_TABR = WS_TABM + 16 * 1024;
constexpr size_t WS_WIN = 2 * MiB;
constexpr size_t WS_WQ = 6 * MiB;
constexpr size_t WS_WKV = 6 * MiB + 512 * 1024;
constexpr size_t WS_WO = 7 * MiB;
constexpr size_t WS_WR = 9 * MiB;
constexpr size_t WS_W1 = 10 * MiB;
constexpr size_t WS_W2 = 138 * MiB;
constexpr size_t WS_HF = 202 * MiB;
constexpr size_t WS_PG = 266 * MiB;
constexpr size_t WS_LIST = 267 * MiB;
constexpr size_t WS_H = 272 * MiB;
constexpr size_t WS_P = 338 * MiB;
constexpr size_t WS_Q = 470 * MiB;
constexpr size_t WS_K = 518 * MiB;
constexpr size_t WS_VT = 568 * MiB;
constexpr size_t WS_LST = 601 * MiB;
constexpr size_t WS_MIX = 667 * MiB;
constexpr size_t WS_ACT = 272 * MiB;
constexpr size_t WS_Y = 528 * MiB;
constexpr size_t WS_END = 784 * MiB;
constexpr size_t WS_PRM = WS_MOD + 256 * 1024;
constexpr int PRM_GQL = 0, PRM_GKVL = 256, PRM_GQH = 384, PRM_GKH = 480, PRM_DECAY = 576, PRM_GRET = 584, PRM_BR = 1096, PRM_GFFN = 1128, PRM_B1 = 2152, PRM_B2 = 67688, PRM_END = 100456;
constexpr int CW_BAR = 4096;
constexpr int CW_CNT = 16384;
constexpr int CW_DIAG = 20480;
#ifndef DIAG
#define DIAG 0
#endif

constexpr int LDS_SCRATCH = 159744;
constexpr int LDS_MISC = LDS_SCRATCH;
constexpr int LDS_BYTES = LDS_SCRATCH + 256;

__device__ __forceinline__ float bf2f(bf16_t h) { return __uint_as_float((unsigned)h << 16); }
__device__ __forceinline__ unsigned f2bf(float f) { unsigned u = __float_as_uint(f); return (u + 0x7fffu + ((u >> 16) & 1u)) >> 16; }
__device__ __forceinline__ unsigned pk2(float lo, float hi) { return f2bf(lo) | (f2bf(hi) << 16); }
__device__ __forceinline__ float lo16(unsigned w) { return __uint_as_float(w << 16); }
__device__ __forceinline__ float hi16(unsigned w) { return __uint_as_float(w & 0xffff0000u); }
__device__ __forceinline__ float wave_sum(float v) {
#pragma unroll
    for (int o = 1; o < 64; o <<= 1) v += __shfl_xor(v, o);
    return v;
}
#define LDS_WAIT() asm volatile("s_waitcnt lgkmcnt(0)" ::: "memory")
__device__ __forceinline__ unsigned cvt4_fp8(float a, float b, float c, float d) { int p = 0; p = __builtin_amdgcn_cvt_pk_fp8_f32(a, b, p, false); p = __builtin_amdgcn_cvt_pk_fp8_f32(c, d, p, true); return (unsigned)p; }
constexpr float WQ_SCALE = 16.f, WKV_SCALE = 8.f, WKV_INV = 1.f / 8.f;
constexpr float WSCALE = 64.f, WINV = 1.f / 64.f;
__device__ __forceinline__ int opaque(int v) { asm volatile("" : "+v"(v)); return v; }
__device__ __forceinline__ int sopaque(int v) { asm volatile("" : "+s"(v)); return v; }
__device__ __forceinline__ int tid_of(int wv) { return sopaque(wv) * 64 + opaque((int)__builtin_amdgcn_mbcnt_hi(~0u, __builtin_amdgcn_mbcnt_lo(~0u, 0u))); }

#define XB_TMO      128
#define XB_XCNT(j)  (256  + 64 * (j))
#define XB_XSUB(j)  (1280 + 64 * (j))
#define XB_XGEN(j)  (2304 + 64 * (j))
#define XB_TOP      3328
#define XB_TOPGEN   3392
#define XCD_BAR_WORDS 3456
#define XB_SPIN_CAP (1u << 20)
__device__ __forceinline__ unsigned xb_ld(unsigned* p)              { return __hip_atomic_load(p, __ATOMIC_RELAXED, __HIP_MEMORY_SCOPE_AGENT); }
__device__ __forceinline__ unsigned xb_add(unsigned* p, unsigned v) { return __hip_atomic_fetch_add(p, v, __ATOMIC_RELAXED, __HIP_MEMORY_SCOPE_AGENT); }
__device__ __forceinline__ unsigned xb_xcc_id() { return (unsigned)__builtin_amdgcn_s_getreg((3 << 11) | 20) & 0xFu; }
#define XB_SPIN(cond, bar) do { unsigned _sp = 0; while (cond) { __builtin_amdgcn_s_sleep(1); \
    if ((++_sp & 255u) == 0u) { if (xb_ld(&(bar)[XB_TMO])) break; if (_sp > XB_SPIN_CAP) { atomicAdd(&(bar)[XB_TMO], 1u); break; } } } } while (0)
struct XcdBarrier { unsigned* bar; unsigned x; volatile LAS unsigned* st; int wv; };
__device__ __forceinline__ XcdBarrier xcd_barrier_post(unsigned* bar, volatile LAS unsigned* st, int wv) {
    XcdBarrier b; b.bar = bar; b.x = xb_xcc_id(); b.st = st; b.wv = wv;
    if (tid_of(wv) == 0) (void)xb_add(&bar[XB_XCNT(b.x)], 1u);
    return b;
}
__device__ __forceinline__ void xcd_barrier_complete(unsigned* bar, unsigned x, unsigned& nloc, unsigned& nx) {
    const unsigned G = gridDim.x * gridDim.y * gridDim.z;
    unsigned sum, cnt, mine, sp = 0u;
    for (;;) {
        sum = 0u; cnt = 0u; mine = 0u;
#pragma unroll 1
        for (unsigned j = 0; j < 16; ++j) { const unsigned c = xb_ld(&bar[XB_XCNT(j)]); sum += c; cnt += (c > 0u) ? 1u : 0u; mine = (j == x) ? c : mine; }
        if (sum == G) break;
        __builtin_amdgcn_s_sleep(1);
        if ((++sp & 255u) == 0u) { if (xb_ld(&bar[XB_TMO])) break; if (sp > XB_SPIN_CAP) { atomicAdd(&bar[XB_TMO], 1u); break; } }
    }
    nloc = mine > 0u ? mine : 1u; nx = cnt > 0u ? cnt : 1u;
}
__device__ __forceinline__ void xcd_barrier(const XcdBarrier& b) {
    asm volatile("s_waitcnt vmcnt(0)" ::: "memory");
    __syncthreads();
    if (tid_of(b.wv) == 0) {
        unsigned* bar = b.bar; asm volatile("" : "+s"(bar));
        __builtin_amdgcn_s_waitcnt(0);
        unsigned nloc = b.st[0], nx = b.st[1];
        if (nloc == 0u) { xcd_barrier_complete(bar, b.x, nloc, nx); b.st[0] = nloc; b.st[1] = nx; }
        const unsigned old = xb_add(&bar[XB_XSUB(b.x)], 1u);
        const unsigned gen = old / nloc;
        if (old + 1u == (gen + 1u) * nloc) {
            __builtin_amdgcn_fence(__ATOMIC_RELEASE, "agent");
            asm volatile("s_waitcnt vmcnt(0)" ::: "memory");
            const unsigned og = xb_add(&bar[XB_TOP], 1u);
            const unsigned tg = og / nx;
            if (og + 1u == (tg + 1u) * nx) xb_add(&bar[XB_TOPGEN], 1u);
            else XB_SPIN(xb_ld(&bar[XB_TOPGEN]) == tg, bar);
            __builtin_amdgcn_fence(__ATOMIC_ACQUIRE, "agent");
            xb_add(&bar[XB_XGEN(b.x)], 1u);
            asm volatile("s_waitcnt vmcnt(0)" ::: "memory");
        } else {
            XB_SPIN(xb_ld(&bar[XB_XGEN(b.x)]) == gen, bar);
            __builtin_amdgcn_fence(__ATOMIC_ACQUIRE, "agent");
            asm volatile("s_waitcnt vmcnt(0)" ::: "memory");
        }
    }
    __syncthreads();
}

struct Args { const float* in[24]; float* out; unsigned char* ws; int ph_lo, ph_hi; int wv, pad; };
#define CAS __attribute__((address_space(4)))
__device__ __forceinline__ Args load_args() { auto p = __builtin_amdgcn_kernarg_segment_ptr(); asm volatile("" : "+s"(p)); Args r; __builtin_memcpy(&r, p, sizeof(Args)); return r; }
enum { I_X = 0, I_C, I_CTX, I_CCTX, I_GATTN, I_GFFN, I_WADA, I_BADA, I_WIN, I_GQL, I_WQUP, I_GQH, I_GKVL, I_WKVUP, I_GKH, I_DECAY, I_GRET, I_WOUT,
       I_WR, I_BR, I_W1, I_B1, I_W2, I_B2 };

template <int MT, int NT, bool SWAP>
__device__ __forceinline__ void mma_ll(f32x4 (&acc)[MT][NT], const LAS bf16_t* sA, int lda, int m0, const LAS bf16_t* sB, int ldb, int n0, int K, int lane) {
    const int fr = lane & 15, fq = lane >> 4;
    for (int k = 0; k < K; k += 32) {
        bf16x8 a[MT], b[NT];
#pragma unroll
        for (int i = 0; i < MT; ++i) a[i] = *(const LAS bf16x8*)(sA + (m0 + 16 * i + fr) * lda + k + 8 * fq);
#pragma unroll
        for (int j = 0; j < NT; ++j) b[j] = *(const LAS bf16x8*)(sB + (n0 + 16 * j + fr) * ldb + k + 8 * fq);
#pragma unroll
        for (int i = 0; i < MT; ++i)
#pragma unroll
            for (int j = 0; j < NT; ++j)
                acc[i][j] = SWAP ? __builtin_amdgcn_mfma_f32_16x16x32_bf16(b[j], a[i], acc[i][j], 0, 0, 0) : __builtin_amdgcn_mfma_f32_16x16x32_bf16(a[i], b[j], acc[i][j], 0, 0, 0);
    }
}
template <int MT, int NT, bool SWAP>
__device__ __forceinline__ void mma_lg(f32x4 (&acc)[MT][NT], const LAS bf16_t* sA, int lda, int m0, const bf16_t* gB, int ldb, int n0, int K, int lane) {
    const int fr = lane & 15, fq = lane >> 4;
#pragma unroll 2
    for (int k = 0; k < K; k += 32) {
        bf16x8 a[MT], b[NT];
#pragma unroll
        for (int j = 0; j < NT; ++j) b[j] = *(const GAS bf16x8*)(gB + (size_t)(n0 + 16 * j + fr) * ldb + k + 8 * fq);
#pragma unroll
        for (int i = 0; i < MT; ++i) a[i] = *(const LAS bf16x8*)(sA + (m0 + 16 * i + fr) * lda + k + 8 * fq);
#pragma unroll
        for (int i = 0; i < MT; ++i)
#pragma unroll
            for (int j = 0; j < NT; ++j)
                acc[i][j] = SWAP ? __builtin_amdgcn_mfma_f32_16x16x32_bf16(b[j], a[i], acc[i][j], 0, 0, 0) : __builtin_amdgcn_mfma_f32_16x16x32_bf16(a[i], b[j], acc[i][j], 0, 0, 0);
    }
}

__device__ __forceinline__ void phase_mod(const Args& a, LAS unsigned char* lds) {
    const int tid = tid_of(a.wv), lane = tid & 63, wave = tid >> 6;
    LAS float* sv = (LAS float*)lds;
    LAS float* red = sv + 5 * 1024;
    float* mod = (float*)(a.ws + WS_MOD);
    for (int i = tid; i < 5 * 1024; i += 512) { const float v = (i < 4096) ? a.in[I_C][i] : a.in[I_CCTX][i - 4096]; sv[i] = v / (1.f + __expf(-v)); }
    __syncthreads();
    const float* W = a.in[I_WADA]; const float* bb = a.in[I_BADA];
    for (int u = blockIdx.x; u < 96; u += gridDim.x) {
        const int col = u * 64 + lane;
        float acc[5] = {0.f, 0.f, 0.f, 0.f, 0.f};
        for (int k = wave * 128; k < wave * 128 + 128; ++k) {
            const float w = W[(size_t)k * 6144 + col];
#pragma unroll
            for (int v = 0; v < 5; ++v) acc[v] += sv[v * 1024 + k] * w;
        }
#pragma unroll
        for (int v = 0; v < 5; ++v) red[(wave * 5 + v) * 64 + lane] = acc[v];
        __syncthreads();
        if (tid < 320) { const int v = tid >> 6; float s = bb[u * 64 + lane];
#pragma unroll
            for (int w = 0; w < 8; ++w) s += red[(w * 5 + v) * 64 + lane];
            mod[v * 6144 + u * 64 + lane] = s; }
        __syncthreads();
    }
    const int gt = blockIdx.x * 512 + tid;
    if (gt < 192 * 8) { const int pi = gt >> 3, f = gt & 7; const float pos = (float)(pi < 128 ? pi : pi - 128);
        const float inv = exp2f(-(float)f * (13.287712379549449f / 8.f)); const float rev = pos * inv * 0.15915494309189535f;
        float* tm = (float*)(a.ws + WS_TABM); tm[gt * 2] = __builtin_amdgcn_cosf(rev); tm[gt * 2 + 1] = __builtin_amdgcn_sinf(rev); }
    else if (gt < 192 * 8 + 192 * 16) { const int g2 = gt - 192 * 8; const int pi = g2 >> 4, f = g2 & 15; const float pos = (float)(pi < 128 ? pi : pi - 128);
        const float inv = exp2f(-(float)f * (13.287712379549449f / 16.f)); const float rev = pos * inv * 0.15915494309189535f;
        float* tr = (float*)(a.ws + WS_TABR); tr[g2 * 2] = __builtin_amdgcn_cosf(rev); tr[g2 * 2 + 1] = __builtin_amdgcn_sinf(rev); }
}

__device__ __forceinline__ void transpose_item(const float* W, int K, int N, bf16_t* WT, LAS float* scr, int item, int lane) {
    const int nblk = N / 32, kb = item / nblk, nb = item % nblk, k0 = 64 * kb, n0 = 32 * nb;
    float wv_[32];
#pragma unroll
    for (int i = 0; i < 32; ++i) { const int kk = 2 * i + (lane >> 5); wv_[i] = W[(size_t)(k0 + kk) * N + n0 + (lane & 31)]; }
#pragma unroll
    for (int i = 0; i < 32; ++i) { const int kk = 2 * i + (lane >> 5); scr[kk * 33 + (lane & 31)] = wv_[i]; }
    LDS_WAIT();
    const int c = lane & 7;
#pragma unroll
    for (int j = 0; j < 4; ++j) { const int n = (lane >> 3) + 8 * j; const LAS float* s = scr + (8 * c) * 33 + n;
        u32x4 o; o.x = pk2(s[0 * 33], s[1 * 33]); o.y = pk2(s[2 * 33], s[3 * 33]); o.z = pk2(s[4 * 33], s[5 * 33]); o.w = pk2(s[6 * 33], s[7 * 33]);
        *(GAS u32x4*)(WT + (size_t)(n0 + n) * K + k0 + 8 * c) = o; }
    LDS_WAIT();
}
__device__ __forceinline__ void transpose_item8(const float* W, int K, int N, unsigned char* WT, float sc, LAS float* scr, int item, int lane) {
    const int nblk = N / 32, kb = item / nblk, nb = item % nblk, k0 = 64 * kb, n0 = 32 * nb;
    float wv_[32];
#pragma unroll
    for (int i = 0; i < 32; ++i) { const int kk = 2 * i + (lane >> 5); wv_[i] = W[(size_t)(k0 + kk) * N + n0 + (lane & 31)]; }
#pragma unroll
    for (int i = 0; i < 32; ++i) { const int kk = 2 * i + (lane >> 5); scr[kk * 33 + (lane & 31)] = wv_[i]; }
    LDS_WAIT();
    const int c = lane & 7;
#pragma unroll
    for (int j = 0; j < 4; ++j) { const int n = (lane >> 3) + 8 * j; const LAS float* s = scr + (8 * c) * 33 + n;
        u32x2 o; o.x = cvt4_fp8(s[0 * 33] * sc, s[1 * 33] * sc, s[2 * 33] * sc, s[3 * 33] * sc); o.y = cvt4_fp8(s[4 * 33] * sc, s[5 * 33] * sc, s[6 * 33] * sc, s[7 * 33] * sc);
        *(GAS u32x2*)(WT + (size_t)(n0 + n) * K + k0 + 8 * c) = o; }
    LDS_WAIT();
}
__device__ __forceinline__ void phase_prep(const Args& a, LAS unsigned char* lds) {
    const int tid = tid_of(a.wv), lane = tid & 63, wave = tid >> 6;
    LAS float* scr = (LAS float*)(lds + wave * 16384);
    const int gw = blockIdx.x * 8 + wave, NGW = gridDim.x * 8;
    constexpr int I_IN = 16 * 61, I_QU = 4 * 24, I_KVU = 2 * 32, I_O = 16 * 32, I_1 = 16 * 64, I_2 = 16 * 32;
    constexpr int NITEMS = I_IN + I_QU + I_KVU + I_O + 32 * I_1 + 32 * I_2;
    const int nitems = gridDim.x == 256 ? I_IN + I_QU + I_KVU + I_O : NITEMS;
    for (int it = gw; it < nitems; it += NGW) {
        int r = it;
        if (r < I_IN) { transpose_item(a.in[I_WIN], 1024, DIN, (bf16_t*)(a.ws + WS_WIN), scr, r, lane); continue; } r -= I_IN;
        if (r < I_QU) { transpose_item8(a.in[I_WQUP], 256, 768, a.ws + WS_WQ, WQ_SCALE, scr, r, lane); continue; } r -= I_QU;
        if (r < I_KVU) { transpose_item8(a.in[I_WKVUP], 128, 1024, a.ws + WS_WKV, WKV_SCALE, scr, r, lane); continue; } r -= I_KVU;
        if (r < I_O) { transpose_item(a.in[I_WOUT], 1024, 1024, (bf16_t*)(a.ws + WS_WO), scr, r, lane); continue; } r -= I_O;
        if (r < 32 * I_1) { const int e = r / I_1; transpose_item8(a.in[I_W1] + (size_t)e * 1024 * 2048, 1024, 2048, a.ws + WS_W1 + (size_t)e * 2048 * 1024, WSCALE, scr, r % I_1, lane); continue; } r -= 32 * I_1;
        { const int e = r / I_2; transpose_item8(a.in[I_W2] + (size_t)e * 1024 * 1024, 1024, 1024, a.ws + WS_W2 + (size_t)e * 1024 * 1024, WSCALE, scr, r % I_2, lane); }
    }
    const int gt = blockIdx.x * 512 + tid, NGT = gridDim.x * 512;
    for (int i = gt; i < 96 * 1024 / 8; i += NGT) *(GAS u32x4*)((bf16_t*)(a.ws + WS_WIN) + (size_t)DIN * 1024 + (size_t)i * 8) = (u32x4){0u, 0u, 0u, 0u};
    for (int i = gt; i < 32 * 1024; i += NGT) { const int n = i >> 10, k = i & 1023; const float w = a.in[I_WR][k * 32 + n]; const unsigned h = f2bf(w);
        bf16_t* wr = (bf16_t*)(a.ws + WS_WR); wr[i] = (bf16_t)h; wr[32768 + i] = (bf16_t)f2bf(w - bf2f((bf16_t)h)); }
    {
        float* prm = (float*)(a.ws + WS_PRM);
        for (int i = gt; i < PRM_END; i += NGT) {
            float v;
            if (i < PRM_GKVL) v = a.in[I_GQL][i - PRM_GQL]; else if (i < PRM_GQH) v = a.in[I_GKVL][i - PRM_GKVL]; else if (i < PRM_GKH) v = a.in[I_GQH][i - PRM_GQH];
            else if (i < PRM_DECAY) v = a.in[I_GKH][i - PRM_GKH]; else if (i < PRM_GRET) v = a.in[I_DECAY][i - PRM_DECAY]; else if (i < PRM_BR) v = a.in[I_GRET][i - PRM_GRET];
            else if (i < PRM_GFFN) v = a.in[I_BR][i - PRM_BR]; else if (i < PRM_B1) v = a.in[I_GFFN][i - PRM_GFFN]; else if (i < PRM_B2) v = a.in[I_B1][i - PRM_B1]; else v = a.in[I_B2][i - PRM_B2];
            prm[i] = v;
        }
    }
    const float* mod = (const float*)(a.ws + WS_MOD); const float* g = a.in[I_GATTN];
    for (int m = gw; m < TA; m += NGW) {
        const float* xr; int mv;
        if (m < T) { xr = a.in[I_X] + (size_t)m * DM; mv = m >> 13; } else { xr = a.in[I_CTX] + (size_t)(m - T) * DM; mv = 4; }
        const float* sh = mod + mv * 6144; const float* sc = sh + 1024;
        f32x4 v[4]; float ss = 0.f;
#pragma unroll
        for (int j = 0; j < 4; ++j) { v[j] = *(const GAS f32x4*)(xr + j * 256 + lane * 4); ss += (v[j].x * v[j].x + v[j].y * v[j].y) + (v[j].z * v[j].z + v[j].w * v[j].w); }
        const float rstd = rsqrtf(wave_sum(ss) * (1.f / DM) + EPS);
        bf16_t* hr = (bf16_t*)(a.ws + WS_H) + (size_t)m * DM;
#pragma unroll
        for (int j = 0; j < 4; ++j) { const int c = j * 256 + lane * 4; const f32x4 gg = *(const GAS f32x4*)(g + c), s1 = *(const GAS f32x4*)(sc + c), s0 = *(const GAS f32x4*)(sh + c);
            const f32x4 o = (v[j] * rstd * gg) * (s1 + 1.f) + s0; u32x2 w; w.x = pk2(o.x, o.y); w.y = pk2(o.z, o.w); *(GAS u32x2*)(hr + c) = w; }
    }
}

#define MOE_ITEM(it_, P_, D_, N_) do { constexpr int I_1 = 16 * 64, I_2 = 16 * 32; \
    const bool up_ = (it_) < 32 * I_1; const int r_ = up_ ? (it_) : (it_) - 32 * I_1; N_ = up_ ? 2048 : 1024; const int per_ = up_ ? I_1 : I_2, e_ = r_ / per_, item_ = r_ % per_; \
    const int nblk_ = N_ / 32, kb_ = item_ / nblk_, nb_ = item_ % nblk_, k0_ = 64 * kb_, n0_ = 32 * nb_; \
    P_ = (up_ ? a.in[I_W1] : a.in[I_W2]) + (size_t)e_ * 1024 * N_ + (size_t)(k0_ + (lane >> 5)) * N_ + n0_ + (lane & 31); \
    D_ = a.ws + (up_ ? WS_W1 : WS_W2) + (size_t)e_ * N_ * 1024 + (size_t)n0_ * 1024 + k0_; } while (0)
__device__ __forceinline__ void moe_convert(const Args& a, LAS unsigned char* lds, int it0, int itstep, int itend) {
    const int tid = tid_of(a.wv), lane = tid & 63, wave = tid >> 6;
    LAS float* scr = (LAS float*)(lds + wave * 16384);
    const int NIT = itend;
    __syncthreads();
    float wc[32], wn[32];
    int it = it0 + wave;
    if (it >= NIT) { __syncthreads(); return; }
    const float* pc; unsigned char* dc; int nc;
    MOE_ITEM(it, pc, dc, nc);
#pragma unroll
    for (int i = 0; i < 32; ++i) wc[i] = pc[(size_t)(2 * i) * nc];
#pragma unroll 1
    while (it < NIT) {
        const int itn = it + itstep; const bool more = itn < NIT;
        const float* pn; unsigned char* dn; int nn; const int itx = more ? itn : it;
        MOE_ITEM(itx, pn, dn, nn);
        if (more) {
#pragma unroll
            for (int i = 0; i < 32; ++i) wn[i] = pn[(size_t)(2 * i) * nn]; }
#pragma unroll
        for (int i = 0; i < 32; ++i) { const int kk = 2 * i + (lane >> 5); scr[kk * 33 + (lane & 31)] = wc[i]; }
        LDS_WAIT();
        const int c = lane & 7;
#pragma unroll
        for (int j = 0; j < 4; ++j) { const int n = (lane >> 3) + 8 * j; const LAS float* s_ = scr + (8 * c) * 33 + n;
            u32x2 o; o.x = cvt4_fp8(s_[0 * 33] * WSCALE, s_[1 * 33] * WSCALE, s_[2 * 33] * WSCALE, s_[3 * 33] * WSCALE); o.y = cvt4_fp8(s_[4 * 33] * WSCALE, s_[5 * 33] * WSCALE, s_[6 * 33] * WSCALE, s_[7 * 33] * WSCALE);
            *(GAS u32x2*)(dc + (size_t)n * 1024 + 8 * c) = o; }
        LDS_WAIT();
#pragma unroll
        for (int i = 0; i < 32; ++i) wc[i] = wn[i];
        dc = dn; it = itn;
    }
    __syncthreads();
}
#undef MOE_ITEM

struct GUnit { const bf16_t* Bt; int m0, n0, nvalid, e; };
template <class RowFn, class Epi>
__device__ __forceinline__ void gemm_tile(LAS unsigned char* lds, const bf16_t* A, int K, const GUnit& u, const RowFn& rowfn, const Epi& epi) {
    LAS bf16_t* sA = (LAS bf16_t*)lds;
    LAS bf16_t* sB = (LAS bf16_t*)(lds + 256 * 72 * 2);
    const int tid = opaque((int)threadIdx.x), lane = tid & 63, wave = tid >> 6, wm = wave >> 1, wn = wave & 1;
    const int ch = tid & 7, r0 = tid >> 3;
    const bf16_t* ap[4]; const bf16_t* bp[2];
#pragma unroll
    for (int i = 0; i < 4; ++i) { const int r = r0 + 64 * i; const int rr = r < u.nvalid ? r : 0; ap[i] = A + (size_t)rowfn(u, rr) * K + ch * 8; }
#pragma unroll
    for (int i = 0; i < 2; ++i) bp[i] = u.Bt + (size_t)(r0 + 64 * i) * K + ch * 8;
    f32x4 acc[4][4];
#pragma unroll
    for (int i = 0; i < 4; ++i)
#pragma unroll
        for (int j = 0; j < 4; ++j) acc[i][j] = (f32x4){0.f, 0.f, 0.f, 0.f};
    u32x4 ra[4], rb[2];
#pragma unroll
    for (int i = 0; i < 4; ++i) ra[i] = *(const GAS u32x4*)(ap[i]);
#pragma unroll
    for (int i = 0; i < 2; ++i) rb[i] = *(const GAS u32x4*)(bp[i]);
    const int nk = K / 64;
    for (int kt = 0; kt < nk; ++kt) {
        __syncthreads();
#pragma unroll
        for (int i = 0; i < 4; ++i) *(LAS u32x4*)(sA + (r0 + 64 * i) * 72 + ch * 8) = ra[i];
#pragma unroll
        for (int i = 0; i < 2; ++i) *(LAS u32x4*)(sB + (r0 + 64 * i) * 72 + ch * 8) = rb[i];
        __syncthreads();
        if (kt + 1 < nk) {
#pragma unroll
            for (int i = 0; i < 4; ++i) ra[i] = *(const GAS u32x4*)(ap[i] + (kt + 1) * 64);
#pragma unroll
            for (int i = 0; i < 2; ++i) rb[i] = *(const GAS u32x4*)(bp[i] + (kt + 1) * 64);
        }
        mma_ll<4, 4, true>(acc, sA, 72, wm * 64, sB, 72, wn * 64, 64, lane);
    }
    epi(acc, u, wm, wn, lane);
}
struct RowDense { __device__ __forceinline__ int operator()(const GUnit& u, int r) const { return u.m0 + r; } };
struct RowPairTok { const unsigned* list; __device__ __forceinline__ int operator()(const GUnit& u, int r) const { return (int)(list[(size_t)u.e * 32768 + u.m0 + r] >> 2); } };
struct RowPair { const unsigned* list; __device__ __forceinline__ int operator()(const GUnit& u, int r) const { return (int)list[(size_t)u.e * 32768 + u.m0 + r]; } };

struct EpiP { bf16_t* P;
    __device__ __forceinline__ void operator()(const f32x4 (&acc)[4][4], const GUnit& u, int wm, int wn, int lane) const {
        const int fr = lane & 15, fq = lane >> 4;
#pragma unroll
        for (int i = 0; i < 4; ++i) { const int row = u.m0 + wm * 64 + 16 * i + fr;
#pragma unroll
            for (int j = 0; j < 4; ++j) { const int col = u.n0 + wn * 64 + 16 * j + 4 * fq; u32x2 w; w.x = pk2(acc[i][j][0], acc[i][j][1]); w.y = pk2(acc[i][j][2], acc[i][j][3]);
                *(GAS u32x2*)(P + (size_t)row * DINP + col) = w; } }
    } };
struct EpiOut { const float* x; const float* mod; float* out;
    __device__ __forceinline__ void operator()(const f32x4 (&acc)[4][4], const GUnit& u, int wm, int wn, int lane) const {
        const int fr = lane & 15, fq = lane >> 4;
#pragma unroll
        for (int i = 0; i < 4; ++i) { const int row = u.m0 + wm * 64 + 16 * i + fr; const float* gate = mod + (row >> 13) * 6144 + 2 * 1024;
#pragma unroll
            for (int j = 0; j < 4; ++j) { const int col = u.n0 + wn * 64 + 16 * j + 4 * fq;
                const f32x4 xv = *(const GAS f32x4*)(x + (size_t)row * DM + col), gv = *(const GAS f32x4*)(gate + col);
                *(GAS f32x4*)(out + (size_t)row * DM + col) = xv + gv * acc[i][j]; } }
    } };
struct EpiM1 { const unsigned* list; const float* b1; bf16_t* act;
    __device__ __forceinline__ void operator()(const f32x4 (&acc)[4][4], const GUnit& u, int wm, int wn, int lane) const {
        const int fr = lane & 15, fq = lane >> 4;
#pragma unroll
        for (int i = 0; i < 4; ++i) { const int r = wm * 64 + 16 * i + fr; if (r >= u.nvalid) continue;
            const unsigned pair = list[(size_t)u.e * 32768 + u.m0 + r];
#pragma unroll
            for (int j = 0; j < 4; ++j) { const int col = u.n0 + wn * 64 + 16 * j + 4 * fq; const f32x4 bv = *(const GAS f32x4*)(b1 + (size_t)u.e * 2048 + col);
                const f32x4 v = acc[i][j] + bv;
                const float g0 = fminf(v[0], 7.f), l0 = fminf(fmaxf(v[1], -7.f), 7.f), g1 = fminf(v[2], 7.f), l1 = fminf(fmaxf(v[3], -7.f), 7.f);
                const float a0 = g0 / (1.f + __expf(-1.702f * g0)) * (l0 + 1.f), a1 = g1 / (1.f + __expf(-1.702f * g1)) * (l1 + 1.f);
                *(GAS unsigned*)(act + (size_t)pair * DFF + (col >> 1)) = pk2(a0, a1); } }
    } };
struct EpiM2 { const unsigned* list; const float* b2; const float* pg; bf16_t* y;
    __device__ __forceinline__ void operator()(const f32x4 (&acc)[4][4], const GUnit& u, int wm, int wn, int lane) const {
        const int fr = lane & 15, fq = lane >> 4;
#pragma unroll
        for (int i = 0; i < 4; ++i) { const int r = wm * 64 + 16 * i + fr; if (r >= u.nvalid) continue;
            const unsigned pair = list[(size_t)u.e * 32768 + u.m0 + r]; const float g = pg[pair];
#pragma unroll
            for (int j = 0; j < 4; ++j) { const int col = u.n0 + wn * 64 + 16 * j + 4 * fq; const f32x4 bv = *(const GAS f32x4*)(b2 + (size_t)u.e * 1024 + col);
                const f32x4 v = (acc[i][j] + bv) * g; u32x2 w; w.x = pk2(v[0], v[1]); w.y = pk2(v[2], v[3]);
                *(GAS u32x2*)(y + (size_t)pair * DM + col) = w; } }
    } };

namespace pg8 {
constexpr int BM = 256, BK = 64, HALF = 128, HTB = HALF * BK * 2, STAGE_BYTES = 8 * HTB, NXCD = 8, WGM = 8;
__host__ __device__ __forceinline__ int lds_byte(int r, int c) { const int st = (r >> 4) * 2 + (c >> 5), rr = r & 15, cc = c & 31, ob = rr * 64 + cc * 2; return st * 1024 + (ob ^ (((ob >> 9) & 1) << 5)); }
__host__ __device__ __forceinline__ void stage_rc(int b, int& R, int& C) { const int st = b / 1024, sb = b % 1024, swz = sb ^ (((sb >> 9) & 1) << 5); R = (st >> 1) * 16 + swz / 64; C = (st & 1) * 32 + (swz % 64) / 2; }
__host__ __device__ __forceinline__ int perm32(int rho) { const int n = rho >> 4, i = rho & 15; return 8 * (i >> 2) + 4 * n + (i & 3); }
struct Unit { int pm, pn; const char* A; const char* B; int e, nvalid, ul; };
struct DenseOrder {
    int nM, nN, nwg, G, c; const char* A; const char* B; size_t tstep;
    __device__ void init(const void* A_, const void* B_, int M, int N, int K, int G_, int c_) { nM = M / BM; nN = N / BM; nwg = nM * nN; G = G_; c = c_; A = (const char*)A_; B = (const char*)B_; tstep = (size_t)BM * K * 2; }
    __device__ bool next(int i, Unit& u) const {
        const long L = (long)i * G + c; if (L >= nwg) return false;
        int wgid = (int)L; { const int q = nwg / NXCD, r = nwg % NXCD, xcd = wgid % NXCD, off = wgid / NXCD; wgid = (xcd < r ? xcd * (q + 1) : r * (q + 1) + (xcd - r) * q) + off; }
        const int nig = WGM * nN, gid = wgid / nig, fm = gid * WGM, gsz = (nM - fm) < WGM ? (nM - fm) : WGM;
        u.pm = fm + ((wgid % nig) % gsz); u.pn = (wgid % nig) / gsz; u.A = A + (size_t)u.pm * tstep; u.B = B + (size_t)u.pn * tstep; u.e = 0; u.nvalid = 256; u.ul = 0; return true;
    }
};
template <int NCT> struct ExpertOrder {
    const LAS int* pre; int G, c; const char* A; const char* W; size_t wstride; int rowbytes;
    __device__ bool next(int i, Unit& u) const {
        const int L = i * G + c; const int nunit = pre[32] * NCT; if (L >= nunit) return false;
        const int ti = L / NCT; u.pn = L % NCT; int e = 0;
        for (int k = 1; k < 32; ++k) if (pre[k] <= ti) e = k;
        u.pm = ti - pre[e]; u.e = e; const int cnt = pre[33 + e]; u.nvalid = (cnt - u.pm * 256) < 256 ? (cnt - u.pm * 256) : 256; u.ul = i;
        u.A = A; u.B = W + (size_t)e * wstride + (size_t)u.pn * 256 * rowbytes; return true;
    }
};
__device__ __forceinline__ unsigned cvt_pk_bf16(float lo, float hi) { unsigned r; asm volatile("v_cvt_pk_bf16_f32 %0, %1, %2" : "=v"(r) : "v"(lo), "v"(hi)); return r; }
typedef int i32x4 __attribute__((ext_vector_type(4))); typedef int i32x8 __attribute__((ext_vector_type(8)));
__device__ __forceinline__ bf16x8 lo8(i32x8 v) { return __builtin_bit_cast(bf16x8, (i32x4)__builtin_shufflevector(v, v, 0, 1, 2, 3)); }
__device__ __forceinline__ bf16x8 hi8(i32x8 v) { return __builtin_bit_cast(bf16x8, (i32x4)__builtin_shufflevector(v, v, 4, 5, 6, 7)); }

template <class Epi, class Sched, bool GATHER, bool FP8 = false>
__device__ __forceinline__ void gemm_phase(LAS unsigned char* lds, const LAS int* tab, const LAS bf16_t* aux, int ashift, int K, const Sched& S, const Epi& E, int wv) {
    const int tid = tid_of(wv), wid = wv, lane = tid & 63, wr = wid >> 2, wc = wid & 3, fr = lane & 15, fq = lane >> 4;
    const int nt = K / BK;
    unsigned voffA[2], voffB[2]; unsigned cb0 = 0; int rg0 = 0;
#pragma unroll
    for (int i = 0; i < 2; ++i) { int R, C; stage_rc(tid * 16 + i * 8192, R, C); const int Rb = (R & ~31) + perm32(R & 31);
        voffA[i] = (unsigned)(R * K + C) * 2u; voffB[i] = (unsigned)(Rb * K + C) * 2u; if (i == 0) { cb0 = (unsigned)C * 2u; rg0 = R; } }
    const size_t kstep = (size_t)(BK * 2);
    const size_t hstep = (size_t)HALF * K * 2;
    const size_t hstepA = GATHER ? 0 : hstep;
    const unsigned ldsw = (unsigned)wid * 1024u;
    const int aoff = lds_byte(wr * 64 + fr, fq * 8), boff = lds_byte(wc * 32 + fr, fq * 8);
    int cul = 0, nul = 0;
#define PG8_SA(b, h) (((b) * 2 + (h)) * HTB)
#define PG8_SB(b, h) ((4 + (b) * 2 + (h)) * HTB)
#define PG8_STAGE(bufoff, gbase, voff) do { _Pragma("unroll") for (int _i = 0; _i < 2; ++_i) \
        __builtin_amdgcn_global_load_lds((const unsigned*)((const char*)(gbase) + (voff)[_i]), (LAS unsigned*)(lds + (bufoff) + ldsw + _i * 8192), 16, 0, 0); } while (0)
#define PG8_STAGE_A(bufoff, gbase, h, usenext) do { const int ulx_ = (usenext) ? nul : cul; _Pragma("unroll") for (int _i = 0; _i < 2; ++_i) { \
        unsigned vo_; if constexpr (GATHER) vo_ = (unsigned)(tab[ulx_ * 256 + (h) * 128 + rg0 + 64 * _i] >> ashift) * (unsigned)(K * 2) + cb0; else vo_ = voffA[_i]; \
        __builtin_amdgcn_global_load_lds((const unsigned*)((const char*)(gbase) + (h) * hstepA + vo_), (LAS unsigned*)(lds + (bufoff) + ldsw + _i * 8192), 16, 0, 0); } } while (0)
#define PG8_LDA(dst, b, h) do { _Pragma("unroll") for (int m = 0; m < 4; ++m) { const i32x4 lo_ = *(const LAS i32x4*)(lds + PG8_SA(b, h) + aoff + m * 2048), hi_ = *(const LAS i32x4*)(lds + PG8_SA(b, h) + aoff + m * 2048 + 1024); \
        dst[m] = __builtin_shufflevector(lo_, hi_, 0, 1, 2, 3, 4, 5, 6, 7); } } while (0)
#define PG8_LDB(dst, b, h) do { _Pragma("unroll") for (int n = 0; n < 2; ++n) { const i32x4 lo_ = *(const LAS i32x4*)(lds + PG8_SB(b, h) + boff + n * 2048), hi_ = *(const LAS i32x4*)(lds + PG8_SB(b, h) + boff + n * 2048 + 1024); \
        dst[n] = __builtin_shufflevector(lo_, hi_, 0, 1, 2, 3, 4, 5, 6, 7); } } while (0)
#define PG8_MMA(ai, bj, At, Bt) do { __builtin_amdgcn_s_setprio(1); _Pragma("unroll") for (int m = 0; m < 4; ++m) _Pragma("unroll") for (int n = 0; n < 2; ++n) { \
        if constexpr (FP8) { asm("v_mfma_f32_16x16x128_f8f6f4 %0, %1, %2, %0" : "+v"(acc[ai][bj][m][n]) : "v"(Bt[n]), "v"(At[m])); } \
        else { acc[ai][bj][m][n] = __builtin_amdgcn_mfma_f32_16x16x32_bf16(lo8(Bt[n]), lo8(At[m]), acc[ai][bj][m][n], 0, 0, 0); \
               acc[ai][bj][m][n] = __builtin_amdgcn_mfma_f32_16x16x32_bf16(hi8(Bt[n]), hi8(At[m]), acc[ai][bj][m][n], 0, 0, 0); } } \
        __builtin_amdgcn_s_setprio(0); } while (0)
#define PG8_WAIT_V(n) asm volatile("s_waitcnt vmcnt(" #n ")" ::: "memory")
#define PG8_WAIT_L(n) asm volatile("s_waitcnt lgkmcnt(" #n ")" ::: "memory")
#define PG8_BAR __builtin_amdgcn_s_barrier()
#define PG8_SCHED __builtin_amdgcn_sched_barrier(0)
    Unit cur, nxt; int ui = 0;
    if (!S.next(0, cur)) return;
    cul = cur.ul; nul = cur.ul;
    f32x4 acc[2][2][4][2];
#pragma unroll
    for (int a = 0; a < 2; ++a)
#pragma unroll
        for (int b = 0; b < 2; ++b)
#pragma unroll
            for (int m = 0; m < 4; ++m)
#pragma unroll
                for (int n = 0; n < 2; ++n) acc[a][b][m][n] = (f32x4){0.f, 0.f, 0.f, 0.f};
    i32x8 At[4], B0[2], B1[2];
    const char* cA = cur.A; const char* cB = cur.B;
    PG8_STAGE(PG8_SB(0, 0), cB, voffB); PG8_STAGE(PG8_SB(0, 1), cB + hstep, voffB); PG8_STAGE_A(PG8_SA(0, 0), cA, 0, false); PG8_STAGE_A(PG8_SA(0, 1), cA, 1, false);
    if (wr == 1) PG8_BAR;
    PG8_WAIT_V(2); PG8_BAR;
    PG8_STAGE(PG8_SB(1, 0), cB + kstep, voffB); PG8_STAGE_A(PG8_SA(1, 0), cA + kstep, 0, false); PG8_STAGE(PG8_SB(1, 1), cB + hstep + kstep, voffB);
    PG8_WAIT_V(6); PG8_BAR;
    for (;;) {
        const bool has_next = S.next(ui + 1, nxt);
        const char* nA = has_next ? nxt.A : cA; const char* nB = has_next ? nxt.B : cB;
        nul = has_next ? nxt.ul : cur.ul;
#if DIAG >= 10
        long long tk0_ = 0; if (DIAG == 10 + Epi::ID && ui == 0) tk0_ = (long long)__builtin_amdgcn_s_memtime();
        if (DIAG == 20 + Epi::ID && ui <= 1) { const long long tn_ = (long long)__builtin_amdgcn_s_memtime();
            if (ui == 0) { if (blockIdx.x == 0 && tid == 0) { ((volatile LAS unsigned*)(lds + 159744))[41] = (unsigned)tn_; } }
            else if (blockIdx.x == 0 && tid == 0) { const unsigned d_ = (unsigned)tn_ - ((volatile LAS unsigned*)(lds + 159744))[41]; const float q = rintf((float)d_ * (1.f / 1000.f));
                ((volatile LAS unsigned*)(lds + 159744))[40] = __float_as_uint(q * 1e-5f); } }
#endif
#pragma unroll 1
        for (int t = 0; t < nt; t += 2) {
            const bool last = (t == nt - 2);
            const char* a1 = cA + (size_t)(t + 1) * kstep;
            const char* a2 = last ? nA : cA + (size_t)(t + 2) * kstep; const char* b2 = last ? nB : cB + (size_t)(t + 2) * kstep;
            const char* a3 = a2 + kstep; const char* b3 = b2 + kstep;
            PG8_LDB(B0, 0, 0); PG8_LDB(B1, 0, 1); PG8_SCHED; PG8_LDA(At, 0, 0); PG8_STAGE_A(PG8_SA(1, 1), a1, 1, false);
            PG8_WAIT_V(8); PG8_WAIT_L(0); PG8_BAR; PG8_MMA(0, 0, At, B0); PG8_MMA(0, 1, At, B1); PG8_BAR; PG8_SCHED;
            PG8_LDA(At, 0, 1); PG8_STAGE(PG8_SB(0, 0), b2, voffB); PG8_STAGE(PG8_SB(0, 1), b2 + hstep, voffB); PG8_STAGE_A(PG8_SA(0, 0), a2, 0, last);
            PG8_WAIT_V(8); PG8_WAIT_L(0); PG8_BAR; PG8_MMA(1, 0, At, B0); PG8_MMA(1, 1, At, B1); PG8_BAR; PG8_SCHED;
            PG8_LDB(B0, 1, 0); PG8_LDB(B1, 1, 1); PG8_SCHED; PG8_LDA(At, 1, 0); PG8_STAGE_A(PG8_SA(0, 1), a2, 1, last);
            PG8_WAIT_V(8); PG8_WAIT_L(0); PG8_BAR; PG8_MMA(0, 0, At, B0); PG8_MMA(0, 1, At, B1); PG8_BAR; PG8_SCHED;
            PG8_LDA(At, 1, 1); PG8_STAGE(PG8_SB(1, 0), b3, voffB); PG8_STAGE(PG8_SB(1, 1), b3 + hstep, voffB); PG8_STAGE_A(PG8_SA(1, 0), a3, 0, last);
            PG8_WAIT_V(8); PG8_WAIT_L(0); PG8_BAR; PG8_MMA(1, 0, At, B0); PG8_MMA(1, 1, At, B1); PG8_BAR; PG8_SCHED;
        }
#if DIAG >= 10
        if (DIAG == 10 + Epi::ID && ui == 0) { const long long tk1_ = (long long)__builtin_amdgcn_s_memtime();
            if (blockIdx.x == 0 && tid == 0) { const float perk = (float)(tk1_ - tk0_) / (float)nt; const float q = rintf(perk * (1.f / 250.f));
                ((volatile LAS unsigned*)(lds + 159744))[40] = __float_as_uint(q * 2e-5f); } }
#endif
        if (wr == 0) PG8_BAR;
        if constexpr (FP8) asm volatile("s_nop 15\n\ts_nop 7" ::: "memory");
        E(acc, cur, tab, aux, wr, wc, fr, fq);
        if (!has_next) break;
#pragma unroll
        for (int a = 0; a < 2; ++a)
#pragma unroll
            for (int b = 0; b < 2; ++b)
#pragma unroll
                for (int m = 0; m < 4; ++m)
#pragma unroll
                    for (int n = 0; n < 2; ++n) acc[a][b][m][n] = (f32x4){0.f, 0.f, 0.f, 0.f};
        cur = nxt; cA = nA; cB = nB; ++ui;
        cul = cur.ul;
        if (wr == 1) PG8_BAR;
    }
    PG8_WAIT_V(0);
    PG8_BAR;
#undef PG8_SA
#undef PG8_SB
#undef PG8_STAGE
#undef PG8_STAGE_A
#undef PG8_LDA
#undef PG8_LDB
#undef PG8_MMA
#undef PG8_WAIT_V
#undef PG8_WAIT_L
#undef PG8_BAR
#undef PG8_SCHED
}

struct EpiP { static constexpr int ID = 2; bf16_t* P;
    __device__ __forceinline__ void operator()(const f32x4 (&acc)[2][2][4][2], const Unit& u, const LAS int*, const LAS bf16_t*, int wr, int wc, int fr, int fq) const {
        const int row0 = u.pm * BM + wr * 64 + fr, col0 = u.pn * BM + wc * 32 + 8 * fq;
#pragma unroll
        for (int ai = 0; ai < 2; ++ai)
#pragma unroll
            for (int m = 0; m < 4; ++m) { bf16_t* rowp = P + (size_t)(row0 + ai * HALF + m * 16) * DINP + col0;
#pragma unroll
                for (int bj = 0; bj < 2; ++bj) { const f32x4 v0 = acc[ai][bj][m][0], v1 = acc[ai][bj][m][1]; u32x4 w;
                    w.x = cvt_pk_bf16(v0[0], v0[1]); w.y = cvt_pk_bf16(v0[2], v0[3]); w.z = cvt_pk_bf16(v1[0], v1[1]); w.w = cvt_pk_bf16(v1[2], v1[3]);
                    *(GAS u32x4*)(rowp + bj * HALF) = w; } }
    } };
struct EpiOut { static constexpr int ID = 6; const float* x; const float* mod; float* out;
    __device__ __forceinline__ void operator()(const f32x4 (&acc)[2][2][4][2], const Unit& u, const LAS int*, const LAS bf16_t*, int wr, int wc, int fr, int fq) const {
        const int row0 = u.pm * BM + wr * 64 + fr, col0 = u.pn * BM + wc * 32 + 8 * fq;
        const float* gate = mod + (row0 >> 13) * 6144 + 2 * 1024;
#pragma unroll
        for (int bj = 0; bj < 2; ++bj) { const f32x4 g0 = *(const GAS f32x4*)(gate + col0 + bj * HALF), g1 = *(const GAS f32x4*)(gate + col0 + bj * HALF + 4);
#pragma unroll
            for (int ai = 0; ai < 2; ++ai)
#pragma unroll
                for (int m = 0; m < 4; ++m) { const size_t off = (size_t)(row0 + ai * HALF + m * 16) * DM + col0 + bj * HALF;
                    const f32x4 x0 = *(const GAS f32x4*)(x + off), x1 = *(const GAS f32x4*)(x + off + 4);
                    *(GAS f32x4*)(out + off) = x0 + g0 * acc[ai][bj][m][0]; *(GAS f32x4*)(out + off + 4) = x1 + g1 * acc[ai][bj][m][1]; } }
    } };
typedef _Float16 h2_t __attribute__((ext_vector_type(2))); typedef short s2_t __attribute__((ext_vector_type(2)));
struct EpiM1 { static constexpr int ID = 8; unsigned char* act;
    __device__ __forceinline__ void operator()(const f32x4 (&acc)[2][2][4][2], const Unit& u, const LAS int* tab, const LAS bf16_t* aux, int wr, int wc, int fr, int fq) const {
        const int cl = wc * 32 + 8 * fq, col0 = u.pn * BM + cl;
        h2_t bg[2][2], bl[2][2];
#pragma unroll
        for (int bj = 0; bj < 2; ++bj) { const u32x4 w = *(const LAS u32x4*)(aux + u.ul * 256 + bj * HALF + cl);
#pragma unroll
            for (int n = 0; n < 2; ++n) { bg[bj][n] = (h2_t){(_Float16)lo16(w[2 * n]), (_Float16)lo16(w[2 * n + 1])}; bl[bj][n] = (h2_t){(_Float16)hi16(w[2 * n]), (_Float16)hi16(w[2 * n + 1])}; } }
        const h2_t winv = {(_Float16)WINV, (_Float16)WINV}, seven = {(_Float16)7.f, (_Float16)7.f}, one = {(_Float16)1.f, (_Float16)1.f}, cexp = {(_Float16)-2.4554669595930156f, (_Float16)-2.4554669595930156f};
#pragma unroll
        for (int ai = 0; ai < 2; ++ai)
#pragma unroll
            for (int m = 0; m < 4; ++m) { const int r = ai * HALF + wr * 64 + m * 16 + fr; const bool ok = r < u.nvalid;
                const int pair = tab[u.ul * 256 + r]; unsigned char* rowp = act + (size_t)pair * DFF + (col0 >> 1);
#pragma unroll
                for (int bj = 0; bj < 2; ++bj) { s2_t pk = {0, 0};
#pragma unroll
                    for (int n = 0; n < 2; ++n) { const f32x4 v = acc[ai][bj][m][n];
                        h2_t g = __builtin_bit_cast(h2_t, __builtin_amdgcn_cvt_pkrtz(v[0], v[2])), l = __builtin_bit_cast(h2_t, __builtin_amdgcn_cvt_pkrtz(v[1], v[3]));
                        g = g * winv + bg[bj][n]; l = l * winv + bl[bj][n];
                        g = __builtin_elementwise_min(g, seven); l = __builtin_elementwise_min(__builtin_elementwise_max(l, -seven), seven);
                        const h2_t e = __builtin_elementwise_exp2(g * cexp);
                        const h2_t d = e + one; const h2_t rc = {(_Float16)__builtin_amdgcn_rcph(d[0]), (_Float16)__builtin_amdgcn_rcph(d[1])};
                        const h2_t o = (g * rc) * (l + one);
                        pk = n == 0 ? __builtin_amdgcn_cvt_scalef32_pk_fp8_f16(pk, o, 1.0f, false) : __builtin_amdgcn_cvt_scalef32_pk_fp8_f16(pk, o, 1.0f, true); }
                    if (ok) *(GAS unsigned*)(rowp + bj * (HALF / 2)) = __builtin_bit_cast(unsigned, pk); } }
    } };
constexpr float YSCALE = 8.f, YINV = 1.f / 8.f;
struct EpiM2 { static constexpr int ID = 9; unsigned char* y;
    __device__ __forceinline__ void operator()(const f32x4 (&acc)[2][2][4][2], const Unit& u, const LAS int* tab, const LAS bf16_t* aux, int wr, int wc, int fr, int fq) const {
        const int cl = wc * 32 + 8 * fq, col0 = u.pn * BM + cl;
        h2_t bv[2][2][2];
#pragma unroll
        for (int bj = 0; bj < 2; ++bj) { const u32x4 w = *(const LAS u32x4*)(aux + u.ul * 256 + bj * HALF + cl);
#pragma unroll
            for (int n = 0; n < 2; ++n) { bv[bj][n][0] = (h2_t){(_Float16)lo16(w[2 * n]), (_Float16)hi16(w[2 * n])}; bv[bj][n][1] = (h2_t){(_Float16)lo16(w[2 * n + 1]), (_Float16)hi16(w[2 * n + 1])}; } }
        const h2_t winv = {(_Float16)WINV, (_Float16)WINV};
#pragma unroll
        for (int ai = 0; ai < 2; ++ai)
#pragma unroll
            for (int m = 0; m < 4; ++m) { const int r = ai * HALF + wr * 64 + m * 16 + fr; const bool ok = r < u.nvalid;
                const int pair = tab[u.ul * 256 + r]; const _Float16 gs = (_Float16)(bf2f(aux[9 * 256 + u.ul * 256 + r]) * YSCALE); const h2_t g = {gs, gs}; unsigned char* rowp = y + (size_t)pair * DM + col0;
#pragma unroll
                for (int bj = 0; bj < 2; ++bj) { u32x2 w;
#pragma unroll
                    for (int n = 0; n < 2; ++n) { const f32x4 v = acc[ai][bj][m][n];
                        const h2_t p0 = (__builtin_bit_cast(h2_t, __builtin_amdgcn_cvt_pkrtz(v[0], v[1])) * winv + bv[bj][n][0]) * g, p1 = (__builtin_bit_cast(h2_t, __builtin_amdgcn_cvt_pkrtz(v[2], v[3])) * winv + bv[bj][n][1]) * g;
                        s2_t pk = {0, 0}; pk = __builtin_amdgcn_cvt_scalef32_pk_fp8_f16(pk, p0, 1.0f, false); pk = __builtin_amdgcn_cvt_scalef32_pk_fp8_f16(pk, p1, 1.0f, true);
                        w[n] = __builtin_bit_cast(unsigned, pk); }
                    if (ok) *(GAS u32x2*)(rowp + bj * HALF) = w; } }
    } };
}
constexpr int PG8_TAB_OFF = pg8::STAGE_BYTES;
constexpr int PG8_AUX_OFF = PG8_TAB_OFF + 18 * 1024;
constexpr int PG8_PRE_OFF = PG8_AUX_OFF + 9 * 1024;
static_assert(PG8_PRE_OFF + 512 <= LDS_SCRATCH, "LDS map");

template <int NCT, class Epi>
__device__ __forceinline__ void phase_moe_pg8(const Args& a, LAS unsigned char* lds, const unsigned char* A, int ashift, const unsigned char* Wt, size_t wstride, const float* bias, int nbias, const float* gates, const Epi& E) {
    LAS int* tab = (LAS int*)(lds + PG8_TAB_OFF); LAS int* pre = (LAS int*)(lds + PG8_PRE_OFF); LAS bf16_t* aux = (LAS bf16_t*)(lds + PG8_AUX_OFF);
    const unsigned* cnt = (const unsigned*)(a.ws + WS_CTL) + CW_CNT; const unsigned* list = (const unsigned*)(a.ws + WS_LIST);
    __syncthreads();
    const int tidm = tid_of(a.wv);
    if (tidm < NE) pre[33 + tidm] = (int)__hip_atomic_load(cnt + 64 * tidm, __ATOMIC_RELAXED, __HIP_MEMORY_SCOPE_AGENT);
    __syncthreads();
    if (tidm == 0) { int s = 0;
#pragma unroll 1
        for (int e = 0; e < NE; ++e) { const int c = pre[33 + e]; pre[e] = s; s += (c + 255) >> 8; } pre[32] = s; }
    __syncthreads();
    const int G_ = (int)gridDim.x, bx_ = (int)blockIdx.x, vcu_ = (G_ % 8 == 0) ? (bx_ % 8) * (G_ / 8) + bx_ / 8 : bx_;
    pg8::ExpertOrder<NCT> S{pre, G_, vcu_, (const char*)A, (const char*)Wt, wstride, 1024};
    constexpr int NU = NCT == 8 ? 18 : 9; constexpr bool HASG = NCT == 4;
    const int nunit_ = pre[32] * NCT;
    unsigned val[NU]; float gv[NU];
#pragma unroll
    for (int i = 0; i < NU; ++i) { pg8::Unit u; val[i] = 0u;
        if (S.next(i, u)) { if (tidm < 256) val[i] = list[(size_t)u.e * 32768 + u.pm * 256 + (tidm < u.nvalid ? tidm : 0)]; else val[i] = __float_as_uint(bias[(size_t)u.e * nbias + u.pn * 256 + tidm - 256]); } }
#pragma unroll
    for (int i = 0; i < NU; ++i) { gv[i] = 0.f; if (HASG && tidm < 256 && i * G_ + vcu_ < nunit_) gv[i] = gates[val[i]]; }
#pragma unroll
    for (int i = 0; i < NU; ++i) if (i * G_ + vcu_ < nunit_) {
        if (tidm < 256) { tab[i * 256 + tidm] = (int)val[i]; if (HASG) aux[9 * 256 + i * 256 + tidm] = (bf16_t)f2bf(gv[i]); }
        else aux[i * 256 + tidm - 256] = (bf16_t)f2bf(__uint_as_float(val[i])); }
    __syncthreads();
    pg8::gemm_phase<Epi, pg8::ExpertOrder<NCT>, true, true>(lds, tab, aux, ashift, 512, S, E, a.wv);
}

__device__ __forceinline__ void mla_tile(const Args& a, LAS unsigned char* lds, int tile, int r0 = 0, int nrows = 128) {
    const int tid = tid_of(a.wv), lane = tid & 63, wave = a.wv, fr = lane & 15, fq = lane >> 4;
    const bool lat = tile < 256;
    const int prow0 = tile * 128;
    const int b = lat ? (prow0 >> 13) : ((prow0 - T) >> 8);
    const int tpos0 = lat ? (prow0 & 8191) : ((prow0 - T) & 255);
    const int key0 = lat ? (LC + tpos0) : tpos0;
    LAS unsigned char* Aq = lds;
    LAS unsigned char* Akv = lds + 34816;
    LAS float* kpe = (LAS float*)(lds + 34816 + 18432);
    LAS float* sspe = (LAS float*)(lds + 34816 + 18432 + 16384);
    const bf16_t* P = (const bf16_t*)(a.ws + WS_P);
    const float* tabm = (const float*)(a.ws + WS_TABM);
    __syncthreads();
    if ((tid >> 2) >= r0 && (tid >> 2) < r0 + nrows) {
        const int r = tid >> 2, part = tid & 3;
        const bf16_t* pr = P + (size_t)(prow0 + r) * DINP;
        u32x4 q[8]; float ss = 0.f;
#pragma unroll
        for (int i = 0; i < 8; ++i) { q[i] = *(const GAS u32x4*)(pr + OFF_Q + part * 64 + i * 8);
#pragma unroll
            for (int e = 0; e < 4; ++e) { const float lo = lo16(q[i][e]), hi = hi16(q[i][e]); ss += lo * lo + hi * hi; } }
        ss += __shfl_xor(ss, 1); ss += __shfl_xor(ss, 2);
        float rstd = rsqrtf(ss * (1.f / 256.f) + EPS);
        const float* gq = a.in[I_GQL] + part * 64;
#pragma unroll
        for (int i = 0; i < 8; ++i) { u32x2 o;
#pragma unroll
            for (int e = 0; e < 2; ++e) o[e] = cvt4_fp8(lo16(q[i][2 * e]) * rstd * gq[i * 8 + 4 * e], hi16(q[i][2 * e]) * rstd * gq[i * 8 + 4 * e + 1], lo16(q[i][2 * e + 1]) * rstd * gq[i * 8 + 4 * e + 2], hi16(q[i][2 * e + 1]) * rstd * gq[i * 8 + 4 * e + 3]);
            *(LAS u32x2*)(Aq + r * 272 + part * 64 + i * 8) = o; }
        u32x4 kv[4]; ss = 0.f;
#pragma unroll
        for (int i = 0; i < 4; ++i) { kv[i] = *(const GAS u32x4*)(pr + OFF_KV + part * 32 + i * 8);
#pragma unroll
            for (int e = 0; e < 4; ++e) { const float lo = lo16(kv[i][e]), hi = hi16(kv[i][e]); ss += lo * lo + hi * hi; } }
        ss += __shfl_xor(ss, 1); ss += __shfl_xor(ss, 2);
        rstd = rsqrtf(ss * (1.f / 128.f) + EPS);
        const float* gkv = a.in[I_GKVL] + part * 32;
#pragma unroll
        for (int i = 0; i < 4; ++i) { u32x2 o;
#pragma unroll
            for (int e = 0; e < 2; ++e) o[e] = cvt4_fp8(lo16(kv[i][2 * e]) * rstd * gkv[i * 8 + 4 * e], hi16(kv[i][2 * e]) * rstd * gkv[i * 8 + 4 * e + 1], lo16(kv[i][2 * e + 1]) * rstd * gkv[i * 8 + 4 * e + 2], hi16(kv[i][2 * e + 1]) * rstd * gkv[i * 8 + 4 * e + 3]);
            *(LAS u32x2*)(Akv + r * 144 + part * 32 + i * 8) = o; }
        const u32x4 pe = *(const GAS u32x4*)(pr + OFF_PE + part * 8); ss = 0.f;
#pragma unroll
        for (int e = 0; e < 4; ++e) { const float lo = lo16(pe[e]), hi = hi16(pe[e]); ss += lo * lo + hi * hi; kpe[r * 32 + part * 8 + 2 * e] = lo; kpe[r * 32 + part * 8 + 2 * e + 1] = hi; }
        ss += __shfl_xor(ss, 1); ss += __shfl_xor(ss, 2);
        if (part == 0) sspe[r] = ss;
    }
    __syncthreads();
    const int h = wave, bh = b * NH + h;
    typedef int i32x4m __attribute__((ext_vector_type(4))); typedef int i32x8m __attribute__((ext_vector_type(8)));
#define LD32G(p) __builtin_shufflevector(*(const GAS i32x4m*)(p), *(const GAS i32x4m*)((p) + 16), 0, 1, 2, 3, 4, 5, 6, 7)
#define LD32L(p) __builtin_shufflevector(*(const LAS i32x4m*)(p), *(const LAS i32x4m*)((p) + 16), 0, 1, 2, 3, 4, 5, 6, 7)
    if (lat) {
        const unsigned char* WQ = a.ws + WS_WQ + (size_t)h * QK * 256;
        const float* gqh = a.in[I_GQH];
        unsigned char* Qo = a.ws + WS_Q + ((size_t)bh * SEQ + tpos0) * QK8;
        i32x8m bq[2][6];
#pragma unroll
        for (int s2 = 0; s2 < 2; ++s2)
#pragma unroll
            for (int j = 0; j < 6; ++j) bq[s2][j] = LD32G(WQ + (size_t)(16 * j + fr) * 256 + 128 * s2 + 32 * fq);
        f32x4 gqv[6];
#pragma unroll
        for (int j = 0; j < 6; ++j) gqv[j] = *(const GAS f32x4*)(gqh + 16 * j + 4 * fq);
#pragma unroll 1
        for (int rq = 0; rq < 8; ++rq) {
            const int row = rq * 16 + fr, t = tpos0 + row;
            f32x4 csq[2][2];
#pragma unroll
            for (int ax = 0; ax < 2; ++ax) { const int pi = ax == 0 ? (t >> 6) : 128 + (t & 63); const float* cs = tabm + (pi * 8 + 4 * (fq & 1)) * 2;
                csq[ax][0] = *(const GAS f32x4*)(cs); csq[ax][1] = *(const GAS f32x4*)(cs + 4); }
            f32x4 acc[6];
#pragma unroll
            for (int j = 0; j < 6; ++j) acc[j] = (f32x4){0.f, 0.f, 0.f, 0.f};
#pragma unroll
            for (int s2 = 0; s2 < 2; ++s2) { const i32x8m af = LD32L(Aq + row * 272 + 128 * s2 + 32 * fq);
#pragma unroll
                for (int j = 0; j < 6; ++j) acc[j] = __builtin_amdgcn_mfma_scale_f32_16x16x128_f8f6f4(bq[s2][j], af, acc[j], 0, 0, 0, 0, 0, 0); }
            float ss = 0.f;
#pragma unroll
            for (int j = 0; j < 6; ++j) ss += (acc[j][0] * acc[j][0] + acc[j][1] * acc[j][1]) + (acc[j][2] * acc[j][2] + acc[j][3] * acc[j][3]);
            ss += __shfl_xor(ss, 16); ss += __shfl_xor(ss, 32);
            const float rstd = rsqrtf(ss * (1.f / 96.f) + EPS * (WQ_SCALE * WQ_SCALE)) * QSCALE;
#pragma unroll
            for (int j = 0; j < 6; ++j) {
                const int col = 16 * j + 4 * fq; const f32x4 gv = gqv[j];
                f32x4 v = acc[j] * gv * rstd;
                if (j >= 4) {
                    const int ax = j - 4;
#pragma unroll
                    for (int r = 0; r < 4; ++r) { const float other = __shfl_xor(v[r], 32); const float c = csq[ax][r >> 1][2 * (r & 1)], sn = csq[ax][r >> 1][2 * (r & 1) + 1];
                        v[r] = (fq < 2) ? (v[r] * c - other * sn) : (v[r] * c + other * sn); }
                }
                *(GAS unsigned*)(Qo + (size_t)row * QK8 + col) = cvt4_fp8(v[0], v[1], v[2], v[3]);
            }
            *(GAS u32x2*)(Qo + (size_t)row * QK8 + QK + 8 * fq) = (u32x2){0u, 0u};
        }
    }
    {
        const unsigned char* WKV = a.ws + WS_WKV + (size_t)h * 128 * 128;
        const float* gkh = a.in[I_GKH];
        unsigned char* Ko = a.ws + WS_K + ((size_t)bh * SKV + key0) * QK8;
        unsigned char* Vo = a.ws + WS_VT + (size_t)bh * DV * SKV + key0;
        i32x8m bkv[8];
#pragma unroll
        for (int j = 0; j < 8; ++j) bkv[j] = LD32G(WKV + (size_t)(16 * j + fr) * 128 + 32 * fq);
        f32x4 gkv[4]; float gp0[4], gp1[4];
#pragma unroll
        for (int j = 0; j < 4; ++j) gkv[j] = *(const GAS f32x4*)(gkh + 16 * j + 4 * fq);
#pragma unroll
        for (int r = 0; r < 4; ++r) { const int c0 = (fq >> 1) * 16 + 4 * (fq & 1) + r; gp0[r] = gkh[64 + c0]; gp1[r] = gkh[64 + c0 + 8]; }
#pragma unroll 1
        for (int rq = r0 >> 4; rq < ((r0 + nrows) >> 4); ++rq) {
            f32x4 csk[2];
            { const int t = tpos0 + rq * 16 + fr, ax = fq >> 1, pi = ax == 0 ? (t >> 6) : 128 + (t & 63); const float* cs = tabm + (pi * 8 + 4 * (fq & 1)) * 2;
              csk[0] = *(const GAS f32x4*)(cs); csk[1] = *(const GAS f32x4*)(cs + 4); }
            f32x4 acc[1][8];
#pragma unroll
            for (int i = 0; i < 1; ++i)
#pragma unroll
                for (int j = 0; j < 8; ++j) acc[i][j] = (f32x4){0.f, 0.f, 0.f, 0.f};
            { const i32x8m af = LD32L(Akv + (rq * 16 + fr) * 144 + 32 * fq);
#pragma unroll
              for (int j = 0; j < 8; ++j) acc[0][j] = __builtin_amdgcn_mfma_scale_f32_16x16x128_f8f6f4(bkv[j], af, acc[0][j], 0, 0, 0, 0, 0, 0) ; }
#pragma unroll
            for (int j = 0; j < 8; ++j) acc[0][j] = acc[0][j] * WKV_INV;
#pragma unroll
            for (int i = 0; i < 1; ++i) {
                const int row = rq * 16 + 16 * i + fr, t = tpos0 + row;
                const int kk = row & 63; const int vrow = (row & 64) + 32 * ((kk >> 2) & 1) + (kk & 3) + 4 * ((kk & 31) >> 3) + 16 * (kk >> 5);
                float ss = 0.f;
#pragma unroll
                for (int j = 0; j < 4; ++j) ss += (acc[i][j][0] * acc[i][j][0] + acc[i][j][1] * acc[i][j][1]) + (acc[i][j][2] * acc[i][j][2] + acc[i][j][3] * acc[i][j][3]);
                ss += __shfl_xor(ss, 16); ss += __shfl_xor(ss, 32);
                const float rstd = rsqrtf((ss + sspe[row]) * (1.f / 96.f) + EPS);
#pragma unroll
                for (int j = 0; j < 4; ++j) { const int col = 16 * j + 4 * fq; const f32x4 gv = gkv[j]; const f32x4 v = acc[i][j] * gv * rstd;
                    *(GAS unsigned*)(Ko + (size_t)row * QK8 + col) = cvt4_fp8(v[0], v[1], v[2], v[3]); }
                {
                    const int ax = fq >> 1, f0 = 4 * (fq & 1);
                    float o0[4], o1[4];
#pragma unroll
                    for (int r = 0; r < 4; ++r) { const int c0 = ax * 16 + f0 + r, c1 = c0 + 8;
                        const float x0 = kpe[row * 32 + c0] * rstd * gp0[r], x1 = kpe[row * 32 + c1] * rstd * gp1[r];
                        const float c = lat ? csk[r >> 1][2 * (r & 1)] : 1.f, s = lat ? csk[r >> 1][2 * (r & 1) + 1] : 0.f;
                        o0[r] = x0 * c - x1 * s; o1[r] = x1 * c + x0 * s; }
                    *(GAS unsigned*)(Ko + (size_t)row * QK8 + 64 + ax * 16 + f0) = cvt4_fp8(o0[0], o0[1], o0[2], o0[3]);
                    *(GAS unsigned*)(Ko + (size_t)row * QK8 + 64 + ax * 16 + 8 + f0) = cvt4_fp8(o1[0], o1[1], o1[2], o1[3]);
                    *(GAS u32x2*)(Ko + (size_t)row * QK8 + QK + 8 * fq) = (u32x2){0u, 0u};
                }
#pragma unroll
                for (int j = 4; j < 8; ++j)
#pragma unroll
                    for (int r = 0; r < 4; ++r) { const int d = 16 * (j - 4) + 4 * fq + r; Vo[(size_t)d * SKV + vrow] = (unsigned char)(cvt4_fp8(acc[i][j][r], 0.f, 0.f, 0.f) & 0xffu); }
            }
        }
    }
}

__device__ __forceinline__ float log_gamma(const float* logit) { const float x = *logit; return -log1pf(__expf(-x)); }

__device__ __forceinline__ void rope16(float (&out)[16], const bf16_t* rowp  , int part, const float* cs  , float scale) {
    const u32x4 a0 = *(const GAS u32x4*)(rowp + part * 16), a1 = *(const GAS u32x4*)(rowp + part * 16 + 8);
    const u32x4 b0 = *(const GAS u32x4*)(rowp + (part ^ 1) * 16), b1 = *(const GAS u32x4*)(rowp + (part ^ 1) * 16 + 8);
    float xs[16], xo[16];
#pragma unroll
    for (int e = 0; e < 4; ++e) { xs[2 * e] = lo16(a0[e]); xs[2 * e + 1] = hi16(a0[e]); xs[8 + 2 * e] = lo16(a1[e]); xs[8 + 2 * e + 1] = hi16(a1[e]);
        xo[2 * e] = lo16(b0[e]); xo[2 * e + 1] = hi16(b0[e]); xo[8 + 2 * e] = lo16(b1[e]); xo[8 + 2 * e + 1] = hi16(b1[e]); }
    if (cs) {
        const float sg = (part & 1) ? 1.f : -1.f;
#pragma unroll
        for (int q = 0; q < 8; ++q) { const f32x4 t = *(const GAS f32x4*)(cs + 4 * q);
            out[2 * q] = (xs[2 * q] * t[0] + sg * xo[2 * q] * t[1]) * scale; out[2 * q + 1] = (xs[2 * q + 1] * t[2] + sg * xo[2 * q + 1] * t[3]) * scale; }
    } else {
#pragma unroll
        for (int f = 0; f < 16; ++f) out[f] = xs[f] * scale;
    }
}

__device__ __forceinline__ void ret_local_unit(const Args& a, LAS unsigned char* lds, int unit) {
    const int tid = tid_of(a.wv), lane = tid & 63, wave = a.wv, fr = lane & 15, fq = lane >> 4;
    const int bh = unit / NSLOT, slot = unit % NSLOT, b = bh >> 2, h = bh & 3;
    const bool lat = slot >= 2;
    const int prow0 = lat ? b * SEQ + (slot - 2) * RC : T + b * LC + slot * RC;
    const int tpos0 = lat ? (slot - 2) * RC : 0;
    LAS bf16_t* KfT = (LAS bf16_t*)lds;
    LAS bf16_t* KbT = (LAS bf16_t*)(lds + 17408);
    LAS bf16_t* VT = (LAS bf16_t*)(lds + 34816);
    const bf16_t* P = (const bf16_t*)(a.ws + WS_P);
    const float* tabr = (const float*)(a.ws + WS_TABR);
    const float lgf = log_gamma(a.in[I_DECAY] + h), lgb = log_gamma(a.in[I_DECAY] + 4 + h);
    __syncthreads();
    {
        const int j = tid >> 2, part = tid & 3, t = tpos0 + j, ax = part >> 1;
        const int pi = ax == 0 ? (t >> 6) : 128 + (t & 63);
        float o[16]; rope16(o, P + (size_t)(prow0 + j) * DINP + OFF_RK + h * 64, part, lat ? tabr + pi * 32 : nullptr, 0.125f);
        const float wf = __expf(lgf * (float)(127 - j)), wb = __expf(lgb * (float)j);
#pragma unroll
        for (int f = 0; f < 16; ++f) { const int d = part * 16 + f; KfT[d * 136 + j] = (bf16_t)f2bf(o[f] * wf); KbT[d * 136 + j] = (bf16_t)f2bf(o[f] * wb); }
    }
    for (int idx = tid; idx < 128 * 16; idx += 512) {
        const int j = idx >> 4, c = idx & 15;
        const u32x4 v = *(const GAS u32x4*)(P + (size_t)(prow0 + j) * DINP + OFF_RV + h * 128 + c * 8);
#pragma unroll
        for (int e = 0; e < 4; ++e) { VT[(c * 8 + 2 * e) * 136 + j] = (bf16_t)(v[e] & 0xffffu); VT[(c * 8 + 2 * e + 1) * 136 + j] = (bf16_t)(v[e] >> 16); }
    }
    __syncthreads();
    const int dir = wave >> 2, mi = wave & 3;
    f32x4 acc[1][8];
#pragma unroll
    for (int j = 0; j < 8; ++j) acc[0][j] = (f32x4){0.f, 0.f, 0.f, 0.f};
    mma_ll<1, 8, false>(acc, dir ? KbT : KfT, 136, 16 * mi, VT, 136, 0, 128, lane);
    float* out = (float*)(a.ws + WS_LST) + ((size_t)(bh * 2 + dir) * NSLOT + slot) * 8192;
#pragma unroll
    for (int j = 0; j < 8; ++j) *(GAS f32x4*)(out + (size_t)(16 * j + fr) * 64 + 16 * mi + 4 * fq) = acc[0][j];
}

__device__ __forceinline__ void phase_ret_scan(const Args& a) {
    const int gt = blockIdx.x * 512 + tid_of(a.wv);
    if (gt >= 32 * 2048) return;
    const int bd = gt >> 11, v4 = gt & 2047, dir = bd & 1, h = (bd >> 1) & 3;
    const float lg = log_gamma(a.in[I_DECAY] + dir * 4 + h);
    const float g = __expf(lg * 128.f);
    float* base = (float*)(a.ws + WS_LST) + (size_t)bd * NSLOT * 8192 + v4 * 4;
    f32x4 S = (f32x4){0.f, 0.f, 0.f, 0.f};
#pragma unroll 1
    for (int bt = 0; bt < 5; ++bt) {
        f32x4 L[13];
#pragma unroll
        for (int q = 0; q < 13; ++q) { const int n = bt * 13 + q; const int slot = dir == 0 ? n : (n == 0 ? 1 : (n == 1 ? 0 : 67 - n)); L[q] = *(const GAS f32x4*)(base + (size_t)slot * 8192); }
#pragma unroll
        for (int q = 0; q < 13; ++q) { const int n = bt * 13 + q; const int slot = dir == 0 ? n : (n == 0 ? 1 : (n == 1 ? 0 : 67 - n)); S = S * g + L[q]; *(GAS f32x4*)(base + (size_t)slot * 8192) = S; }
    }
}

__device__ __forceinline__ void ret_out_unit(const Args& a, LAS unsigned char* lds, int unit) {
    const int tid = tid_of(a.wv), lane = tid & 63, wave = a.wv, fr = lane & 15, fq = lane >> 4;
    const int bh = unit >> 6, c = unit & 63, b = bh >> 2, h = bh & 3;
    const int prow0 = b * SEQ + c * RC, tpos0 = c * RC;
    LAS bf16_t* Qs = (LAS bf16_t*)lds;
    LAS bf16_t* Ks = (LAS bf16_t*)(lds + 18432);
    LAS bf16_t* VT = (LAS bf16_t*)(lds + 36864);
    LAS bf16_t* SfT = (LAS bf16_t*)(lds + 71680);
    LAS bf16_t* SbT = (LAS bf16_t*)(lds + 90112);
    LAS bf16_t* Ws = (LAS bf16_t*)(lds + 108544);
    const bf16_t* P = (const bf16_t*)(a.ws + WS_P);
    const float* tabr = (const float*)(a.ws + WS_TABR);
    const float lgf = log_gamma(a.in[I_DECAY] + h), lgb = log_gamma(a.in[I_DECAY] + 4 + h);
    __syncthreads();
    {
        const int j = tid >> 2, part = tid & 3, t = tpos0 + j, ax = part >> 1;
        const int pi = ax == 0 ? (t >> 6) : 128 + (t & 63);
        float oq[16], ok[16];
        rope16(oq, P + (size_t)(prow0 + j) * DINP + OFF_RQ + h * 64, part, tabr + pi * 32, 1.f);
        rope16(ok, P + (size_t)(prow0 + j) * DINP + OFF_RK + h * 64, part, tabr + pi * 32, 0.125f);
        u32x4 w0, w1;
        w0 = (u32x4){pk2(oq[0], oq[1]), pk2(oq[2], oq[3]), pk2(oq[4], oq[5]), pk2(oq[6], oq[7])}; w1 = (u32x4){pk2(oq[8], oq[9]), pk2(oq[10], oq[11]), pk2(oq[12], oq[13]), pk2(oq[14], oq[15])};
        *(LAS u32x4*)(Qs + j * 72 + part * 16) = w0; *(LAS u32x4*)(Qs + j * 72 + part * 16 + 8) = w1;
        w0 = (u32x4){pk2(ok[0], ok[1]), pk2(ok[2], ok[3]), pk2(ok[4], ok[5]), pk2(ok[6], ok[7])}; w1 = (u32x4){pk2(ok[8], ok[9]), pk2(ok[10], ok[11]), pk2(ok[12], ok[13]), pk2(ok[14], ok[15])};
        *(LAS u32x4*)(Ks + j * 72 + part * 16) = w0; *(LAS u32x4*)(Ks + j * 72 + part * 16 + 8) = w1;
    }
    for (int idx = tid; idx < 128 * 16; idx += 512) {
        const int j = idx >> 4, cch = idx & 15;
        const u32x4 v = *(const GAS u32x4*)(P + (size_t)(prow0 + j) * DINP + OFF_RV + h * 128 + cch * 8);
#pragma unroll
        for (int e = 0; e < 4; ++e) { VT[(cch * 8 + 2 * e) * 136 + j] = (bf16_t)(v[e] & 0xffffu); VT[(cch * 8 + 2 * e + 1) * 136 + j] = (bf16_t)(v[e] >> 16); }
    }
    {
        const float* sf = (const float*)(a.ws + WS_LST) + ((size_t)(bh * 2 + 0) * NSLOT + (c + 1)) * 8192;
        const float* sb = (const float*)(a.ws + WS_LST) + ((size_t)(bh * 2 + 1) * NSLOT + (c == 63 ? 0 : c + 3)) * 8192;
        for (int idx = tid; idx < 2048; idx += 512) {
            const int e = idx >> 4, d = (idx & 15) * 4;
            const f32x4 x = *(const GAS f32x4*)(sf + idx * 4), y = *(const GAS f32x4*)(sb + idx * 4);
            u32x2 w; w.x = pk2(x[0], x[1]); w.y = pk2(x[2], x[3]); *(LAS u32x2*)(SfT + e * 72 + d) = w;
            w.x = pk2(y[0], y[1]); w.y = pk2(y[2], y[3]); *(LAS u32x2*)(SbT + e * 72 + d) = w;
        }
    }
    __syncthreads();
    const int i0 = 16 * wave, irow = i0 + fr;
    u32x2 gwv[8];
    { const bf16_t* pg_ = P + (size_t)(prow0 + irow) * DINP + OFF_RG + h * 128;
#pragma unroll
      for (int j = 0; j < 8; ++j) gwv[j] = *(const GAS u32x2*)(pg_ + 16 * j + 4 * fq); }
    f32x4 accS[1][8], accF[1][8], accB[1][8], accO[1][8];
#pragma unroll
    for (int j = 0; j < 8; ++j) { accS[0][j] = (f32x4){0.f, 0.f, 0.f, 0.f}; accF[0][j] = accS[0][j]; accB[0][j] = accS[0][j]; accO[0][j] = accS[0][j]; }
    mma_ll<1, 8, true>(accS, Qs, 72, i0, Ks, 72, 0, 64, lane);
    mma_ll<1, 8, true>(accF, Qs, 72, i0, SfT, 72, 0, 64, lane);
    mma_ll<1, 8, true>(accB, Qs, 72, i0, SbT, 72, 0, 64, lane);
#pragma unroll
    for (int j = 0; j < 8; ++j) {
        float w[4];
#pragma unroll
        for (int r = 0; r < 4; ++r) { const int jj = 16 * j + 4 * fq + r; const int df = irow - jj;
            const float dec = df > 0 ? __expf(lgf * (float)df) : (df < 0 ? __expf(lgb * (float)(-df)) : 2.f);
            w[r] = accS[0][j][r] * dec; }
        u32x2 pw; pw.x = pk2(w[0], w[1]); pw.y = pk2(w[2], w[3]);
        *(LAS u32x2*)(Ws + irow * 136 + 16 * j + 4 * fq) = pw;
    }
    LDS_WAIT(); __builtin_amdgcn_wave_barrier();
    mma_ll<1, 8, true>(accO, Ws, 136, i0, VT, 136, 0, 128, lane);
    const float wf = __expf(lgf * (float)(irow + 1)), wb = __expf(lgb * (float)(128 - irow));
    float ss = 0.f;
#pragma unroll
    for (int j = 0; j < 8; ++j) { accO[0][j] = accO[0][j] + accF[0][j] * wf + accB[0][j] * wb;
        ss += (accO[0][j][0] * accO[0][j][0] + accO[0][j][1] * accO[0][j][1]) + (accO[0][j][2] * accO[0][j][2] + accO[0][j][3] * accO[0][j][3]); }
    ss += __shfl_xor(ss, 16); ss += __shfl_xor(ss, 32);
    const float rstd = rsqrtf(ss * (1.f / 128.f) + EPS);
    const float* gro = a.in[I_GRET] + h * 128;
    bf16_t* mix = (bf16_t*)(a.ws + WS_MIX) + (size_t)(prow0 + irow) * DM + 512 + h * 128;
#pragma unroll
    for (int j = 0; j < 8; ++j) { const int e = 16 * j + 4 * fq; const f32x4 gv = *(const GAS f32x4*)(gro + e); const u32x2 gw = gwv[j];
        const float g0 = lo16(gw.x), g1 = hi16(gw.x), g2 = lo16(gw.y), g3 = hi16(gw.y);
        f32x4 v = accO[0][j] * gv * rstd;
        v[0] *= g0 / (1.f + __expf(-g0)); v[1] *= g1 / (1.f + __expf(-g1)); v[2] *= g2 / (1.f + __expf(-g2)); v[3] *= g3 / (1.f + __expf(-g3));
        u32x2 w; w.x = pk2(v[0], v[1]); w.y = pk2(v[2], v[3]); *(GAS u32x2*)(mix + e) = w; }
}

namespace att {
constexpr int KLD8 = 144  , VLD8 = 80  , KBUF = 64 * KLD8, VBUF = 64 * VLD8, NKB = 3, NVB = 4;
constexpr int L_K = 0, L_V = NKB * KBUF, L_WS = NKB * KBUF + NVB * VBUF;
__device__ __forceinline__ int crow(int r, int hi) { return (r & 3) + 8 * (r >> 2) + 4 * hi; }
typedef __bf16 bf16x2_t __attribute__((ext_vector_type(2))); typedef float f32x2_t __attribute__((ext_vector_type(2)));
__device__ __forceinline__ unsigned cvtpk(float lo, float hi) { f32x2_t v = {lo, hi}; bf16x2_t b = __builtin_convertvector(v, bf16x2_t); return __builtin_bit_cast(unsigned, b); }
#define SBAR() __builtin_amdgcn_sched_barrier(0)
typedef int i32x4 __attribute__((ext_vector_type(4))); typedef int i32x8 __attribute__((ext_vector_type(8)));
constexpr float PSHIFT = 2.f;
template <bool SHIFT>
__device__ __forceinline__ i32x8 softmax_pack8(f32x16& p0, f32x16& p1, float negm) {
    const float sh = negm + 8.f - PSHIFT;
#pragma unroll
    for (int r = 0; r < 16; ++r) { p0[r] = __builtin_amdgcn_exp2f(SHIFT ? p0[r] + sh : p0[r]); p1[r] = __builtin_amdgcn_exp2f(SHIFT ? p1[r] + sh : p1[r]); }
    i32x8 w;
#pragma unroll
    for (int q = 0; q < 4; ++q) { w[q] = (int)cvt4_fp8(p0[4 * q], p0[4 * q + 1], p0[4 * q + 2], p0[4 * q + 3]); w[4 + q] = (int)cvt4_fp8(p1[4 * q], p1[4 * q + 1], p1[4 * q + 2], p1[4 * q + 3]); }
    return w;
}
template <bool SHIFT>
__device__ __forceinline__ void unit64(const Args& a, LAS unsigned char* lds, int bh, int qb, float negm) {
    const int wid = sopaque(a.wv), tid = tid_of(wid), lane = tid & 63, r32 = lane & 31, hi = lane >> 5;
    const unsigned char* QwA = a.ws + WS_Q + ((size_t)bh * SEQ + qb * 512 + wid * 64 + r32) * QK8 + hi * 32;
    const unsigned char* Kh = a.ws + WS_K + (size_t)bh * SKV * QK8;
    const unsigned char* Vh = a.ws + WS_VT + (size_t)bh * DV * SKV;
    LAS unsigned char* Kl = lds + L_K; LAS unsigned char* Vl = lds + L_V;
    LAS float* wsf = (LAS float*)(lds + L_WS) + wid * 64;
    i32x8 qA8[2], qB8[2];
#pragma unroll
    for (int s2 = 0; s2 < 2; ++s2) { const i32x4 a0_ = *(const GAS i32x4*)(QwA + 64 * s2), a1_ = *(const GAS i32x4*)(QwA + 64 * s2 + 16), b0_ = *(const GAS i32x4*)(QwA + 32 * QK8 + 64 * s2), b1_ = *(const GAS i32x4*)(QwA + 32 * QK8 + 64 * s2 + 16);
        qA8[s2] = __builtin_shufflevector(a0_, a1_, 0, 1, 2, 3, 4, 5, 6, 7); qB8[s2] = __builtin_shufflevector(b0_, b1_, 0, 1, 2, 3, 4, 5, 6, 7); }
    unsigned soff[2]; int dsto[2];
#pragma unroll
    for (int m = 0; m < 2; ++m) { const int j = (wid + 8 * m) < 14 ? wid + 8 * m : wid + 8 * m - 8;
        if (j < 9) { const int p = j * 64 + lane, row = p / 9, c = p % 9; soff[m] = (unsigned)(row * QK8 + (c < 8 ? c : 7) * 16); dsto[m] = L_K + j * 1024; }
        else { const int jv = j - 9, p = jv * 64 + lane, d = p / 5, c = p % 5; soff[m] = (unsigned)(d * SKV + (c < 4 ? c : 3) * 16); dsto[m] = L_V + jv * 1024; } }
    const char* Kb = (const char*)Kh; const char* Vb = (const char*)Vh;
#define DMA(t, kslot, vslot) do { _Pragma("unroll") for (int pm_ = 0; pm_ < 2; ++pm_) { const int j_ = (wid + 8 * pm_) < 14 ? wid + 8 * pm_ : wid + 8 * pm_ - 8; { \
        const char* src_ = (j_ < 9 ? Kb + (size_t)(t) * (64 * QK8) : Vb + (size_t)(t) * 64) + soff[pm_]; \
        __builtin_amdgcn_global_load_lds((const unsigned*)src_, (LAS unsigned*)(lds + dsto[pm_] + (j_ < 9 ? (kslot) * KBUF : (vslot) * VBUF)), 16, 0, 0); } } } while (0)
    i32x8 ones8;
#pragma unroll
    for (int q = 0; q < 8; ++q) ones8[q] = r32 == 0 ? 0x38383838 : 0;
    f32x16 oA[2], oB[2], sA, sB;
#pragma unroll
    for (int r = 0; r < 16; ++r) { oA[0][r] = 0.f; oA[1][r] = 0.f; oB[0][r] = 0.f; oB[1][r] = 0.f; sA[r] = 0.f; sB[r] = 0.f; }
    constexpr int NT = SKV / 64;
    __syncthreads();
    DMA(0, 0, 0); DMA(1, 1, 1); __syncthreads();
#ifndef ATT_STAGGER
#define ATT_STAGGER 0
#endif
    const bool late = ATT_STAGGER && wid >= 4;
#define TILE_BAR(more) do { if (more) asm volatile("s_waitcnt vmcnt(2) lgkmcnt(0)\n\ts_barrier" ::: "memory"); else asm volatile("s_waitcnt vmcnt(0) lgkmcnt(0)\n\ts_barrier" ::: "memory"); } while (0)
    int ks = 0, vs = 0;
    for (int i = 0; i < NT; ++i) {
        const bool more = i + 2 < NT;
        if (more) DMA(i + 2, (ks == 0 ? 2 : ks - 1), ((vs + 2) & 3));
        SBAR();
        f32x16 pA0, pA1, pB0, pB1;
#pragma unroll
        for (int r = 0; r < 16; ++r) { pA0[r] = PSHIFT; pA1[r] = PSHIFT; pB0[r] = PSHIFT; pB1[r] = PSHIFT; }
        const LAS unsigned char* Ks = Kl + ks * KBUF + r32 * KLD8 + 32 * hi;
#pragma unroll
        for (int s2 = 0; s2 < 2; ++s2) {
            const i32x4 c0_ = *(const LAS i32x4*)(Ks + 64 * s2), c1_ = *(const LAS i32x4*)(Ks + 64 * s2 + 16), d0_ = *(const LAS i32x4*)(Ks + 32 * KLD8 + 64 * s2), d1_ = *(const LAS i32x4*)(Ks + 32 * KLD8 + 64 * s2 + 16);
            const i32x8 k0 = __builtin_shufflevector(c0_, c1_, 0, 1, 2, 3, 4, 5, 6, 7), k1 = __builtin_shufflevector(d0_, d1_, 0, 1, 2, 3, 4, 5, 6, 7);
            pA0 = __builtin_amdgcn_mfma_scale_f32_32x32x64_f8f6f4(k0, qA8[s2], pA0, 0, 0, 0, 0, 0, 0); pB0 = __builtin_amdgcn_mfma_scale_f32_32x32x64_f8f6f4(k0, qB8[s2], pB0, 0, 0, 0, 0, 0, 0);
            pA1 = __builtin_amdgcn_mfma_scale_f32_32x32x64_f8f6f4(k1, qA8[s2], pA1, 0, 0, 0, 0, 0, 0); pB1 = __builtin_amdgcn_mfma_scale_f32_32x32x64_f8f6f4(k1, qB8[s2], pB1, 0, 0, 0, 0, 0, 0);
        }
        SBAR();
        if (late) TILE_BAR(more);
        const LAS unsigned char* Vs = Vl + vs * VBUF + r32 * VLD8 + 32 * hi;
        const i32x4 e0_ = *(const LAS i32x4*)(Vs), e1_ = *(const LAS i32x4*)(Vs + 16), f0_ = *(const LAS i32x4*)(Vs + 32 * VLD8), f1_ = *(const LAS i32x4*)(Vs + 32 * VLD8 + 16);
        const i32x8 v0 = __builtin_shufflevector(e0_, e1_, 0, 1, 2, 3, 4, 5, 6, 7), v1 = __builtin_shufflevector(f0_, f1_, 0, 1, 2, 3, 4, 5, 6, 7);
        { const i32x8 pa = softmax_pack8<SHIFT>(pA0, pA1, negm);
          oA[0] = __builtin_amdgcn_mfma_scale_f32_32x32x64_f8f6f4(pa, v0, oA[0], 0, 0, 0, 0, 0, 0); oA[1] = __builtin_amdgcn_mfma_scale_f32_32x32x64_f8f6f4(pa, v1, oA[1], 0, 0, 0, 0, 0, 0);
          sA = __builtin_amdgcn_mfma_scale_f32_32x32x64_f8f6f4(pa, ones8, sA, 0, 0, 0, 0, 0, 0); }
        { const i32x8 pa = softmax_pack8<SHIFT>(pB0, pB1, negm);
          oB[0] = __builtin_amdgcn_mfma_scale_f32_32x32x64_f8f6f4(pa, v0, oB[0], 0, 0, 0, 0, 0, 0); oB[1] = __builtin_amdgcn_mfma_scale_f32_32x32x64_f8f6f4(pa, v1, oB[1], 0, 0, 0, 0, 0, 0);
          sB = __builtin_amdgcn_mfma_scale_f32_32x32x64_f8f6f4(pa, ones8, sB, 0, 0, 0, 0, 0, 0); }
        SBAR();
        if (!late) TILE_BAR(more);
        ks = ks == 2 ? 0 : ks + 1; vs = (vs + 1) & 3;
    }
#undef DMA
#undef TILE_BAR
    if (r32 == 0) {
#pragma unroll
        for (int r = 0; r < 16; ++r) { wsf[crow(r, hi)] = sA[r]; wsf[32 + crow(r, hi)] = sB[r]; } }
    LDS_WAIT(); __builtin_amdgcn_wave_barrier();
    const int b = bh >> 3, h = bh & 7;
    const int lz = opaque(lane), r32z = lz & 31, hiz = lz >> 5;
    bf16_t* Ow = (bf16_t*)(a.ws + WS_MIX) + ((size_t)b * SEQ + qb * 512 + wid * 64) * DM + h * DV;
    const unsigned ooff = (unsigned)(4 * hiz * DM + r32z);
#pragma unroll
    for (int r = 0; r < 16; ++r) { const int orow = crow(r, hiz); const float rlA = 1.f / wsf[orow], rlB = 1.f / wsf[32 + orow];
        const unsigned off = ooff + (unsigned)(((r & 3) + 8 * (r >> 2)) * DM);
        Ow[off] = (bf16_t)f2bf(oA[0][r] * rlA); Ow[off + 32] = (bf16_t)f2bf(oA[1][r] * rlA);
        Ow[off + 32 * DM] = (bf16_t)f2bf(oB[0][r] * rlB); Ow[off + 32 * DM + 32] = (bf16_t)f2bf(oB[1][r] * rlB); }
}
#undef SBAR
}


#if DIAG == 5
__device__ __forceinline__ void attn_selfcheck(const Args& a, LAS unsigned char* lds) {
    const int tid = tid_of(a.wv);
    LAS float* red = (LAS float*)lds;
    __syncthreads();
    if (blockIdx.x == 0) {
        const int row = tid >> 3, ds = (tid & 7) * 8;
        const unsigned char* q = a.ws + WS_Q + (size_t)row * QK8; const unsigned char* K = a.ws + WS_K; const unsigned char* V = a.ws + WS_VT;
        float qf[96];
        float acc[8] = {0.f, 0.f, 0.f, 0.f, 0.f, 0.f, 0.f, 0.f}; float l = 0.f;
        for (int key = 0; key < SKV; ++key) {
            float s = 0.f;
            for (int c = 0; c < 96; c += 4) { const int kw = *(const GAS int*)(K + (size_t)key * QK8 + c), qw = *(const GAS int*)(q + c);
                s += __builtin_amdgcn_cvt_f32_fp8(kw, 0) * __builtin_amdgcn_cvt_f32_fp8(qw, 0) + __builtin_amdgcn_cvt_f32_fp8(kw, 1) * __builtin_amdgcn_cvt_f32_fp8(qw, 1)
                   + __builtin_amdgcn_cvt_f32_fp8(kw, 2) * __builtin_amdgcn_cvt_f32_fp8(qw, 2) + __builtin_amdgcn_cvt_f32_fp8(kw, 3) * __builtin_amdgcn_cvt_f32_fp8(qw, 3); }
            const float p = exp2f(s);
            const int kk = key & 63, pos = (key & ~63) + 32 * ((kk >> 2) & 1) + (kk & 3) + 4 * ((kk & 31) >> 3) + 16 * (kk >> 5);
            l += p;
#pragma unroll
            for (int e = 0; e < 8; ++e) { const int w = V[(size_t)(ds + e) * SKV + pos]; acc[e] += p * __builtin_amdgcn_cvt_f32_fp8(w, 0); }
        }
        (void)qf;
        float emax = 0.f, omax = 0.f;
        const bf16_t* mix = (const bf16_t*)(a.ws + WS_MIX) + (size_t)row * DM + ds;
#pragma unroll
        for (int e = 0; e < 8; ++e) { const float o = acc[e] / l; emax = fmaxf(emax, fabsf(o - bf2f(mix[e]))); omax = fmaxf(omax, fabsf(o)); }
        red[tid] = emax; red[512 + tid] = omax;
        __syncthreads();
        if (tid == 0) { float e = 0.f, o = 0.f; for (int i = 0; i < 512; ++i) { e = fmaxf(e, red[i]); o = fmaxf(o, red[512 + i]); }
            ((unsigned*)(a.ws + WS_CTL))[CW_DIAG] = __float_as_uint(e / o * 0.1f); }
    }
    __syncthreads();
}
#endif

__device__ __forceinline__ void phase_router(const Args& a, LAS unsigned char* lds) {
    const int tid = tid_of(a.wv), lane = tid & 63, wave = a.wv, fr = lane & 15, fq = lane >> 4;
    LAS bf16_t* Ah = (LAS bf16_t*)lds;
    LAS bf16_t* Al = (LAS bf16_t*)(lds + 33024);
    LAS float* red = (LAS float*)(lds + 66048);
    LAS int* hist = (LAS int*)(lds + 66048 + 16384);
    LAS int* base = hist + 32;
    LAS int* pk_e = base + 32;
    LAS int* pk_r = pk_e + 512;
    LAS int* pk_p = pk_r + 512;
    const float* mod = (const float*)(a.ws + WS_MOD); const float* g = a.in[I_GFFN];
    const bf16_t* WR = (const bf16_t*)(a.ws + WS_WR);
    unsigned char* HF = a.ws + WS_HF;
    float* PG = (float*)(a.ws + WS_PG);
    unsigned* cnt = (unsigned*)(a.ws + WS_CTL) + CW_CNT;
    unsigned* list = (unsigned*)(a.ws + WS_LIST);
    LAS float* lg = (LAS float*)(pk_p + 512);
    bf16x8 bh[4][2], bl[4][2];
#pragma unroll
    for (int ks = 0; ks < 4; ++ks)
#pragma unroll
        for (int j = 0; j < 2; ++j) { bh[ks][j] = *(const GAS bf16x8*)(WR + (size_t)(16 * j + fr) * 1024 + wave * 128 + 32 * ks + 8 * fq); bl[ks][j] = *(const GAS bf16x8*)(WR + 32768 + (size_t)(16 * j + fr) * 1024 + wave * 128 + 32 * ks + 8 * fq); }
    for (int tile = blockIdx.x; tile < T / 128; tile += gridDim.x) {
        __syncthreads();
        if (tid < 32) hist[tid] = 0;
        f32x4 v[2][4];
#pragma unroll
        for (int rr = 0; rr < 2; ++rr) { const float* xr = a.out + (size_t)(tile * 128 + wave * 2 + rr) * DM;
#pragma unroll
            for (int j = 0; j < 4; ++j) v[rr][j] = *(const GAS f32x4*)(xr + j * 256 + lane * 4); }
#pragma unroll 1
        for (int it = 0; it < 8; ++it) {
            const int tok0 = tile * 128 + it * 16;
#pragma unroll
            for (int rr = 0; rr < 2; ++rr) {
                const int row = wave * 2 + rr, tok = tok0 + row;
                const float* sh = mod + (tok >> 13) * 6144 + 3 * 1024; const float* sc = sh + 1024;
                float ss = 0.f;
#pragma unroll
                for (int j = 0; j < 4; ++j) ss += (v[rr][j].x * v[rr][j].x + v[rr][j].y * v[rr][j].y) + (v[rr][j].z * v[rr][j].z + v[rr][j].w * v[rr][j].w);
                const float rstd = rsqrtf(wave_sum(ss) * (1.f / DM) + EPS);
#pragma unroll
                for (int j = 0; j < 4; ++j) { const int c = j * 256 + lane * 4; const f32x4 gg = *(const GAS f32x4*)(g + c), s1 = *(const GAS f32x4*)(sc + c), s0 = *(const GAS f32x4*)(sh + c);
                    const f32x4 o = (v[rr][j] * rstd * gg) * (s1 + 1.f) + s0;
                    const unsigned h0 = f2bf(o.x), h1 = f2bf(o.y), h2 = f2bf(o.z), h3 = f2bf(o.w);
                    u32x2 wh; wh.x = h0 | (h1 << 16); wh.y = h2 | (h3 << 16);
                    u32x2 wl; wl.x = pk2(o.x - bf2f((bf16_t)h0), o.y - bf2f((bf16_t)h1)); wl.y = pk2(o.z - bf2f((bf16_t)h2), o.w - bf2f((bf16_t)h3));
                    *(GAS unsigned*)(HF + (size_t)tok * DM + c) = cvt4_fp8(o.x, o.y, o.z, o.w);
                    *(LAS u32x2*)(Ah + row * 1032 + c) = wh; *(LAS u32x2*)(Al + row * 1032 + c) = wl; }
            }
            if (it < 7) {
#pragma unroll
                for (int rr = 0; rr < 2; ++rr) { const float* xr = a.out + (size_t)(tok0 + 16 + wave * 2 + rr) * DM;
#pragma unroll
                    for (int j = 0; j < 4; ++j) v[rr][j] = *(const GAS f32x4*)(xr + j * 256 + lane * 4); } }
            __syncthreads();
            {
                f32x4 acc[2]; acc[0] = (f32x4){0.f, 0.f, 0.f, 0.f}; acc[1] = acc[0];
#pragma unroll
                for (int ks = 0; ks < 4; ++ks) { const bf16x8 ah = *(const LAS bf16x8*)(Ah + fr * 1032 + wave * 128 + 32 * ks + 8 * fq), al = *(const LAS bf16x8*)(Al + fr * 1032 + wave * 128 + 32 * ks + 8 * fq);
#pragma unroll
                    for (int j = 0; j < 2; ++j) { acc[j] = __builtin_amdgcn_mfma_f32_16x16x32_bf16(ah, bh[ks][j], acc[j], 0, 0, 0); acc[j] = __builtin_amdgcn_mfma_f32_16x16x32_bf16(al, bh[ks][j], acc[j], 0, 0, 0);
                        acc[j] = __builtin_amdgcn_mfma_f32_16x16x32_bf16(ah, bl[ks][j], acc[j], 0, 0, 0); } }
#pragma unroll
                for (int j = 0; j < 2; ++j)
#pragma unroll
                    for (int r = 0; r < 4; ++r) red[(wave * 16 + 4 * fq + r) * 32 + 16 * j + fr] = acc[j][r];
            }
            __syncthreads();
            { const int tk = tid >> 5, e = tid & 31; float sl = a.in[I_BR][e];
#pragma unroll
              for (int w = 0; w < 8; ++w) sl += red[(w * 16 + tk) * 32 + e];
              lg[tk * 32 + e] = sl; }
            __syncthreads();
            if (tid < 16) {
                const int tok = tok0 + tid;
                float best[4]; int bi[4];
#pragma unroll
                for (int k = 0; k < 4; ++k) { best[k] = -3.0e38f; bi[k] = 0; }
                for (int e = 0; e < 32; ++e) {
                    const float s = lg[tid * 32 + e];
                    if (s > best[3]) {
                        if (s > best[0]) { best[3] = best[2]; bi[3] = bi[2]; best[2] = best[1]; bi[2] = bi[1]; best[1] = best[0]; bi[1] = bi[0]; best[0] = s; bi[0] = e; }
                        else if (s > best[1]) { best[3] = best[2]; bi[3] = bi[2]; best[2] = best[1]; bi[2] = bi[1]; best[1] = s; bi[1] = e; }
                        else if (s > best[2]) { best[3] = best[2]; bi[3] = bi[2]; best[2] = s; bi[2] = e; }
                        else { best[3] = s; bi[3] = e; }
                    }
                }
                const float e1 = __expf(best[1] - best[0]), e2 = __expf(best[2] - best[0]), e3 = __expf(best[3] - best[0]);
                const float inv = 1.f / (1.f + e1 + e2 + e3);
                const float gk[4] = {inv, e1 * inv, e2 * inv, e3 * inv};
#pragma unroll
                for (int k = 0; k < 4; ++k) { const int slot = (it * 16 + tid) * 4 + k; const int rk = __hip_atomic_fetch_add(hist + bi[k], 1, __ATOMIC_RELAXED, __HIP_MEMORY_SCOPE_WORKGROUP);
                    pk_e[slot] = bi[k]; pk_r[slot] = rk; pk_p[slot] = tok * 4 + k; PG[tok * 4 + k] = gk[k]; }
            }
        }
        __syncthreads();
        if (tid < 32) base[tid] = (int)__hip_atomic_fetch_add(cnt + 64 * tid, (unsigned)hist[tid], __ATOMIC_RELAXED, __HIP_MEMORY_SCOPE_AGENT);
        __syncthreads();
        { const int e = pk_e[tid]; list[(size_t)e * 32768 + base[e] + pk_r[tid]] = (unsigned)pk_p[tid]; }
    }
}

__device__ __forceinline__ void phase_combine(const Args& a) {
    const int tid = tid_of(a.wv), lane = tid & 63, wave = tid >> 6;
    const int gw = blockIdx.x * 8 + wave, NGW = gridDim.x * 8;
    const float* mod = (const float*)(a.ws + WS_MOD);
    const unsigned char* Y = a.ws + WS_Y;
#if DIAG == 1
    const float dz = 0.1f;
#elif DIAG >= 2
    const float dz = sqrtf(__uint_as_float(__hip_atomic_load((unsigned*)(a.ws + WS_CTL) + CW_DIAG, __ATOMIC_RELAXED, __HIP_MEMORY_SCOPE_AGENT)));
#else
    const float dz = 0.f;
#endif
    for (int tok = gw; tok < T; tok += NGW) {
        const float* gate = mod + (tok >> 13) * 6144 + 5 * 1024;
        float* orow = a.out + (size_t)tok * DM;
#pragma unroll
        for (int j = 0; j < 4; ++j) { const int c = j * 256 + lane * 4;
            f32x4 s = (f32x4){0.f, 0.f, 0.f, 0.f};
#pragma unroll
            for (int k = 0; k < 4; ++k) { const int w = *(const GAS int*)(Y + ((size_t)tok * 4 + k) * DM + c);
                s[0] += __builtin_amdgcn_cvt_f32_fp8(w, 0); s[1] += __builtin_amdgcn_cvt_f32_fp8(w, 1); s[2] += __builtin_amdgcn_cvt_f32_fp8(w, 2); s[3] += __builtin_amdgcn_cvt_f32_fp8(w, 3); }
            s = s * pg8::YINV;
            const f32x4 xv = *(const GAS f32x4*)(orow + c), gv = *(const GAS f32x4*)(gate + c);
            *(GAS f32x4*)(orow + c) = xv + gv * s + dz; }
    }
}

constexpr int N_PHASES = 11;
constexpr int MOE_IT_ALL = 32 * (16 * 64 + 16 * 32), MOE_IT_P2 = 224 * 8 * 6;
__global__ void __launch_bounds__(512, 2) fwd_kernel(Args a0) {
    Args a;
    extern __shared__ __attribute__((aligned(16))) unsigned char lds_raw[];
    LAS unsigned char* lds = (LAS unsigned char*)lds_raw;
    volatile LAS unsigned* MISC = (volatile LAS unsigned*)(lds + LDS_MISC);
    const int wv0 = __builtin_amdgcn_readfirstlane((int)threadIdx.x >> 6);
    const int tid = threadIdx.x;
    if (tid < 64) MISC[tid] = 0u;
    __syncthreads();
    const int lo = sopaque(a0.ph_lo), hi = sopaque(a0.ph_hi);
#define use_bar ((hi - lo) > 1)
    XcdBarrier bar; bar.bar = (unsigned*)(a0.ws + WS_CTL) + CW_BAR; bar.x = 0; bar.st = MISC + 8;
    bar.wv = wv0;
    if (use_bar) bar = xcd_barrier_post((unsigned*)(a0.ws + WS_CTL) + CW_BAR, MISC + 8, wv0);
    const int G = sopaque((int)gridDim.x), bx = sopaque((int)blockIdx.x);
    const int vcu = (G % 8 == 0) ? (bx % 8) * (G / 8) + bx / 8 : bx;
#ifndef ONLY_PHASE
#define ONLY_PHASE -1
#endif
#ifndef PHASE_MASK
#define PHASE_MASK 0x7ff
#endif
#define IN(k) (lo <= (k) && (k) < hi && (ONLY_PHASE < 0 || ONLY_PHASE == (k)) && ((PHASE_MASK >> (k)) & 1))
#if DIAG >= 40
    unsigned long long tprev_ = __builtin_amdgcn_s_memrealtime();
#define TSTAMP(k) do { const unsigned long long tn_ = __builtin_amdgcn_s_memrealtime(); if (DIAG - 40 == (k) && blockIdx.x == 0 && tid == 0) MISC[40] = __float_as_uint(rintf((float)(tn_ - tprev_) * (1.f / 1000.f)) * 1e-5f); tprev_ = tn_; } while (0)
#else
#define TSTAMP(k) do { } while (0)
#endif
#define SEAM(k) do { if ((k) == 9) TSTAMP(k); if ((k) == 9 && DIAG >= 10 && blockIdx.x == 0 && tid == 0) __hip_atomic_store((unsigned*)(a0.ws + WS_CTL) + CW_DIAG, MISC[40], __ATOMIC_RELAXED, __HIP_MEMORY_SCOPE_AGENT); \
        if (use_bar && (k) + 1 < hi) xcd_barrier(bar); if ((k) != 9) TSTAMP(k); } while (0)
#ifndef REPEAT_MASK
#define REPEAT_MASK 0
#endif
#define REP(k) for (int rep_ = 0; rep_ <= ((REPEAT_MASK >> (k)) & 1); ++rep_)
    a = a0; a.wv = wv0;
    if (IN(0)) { phase_mod(a, lds); SEAM(0); }
    REP(1) if (IN(1)) { phase_prep(a, lds); SEAM(1); }
    {
        float* prm = (float*)(a0.ws + WS_PRM);
        a.ws = a0.ws; a.out = a0.out; a.in[I_X] = a0.in[I_X]; a.wv = wv0;
        a.in[I_GQL] = prm + PRM_GQL; a.in[I_GKVL] = prm + PRM_GKVL; a.in[I_GQH] = prm + PRM_GQH; a.in[I_GKH] = prm + PRM_GKH; a.in[I_DECAY] = prm + PRM_DECAY;
        a.in[I_GRET] = prm + PRM_GRET; a.in[I_BR] = prm + PRM_BR; a.in[I_GFFN] = prm + PRM_GFFN; a.in[I_B1] = prm + PRM_B1; a.in[I_B2] = prm + PRM_B2;
    }
    REP(2) if (IN(2)) {
        pg8::DenseOrder S; S.init(a.ws + WS_H, a.ws + WS_WIN, TA, DINP, 1024, G, bx);
        pg8::EpiP E{(bf16_t*)(a.ws + WS_P)};
        pg8::gemm_phase<pg8::EpiP, pg8::DenseOrder, false>(lds, nullptr, nullptr, 0, 1024, S, E, a.wv);
        if (G == 256 && bx >= 32) moe_convert(a, lds, (bx - 32) * 8, 224 * 8, MOE_IT_P2);
        SEAM(2);
    }
    REP(3) if (IN(3)) {
        if (G == 256) {
            int u0, nu;
            if (bx < 32) { u0 = 3 * bx; nu = 3; }
            else { const int c = bx - 32; u0 = 96 + 4 * c + (c < 64 ? c : 64); nu = 4 + (c < 64 ? 1 : 0); }
            for (int k2 = 0; k2 < (bx < 32 ? 2 : 1); ++k2) mla_tile(a, lds, k2 ? 256 + (bx >> 2) : bx, k2 ? 32 * (bx & 3) : 0, k2 ? 32 : 128);
            for (int u = u0; u < u0 + nu; ++u) ret_local_unit(a, lds, u);
        } else { for (int t = bx; t < TA / 128; t += G) mla_tile(a, lds, t); for (int u = bx; u < 16 * NSLOT; u += G) ret_local_unit(a, lds, u); }
        SEAM(3);
    }
    if (IN(4)) { phase_ret_scan(a); SEAM(4); }
    REP(5) if (IN(5)) {
        float negm;
        { float gq = 0.f, gk = 0.f; for (int i = 0; i < QK; ++i) { gq = fmaxf(gq, fabsf(a.in[I_GQH][i])); gk = fmaxf(gk, fabsf(a.in[I_GKH][i])); }
          negm = -(gq * gk * 96.f * QSCALE * 1.03f + 0.5f); negm = __uint_as_float(__builtin_amdgcn_readfirstlane(__float_as_uint(negm))); }
        const bool shift = negm < -64.f;
        __builtin_amdgcn_s_setreg((0 << 11) | (23 << 6) | 1, 1);
#ifndef REP5A
#define REP5A 0
#endif
#ifndef REP5B
#define REP5B 0
#endif
        if (G == 256) {
            const int xg = vcu >> 5, c = vcu & 31, cg = vcu & 3;
#pragma unroll 1
            for (int step = 0; step < 4; ++step) {
                if (step == cg) moe_convert(a, lds, MOE_IT_P2 + vcu * 8, 256 * 8, MOE_IT_ALL);
                if (step < 2) { const int bh = xg * 4 + 2 * step + (c >> 4), qb = c & 15; if (shift) att::unit64<true>(a, lds, bh, qb, negm); else att::unit64<false>(a, lds, bh, qb, negm); }
                else if (step == 2) { for (int u = bx; u < 16 * 64; u += G) ret_out_unit(a, lds, u); }
            }
        } else {
            for (int w = bx; w < 512; w += G) { if (shift) att::unit64<true>(a, lds, w >> 4, w & 15, negm); else att::unit64<false>(a, lds, w >> 4, w & 15, negm); }
            for (int u = bx; u < 16 * 64; u += G) ret_out_unit(a, lds, u);
        }
        SEAM(5);
    }
    REP(6) if (IN(6)) {
        pg8::DenseOrder S; S.init(a.ws + WS_MIX, a.ws + WS_WO, T, DM, 1024, G, bx);
        pg8::EpiOut E{a.in[I_X], (const float*)(a.ws + WS_MOD), a.out};
        pg8::gemm_phase<pg8::EpiOut, pg8::DenseOrder, false>(lds, nullptr, nullptr, 0, 1024, S, E, a.wv);
        SEAM(6);
    }
    if (IN(7)) { phase_router(a, lds); SEAM(7); }
    REP(8) if (IN(8)) {
        pg8::EpiM1 E{a.ws + WS_ACT};
        phase_moe_pg8<8>(a, lds, a.ws + WS_HF, 2, a.ws + WS_W1, (size_t)2048 * 1024, a.in[I_B1], 2048, nullptr, E);
        SEAM(8);
    }
    REP(9) if (IN(9)) {
        pg8::EpiM2 E{a.ws + WS_Y};
        phase_moe_pg8<4>(a, lds, a.ws + WS_ACT, 0, a.ws + WS_W2, (size_t)1024 * 1024, a.in[I_B2], 1024, (const float*)(a.ws + WS_PG), E);
        SEAM(9);
    }
    if (IN(10)) { phase_combine(a); }
#undef IN
#undef SEAM
#undef use_bar
}

extern "C" void kernel_launch(void* const* d_in, const int* in_sizes, int n_in, void* d_out, int out_size, void* d_ws, size_t ws_size, hipStream_t stream) {
    static int grid = 0;
    if (grid == 0) {
        if (n_in != 24 || out_size != T * DM || ws_size < WS_END) { fprintf(stderr, "kernel_launch: unexpected shapes (n_in %d out %d ws %zu)\n", n_in, out_size, ws_size); grid = -1; return; }
        int dev = 0, cus = 0, per_cu = 0;
        if (hipGetDevice(&dev) != hipSuccess || hipDeviceGetAttribute(&cus, hipDeviceAttributeMultiprocessorCount, dev) != hipSuccess) { grid = -1; return; }
        if (hipFuncSetAttribute((const void*)fwd_kernel, hipFuncAttributeMaxDynamicSharedMemorySize, LDS_BYTES) != hipSuccess) { fprintf(stderr, "kernel_launch: hipFuncSetAttribute failed\n"); grid = -1; return; }
        if (hipOccupancyMaxActiveBlocksPerMultiprocessor(&per_cu, (const void*)fwd_kernel, 512, LDS_BYTES) != hipSuccess || per_cu < 1) { fprintf(stderr, "kernel_launch: occupancy query says %d\n", per_cu); per_cu = 1; }
        (void)hipGetLastError();
        grid = cus;
    }
    if (grid < 0) return;
    (void)hipMemsetAsync((char*)d_ws + WS_CTL, 0, 128 * 1024, stream);
    Args a{};
    for (int i = 0; i < 24; ++i) a.in[i] = (const float*)d_in[i];
    a.out = (float*)d_out; a.ws = (unsigned char*)d_ws;
#if MK_N_LAUNCHES == 1
    a.ph_lo = 0; a.ph_hi = N_PHASES;
    void* params[] = {&a};
    hipError_t e = hipLaunchCooperativeKernel((const void*)fwd_kernel, dim3(grid), dim3(512), params, LDS_BYTES, stream);
    if (e != hipSuccess) fprintf(stderr, "kernel_launch: cooperative launch failed: %s (grid %d)\n", hipGetErrorString(e), grid);
#else
    for (int p = 0; p < N_PHASES; ++p) { a.ph_lo = p; a.ph_hi = p + 1; hipLaunchKernelGGL(fwd_kernel, dim3(grid), dim3(512), LDS_BYTES, stream, a); }
#endif
}
```

```cpp
#include <hip/hip_runtime.h>
#include <cstdio>
#include <cstdint>

#ifndef MK_N_LAUNCHES
#define MK_N_LAUNCHES 1
#endif

#define LAS __attribute__((address_space(3)))
#define GAS __attribute__((address_space(1)))
typedef unsigned short bf16_t;
typedef short bf16x8 __attribute__((ext_vector_type(8)));
typedef short s16x4 __attribute__((ext_vector_type(4)));
typedef float f32x4 __attribute__((ext_vector_type(4)));
typedef float f32x16 __attribute__((ext_vector_type(16)));
typedef unsigned u32x4 __attribute__((ext_vector_type(4)));
typedef unsigned u32x2 __attribute__((ext_vector_type(2)));

constexpr int DM = 1024, NB = 4, SEQ = 8192, LC = 256;
constexpr int T = NB * SEQ;
constexpr int TC = NB * LC;
constexpr int TA = T + TC;
constexpr int DIN = 1952, DINP = 2048;
constexpr int OFF_Q = 0, OFF_KV = 256, OFF_PE = 384, OFF_RQ = 416, OFF_RK = 672, OFF_RV = 928, OFF_RG = 1440;
constexpr int NH = 8, QK = 96, QK8 = 128, DV = 64, SKV = LC + SEQ;
constexpr int RH = 4, RDK = 64, RDV = 128, RC = 128, NSLOT = 66;
constexpr int NE = 32, DFF = 1024, NPAIR = T * 4;
constexpr float EPS = 1e-6f;
constexpr float QSCALE = 0.10206207261596577f * 1.4426950408889634f;

constexpr size_t MiB = 1ull << 20;
constexpr size_t WS_CTL = 0, CTL_BYTES = 1 * MiB;
constexpr size_t WS_MOD = 1 * MiB;
constexpr size_t WS_TABM = WS_MOD + 128 * 1024;
constexpr size_t WS_TABR = WS_TABM + 16 * 1024;
constexpr size_t WS_WIN = 2 * MiB;
constexpr size_t WS_WQ = 6 * MiB;
constexpr size_t WS_WKV = 6 * MiB + 512 * 1024;
constexpr size_t WS_WO = 7 * MiB;
constexpr size_t WS_WR = 9 * MiB;
constexpr size_t WS_W1 = 10 * MiB;
constexpr size_t WS_W2 = 138 * MiB;
constexpr size_t WS_HF = 202 * MiB;
constexpr size_t WS_PG = 266 * MiB;
constexpr size_t WS_LIST = 267 * MiB;
constexpr size_t WS_H = 272 * MiB;
constexpr size_t WS_P = 338 * MiB;
constexpr size_t WS_Q = 470 * MiB;
constexpr size_t WS_K = 518 * MiB;
constexpr size_t WS_VT = 568 * MiB;
constexpr size_t WS_LST = 601 * MiB;
constexpr size_t WS_MIX = 667 * MiB;
constexpr size_t WS_ACT = 272 * MiB;
constexpr size_t WS_Y = 528 * MiB;
constexpr size_t WS_END = 784 * MiB;
constexpr size_t WS_PRM = WS_MOD + 256 * 1024;
constexpr int PRM_GQL = 0, PRM_GKVL = 256, PRM_GQH = 384, PRM_GKH = 480, PRM_DECAY = 576, PRM_GRET = 584, PRM_BR = 1096, PRM_GFFN = 1128, PRM_B1 = 2152, PRM_B2 = 67688, PRM_END = 100456;
constexpr int CW_BAR = 4096;
constexpr int CW_CNT = 16384;
constexpr int CW_DIAG = 20480;
#ifndef DIAG
#define DIAG 0
#endif

constexpr int LDS_SCRATCH = 159744;
constexpr int LDS_MISC = LDS_SCRATCH;
constexpr int LDS_BYTES = LDS_SCRATCH + 256;

__device__ __forceinline__ float bf2f(bf16_t h) { return __uint_as_float((unsigned)h << 16); }
__device__ __forceinline__ unsigned f2bf(float f) { unsigned u = __float_as_uint(f); return (u + 0x7fffu + ((u >> 16) & 1u)) >> 16; }
__device__ __forceinline__ unsigned pk2(float lo, float hi) { return f2bf(lo) | (f2bf(hi) << 16); }
__device__ __forceinline__ float lo16(unsigned w) { return __uint_as_float(w << 16); }
__device__ __forceinline__ float hi16(unsigned w) { return __uint_as_float(w & 0xffff0000u); }
__device__ __forceinline__ float wave_sum(float v) {
#pragma unroll
    for (int o = 1; o < 64; o <<= 1) v += __shfl_xor(v, o);
    return v;
}
#define LDS_WAIT() asm volatile("s_waitcnt lgkmcnt(0)" ::: "memory")
__device__ __forceinline__ unsigned cvt4_fp8(float a, float b, float c, float d) { int p = 0; p = __builtin_amdgcn_cvt_pk_fp8_f32(a, b, p, false); p = __builtin_amdgcn_cvt_pk_fp8_f32(c, d, p, true); return (unsigned)p; }
constexpr float WQ_SCALE = 16.f, WKV_SCALE = 8.f, WKV_INV = 1.f / 8.f;
constexpr float WSCALE = 64.f, WINV = 1.f / 64.f;
__device__ __forceinline__ int opaque(int v) { asm volatile("" : "+v"(v)); return v; }
__device__ __forceinline__ int sopaque(int v) { asm volatile("" : "+s"(v)); return v; }
__device__ __forceinline__ int tid_of(int wv) { return sopaque(wv) * 64 + opaque((int)__builtin_amdgcn_mbcnt_hi(~0u, __builtin_amdgcn_mbcnt_lo(~0u, 0u))); }

#define XB_TMO      128
#define XB_XCNT(j)  (256  + 64 * (j))
#define XB_XSUB(j)  (1280 + 64 * (j))
#define XB_XGEN(j)  (2304 + 64 * (j))
#define XB_TOP      3328
#define XB_TOPGEN   3392
#define XCD_BAR_WORDS 3456
#define XB_SPIN_CAP (1u << 20)
__device__ __forceinline__ unsigned xb_ld(unsigned* p)              { return __hip_atomic_load(p, __ATOMIC_RELAXED, __HIP_MEMORY_SCOPE_AGENT); }
__device__ __forceinline__ unsigned xb_add(unsigned* p, unsigned v) { return __hip_atomic_fetch_add(p, v, __ATOMIC_RELAXED, __HIP_MEMORY_SCOPE_AGENT); }
__device__ __forceinline__ unsigned xb_xcc_id() { return (unsigned)__builtin_amdgcn_s_getreg((3 << 11) | 20) & 0xFu; }
#define XB_SPIN(cond, bar) do { unsigned _sp = 0; while (cond) { __builtin_amdgcn_s_sleep(1); \
    if ((++_sp & 255u) == 0u) { if (xb_ld(&(bar)[XB_TMO])) break; if (_sp > XB_SPIN_CAP) { atomicAdd(&(bar)[XB_TMO], 1u); break; } } } } while (0)
struct XcdBarrier { unsigned* bar; unsigned x; volatile LAS unsigned* st; int wv; };
__device__ __forceinline__ XcdBarrier xcd_barrier_post(unsigned* bar, volatile LAS unsigned* st, int wv) {
    XcdBarrier b; b.bar = bar; b.x = xb_xcc_id(); b.st = st; b.wv = wv;
    if (tid_of(wv) == 0) (void)xb_add(&bar[XB_XCNT(b.x)], 1u);
    return b;
}
__device__ __forceinline__ void xcd_barrier_complete(unsigned* bar, unsigned x, unsigned& nloc, unsigned& nx) {
    const unsigned G = gridDim.x * gridDim.y * gridDim.z;
    unsigned sum, cnt, mine, sp = 0u;
    for (;;) {
        sum = 0u; cnt = 0u; mine = 0u;
#pragma unroll 1
        for (unsigned j = 0; j < 16; ++j) { const unsigned c = xb_ld(&bar[XB_XCNT(j)]); sum += c; cnt += (c > 0u) ? 1u : 0u; mine = (j == x) ? c : mine; }
        if (sum == G) break;
        __builtin_amdgcn_s_sleep(1);
        if ((++sp & 255u) == 0u) { if (xb_ld(&bar[XB_TMO])) break; if (sp > XB_SPIN_CAP) { atomicAdd(&bar[XB_TMO], 1u); break; } }
    }
    nloc = mine > 0u ? mine : 1u; nx = cnt > 0u ? cnt : 1u;
}
__device__ __forceinline__ void xcd_barrier(const XcdBarrier& b) {
    asm volatile("s_waitcnt vmcnt(0)" ::: "memory");
    __syncthreads();
    if (tid_of(b.wv) == 0) {
        unsigned* bar = b.bar; asm volatile("" : "+s"(bar));
        __builtin_amdgcn_s_waitcnt(0);
        unsigned nloc = b.st[0], nx = b.st[1];
        if (nloc == 0u) { xcd_barrier_complete(bar, b.x, nloc, nx); b.st[0] = nloc; b.st[1] = nx; }
        const unsigned old = xb_add(&bar[XB_XSUB(b.x)], 1u);
        const unsigned gen = old / nloc;
        if (old + 1u == (gen + 1u) * nloc) {
            __builtin_amdgcn_fence(__ATOMIC_RELEASE, "agent");
            asm volatile("s_waitcnt vmcnt(0)" ::: "memory");
            const unsigned og = xb_add(&bar[XB_TOP], 1u);
            const unsigned tg = og / nx;
            if (og + 1u == (tg + 1u) * nx) xb_add(&bar[XB_TOPGEN], 1u);
            else XB_SPIN(xb_ld(&bar[XB_TOPGEN]) == tg, bar);
            __builtin_amdgcn_fence(__ATOMIC_ACQUIRE, "agent");
            xb_add(&bar[XB_XGEN(b.x)], 1u);
            asm volatile("s_waitcnt vmcnt(0)" ::: "memory");
        } else {
            XB_SPIN(xb_ld(&bar[XB_XGEN(b.x)]) == gen, bar);
            __builtin_amdgcn_fence(__ATOMIC_ACQUIRE, "agent");
            asm volatile("s_waitcnt vmcnt(0)" ::: "memory");
        }
    }
    __syncthreads();
}

struct Args { const float* in[24]; float* out; unsigned char* ws; int ph_lo, ph_hi; int wv, pad; };
#define CAS __attribute__((address_space(4)))
__device__ __forceinline__ Args load_args() { auto p = __builtin_amdgcn_kernarg_segment_ptr(); asm volatile("" : "+s"(p)); Args r; __builtin_memcpy(&r, p, sizeof(Args)); return r; }
enum { I_X = 0, I_C, I_CTX, I_CCTX, I_GATTN, I_GFFN, I_WADA, I_BADA, I_WIN, I_GQL, I_WQUP, I_GQH, I_GKVL, I_WKVUP, I_GKH, I_DECAY, I_GRET, I_WOUT,
       I_WR, I_BR, I_W1, I_B1, I_W2, I_B2 };

template <int MT, int NT, bool SWAP>
__device__ __forceinline__ void mma_ll(f32x4 (&acc)[MT][NT], const LAS bf16_t* sA, int lda, int m0, const LAS bf16_t* sB, int ldb, int n0, int K, int lane) {
    const int fr = lane & 15, fq = lane >> 4;
    for (int k = 0; k < K; k += 32) {
        bf16x8 a[MT], b[NT];
#pragma unroll
        for (int i = 0; i < MT; ++i) a[i] = *(const LAS bf16x8*)(sA + (m0 + 16 * i + fr) * lda + k + 8 * fq);
#pragma unroll
        for (int j = 0; j < NT; ++j) b[j] = *(const LAS bf16x8*)(sB + (n0 + 16 * j + fr) * ldb + k + 8 * fq);
#pragma unroll
        for (int i = 0; i < MT; ++i)
#pragma unroll
            for (int j = 0; j < NT; ++j)
                acc[i][j] = SWAP ? __builtin_amdgcn_mfma_f32_16x16x32_bf16(b[j], a[i], acc[i][j], 0, 0, 0) : __builtin_amdgcn_mfma_f32_16x16x32_bf16(a[i], b[j], acc[i][j], 0, 0, 0);
    }
}
template <int MT, int NT, bool SWAP>
__device__ __forceinline__ void mma_lg(f32x4 (&acc)[MT][NT], const LAS bf16_t* sA, int lda, int m0, const bf16_t* gB, int ldb, int n0, int K, int lane) {
    const int fr = lane & 15, fq = lane >> 4;
#pragma unroll 2
    for (int k = 0; k < K; k += 32) {
        bf16x8 a[MT], b[NT];
#pragma unroll
        for (int j = 0; j < NT; ++j) b[j] = *(const GAS bf16x8*)(gB + (size_t)(n0 + 16 * j + fr) * ldb + k + 8 * fq);
#pragma unroll
        for (int i = 0; i < MT; ++i) a[i] = *(const LAS bf16x8*)(sA + (m0 + 16 * i + fr) * lda + k + 8 * fq);
#pragma unroll
        for (int i = 0; i < MT; ++i)
#pragma unroll
            for (int j = 0; j < NT; ++j)
                acc[i][j] = SWAP ? __builtin_amdgcn_mfma_f32_16x16x32_bf16(b[j], a[i], acc[i][j], 0, 0, 0) : __builtin_amdgcn_mfma_f32_16x16x32_bf16(a[i], b[j], acc[i][j], 0, 0, 0);
    }
}

__device__ __forceinline__ void phase_mod(const Args& a, LAS unsigned char* lds) {
    const int tid = tid_of(a.wv), lane = tid & 63, wave = tid >> 6;
    LAS float* sv = (LAS float*)lds;
    LAS float* red = sv + 5 * 1024;
    float* mod = (float*)(a.ws + WS_MOD);
    for (int i = tid; i < 5 * 1024; i += 512) { const float v = (i < 4096) ? a.in[I_C][i] : a.in[I_CCTX][i - 4096]; sv[i] = v / (1.f + __expf(-v)); }
    __syncthreads();
    const float* W = a.in[I_WADA]; const float* bb = a.in[I_BADA];
    for (int u = blockIdx.x; u < 96; u += gridDim.x) {
        const int col = u * 64 + lane;
        float acc[5] = {0.f, 0.f, 0.f, 0.f, 0.f};
        for (int k = wave * 128; k < wave * 128 + 128; ++k) {
            const float w = W[(size_t)k * 6144 + col];
#pragma unroll
            for (int v = 0; v < 5; ++v) acc[v] += sv[v * 1024 + k] * w;
        }
#pragma unroll
        for (int v = 0; v < 5; ++v) red[(wave * 5 + v) * 64 + lane] = acc[v];
        __syncthreads();
        if (tid < 320) { const int v = tid >> 6; float s = bb[u * 64 + lane];
#pragma unroll
            for (int w = 0; w < 8; ++w) s += red[(w * 5 + v) * 64 + lane];
            mod[v * 6144 + u * 64 + lane] = s; }
        __syncthreads();
    }
    const int gt = blockIdx.x * 512 + tid;
    if (gt < 192 * 8) { const int pi = gt >> 3, f = gt & 7; const float pos = (float)(pi < 128 ? pi : pi - 128);
        const float inv = exp2f(-(float)f * (13.287712379549449f / 8.f)); const float rev = pos * inv * 0.15915494309189535f;
        float* tm = (float*)(a.ws + WS_TABM); tm[gt * 2] = __builtin_amdgcn_cosf(rev); tm[gt * 2 + 1] = __builtin_amdgcn_sinf(rev); }
    else if (gt < 192 * 8 + 192 * 16) { const int g2 = gt - 192 * 8; const int pi = g2 >> 4, f = g2 & 15; const float pos = (float)(pi < 128 ? pi : pi - 128);
        const float inv = exp2f(-(float)f * (13.287712379549449f / 16.f)); const float rev = pos * inv * 0.15915494309189535f;
        float* tr = (float*)(a.ws + WS_TABR); tr[g2 * 2] = __builtin_amdgcn_cosf(rev); tr[g2 * 2 + 1] = __builtin_amdgcn_sinf(rev); }
}

__device__ __forceinline__ void transpose_item(const float* W, int K, int N, bf16_t* WT, LAS float* scr, int item, int lane) {
    const int nblk = N / 32, kb = item / nblk, nb = item % nblk, k0 = 64 * kb, n0 = 32 * nb;
    float wv_[32];
#pragma unroll
    for (int i = 0; i < 32; ++i) { const int kk = 2 * i + (lane >> 5); wv_[i] = W[(size_t)(k0 + kk) * N + n0 + (lane & 31)]; }
#pragma unroll
    for (int i = 0; i < 32; ++i) { const int kk = 2 * i + (lane >> 5); scr[kk * 33 + (lane & 31)] = wv_[i]; }
    LDS_WAIT();
    const int c = lane & 7;
#pragma unroll
    for (int j = 0; j < 4; ++j) { const int n = (lane >> 3) + 8 * j; const LAS float* s = scr + (8 * c) * 33 + n;
        u32x4 o; o.x = pk2(s[0 * 33], s[1 * 33]); o.y = pk2(s[2 * 33], s[3 * 33]); o.z = pk2(s[4 * 33], s[5 * 33]); o.w = pk2(s[6 * 33], s[7 * 33]);
        *(GAS u32x4*)(WT + (size_t)(n0 + n) * K + k0 + 8 * c) = o; }
    LDS_WAIT();
}
__device__ __forceinline__ void transpose_item8(const float* W, int K, int N, unsigned char* WT, float sc, LAS float* scr, int item, int lane) {
    const int nblk = N / 32, kb = item / nblk, nb = item % nblk, k0 = 64 * kb, n0 = 32 * nb;
    float wv_[32];
#pragma unroll
    for (int i = 0; i < 32; ++i) { const int kk = 2 * i + (lane >> 5); wv_[i] = W[(size_t)(k0 + kk) * N + n0 + (lane & 31)]; }
#pragma unroll
    for (int i = 0; i < 32; ++i) { const int kk = 2 * i + (lane >> 5); scr[kk * 33 + (lane & 31)] = wv_[i]; }
    LDS_WAIT();
    const int c = lane & 7;
#pragma unroll
    for (int j = 0; j < 4; ++j) { const int n = (lane >> 3) + 8 * j; const LAS float* s = scr + (8 * c) * 33 + n;
        u32x2 o; o.x = cvt4_fp8(s[0 * 33] * sc, s[1 * 33] * sc, s[2 * 33] * sc, s[3 * 33] * sc); o.y = cvt4_fp8(s[4 * 33] * sc, s[5 * 33] * sc, s[6 * 33] * sc, s[7 * 33] * sc);
        *(GAS u32x2*)(WT + (size_t)(n0 + n) * K + k0 + 8 * c) = o; }
    LDS_WAIT();
}
__device__ __forceinline__ void phase_prep(const Args& a, LAS unsigned char* lds) {
    const int tid = tid_of(a.wv), lane = tid & 63, wave = tid >> 6;
    LAS float* scr = (LAS float*)(lds + wave * 16384);
    const int gw = blockIdx.x * 8 + wave, NGW = gridDim.x * 8;
    constexpr int I_IN = 16 * 61, I_QU = 4 * 24, I_KVU = 2 * 32, I_O = 16 * 32, I_1 = 16 * 64, I_2 = 16 * 32;
    constexpr int NITEMS = I_IN + I_QU + I_KVU + I_O + 32 * I_1 + 32 * I_2;
    const int nitems = gridDim.x == 256 ? I_IN + I_QU + I_KVU + I_O : NITEMS;
    for (int it = gw; it < nitems; it += NGW) {
        int r = it;
        if (r < I_IN) { transpose_item(a.in[I_WIN], 1024, DIN, (bf16_t*)(a.ws + WS_WIN), scr, r, lane); continue; } r -= I_IN;
        if (r < I_QU) { transpose_item8(a.in[I_WQUP], 256, 768, a.ws + WS_WQ, WQ_SCALE, scr, r, lane); continue; } r -= I_QU;
        if (r < I_KVU) { transpose_item8(a.in[I_WKVUP], 128, 1024, a.ws + WS_WKV, WKV_SCALE, scr, r, lane); continue; } r -= I_KVU;
        if (r < I_O) { transpose_item(a.in[I_WOUT], 1024, 1024, (bf16_t*)(a.ws + WS_WO), scr, r, lane); continue; } r -= I_O;
        if (r < 32 * I_1) { const int e = r / I_1; transpose_item8(a.in[I_W1] + (size_t)e * 1024 * 2048, 1024, 2048, a.ws + WS_W1 + (size_t)e * 2048 * 1024, WSCALE, scr, r % I_1, lane); continue; } r -= 32 * I_1;
        { const int e = r / I_2; transpose_item8(a.in[I_W2] + (size_t)e * 1024 * 1024, 1024, 1024, a.ws + WS_W2 + (size_t)e * 1024 * 1024, WSCALE, scr, r % I_2, lane); }
    }
    const int gt = blockIdx.x * 512 + tid, NGT = gridDim.x * 512;
    for (int i = gt; i < 96 * 1024 / 8; i += NGT) *(GAS u32x4*)((bf16_t*)(a.ws + WS_WIN) + (size_t)DIN * 1024 + (size_t)i * 8) = (u32x4){0u, 0u, 0u, 0u};
    for (int i = gt; i < 32 * 1024; i += NGT) { const int n = i >> 10, k = i & 1023; const float w = a.in[I_WR][k * 32 + n]; const unsigned h = f2bf(w);
        bf16_t* wr = (bf16_t*)(a.ws + WS_WR); wr[i] = (bf16_t)h; wr[32768 + i] = (bf16_t)f2bf(w - bf2f((bf16_t)h)); }
    {
        float* prm = (float*)(a.ws + WS_PRM);
        for (int i = gt; i < PRM_END; i += NGT) {
            float v;
            if (i < PRM_GKVL) v = a.in[I_GQL][i - PRM_GQL]; else if (i < PRM_GQH) v = a.in[I_GKVL][i - PRM_GKVL]; else if (i < PRM_GKH) v = a.in[I_GQH][i - PRM_GQH];
            else if (i < PRM_DECAY) v = a.in[I_GKH][i - PRM_GKH]; else if (i < PRM_GRET) v = a.in[I_DECAY][i - PRM_DECAY]; else if (i < PRM_BR) v = a.in[I_GRET][i - PRM_GRET];
            else if (i < PRM_GFFN) v = a.in[I_BR][i - PRM_BR]; else if (i < PRM_B1) v = a.in[I_GFFN][i - PRM_GFFN]; else if (i < PRM_B2) v = a.in[I_B1][i - PRM_B1]; else v = a.in[I_B2][i - PRM_B2];
            prm[i] = v;
        }
    }
    const float* mod = (const float*)(a.ws + WS_MOD); const float* g = a.in[I_GATTN];
    for (int m = gw; m < TA; m += NGW) {
        const float* xr; int mv;
        if (m < T) { xr = a.in[I_X] + (size_t)m * DM; mv = m >> 13; } else { xr = a.in[I_CTX] + (size_t)(m - T) * DM; mv = 4; }
        const float* sh = mod + mv * 6144; const float* sc = sh + 1024;
        f32x4 v[4]; float ss = 0.f;
#pragma unroll
        for (int j = 0; j < 4; ++j) { v[j] = *(const GAS f32x4*)(xr + j * 256 + lane * 4); ss += (v[j].x * v[j].x + v[j].y * v[j].y) + (v[j].z * v[j].z + v[j].w * v[j].w); }
        const float rstd = rsqrtf(wave_sum(ss) * (1.f / DM) + EPS);
        bf16_t* hr = (bf16_t*)(a.ws + WS_H) + (size_t)m * DM;
#pragma unroll
        for (int j = 0; j < 4; ++j) { const int c = j * 256 + lane * 4; const f32x4 gg = *(const GAS f32x4*)(g + c), s1 = *(const GAS f32x4*)(sc + c), s0 = *(const GAS f32x4*)(sh + c);
            const f32x4 o = (v[j] * rstd * gg) * (s1 + 1.f) + s0; u32x2 w; w.x = pk2(o.x, o.y); w.y = pk2(o.z, o.w); *(GAS u32x2*)(hr + c) = w; }
    }
}

#define MOE_ITEM(it_, P_, D_, N_) do { constexpr int I_1 = 16 * 64, I_2 = 16 * 32; \
    const bool up_ = (it_) < 32 * I_1; const int r_ = up_ ? (it_) : (it_) - 32 * I_1; N_ = up_ ? 2048 : 1024; const int per_ = up_ ? I_1 : I_2, e_ = r_ / per_, item_ = r_ % per_; \
    const int nblk_ = N_ / 32, kb_ = item_ / nblk_, nb_ = item_ % nblk_, k0_ = 64 * kb_, n0_ = 32 * nb_; \
    P_ = (up_ ? a.in[I_W1] : a.in[I_W2]) + (size_t)e_ * 1024 * N_ + (size_t)(k0_ + (lane >> 5)) * N_ + n0_ + (lane & 31); \
    D_ = a.ws + (up_ ? WS_W1 : WS_W2) + (size_t)e_ * N_ * 1024 + (size_t)n0_ * 1024 + k0_; } while (0)
__device__ __forceinline__ void moe_convert(const Args& a, LAS unsigned char* lds, int it0, int itstep, int itend) {
    const int tid = tid_of(a.wv), lane = tid & 63, wave = tid >> 6;
    LAS float* scr = (LAS float*)(lds + wave * 16384);
    const int NIT = itend;
    __syncthreads();
    float wc[32], wn[32];
    int it = it0 + wave;
    if (it >= NIT) { __syncthreads(); return; }
    const float* pc; unsigned char* dc; int nc;
    MOE_ITEM(it, pc, dc, nc);
#pragma unroll
    for (int i = 0; i < 32; ++i) wc[i] = pc[(size_t)(2 * i) * nc];
#pragma unroll 1
    while (it < NIT) {
        const int itn = it + itstep; const bool more = itn < NIT;
        const float* pn; unsigned char* dn; int nn; const int itx = more ? itn : it;
        MOE_ITEM(itx, pn, dn, nn);
        if (more) {
#pragma unroll
            for (int i = 0; i < 32; ++i) wn[i] = pn[(size_t)(2 * i) * nn]; }
#pragma unroll
        for (int i = 0; i < 32; ++i) { const int kk = 2 * i + (lane >> 5); scr[kk * 33 + (lane & 31)] = wc[i]; }
        LDS_WAIT();
        const int c = lane & 7;
#pragma unroll
        for (int j = 0; j < 4; ++j) { const int n = (lane >> 3) + 8 * j; const LAS float* s_ = scr + (8 * c) * 33 + n;
            u32x2 o; o.x = cvt4_fp8(s_[0 * 33] * WSCALE, s_[1 * 33] * WSCALE, s_[2 * 33] * WSCALE, s_[3 * 33] * WSCALE); o.y = cvt4_fp8(s_[4 * 33] * WSCALE, s_[5 * 33] * WSCALE, s_[6 * 33] * WSCALE, s_[7 * 33] * WSCALE);
            *(GAS u32x2*)(dc + (size_t)n * 1024 + 8 * c) = o; }
        LDS_WAIT();
#pragma unroll
        for (int i = 0; i < 32; ++i) wc[i] = wn[i];
        dc = dn; it = itn;
    }
    __syncthreads();
}
#undef MOE_ITEM

struct GUnit { const bf16_t* Bt; int m0, n0, nvalid, e; };
template <class RowFn, class Epi>
__device__ __forceinline__ void gemm_tile(LAS unsigned char* lds, const bf16_t* A, int K, const GUnit& u, const RowFn& rowfn, const Epi& epi) {
    LAS bf16_t* sA = (LAS bf16_t*)lds;
    LAS bf16_t* sB = (LAS bf16_t*)(lds + 256 * 72 * 2);
    const int tid = opaque((int)threadIdx.x), lane = tid & 63, wave = tid >> 6, wm = wave >> 1, wn = wave & 1;
    const int ch = tid & 7, r0 = tid >> 3;
    const bf16_t* ap[4]; const bf16_t* bp[2];
#pragma unroll
    for (int i = 0; i < 4; ++i) { const int r = r0 + 64 * i; const int rr = r < u.nvalid ? r : 0; ap[i] = A + (size_t)rowfn(u, rr) * K + ch * 8; }
#pragma unroll
    for (int i = 0; i < 2; ++i) bp[i] = u.Bt + (size_t)(r0 + 64 * i) * K + ch * 8;
    f32x4 acc[4][4];
#pragma unroll
    for (int i = 0; i < 4; ++i)
#pragma unroll
        for (int j = 0; j < 4; ++j) acc[i][j] = (f32x4){0.f, 0.f, 0.f, 0.f};
    u32x4 ra[4], rb[2];
#pragma unroll
    for (int i = 0; i < 4; ++i) ra[i] = *(const GAS u32x4*)(ap[i]);
#pragma unroll
    for (int i = 0; i < 2; ++i) rb[i] = *(const GAS u32x4*)(bp[i]);
    const int nk = K / 64;
    for (int kt = 0; kt < nk; ++kt) {
        __syncthreads();
#pragma unroll
        for (int i = 0; i < 4; ++i) *(LAS u32x4*)(sA + (r0 + 64 * i) * 72 + ch * 8) = ra[i];
#pragma unroll
        for (int i = 0; i < 2; ++i) *(LAS u32x4*)(sB + (r0 + 64 * i) * 72 + ch * 8) = rb[i];
        __syncthreads();
        if (kt + 1 < nk) {
#pragma unroll
            for (int i = 0; i < 4; ++i) ra[i] = *(const GAS u32x4*)(ap[i] + (kt + 1) * 64);
#pragma unroll
            for (int i = 0; i < 2; ++i) rb[i] = *(const GAS u32x4*)(bp[i] + (kt + 1) * 64);
        }
        mma_ll<4, 4, true>(acc, sA, 72, wm * 64, sB, 72, wn * 64, 64, lane);
    }
    epi(acc, u, wm, wn, lane);
}
struct RowDense { __device__ __forceinline__ int operator()(const GUnit& u, int r) const { return u.m0 + r; } };
struct RowPairTok { const unsigned* list; __device__ __forceinline__ int operator()(const GUnit& u, int r) const { return (int)(list[(size_t)u.e * 32768 + u.m0 + r] >> 2); } };
struct RowPair { const unsigned* list; __device__ __forceinline__ int operator()(const GUnit& u, int r) const { return (int)list[(size_t)u.e * 32768 + u.m0 + r]; } };

struct EpiP { bf16_t* P;
    __device__ __forceinline__ void operator()(const f32x4 (&acc)[4][4], const GUnit& u, int wm, int wn, int lane) const {
        const int fr = lane & 15, fq = lane >> 4;
#pragma unroll
        for (int i = 0; i < 4; ++i) { const int row = u.m0 + wm * 64 + 16 * i + fr;
#pragma unroll
            for (int j = 0; j < 4; ++j) { const int col = u.n0 + wn * 64 + 16 * j + 4 * fq; u32x2 w; w.x = pk2(acc[i][j][0], acc[i][j][1]); w.y = pk2(acc[i][j][2], acc[i][j][3]);
                *(GAS u32x2*)(P + (size_t)row * DINP + col) = w; } }
    } };
struct EpiOut { const float* x; const float* mod; float* out;
    __device__ __forceinline__ void operator()(const f32x4 (&acc)[4][4], const GUnit& u, int wm, int wn, int lane) const {
        const int fr = lane & 15, fq = lane >> 4;
#pragma unroll
        for (int i = 0; i < 4; ++i) { const int row = u.m0 + wm * 64 + 16 * i + fr; const float* gate = mod + (row >> 13) * 6144 + 2 * 1024;
#pragma unroll
            for (int j = 0; j < 4; ++j) { const int col = u.n0 + wn * 64 + 16 * j + 4 * fq;
                const f32x4 xv = *(const GAS f32x4*)(x + (size_t)row * DM + col), gv = *(const GAS f32x4*)(gate + col);
                *(GAS f32x4*)(out + (size_t)row * DM + col) = xv + gv * acc[i][j]; } }
    } };
struct EpiM1 { const unsigned* list; const float* b1; bf16_t* act;
    __device__ __forceinline__ void operator()(const f32x4 (&acc)[4][4], const GUnit& u, int wm, int wn, int lane) const {
        const int fr = lane & 15, fq = lane >> 4;
#pragma unroll
        for (int i = 0; i < 4; ++i) { const int r = wm * 64 + 16 * i + fr; if (r >= u.nvalid) continue;
            const unsigned pair = list[(size_t)u.e * 32768 + u.m0 + r];
#pragma unroll
            for (int j = 0; j < 4; ++j) { const int col = u.n0 + wn * 64 + 16 * j + 4 * fq; const f32x4 bv = *(const GAS f32x4*)(b1 + (size_t)u.e * 2048 + col);
                const f32x4 v = acc[i][j] + bv;
                const float g0 = fminf(v[0], 7.f), l0 = fminf(fmaxf(v[1], -7.f), 7.f), g1 = fminf(v[2], 7.f), l1 = fminf(fmaxf(v[3], -7.f), 7.f);
                const float a0 = g0 / (1.f + __expf(-1.702f * g0)) * (l0 + 1.f), a1 = g1 / (1.f + __expf(-1.702f * g1)) * (l1 + 1.f);
                *(GAS unsigned*)(act + (size_t)pair * DFF + (col >> 1)) = pk2(a0, a1); } }
    } };
struct EpiM2 { const unsigned* list; const float* b2; const float* pg; bf16_t* y;
    __device__ __forceinline__ void operator()(const f32x4 (&acc)[4][4], const GUnit& u, int wm, int wn, int lane) const {
        const int fr = lane & 15, fq = lane >> 4;
#pragma unroll
        for (int i = 0; i < 4; ++i) { const int r = wm * 64 + 16 * i + fr; if (r >= u.nvalid) continue;
            const unsigned pair = list[(size_t)u.e * 32768 + u.m0 + r]; const float g = pg[pair];
#pragma unroll
            for (int j = 0; j < 4; ++j) { const int col = u.n0 + wn * 64 + 16 * j + 4 * fq; const f32x4 bv = *(const GAS f32x4*)(b2 + (size_t)u.e * 1024 + col);
                const f32x4 v = (acc[i][j] + bv) * g; u32x2 w; w.x = pk2(v[0], v[1]); w.y = pk2(v[2], v[3]);
                *(GAS u32x2*)(y + (size_t)pair * DM + col) = w; } }
    } };

namespace pg8 {
constexpr int BM = 256, BK = 64, HALF = 128, HTB = HALF * BK * 2, STAGE_BYTES = 8 * HTB, NXCD = 8, WGM = 8;
__host__ __device__ __forceinline__ int lds_byte(int r, int c) { const int st = (r >> 4) * 2 + (c >> 5), rr = r & 15, cc = c & 31, ob = rr * 64 + cc * 2; return st * 1024 + (ob ^ (((ob >> 9) & 1) << 5)); }
__host__ __device__ __forceinline__ void stage_rc(int b, int& R, int& C) { const int st = b / 1024, sb = b % 1024, swz = sb ^ (((sb >> 9) & 1) << 5); R = (st >> 1) * 16 + swz / 64; C = (st & 1) * 32 + (swz % 64) / 2; }
__host__ __device__ __forceinline__ int perm32(int rho) { const int n = rho >> 4, i = rho & 15; return 8 * (i >> 2) + 4 * n + (i & 3); }
struct Unit { int pm, pn; const char* A; const char* B; int e, nvalid, ul, rb; };
struct DenseOrder {
    int nM, nN, nwg, G, c; const char* A; const char* B; size_t tstep;
    __device__ void init(const void* A_, const void* B_, int M, int N, int K, int G_, int c_) { nM = M / BM; nN = N / BM; nwg = nM * nN; G = G_; c = c_; A = (const char*)A_; B = (const char*)B_; tstep = (size_t)BM * K * 2; }
    __device__ bool next(int i, Unit& u) const {
        const long L = (long)i * G + c; if (L >= nwg) return false;
        int wgid = (int)L; { const int q = nwg / NXCD, r = nwg % NXCD, xcd = wgid % NXCD, off = wgid / NXCD; wgid = (xcd < r ? xcd * (q + 1) : r * (q + 1) + (xcd - r) * q) + off; }
        const int nig = WGM * nN, gid = wgid / nig, fm = gid * WGM, gsz = (nM - fm) < WGM ? (nM - fm) : WGM;
        u.pm = fm + ((wgid % nig) % gsz); u.pn = (wgid % nig) / gsz; u.A = A + (size_t)u.pm * tstep; u.B = B + (size_t)u.pn * tstep; u.e = 0; u.nvalid = 256; u.ul = 0; u.rb = 0; return true;
    }
};
template <int NCT> struct ExpertOrder {
    const LAS int* pre; int G, c; const char* A; const char* W; size_t wstride; int rowbytes;
    __device__ bool next(int i, Unit& u) const {
        const int L = i * G + c; const int nunit = pre[32] * NCT; if (L >= nunit) return false;
        const int ti = L / NCT; u.pn = L % NCT; int e = 0;
        for (int k = 1; k < 32; ++k) if (pre[k] <= ti) e = k;
        u.pm = ti - pre[e]; u.e = e; const int cnt = pre[33 + e]; u.nvalid = (cnt - u.pm * 256) < 256 ? (cnt - u.pm * 256) : 256; u.ul = i;
        u.A = A; u.B = W + (size_t)e * wstride + (size_t)u.pn * 256 * rowbytes; u.rb = ti * 256; return true;
    }
};
__device__ __forceinline__ unsigned cvt_pk_bf16(float lo, float hi) { unsigned r; asm volatile("v_cvt_pk_bf16_f32 %0, %1, %2" : "=v"(r) : "v"(lo), "v"(hi)); return r; }
typedef int i32x4 __attribute__((ext_vector_type(4))); typedef int i32x8 __attribute__((ext_vector_type(8)));
__device__ __forceinline__ bf16x8 lo8(i32x8 v) { return __builtin_bit_cast(bf16x8, (i32x4)__builtin_shufflevector(v, v, 0, 1, 2, 3)); }
__device__ __forceinline__ bf16x8 hi8(i32x8 v) { return __builtin_bit_cast(bf16x8, (i32x4)__builtin_shufflevector(v, v, 4, 5, 6, 7)); }

template <class Epi, class Sched, bool GATHER, bool FP8 = false, bool SORTEDA = false>
__device__ __forceinline__ void gemm_phase(LAS unsigned char* lds, const LAS int* tab, const LAS bf16_t* aux, int ashift, int K, const Sched& S, const Epi& E, int wv) {
    const int tid = tid_of(wv), wid = wv, lane = tid & 63, wr = wid >> 2, wc = wid & 3, fr = lane & 15, fq = lane >> 4;
    const int nt = K / BK;
    unsigned voffA[2], voffB[2]; unsigned cb0 = 0; int rg0 = 0;
#pragma unroll
    for (int i = 0; i < 2; ++i) { int R, C; stage_rc(tid * 16 + i * 8192, R, C); const int Rb = (R & ~31) + perm32(R & 31);
        voffA[i] = (unsigned)(R * K + C) * 2u; voffB[i] = (unsigned)(Rb * K + C) * 2u; if (i == 0) { cb0 = (unsigned)C * 2u; rg0 = R; } }
    const size_t kstep = (size_t)(BK * 2);
    const size_t hstep = (size_t)HALF * K * 2;
    const size_t hstepA = GATHER ? 0 : hstep;
    const unsigned ldsw = (unsigned)wid * 1024u;
    const int aoff = lds_byte(wr * 64 + fr, fq * 8), boff = lds_byte(wc * 32 + fr, fq * 8);
    int cul = 0, nul = 0, crb = 0, nrb = 0;
#define PG8_SA(b, h) (((b) * 2 + (h)) * HTB)
#define PG8_SB(b, h) ((4 + (b) * 2 + (h)) * HTB)
#define PG8_STAGE(bufoff, gbase, voff) do { _Pragma("unroll") for (int _i = 0; _i < 2; ++_i) \
        __builtin_amdgcn_global_load_lds((const unsigned*)((const char*)(gbase) + (voff)[_i]), (LAS unsigned*)(lds + (bufoff) + ldsw + _i * 8192), 16, 0, 0); } while (0)
#define PG8_STAGE_A(bufoff, gbase, h, usenext) do { const int ulx_ = (usenext) ? nul : cul; _Pragma("unroll") for (int _i = 0; _i < 2; ++_i) { \
        unsigned vo_; if constexpr (SORTEDA) vo_ = (unsigned)(((usenext) ? nrb : crb) + (h) * 128 + rg0 + 64 * _i) * (unsigned)(K * 2) + cb0; \
        else if constexpr (GATHER) vo_ = (unsigned)(tab[ulx_ * 256 + (h) * 128 + rg0 + 64 * _i] >> ashift) * (unsigned)(K * 2) + cb0; else vo_ = voffA[_i]; \
        __builtin_amdgcn_global_load_lds((const unsigned*)((const char*)(gbase) + (h) * hstepA + vo_), (LAS unsigned*)(lds + (bufoff) + ldsw + _i * 8192), 16, 0, 0); } } while (0)
#define PG8_LDA(dst, b, h) do { _Pragma("unroll") for (int m = 0; m < 4; ++m) { const i32x4 lo_ = *(const LAS i32x4*)(lds + PG8_SA(b, h) + aoff + m * 2048), hi_ = *(const LAS i32x4*)(lds + PG8_SA(b, h) + aoff + m * 2048 + 1024); \
        dst[m] = __builtin_shufflevector(lo_, hi_, 0, 1, 2, 3, 4, 5, 6, 7); } } while (0)
#define PG8_LDB(dst, b, h) do { _Pragma("unroll") for (int n = 0; n < 2; ++n) { const i32x4 lo_ = *(const LAS i32x4*)(lds + PG8_SB(b, h) + boff + n * 2048), hi_ = *(const LAS i32x4*)(lds + PG8_SB(b, h) + boff + n * 2048 + 1024); \
        dst[n] = __builtin_shufflevector(lo_, hi_, 0, 1, 2, 3, 4, 5, 6, 7); } } while (0)
#define PG8_MMA(ai, bj, At, Bt) do { __builtin_amdgcn_s_setprio(1); _Pragma("unroll") for (int m = 0; m < 4; ++m) _Pragma("unroll") for (int n = 0; n < 2; ++n) { \
        if constexpr (FP8) { asm("v_mfma_f32_16x16x128_f8f6f4 %0, %1, %2, %0" : "+v"(acc[ai][bj][m][n]) : "v"(Bt[n]), "v"(At[m])); } \
        else { acc[ai][bj][m][n] = __builtin_amdgcn_mfma_f32_16x16x32_bf16(lo8(Bt[n]), lo8(At[m]), acc[ai][bj][m][n], 0, 0, 0); \
               acc[ai][bj][m][n] = __builtin_amdgcn_mfma_f32_16x16x32_bf16(hi8(Bt[n]), hi8(At[m]), acc[ai][bj][m][n], 0, 0, 0); } } \
        __builtin_amdgcn_s_setprio(0); } while (0)
#define PG8_WAIT_V(n) asm volatile("s_waitcnt vmcnt(" #n ")" ::: "memory")
#define PG8_WAIT_L(n) asm volatile("s_waitcnt lgkmcnt(" #n ")" ::: "memory")
#define PG8_BAR __builtin_amdgcn_s_barrier()
#define PG8_SCHED __builtin_amdgcn_sched_barrier(0)
    Unit cur, nxt; int ui = 0;
    if (!S.next(0, cur)) return;
    cul = cur.ul; nul = cur.ul; crb = cur.rb; nrb = cur.rb;
    f32x4 acc[2][2][4][2];
#pragma unroll
    for (int a = 0; a < 2; ++a)
#pragma unroll
        for (int b = 0; b < 2; ++b)
#pragma unroll
            for (int m = 0; m < 4; ++m)
#pragma unroll
                for (int n = 0; n < 2; ++n) acc[a][b][m][n] = (f32x4){0.f, 0.f, 0.f, 0.f};
    i32x8 At[4], B0[2], B1[2];
    const char* cA = cur.A; const char* cB = cur.B;
    PG8_STAGE(PG8_SB(0, 0), cB, voffB); PG8_STAGE(PG8_SB(0, 1), cB + hstep, voffB); PG8_STAGE_A(PG8_SA(0, 0), cA, 0, false); PG8_STAGE_A(PG8_SA(0, 1), cA, 1, false);
    if (wr == 1) PG8_BAR;
    PG8_WAIT_V(2); PG8_BAR;
    PG8_STAGE(PG8_SB(1, 0), cB + kstep, voffB); PG8_STAGE_A(PG8_SA(1, 0), cA + kstep, 0, false); PG8_STAGE(PG8_SB(1, 1), cB + hstep + kstep, voffB);
    PG8_WAIT_V(6); PG8_BAR;
    for (;;) {
        const bool has_next = S.next(ui + 1, nxt);
        const char* nA = has_next ? nxt.A : cA; const char* nB = has_next ? nxt.B : cB;
        nul = has_next ? nxt.ul : cur.ul; nrb = has_next ? nxt.rb : cur.rb;
#if DIAG >= 10
        long long tk0_ = 0; if (DIAG == 10 + Epi::ID && ui == 0) tk0_ = (long long)__builtin_amdgcn_s_memtime();
        if (DIAG == 20 + Epi::ID && ui <= 1) { const long long tn_ = (long long)__builtin_amdgcn_s_memtime();
            if (ui == 0) { if (blockIdx.x == 0 && tid == 0) { ((volatile LAS unsigned*)(lds + 159744))[41] = (unsigned)tn_; } }
            else if (blockIdx.x == 0 && tid == 0) { const unsigned d_ = (unsigned)tn_ - ((volatile LAS unsigned*)(lds + 159744))[41]; const float q = rintf((float)d_ * (1.f / 1000.f));
                ((volatile LAS unsigned*)(lds + 159744))[40] = __float_as_uint(q * 1e-5f); } }
#endif
#pragma unroll 1
        for (int t = 0; t < nt; t += 2) {
            const bool last = (t == nt - 2);
            const char* a1 = cA + (size_t)(t + 1) * kstep;
            const char* a2 = last ? nA : cA + (size_t)(t + 2) * kstep; const char* b2 = last ? nB : cB + (size_t)(t + 2) * kstep;
            const char* a3 = a2 + kstep; const char* b3 = b2 + kstep;
            PG8_LDB(B0, 0, 0); PG8_LDB(B1, 0, 1); PG8_SCHED; PG8_LDA(At, 0, 0); PG8_STAGE_A(PG8_SA(1, 1), a1, 1, false);
            PG8_WAIT_V(8); PG8_WAIT_L(0); PG8_BAR; PG8_MMA(0, 0, At, B0); PG8_MMA(0, 1, At, B1); PG8_BAR; PG8_SCHED;
            PG8_LDA(At, 0, 1); PG8_STAGE(PG8_SB(0, 0), b2, voffB); PG8_STAGE(PG8_SB(0, 1), b2 + hstep, voffB); PG8_STAGE_A(PG8_SA(0, 0), a2, 0, last);
            PG8_WAIT_V(8); PG8_WAIT_L(0); PG8_BAR; PG8_MMA(1, 0, At, B0); PG8_MMA(1, 1, At, B1); PG8_BAR; PG8_SCHED;
            PG8_LDB(B0, 1, 0); PG8_LDB(B1, 1, 1); PG8_SCHED; PG8_LDA(At, 1, 0); PG8_STAGE_A(PG8_SA(0, 1), a2, 1, last);
            PG8_WAIT_V(8); PG8_WAIT_L(0); PG8_BAR; PG8_MMA(0, 0, At, B0); PG8_MMA(0, 1, At, B1); PG8_BAR; PG8_SCHED;
            PG8_LDA(At, 1, 1); PG8_STAGE(PG8_SB(1, 0), b3, voffB); PG8_STAGE(PG8_SB(1, 1), b3 + hstep, voffB); PG8_STAGE_A(PG8_SA(1, 0), a3, 0, last);
            PG8_WAIT_V(8); PG8_WAIT_L(0); PG8_BAR; PG8_MMA(1, 0, At, B0); PG8_MMA(1, 1, At, B1); PG8_BAR; PG8_SCHED;
        }
#if DIAG >= 10
        if (DIAG == 10 + Epi::ID && ui == 0) { const long long tk1_ = (long long)__builtin_amdgcn_s_memtime();
            if (blockIdx.x == 0 && tid == 0) { const float perk = (float)(tk1_ - tk0_) / (float)nt; const float q = rintf(perk * (1.f / 250.f));
                ((volatile LAS unsigned*)(lds + 159744))[40] = __float_as_uint(q * 2e-5f); } }
#endif
        if (wr == 0) PG8_BAR;
        if constexpr (FP8) asm volatile("s_nop 15\n\ts_nop 7" ::: "memory");
        E(acc, cur, tab, aux, wr, wc, fr, fq);
        if (!has_next) break;
#pragma unroll
        for (int a = 0; a < 2; ++a)
#pragma unroll
            for (int b = 0; b < 2; ++b)
#pragma unroll
                for (int m = 0; m < 4; ++m)
#pragma unroll
                    for (int n = 0; n < 2; ++n) acc[a][b][m][n] = (f32x4){0.f, 0.f, 0.f, 0.f};
        cur = nxt; cA = nA; cB = nB; ++ui;
        cul = cur.ul; crb = cur.rb;
        if (wr == 1) PG8_BAR;
    }
    PG8_WAIT_V(0);
    PG8_BAR;
#undef PG8_SA
#undef PG8_SB
#undef PG8_STAGE
#undef PG8_STAGE_A
#undef PG8_LDA
#undef PG8_LDB
#undef PG8_MMA
#undef PG8_WAIT_V
#undef PG8_WAIT_L
#undef PG8_BAR
#undef PG8_SCHED
}

struct EpiP { static constexpr int ID = 2; bf16_t* P;
    __device__ __forceinline__ void operator()(const f32x4 (&acc)[2][2][4][2], const Unit& u, const LAS int*, const LAS bf16_t*, int wr, int wc, int fr, int fq) const {
        const int row0 = u.pm * BM + wr * 64 + fr, col0 = u.pn * BM + wc * 32 + 8 * fq;
#pragma unroll
        for (int ai = 0; ai < 2; ++ai)
#pragma unroll
            for (int m = 0; m < 4; ++m) { bf16_t* rowp = P + (size_t)(row0 + ai * HALF + m * 16) * DINP + col0;
#pragma unroll
                for (int bj = 0; bj < 2; ++bj) { const f32x4 v0 = acc[ai][bj][m][0], v1 = acc[ai][bj][m][1]; u32x4 w;
                    w.x = cvt_pk_bf16(v0[0], v0[1]); w.y = cvt_pk_bf16(v0[2], v0[3]); w.z = cvt_pk_bf16(v1[0], v1[1]); w.w = cvt_pk_bf16(v1[2], v1[3]);
                    *(GAS u32x4*)(rowp + bj * HALF) = w; } }
    } };
struct EpiOut { static constexpr int ID = 6; const float* x; const float* mod; float* out;
    __device__ __forceinline__ void operator()(const f32x4 (&acc)[2][2][4][2], const Unit& u, const LAS int*, const LAS bf16_t*, int wr, int wc, int fr, int fq) const {
        const int row0 = u.pm * BM + wr * 64 + fr, col0 = u.pn * BM + wc * 32 + 8 * fq;
        const float* gate = mod + (row0 >> 13) * 6144 + 2 * 1024;
#pragma unroll
        for (int bj = 0; bj < 2; ++bj) { const f32x4 g0 = *(const GAS f32x4*)(gate + col0 + bj * HALF), g1 = *(const GAS f32x4*)(gate + col0 + bj * HALF + 4);
#pragma unroll
            for (int ai = 0; ai < 2; ++ai)
#pragma unroll
                for (int m = 0; m < 4; ++m) { const size_t off = (size_t)(row0 + ai * HALF + m * 16) * DM + col0 + bj * HALF;
                    const f32x4 x0 = *(const GAS f32x4*)(x + off), x1 = *(const GAS f32x4*)(x + off + 4);
                    *(GAS f32x4*)(out + off) = x0 + g0 * acc[ai][bj][m][0]; *(GAS f32x4*)(out + off + 4) = x1 + g1 * acc[ai][bj][m][1]; } }
    } };
typedef _Float16 h2_t __attribute__((ext_vector_type(2))); typedef short s2_t __attribute__((ext_vector_type(2)));
struct EpiM1 { static constexpr int ID = 8; unsigned char* act;
    __device__ __forceinline__ void operator()(const f32x4 (&acc)[2][2][4][2], const Unit& u, const LAS int* tab, const LAS bf16_t* aux, int wr, int wc, int fr, int fq) const {
        const int cl = wc * 32 + 8 * fq, col0 = u.pn * BM + cl;
        h2_t bg[2][2], bl[2][2];
#pragma unroll
        for (int bj = 0; bj < 2; ++bj) { const u32x4 w = *(const LAS u32x4*)(aux + u.ul * 256 + bj * HALF + cl);
#pragma unroll
            for (int n = 0; n < 2; ++n) { bg[bj][n] = (h2_t){(_Float16)lo16(w[2 * n]), (_Float16)lo16(w[2 * n + 1])}; bl[bj][n] = (h2_t){(_Float16)hi16(w[2 * n]), (_Float16)hi16(w[2 * n + 1])}; } }
        const h2_t winv = {(_Float16)WINV, (_Float16)WINV}, seven = {(_Float16)7.f, (_Float16)7.f}, one = {(_Float16)1.f, (_Float16)1.f}, cexp = {(_Float16)-2.4554669595930156f, (_Float16)-2.4554669595930156f};
#pragma unroll
        for (int ai = 0; ai < 2; ++ai)
#pragma unroll
            for (int m = 0; m < 4; ++m) { const int r = ai * HALF + wr * 64 + m * 16 + fr; const bool ok = r < u.nvalid;
                unsigned char* rowp = act + (size_t)(u.rb + r) * DFF + (col0 >> 1);
#pragma unroll
                for (int bj = 0; bj < 2; ++bj) { s2_t pk = {0, 0};
#pragma unroll
                    for (int n = 0; n < 2; ++n) { const f32x4 v = acc[ai][bj][m][n];
                        h2_t g = __builtin_bit_cast(h2_t, __builtin_amdgcn_cvt_pkrtz(v[0], v[2])), l = __builtin_bit_cast(h2_t, __builtin_amdgcn_cvt_pkrtz(v[1], v[3]));
                        g = g * winv + bg[bj][n]; l = l * winv + bl[bj][n];
                        g = __builtin_elementwise_min(g, seven); l = __builtin_elementwise_min(__builtin_elementwise_max(l, -seven), seven);
                        const h2_t e = __builtin_elementwise_exp2(g * cexp);
                        const h2_t d = e + one; const h2_t rc = {(_Float16)__builtin_amdgcn_rcph(d[0]), (_Float16)__builtin_amdgcn_rcph(d[1])};
                        const h2_t o = (g * rc) * (l + one);
                        pk = n == 0 ? __builtin_amdgcn_cvt_scalef32_pk_fp8_f16(pk, o, 1.0f, false) : __builtin_amdgcn_cvt_scalef32_pk_fp8_f16(pk, o, 1.0f, true); }
                    if (ok) *(GAS unsigned*)(rowp + bj * (HALF / 2)) = __builtin_bit_cast(unsigned, pk); } }
    } };
constexpr float YSCALE = 8.f, YINV = 1.f / 8.f;
struct EpiM2 { static constexpr int ID = 9; unsigned char* y;
    __device__ __forceinline__ void operator()(const f32x4 (&acc)[2][2][4][2], const Unit& u, const LAS int* tab, const LAS bf16_t* aux, int wr, int wc, int fr, int fq) const {
        const int cl = wc * 32 + 8 * fq, col0 = u.pn * BM + cl;
        h2_t bv[2][2][2];
#pragma unroll
        for (int bj = 0; bj < 2; ++bj) { const u32x4 w = *(const LAS u32x4*)(aux + u.ul * 256 + bj * HALF + cl);
#pragma unroll
            for (int n = 0; n < 2; ++n) { bv[bj][n][0] = (h2_t){(_Float16)lo16(w[2 * n]), (_Float16)hi16(w[2 * n])}; bv[bj][n][1] = (h2_t){(_Float16)lo16(w[2 * n + 1]), (_Float16)hi16(w[2 * n + 1])}; } }
        const h2_t winv = {(_Float16)WINV, (_Float16)WINV};
#pragma unroll
        for (int ai = 0; ai < 2; ++ai)
#pragma unroll
            for (int m = 0; m < 4; ++m) { const int r = ai * HALF + wr * 64 + m * 16 + fr; const bool ok = r < u.nvalid;
                const int pair = tab[u.ul * 256 + r]; const _Float16 gs = (_Float16)(bf2f(aux[9 * 256 + u.ul * 256 + r]) * YSCALE); const h2_t g = {gs, gs}; unsigned char* rowp = y + (size_t)pair * DM + col0;
#pragma unroll
                for (int bj = 0; bj < 2; ++bj) { u32x2 w;
#pragma unroll
                    for (int n = 0; n < 2; ++n) { const f32x4 v = acc[ai][bj][m][n];
                        const h2_t p0 = (__builtin_bit_cast(h2_t, __builtin_amdgcn_cvt_pkrtz(v[0], v[1])) * winv + bv[bj][n][0]) * g, p1 = (__builtin_bit_cast(h2_t, __builtin_amdgcn_cvt_pkrtz(v[2], v[3])) * winv + bv[bj][n][1]) * g;
                        s2_t pk = {0, 0}; pk = __builtin_amdgcn_cvt_scalef32_pk_fp8_f16(pk, p0, 1.0f, false); pk = __builtin_amdgcn_cvt_scalef32_pk_fp8_f16(pk, p1, 1.0f, true);
                        w[n] = __builtin_bit_cast(unsigned, pk); }
                    if (ok) *(GAS u32x2*)(rowp + bj * HALF) = w; } }
    } };
}
constexpr int PG8_TAB_OFF = pg8::STAGE_BYTES;
constexpr int PG8_AUX_OFF = PG8_TAB_OFF + 18 * 1024;
constexpr int PG8_PRE_OFF = PG8_AUX_OFF + 9 * 1024;
static_assert(PG8_PRE_OFF + 512 <= LDS_SCRATCH, "LDS map");

template <int NCT, class Epi>
__device__ __forceinline__ void phase_moe_pg8(const Args& a, LAS unsigned char* lds, const unsigned char* A, int ashift, const unsigned char* Wt, size_t wstride, const float* bias, int nbias, const float* gates, const Epi& E) {
    LAS int* tab = (LAS int*)(lds + PG8_TAB_OFF); LAS int* pre = (LAS int*)(lds + PG8_PRE_OFF); LAS bf16_t* aux = (LAS bf16_t*)(lds + PG8_AUX_OFF);
    const unsigned* cnt = (const unsigned*)(a.ws + WS_CTL) + CW_CNT; const unsigned* list = (const unsigned*)(a.ws + WS_LIST);
    __syncthreads();
    const int tidm = tid_of(a.wv);
    if (tidm < NE) pre[33 + tidm] = (int)__hip_atomic_load(cnt + 64 * tidm, __ATOMIC_RELAXED, __HIP_MEMORY_SCOPE_AGENT);
    __syncthreads();
    if (tidm == 0) { int s = 0;
#pragma unroll 1
        for (int e = 0; e < NE; ++e) { const int c = pre[33 + e]; pre[e] = s; s += (c + 255) >> 8; } pre[32] = s; }
    __syncthreads();
    const int G_ = (int)gridDim.x, bx_ = (int)blockIdx.x, vcu_ = (G_ % 8 == 0) ? (bx_ % 8) * (G_ / 8) + bx_ / 8 : bx_;
    pg8::ExpertOrder<NCT> S{pre, G_, vcu_, (const char*)A, (const char*)Wt, wstride, 1024};
    constexpr int NU = NCT == 8 ? 18 : 9; constexpr bool HASG = NCT == 4;
    const int nunit_ = pre[32] * NCT;
    unsigned val[NU]; float gv[NU];
#pragma unroll
    for (int i = 0; i < NU; ++i) { pg8::Unit u; val[i] = 0u;
        if (S.next(i, u)) { if (tidm < 256) val[i] = list[(size_t)u.e * 32768 + u.pm * 256 + (tidm < u.nvalid ? tidm : 0)]; else val[i] = __float_as_uint(bias[(size_t)u.e * nbias + u.pn * 256 + tidm - 256]); } }
#pragma unroll
    for (int i = 0; i < NU; ++i) { gv[i] = 0.f; if (HASG && tidm < 256 && i * G_ + vcu_ < nunit_) gv[i] = gates[val[i]]; }
#pragma unroll
    for (int i = 0; i < NU; ++i) if (i * G_ + vcu_ < nunit_) {
        if (tidm < 256) { tab[i * 256 + tidm] = (int)val[i]; if (HASG) aux[9 * 256 + i * 256 + tidm] = (bf16_t)f2bf(gv[i]); }
        else aux[i * 256 + tidm - 256] = (bf16_t)f2bf(__uint_as_float(val[i])); }
    __syncthreads();
    pg8::gemm_phase<Epi, pg8::ExpertOrder<NCT>, true, true, NCT == 4>(lds, tab, aux, ashift, 512, S, E, a.wv);
}

__device__ __forceinline__ void mla_tile(const Args& a, LAS unsigned char* lds, int tile, int r0 = 0, int nrows = 128) {
    const int tid = tid_of(a.wv), lane = tid & 63, wave = a.wv, fr = lane & 15, fq = lane >> 4;
    const bool lat = tile < 256;
    const int prow0 = tile * 128;
    const int b = lat ? (prow0 >> 13) : ((prow0 - T) >> 8);
    const int tpos0 = lat ? (prow0 & 8191) : ((prow0 - T) & 255);
    const int key0 = lat ? (LC + tpos0) : tpos0;
    LAS unsigned char* Aq = lds;
    LAS unsigned char* Akv = lds + 34816;
    LAS float* kpe = (LAS float*)(lds + 34816 + 18432);
    LAS float* sspe = (LAS float*)(lds + 34816 + 18432 + 16384);
    const bf16_t* P = (const bf16_t*)(a.ws + WS_P);
    const float* tabm = (const float*)(a.ws + WS_TABM);
    __syncthreads();
    if ((tid >> 2) >= r0 && (tid >> 2) < r0 + nrows) {
        const int r = tid >> 2, part = tid & 3;
        const bf16_t* pr = P + (size_t)(prow0 + r) * DINP;
        u32x4 q[8]; float ss = 0.f;
#pragma unroll
        for (int i = 0; i < 8; ++i) { q[i] = *(const GAS u32x4*)(pr + OFF_Q + part * 64 + i * 8);
#pragma unroll
            for (int e = 0; e < 4; ++e) { const float lo = lo16(q[i][e]), hi = hi16(q[i][e]); ss += lo * lo + hi * hi; } }
        ss += __shfl_xor(ss, 1); ss += __shfl_xor(ss, 2);
        float rstd = rsqrtf(ss * (1.f / 256.f) + EPS);
        const float* gq = a.in[I_GQL] + part * 64;
#pragma unroll
        for (int i = 0; i < 8; ++i) { u32x2 o;
#pragma unroll
            for (int e = 0; e < 2; ++e) o[e] = cvt4_fp8(lo16(q[i][2 * e]) * rstd * gq[i * 8 + 4 * e], hi16(q[i][2 * e]) * rstd * gq[i * 8 + 4 * e + 1], lo16(q[i][2 * e + 1]) * rstd * gq[i * 8 + 4 * e + 2], hi16(q[i][2 * e + 1]) * rstd * gq[i * 8 + 4 * e + 3]);
            *(LAS u32x2*)(Aq + r * 272 + part * 64 + i * 8) = o; }
        u32x4 kv[4]; ss = 0.f;
#pragma unroll
        for (int i = 0; i < 4; ++i) { kv[i] = *(const GAS u32x4*)(pr + OFF_KV + part * 32 + i * 8);
#pragma unroll
            for (int e = 0; e < 4; ++e) { const float lo = lo16(kv[i][e]), hi = hi16(kv[i][e]); ss += lo * lo + hi * hi; } }
        ss += __shfl_xor(ss, 1); ss += __shfl_xor(ss, 2);
        rstd = rsqrtf(ss * (1.f / 128.f) + EPS);
        const float* gkv = a.in[I_GKVL] + part * 32;
#pragma unroll
        for (int i = 0; i < 4; ++i) { u32x2 o;
#pragma unroll
            for (int e = 0; e < 2; ++e) o[e] = cvt4_fp8(lo16(kv[i][2 * e]) * rstd * gkv[i * 8 + 4 * e], hi16(kv[i][2 * e]) * rstd * gkv[i * 8 + 4 * e + 1], lo16(kv[i][2 * e + 1]) * rstd * gkv[i * 8 + 4 * e + 2], hi16(kv[i][2 * e + 1]) * rstd * gkv[i * 8 + 4 * e + 3]);
            *(LAS u32x2*)(Akv + r * 144 + part * 32 + i * 8) = o; }
        const u32x4 pe = *(const GAS u32x4*)(pr + OFF_PE + part * 8); ss = 0.f;
#pragma unroll
        for (int e = 0; e < 4; ++e) { const float lo = lo16(pe[e]), hi = hi16(pe[e]); ss += lo * lo + hi * hi; kpe[r * 32 + part * 8 + 2 * e] = lo; kpe[r * 32 + part * 8 + 2 * e + 1] = hi; }
        ss += __shfl_xor(ss, 1); ss += __shfl_xor(ss, 2);
        if (part == 0) sspe[r] = ss;
    }
    __syncthreads();
    const int h = wave, bh = b * NH + h;
    typedef int i32x4m __attribute__((ext_vector_type(4))); typedef int i32x8m __attribute__((ext_vector_type(8)));
#define LD32G(p) __builtin_shufflevector(*(const GAS i32x4m*)(p), *(const GAS i32x4m*)((p) + 16), 0, 1, 2, 3, 4, 5, 6, 7)
#define LD32L(p) __builtin_shufflevector(*(const LAS i32x4m*)(p), *(const LAS i32x4m*)((p) + 16), 0, 1, 2, 3, 4, 5, 6, 7)
    if (lat) {
        const unsigned char* WQ = a.ws + WS_WQ + (size_t)h * QK * 256;
        const float* gqh = a.in[I_GQH];
        unsigned char* Qo = a.ws + WS_Q + ((size_t)bh * SEQ + tpos0) * QK8;
        i32x8m bq[2][6];
#pragma unroll
        for (int s2 = 0; s2 < 2; ++s2)
#pragma unroll
            for (int j = 0; j < 6; ++j) bq[s2][j] = LD32G(WQ + (size_t)(16 * j + fr) * 256 + 128 * s2 + 32 * fq);
        f32x4 gqv[6];
#pragma unroll
        for (int j = 0; j < 6; ++j) gqv[j] = *(const GAS f32x4*)(gqh + 16 * j + 4 * fq);
#pragma unroll 1
        for (int rq = 0; rq < 8; ++rq) {
            const int row = rq * 16 + fr, t = tpos0 + row;
            f32x4 csq[2][2];
#pragma unroll
            for (int ax = 0; ax < 2; ++ax) { const int pi = ax == 0 ? (t >> 6) : 128 + (t & 63); const float* cs = tabm + (pi * 8 + 4 * (fq & 1)) * 2;
                csq[ax][0] = *(const GAS f32x4*)(cs); csq[ax][1] = *(const GAS f32x4*)(cs + 4); }
            f32x4 acc[6];
#pragma unroll
            for (int j = 0; j < 6; ++j) acc[j] = (f32x4){0.f, 0.f, 0.f, 0.f};
#pragma unroll
            for (int s2 = 0; s2 < 2; ++s2) { const i32x8m af = LD32L(Aq + row * 272 + 128 * s2 + 32 * fq);
#pragma unroll
                for (int j = 0; j < 6; ++j) acc[j] = __builtin_amdgcn_mfma_scale_f32_16x16x128_f8f6f4(bq[s2][j], af, acc[j], 0, 0, 0, 0, 0, 0); }
            float ss = 0.f;
#pragma unroll
            for (int j = 0; j < 6; ++j) ss += (acc[j][0] * acc[j][0] + acc[j][1] * acc[j][1]) + (acc[j][2] * acc[j][2] + acc[j][3] * acc[j][3]);
            ss += __shfl_xor(ss, 16); ss += __shfl_xor(ss, 32);
            const float rstd = rsqrtf(ss * (1.f / 96.f) + EPS * (WQ_SCALE * WQ_SCALE)) * QSCALE;
#pragma unroll
            for (int j = 0; j < 6; ++j) {
                const int col = 16 * j + 4 * fq; const f32x4 gv = gqv[j];
                f32x4 v = acc[j] * gv * rstd;
                if (j >= 4) {
                    const int ax = j - 4;
#pragma unroll
                    for (int r = 0; r < 4; ++r) { const float other = __shfl_xor(v[r], 32); const float c = csq[ax][r >> 1][2 * (r & 1)], sn = csq[ax][r >> 1][2 * (r & 1) + 1];
                        v[r] = (fq < 2) ? (v[r] * c - other * sn) : (v[r] * c + other * sn); }
                }
                *(GAS unsigned*)(Qo + (size_t)row * QK8 + col) = cvt4_fp8(v[0], v[1], v[2], v[3]);
            }
            *(GAS u32x2*)(Qo + (size_t)row * QK8 + QK + 8 * fq) = (u32x2){0u, 0u};
        }
    }
    {
        const unsigned char* WKV = a.ws + WS_WKV + (size_t)h * 128 * 128;
        const float* gkh = a.in[I_GKH];
        unsigned char* Ko = a.ws + WS_K + ((size_t)bh * SKV + key0) * QK8;
        unsigned char* Vo = a.ws + WS_VT + (size_t)bh * DV * SKV + key0;
        i32x8m bkv[8];
#pragma unroll
        for (int j = 0; j < 8; ++j) bkv[j] = LD32G(WKV + (size_t)(16 * j + fr) * 128 + 32 * fq);
        f32x4 gkv[4]; float gp0[4], gp1[4];
#pragma unroll
        for (int j = 0; j < 4; ++j) gkv[j] = *(const GAS f32x4*)(gkh + 16 * j + 4 * fq);
#pragma unroll
        for (int r = 0; r < 4; ++r) { const int c0 = (fq >> 1) * 16 + 4 * (fq & 1) + r; gp0[r] = gkh[64 + c0]; gp1[r] = gkh[64 + c0 + 8]; }
#pragma unroll 1
        for (int rq = r0 >> 4; rq < ((r0 + nrows) >> 4); ++rq) {
            f32x4 csk[2];
            { const int t = tpos0 + rq * 16 + fr, ax = fq >> 1, pi = ax == 0 ? (t >> 6) : 128 + (t & 63); const float* cs = tabm + (pi * 8 + 4 * (fq & 1)) * 2;
              csk[0] = *(const GAS f32x4*)(cs); csk[1] = *(const GAS f32x4*)(cs + 4); }
            f32x4 acc[1][8];
#pragma unroll
            for (int i = 0; i < 1; ++i)
#pragma unroll
                for (int j = 0; j < 8; ++j) acc[i][j] = (f32x4){0.f, 0.f, 0.f, 0.f};
            { const i32x8m af = LD32L(Akv + (rq * 16 + fr) * 144 + 32 * fq);
#pragma unroll
              for (int j = 0; j < 8; ++j) acc[0][j] = __builtin_amdgcn_mfma_scale_f32_16x16x128_f8f6f4(bkv[j], af, acc[0][j], 0, 0, 0, 0, 0, 0) ; }
#pragma unroll
            for (int j = 0; j < 8; ++j) acc[0][j] = acc[0][j] * WKV_INV;
#pragma unroll
            for (int i = 0; i < 1; ++i) {
                const int row = rq * 16 + 16 * i + fr, t = tpos0 + row;
                const int kk = row & 63; const int vrow = (row & 64) + 32 * ((kk >> 2) & 1) + (kk & 3) + 4 * ((kk & 31) >> 3) + 16 * (kk >> 5);
                float ss = 0.f;
#pragma unroll
                for (int j = 0; j < 4; ++j) ss += (acc[i][j][0] * acc[i][j][0] + acc[i][j][1] * acc[i][j][1]) + (acc[i][j][2] * acc[i][j][2] + acc[i][j][3] * acc[i][j][3]);
                ss += __shfl_xor(ss, 16); ss += __shfl_xor(ss, 32);
                const float rstd = rsqrtf((ss + sspe[row]) * (1.f / 96.f) + EPS);
#pragma unroll
                for (int j = 0; j < 4; ++j) { const int col = 16 * j + 4 * fq; const f32x4 gv = gkv[j]; const f32x4 v = acc[i][j] * gv * rstd;
                    *(GAS unsigned*)(Ko + (size_t)row * QK8 + col) = cvt4_fp8(v[0], v[1], v[2], v[3]); }
                {
                    const int ax = fq >> 1, f0 = 4 * (fq & 1);
                    float o0[4], o1[4];
#pragma unroll
                    for (int r = 0; r < 4; ++r) { const int c0 = ax * 16 + f0 + r, c1 = c0 + 8;
                        const float x0 = kpe[row * 32 + c0] * rstd * gp0[r], x1 = kpe[row * 32 + c1] * rstd * gp1[r];
                        const float c = lat ? csk[r >> 1][2 * (r & 1)] : 1.f, s = lat ? csk[r >> 1][2 * (r & 1) + 1] : 0.f;
                        o0[r] = x0 * c - x1 * s; o1[r] = x1 * c + x0 * s; }
                    *(GAS unsigned*)(Ko + (size_t)row * QK8 + 64 + ax * 16 + f0) = cvt4_fp8(o0[0], o0[1], o0[2], o0[3]);
                    *(GAS unsigned*)(Ko + (size_t)row * QK8 + 64 + ax * 16 + 8 + f0) = cvt4_fp8(o1[0], o1[1], o1[2], o1[3]);
                    *(GAS u32x2*)(Ko + (size_t)row * QK8 + QK + 8 * fq) = (u32x2){0u, 0u};
                }
#pragma unroll
                for (int j = 4; j < 8; ++j)
#pragma unroll
                    for (int r = 0; r < 4; ++r) { const int d = 16 * (j - 4) + 4 * fq + r; Vo[(size_t)d * SKV + vrow] = (unsigned char)(cvt4_fp8(acc[i][j][r], 0.f, 0.f, 0.f) & 0xffu); }
            }
        }
    }
}

__device__ __forceinline__ float log_gamma(const float* logit) { const float x = *logit; return -log1pf(__expf(-x)); }

__device__ __forceinline__ void rope16(float (&out)[16], const bf16_t* rowp  , int part, const float* cs  , float scale) {
    const u32x4 a0 = *(const GAS u32x4*)(rowp + part * 16), a1 = *(const GAS u32x4*)(rowp + part * 16 + 8);
    const u32x4 b0 = *(const GAS u32x4*)(rowp + (part ^ 1) * 16), b1 = *(const GAS u32x4*)(rowp + (part ^ 1) * 16 + 8);
    float xs[16], xo[16];
#pragma unroll
    for (int e = 0; e < 4; ++e) { xs[2 * e] = lo16(a0[e]); xs[2 * e + 1] = hi16(a0[e]); xs[8 + 2 * e] = lo16(a1[e]); xs[8 + 2 * e + 1] = hi16(a1[e]);
        xo[2 * e] = lo16(b0[e]); xo[2 * e + 1] = hi16(b0[e]); xo[8 + 2 * e] = lo16(b1[e]); xo[8 + 2 * e + 1] = hi16(b1[e]); }
    if (cs) {
        const float sg = (part & 1) ? 1.f : -1.f;
#pragma unroll
        for (int q = 0; q < 8; ++q) { const f32x4 t = *(const GAS f32x4*)(cs + 4 * q);
            out[2 * q] = (xs[2 * q] * t[0] + sg * xo[2 * q] * t[1]) * scale; out[2 * q + 1] = (xs[2 * q + 1] * t[2] + sg * xo[2 * q + 1] * t[3]) * scale; }
    } else {
#pragma unroll
        for (int f = 0; f < 16; ++f) out[f] = xs[f] * scale;
    }
}

__device__ __forceinline__ void ret_local_unit(const Args& a, LAS unsigned char* lds, int unit) {
    const int tid = tid_of(a.wv), lane = tid & 63, wave = a.wv, fr = lane & 15, fq = lane >> 4;
    const int bh = unit / NSLOT, slot = unit % NSLOT, b = bh >> 2, h = bh & 3;
    const bool lat = slot >= 2;
    const int prow0 = lat ? b * SEQ + (slot - 2) * RC : T + b * LC + slot * RC;
    const int tpos0 = lat ? (slot - 2) * RC : 0;
    LAS bf16_t* KfT = (LAS bf16_t*)lds;
    LAS bf16_t* KbT = (LAS bf16_t*)(lds + 17408);
    LAS bf16_t* VT = (LAS bf16_t*)(lds + 34816);
    const bf16_t* P = (const bf16_t*)(a.ws + WS_P);
    const float* tabr = (const float*)(a.ws + WS_TABR);
    const float lgf = log_gamma(a.in[I_DECAY] + h), lgb = log_gamma(a.in[I_DECAY] + 4 + h);
    __syncthreads();
    {
        const int j = tid >> 2, part = tid & 3, t = tpos0 + j, ax = part >> 1;
        const int pi = ax == 0 ? (t >> 6) : 128 + (t & 63);
        float o[16]; rope16(o, P + (size_t)(prow0 + j) * DINP + OFF_RK + h * 64, part, lat ? tabr + pi * 32 : nullptr, 0.125f);
        const float wf = __expf(lgf * (float)(127 - j)), wb = __expf(lgb * (float)j);
#pragma unroll
        for (int f = 0; f < 16; ++f) { const int d = part * 16 + f; KfT[d * 136 + j] = (bf16_t)f2bf(o[f] * wf); KbT[d * 136 + j] = (bf16_t)f2bf(o[f] * wb); }
    }
    for (int idx = tid; idx < 128 * 16; idx += 512) {
        const int j = idx >> 4, c = idx & 15;
        const u32x4 v = *(const GAS u32x4*)(P + (size_t)(prow0 + j) * DINP + OFF_RV + h * 128 + c * 8);
#pragma unroll
        for (int e = 0; e < 4; ++e) { VT[(c * 8 + 2 * e) * 136 + j] = (bf16_t)(v[e] & 0xffffu); VT[(c * 8 + 2 * e + 1) * 136 + j] = (bf16_t)(v[e] >> 16); }
    }
    __syncthreads();
    const int dir = wave >> 2, mi = wave & 3;
    f32x4 acc[1][8];
#pragma unroll
    for (int j = 0; j < 8; ++j) acc[0][j] = (f32x4){0.f, 0.f, 0.f, 0.f};
    mma_ll<1, 8, false>(acc, dir ? KbT : KfT, 136, 16 * mi, VT, 136, 0, 128, lane);
    float* out = (float*)(a.ws + WS_LST) + ((size_t)(bh * 2 + dir) * NSLOT + slot) * 8192;
#pragma unroll
    for (int j = 0; j < 8; ++j) *(GAS f32x4*)(out + (size_t)(16 * j + fr) * 64 + 16 * mi + 4 * fq) = acc[0][j];
}

__device__ __forceinline__ void phase_ret_scan(const Args& a) {
    const int gt = blockIdx.x * 512 + tid_of(a.wv);
    if (gt >= 32 * 2048) return;
    const int bd = gt >> 11, v4 = gt & 2047, dir = bd & 1, h = (bd >> 1) & 3;
    const float lg = log_gamma(a.in[I_DECAY] + dir * 4 + h);
    const float g = __expf(lg * 128.f);
    float* base = (float*)(a.ws + WS_LST) + (size_t)bd * NSLOT * 8192 + v4 * 4;
    f32x4 S = (f32x4){0.f, 0.f, 0.f, 0.f};
#pragma unroll 1
    for (int bt = 0; bt < 5; ++bt) {
        f32x4 L[13];
#pragma unroll
        for (int q = 0; q < 13; ++q) { const int n = bt * 13 + q; const int slot = dir == 0 ? n : (n == 0 ? 1 : (n == 1 ? 0 : 67 - n)); L[q] = *(const GAS f32x4*)(base + (size_t)slot * 8192); }
#pragma unroll
        for (int q = 0; q < 13; ++q) { const int n = bt * 13 + q; const int slot = dir == 0 ? n : (n == 0 ? 1 : (n == 1 ? 0 : 67 - n)); S = S * g + L[q]; *(GAS f32x4*)(base + (size_t)slot * 8192) = S; }
    }
}

__device__ __forceinline__ void ret_out_unit(const Args& a, LAS unsigned char* lds, int unit) {
    const int tid = tid_of(a.wv), lane = tid & 63, wave = a.wv, fr = lane & 15, fq = lane >> 4;
    const int bh = unit >> 6, c = unit & 63, b = bh >> 2, h = bh & 3;
    const int prow0 = b * SEQ + c * RC, tpos0 = c * RC;
    LAS bf16_t* Qs = (LAS bf16_t*)lds;
    LAS bf16_t* Ks = (LAS bf16_t*)(lds + 18432);
    LAS bf16_t* VT = (LAS bf16_t*)(lds + 36864);
    LAS bf16_t* SfT = (LAS bf16_t*)(lds + 71680);
    LAS bf16_t* SbT = (LAS bf16_t*)(lds + 90112);
    LAS bf16_t* Ws = (LAS bf16_t*)(lds + 108544);
    const bf16_t* P = (const bf16_t*)(a.ws + WS_P);
    const float* tabr = (const float*)(a.ws + WS_TABR);
    const float lgf = log_gamma(a.in[I_DECAY] + h), lgb = log_gamma(a.in[I_DECAY] + 4 + h);
    __syncthreads();
    {
        const int j = tid >> 2, part = tid & 3, t = tpos0 + j, ax = part >> 1;
        const int pi = ax == 0 ? (t >> 6) : 128 + (t & 63);
        float oq[16], ok[16];
        rope16(oq, P + (size_t)(prow0 + j) * DINP + OFF_RQ + h * 64, part, tabr + pi * 32, 1.f);
        rope16(ok, P + (size_t)(prow0 + j) * DINP + OFF_RK + h * 64, part, tabr + pi * 32, 0.125f);
        u32x4 w0, w1;
        w0 = (u32x4){pk2(oq[0], oq[1]), pk2(oq[2], oq[3]), pk2(oq[4], oq[5]), pk2(oq[6], oq[7])}; w1 = (u32x4){pk2(oq[8], oq[9]), pk2(oq[10], oq[11]), pk2(oq[12], oq[13]), pk2(oq[14], oq[15])};
        *(LAS u32x4*)(Qs + j * 72 + part * 16) = w0; *(LAS u32x4*)(Qs + j * 72 + part * 16 + 8) = w1;
        w0 = (u32x4){pk2(ok[0], ok[1]), pk2(ok[2], ok[3]), pk2(ok[4], ok[5]), pk2(ok[6], ok[7])}; w1 = (u32x4){pk2(ok[8], ok[9]), pk2(ok[10], ok[11]), pk2(ok[12], ok[13]), pk2(ok[14], ok[15])};
        *(LAS u32x4*)(Ks + j * 72 + part * 16) = w0; *(LAS u32x4*)(Ks + j * 72 + part * 16 + 8) = w1;
    }
    for (int idx = tid; idx < 128 * 16; idx += 512) {
        const int j = idx >> 4, cch = idx & 15;
        const u32x4 v = *(const GAS u32x4*)(P + (size_t)(prow0 + j) * DINP + OFF_RV + h * 128 + cch * 8);
#pragma unroll
        for (int e = 0; e < 4; ++e) { VT[(cch * 8 + 2 * e) * 136 + j] = (bf16_t)(v[e] & 0xffffu); VT[(cch * 8 + 2 * e + 1) * 136 + j] = (bf16_t)(v[e] >> 16); }
    }
    {
        const float* sf = (const float*)(a.ws + WS_LST) + ((size_t)(bh * 2 + 0) * NSLOT + (c + 1)) * 8192;
        const float* sb = (const float*)(a.ws + WS_LST) + ((size_t)(bh * 2 + 1) * NSLOT + (c == 63 ? 0 : c + 3)) * 8192;
        for (int idx = tid; idx < 2048; idx += 512) {
            const int e = idx >> 4, d = (idx & 15) * 4;
            const f32x4 x = *(const GAS f32x4*)(sf + idx * 4), y = *(const GAS f32x4*)(sb + idx * 4);
            u32x2 w; w.x = pk2(x[0], x[1]); w.y = pk2(x[2], x[3]); *(LAS u32x2*)(SfT + e * 72 + d) = w;
            w.x = pk2(y[0], y[1]); w.y = pk2(y[2], y[3]); *(LAS u32x2*)(SbT + e * 72 + d) = w;
        }
    }
    __syncthreads();
    const int i0 = 16 * wave, irow = i0 + fr;
    u32x2 gwv[8];
    { const bf16_t* pg_ = P + (size_t)(prow0 + irow) * DINP + OFF_RG + h * 128;
#pragma unroll
      for (int j = 0; j < 8; ++j) gwv[j] = *(const GAS u32x2*)(pg_ + 16 * j + 4 * fq); }
    f32x4 accS[1][8], accF[1][8], accB[1][8], accO[1][8];
#pragma unroll
    for (int j = 0; j < 8; ++j) { accS[0][j] = (f32x4){0.f, 0.f, 0.f, 0.f}; accF[0][j] = accS[0][j]; accB[0][j] = accS[0][j]; accO[0][j] = accS[0][j]; }
    mma_ll<1, 8, true>(accS, Qs, 72, i0, Ks, 72, 0, 64, lane);
    mma_ll<1, 8, true>(accF, Qs, 72, i0, SfT, 72, 0, 64, lane);
    mma_ll<1, 8, true>(accB, Qs, 72, i0, SbT, 72, 0, 64, lane);
#pragma unroll
    for (int j = 0; j < 8; ++j) {
        float w[4];
#pragma unroll
        for (int r = 0; r < 4; ++r) { const int jj = 16 * j + 4 * fq + r; const int df = irow - jj;
            const float dec = df > 0 ? __expf(lgf * (float)df) : (df < 0 ? __expf(lgb * (float)(-df)) : 2.f);
            w[r] = accS[0][j][r] * dec; }
        u32x2 pw; pw.x = pk2(w[0], w[1]); pw.y = pk2(w[2], w[3]);
        *(LAS u32x2*)(Ws + irow * 136 + 16 * j + 4 * fq) = pw;
    }
    LDS_WAIT(); __builtin_amdgcn_wave_barrier();
    mma_ll<1, 8, true>(accO, Ws, 136, i0, VT, 136, 0, 128, lane);
    const float wf = __expf(lgf * (float)(irow + 1)), wb = __expf(lgb * (float)(128 - irow));
    float ss = 0.f;
#pragma unroll
    for (int j = 0; j < 8; ++j) { accO[0][j] = accO[0][j] + accF[0][j] * wf + accB[0][j] * wb;
        ss += (accO[0][j][0] * accO[0][j][0] + accO[0][j][1] * accO[0][j][1]) + (accO[0][j][2] * accO[0][j][2] + accO[0][j][3] * accO[0][j][3]); }
    ss += __shfl_xor(ss, 16); ss += __shfl_xor(ss, 32);
    const float rstd = rsqrtf(ss * (1.f / 128.f) + EPS);
    const float* gro = a.in[I_GRET] + h * 128;
    bf16_t* mix = (bf16_t*)(a.ws + WS_MIX) + (size_t)(prow0 + irow) * DM + 512 + h * 128;
#pragma unroll
    for (int j = 0; j < 8; ++j) { const int e = 16 * j + 4 * fq; const f32x4 gv = *(const GAS f32x4*)(gro + e); const u32x2 gw = gwv[j];
        const float g0 = lo16(gw.x), g1 = hi16(gw.x), g2 = lo16(gw.y), g3 = hi16(gw.y);
        f32x4 v = accO[0][j] * gv * rstd;
        v[0] *= g0 / (1.f + __expf(-g0)); v[1] *= g1 / (1.f + __expf(-g1)); v[2] *= g2 / (1.f + __expf(-g2)); v[3] *= g3 / (1.f + __expf(-g3));
        u32x2 w; w.x = pk2(v[0], v[1]); w.y = pk2(v[2], v[3]); *(GAS u32x2*)(mix + e) = w; }
}

namespace att {
constexpr int KLD8 = 144  , VLD8 = 80  , KBUF = 64 * KLD8, VBUF = 64 * VLD8, NKB = 3, NVB = 4;
constexpr int L_K = 0, L_V = NKB * KBUF, L_WS = NKB * KBUF + NVB * VBUF;
__device__ __forceinline__ int crow(int r, int hi) { return (r & 3) + 8 * (r >> 2) + 4 * hi; }
typedef __bf16 bf16x2_t __attribute__((ext_vector_type(2))); typedef float f32x2_t __attribute__((ext_vector_type(2)));
__device__ __forceinline__ unsigned cvtpk(float lo, float hi) { f32x2_t v = {lo, hi}; bf16x2_t b = __builtin_convertvector(v, bf16x2_t); return __builtin_bit_cast(unsigned, b); }
#define SBAR() __builtin_amdgcn_sched_barrier(0)
typedef int i32x4 __attribute__((ext_vector_type(4))); typedef int i32x8 __attribute__((ext_vector_type(8)));
constexpr float PSHIFT = 2.f;
template <bool SHIFT>
__device__ __forceinline__ i32x8 softmax_pack8(f32x16& p0, f32x16& p1, float negm) {
    const float sh = negm + 8.f - PSHIFT;
#pragma unroll
    for (int r = 0; r < 16; ++r) { p0[r] = __builtin_amdgcn_exp2f(SHIFT ? p0[r] + sh : p0[r]); p1[r] = __builtin_amdgcn_exp2f(SHIFT ? p1[r] + sh : p1[r]); }
    i32x8 w;
#pragma unroll
    for (int q = 0; q < 4; ++q) { w[q] = (int)cvt4_fp8(p0[4 * q], p0[4 * q + 1], p0[4 * q + 2], p0[4 * q + 3]); w[4 + q] = (int)cvt4_fp8(p1[4 * q], p1[4 * q + 1], p1[4 * q + 2], p1[4 * q + 3]); }
    return w;
}
template <bool SHIFT>
__device__ __forceinline__ void unit64(const Args& a, LAS unsigned char* lds, int bh, int qb, float negm) {
    const int wid = sopaque(a.wv), tid = tid_of(wid), lane = tid & 63, r32 = lane & 31, hi = lane >> 5;
    const unsigned char* QwA = a.ws + WS_Q + ((size_t)bh * SEQ + qb * 512 + wid * 64 + r32) * QK8 + hi * 32;
    const unsigned char* Kh = a.ws + WS_K + (size_t)bh * SKV * QK8;
    const unsigned char* Vh = a.ws + WS_VT + (size_t)bh * DV * SKV;
    LAS unsigned char* Kl = lds + L_K; LAS unsigned char* Vl = lds + L_V;
    LAS float* wsf = (LAS float*)(lds + L_WS) + wid * 64;
    i32x8 qA8[2], qB8[2];
#pragma unroll
    for (int s2 = 0; s2 < 2; ++s2) { const i32x4 a0_ = *(const GAS i32x4*)(QwA + 64 * s2), a1_ = *(const GAS i32x4*)(QwA + 64 * s2 + 16), b0_ = *(const GAS i32x4*)(QwA + 32 * QK8 + 64 * s2), b1_ = *(const GAS i32x4*)(QwA + 32 * QK8 + 64 * s2 + 16);
        qA8[s2] = __builtin_shufflevector(a0_, a1_, 0, 1, 2, 3, 4, 5, 6, 7); qB8[s2] = __builtin_shufflevector(b0_, b1_, 0, 1, 2, 3, 4, 5, 6, 7); }
    unsigned soff[2]; int dsto[2];
#pragma unroll
    for (int m = 0; m < 2; ++m) { const int j = (wid + 8 * m) < 14 ? wid + 8 * m : wid + 8 * m - 8;
        if (j < 9) { const int p = j * 64 + lane, row = p / 9, c = p % 9; soff[m] = (unsigned)(row * QK8 + (c < 8 ? c : 7) * 16); dsto[m] = L_K + j * 1024; }
        else { const int jv = j - 9, p = jv * 64 + lane, d = p / 5, c = p % 5; soff[m] = (unsigned)(d * SKV + (c < 4 ? c : 3) * 16); dsto[m] = L_V + jv * 1024; } }
    const char* Kb = (const char*)Kh; const char* Vb = (const char*)Vh;
#define DMA(t, kslot, vslot) do { _Pragma("unroll") for (int pm_ = 0; pm_ < 2; ++pm_) { const int j_ = (wid + 8 * pm_) < 14 ? wid + 8 * pm_ : wid + 8 * pm_ - 8; { \
        const char* src_ = (j_ < 9 ? Kb + (size_t)(t) * (64 * QK8) : Vb + (size_t)(t) * 64) + soff[pm_]; \
        __builtin_amdgcn_global_load_lds((const unsigned*)src_, (LAS unsigned*)(lds + dsto[pm_] + (j_ < 9 ? (kslot) * KBUF : (vslot) * VBUF)), 16, 0, 0); } } } while (0)
    i32x8 ones8;
#pragma unroll
    for (int q = 0; q < 8; ++q) ones8[q] = r32 == 0 ? 0x38383838 : 0;
    f32x16 oA[2], oB[2], sA, sB;
#pragma unroll
    for (int r = 0; r < 16; ++r) { oA[0][r] = 0.f; oA[1][r] = 0.f; oB[0][r] = 0.f; oB[1][r] = 0.f; sA[r] = 0.f; sB[r] = 0.f; }
    constexpr int NT = SKV / 64;
    __syncthreads();
    DMA(0, 0, 0); DMA(1, 1, 1); __syncthreads();
#ifndef ATT_STAGGER
#define ATT_STAGGER 0
#endif
    const bool late = ATT_STAGGER && wid >= 4;
#define TILE_BAR(more) do { if (more) asm volatile("s_waitcnt vmcnt(2) lgkmcnt(0)\n\ts_barrier" ::: "memory"); else asm volatile("s_waitcnt vmcnt(0) lgkmcnt(0)\n\ts_barrier" ::: "memory"); } while (0)
    int ks = 0, vs = 0;
    for (int i = 0; i < NT; ++i) {
        const bool more = i + 2 < NT;
        if (more) DMA(i + 2, (ks == 0 ? 2 : ks - 1), ((vs + 2) & 3));
        SBAR();
        f32x16 pA0, pA1, pB0, pB1;
#pragma unroll
        for (int r = 0; r < 16; ++r) { pA0[r] = PSHIFT; pA1[r] = PSHIFT; pB0[r] = PSHIFT; pB1[r] = PSHIFT; }
        const LAS unsigned char* Ks = Kl + ks * KBUF + r32 * KLD8 + 32 * hi;
#pragma unroll
        for (int s2 = 0; s2 < 2; ++s2) {
            const i32x4 c0_ = *(const LAS i32x4*)(Ks + 64 * s2), c1_ = *(const LAS i32x4*)(Ks + 64 * s2 + 16), d0_ = *(const LAS i32x4*)(Ks + 32 * KLD8 + 64 * s2), d1_ = *(const LAS i32x4*)(Ks + 32 * KLD8 + 64 * s2 + 16);
            const i32x8 k0 = __builtin_shufflevector(c0_, c1_, 0, 1, 2, 3, 4, 5, 6, 7), k1 = __builtin_shufflevector(d0_, d1_, 0, 1, 2, 3, 4, 5, 6, 7);
            pA0 = __builtin_amdgcn_mfma_scale_f32_32x32x64_f8f6f4(k0, qA8[s2], pA0, 0, 0, 0, 0, 0, 0); pB0 = __builtin_amdgcn_mfma_scale_f32_32x32x64_f8f6f4(k0, qB8[s2], pB0, 0, 0, 0, 0, 0, 0);
            pA1 = __builtin_amdgcn_mfma_scale_f32_32x32x64_f8f6f4(k1, qA8[s2], pA1, 0, 0, 0, 0, 0, 0); pB1 = __builtin_amdgcn_mfma_scale_f32_32x32x64_f8f6f4(k1, qB8[s2], pB1, 0, 0, 0, 0, 0, 0);
        }
        SBAR();
        if (late) TILE_BAR(more);
        const LAS unsigned char* Vs = Vl + vs * VBUF + r32 * VLD8 + 32 * hi;
        const i32x4 e0_ = *(const LAS i32x4*)(Vs), e1_ = *(const LAS i32x4*)(Vs + 16), f0_ = *(const LAS i32x4*)(Vs + 32 * VLD8), f1_ = *(const LAS i32x4*)(Vs + 32 * VLD8 + 16);
        const i32x8 v0 = __builtin_shufflevector(e0_, e1_, 0, 1, 2, 3, 4, 5, 6, 7), v1 = __builtin_shufflevector(f0_, f1_, 0, 1, 2, 3, 4, 5, 6, 7);
        { const i32x8 pa = softmax_pack8<SHIFT>(pA0, pA1, negm);
          oA[0] = __builtin_amdgcn_mfma_scale_f32_32x32x64_f8f6f4(pa, v0, oA[0], 0, 0, 0, 0, 0, 0); oA[1] = __builtin_amdgcn_mfma_scale_f32_32x32x64_f8f6f4(pa, v1, oA[1], 0, 0, 0, 0, 0, 0);
          sA = __builtin_amdgcn_mfma_scale_f32_32x32x64_f8f6f4(pa, ones8, sA, 0, 0, 0, 0, 0, 0); }
        { const i32x8 pa = softmax_pack8<SHIFT>(pB0, pB1, negm);
          oB[0] = __builtin_amdgcn_mfma_scale_f32_32x32x64_f8f6f4(pa, v0, oB[0], 0, 0, 0, 0, 0, 0); oB[1] = __builtin_amdgcn_mfma_scale_f32_32x32x64_f8f6f4(pa, v1, oB[1], 0, 0, 0, 0, 0, 0);
          sB = __builtin_amdgcn_mfma_scale_f32_32x32x64_f8f6f4(pa, ones8, sB, 0, 0, 0, 0, 0, 0); }
        SBAR();
        if (!late) TILE_BAR(more);
        ks = ks == 2 ? 0 : ks + 1; vs = (vs + 1) & 3;
    }
#undef DMA
#undef TILE_BAR
    if (r32 == 0) {
#pragma unroll
        for (int r = 0; r < 16; ++r) { wsf[crow(r, hi)] = sA[r]; wsf[32 + crow(r, hi)] = sB[r]; } }
    LDS_WAIT(); __builtin_amdgcn_wave_barrier();
    const int b = bh >> 3, h = bh & 7;
    const int lz = opaque(lane), r32z = lz & 31, hiz = lz >> 5;
    bf16_t* Ow = (bf16_t*)(a.ws + WS_MIX) + ((size_t)b * SEQ + qb * 512 + wid * 64) * DM + h * DV;
    const unsigned ooff = (unsigned)(4 * hiz * DM + r32z);
#pragma unroll
    for (int r = 0; r < 16; ++r) { const int orow = crow(r, hiz); const float rlA = 1.f / wsf[orow], rlB = 1.f / wsf[32 + orow];
        const unsigned off = ooff + (unsigned)(((r & 3) + 8 * (r >> 2)) * DM);
        Ow[off] = (bf16_t)f2bf(oA[0][r] * rlA); Ow[off + 32] = (bf16_t)f2bf(oA[1][r] * rlA);
        Ow[off + 32 * DM] = (bf16_t)f2bf(oB[0][r] * rlB); Ow[off + 32 * DM + 32] = (bf16_t)f2bf(oB[1][r] * rlB); }
}
#undef SBAR
}


#if DIAG == 5
__device__ __forceinline__ void attn_selfcheck(const Args& a, LAS unsigned char* lds) {
    const int tid = tid_of(a.wv);
    LAS float* red = (LAS float*)lds;
    __syncthreads();
    if (blockIdx.x == 0) {
        const int row = tid >> 3, ds = (tid & 7) * 8;
        const unsigned char* q = a.ws + WS_Q + (size_t)row * QK8; const unsigned char* K = a.ws + WS_K; const unsigned char* V = a.ws + WS_VT;
        float qf[96];
        float acc[8] = {0.f, 0.f, 0.f, 0.f, 0.f, 0.f, 0.f, 0.f}; float l = 0.f;
        for (int key = 0; key < SKV; ++key) {
            float s = 0.f;
            for (int c = 0; c < 96; c += 4) { const int kw = *(const GAS int*)(K + (size_t)key * QK8 + c), qw = *(const GAS int*)(q + c);
                s += __builtin_amdgcn_cvt_f32_fp8(kw, 0) * __builtin_amdgcn_cvt_f32_fp8(qw, 0) + __builtin_amdgcn_cvt_f32_fp8(kw, 1) * __builtin_amdgcn_cvt_f32_fp8(qw, 1)
                   + __builtin_amdgcn_cvt_f32_fp8(kw, 2) * __builtin_amdgcn_cvt_f32_fp8(qw, 2) + __builtin_amdgcn_cvt_f32_fp8(kw, 3) * __builtin_amdgcn_cvt_f32_fp8(qw, 3); }
            const float p = exp2f(s);
            const int kk = key & 63, pos = (key & ~63) + 32 * ((kk >> 2) & 1) + (kk & 3) + 4 * ((kk & 31) >> 3) + 16 * (kk >> 5);
            l += p;
#pragma unroll
            for (int e = 0; e < 8; ++e) { const int w = V[(size_t)(ds + e) * SKV + pos]; acc[e] += p * __builtin_amdgcn_cvt_f32_fp8(w, 0); }
        }
        (void)qf;
        float emax = 0.f, omax = 0.f;
        const bf16_t* mix = (const bf16_t*)(a.ws + WS_MIX) + (size_t)row * DM + ds;
#pragma unroll
        for (int e = 0; e < 8; ++e) { const float o = acc[e] / l; emax = fmaxf(emax, fabsf(o - bf2f(mix[e]))); omax = fmaxf(omax, fabsf(o)); }
        red[tid] = emax; red[512 + tid] = omax;
        __syncthreads();
        if (tid == 0) { float e = 0.f, o = 0.f; for (int i = 0; i < 512; ++i) { e = fmaxf(e, red[i]); o = fmaxf(o, red[512 + i]); }
            ((unsigned*)(a.ws + WS_CTL))[CW_DIAG] = __float_as_uint(e / o * 0.1f); }
    }
    __syncthreads();
}
#endif

__device__ __forceinline__ void phase_router(const Args& a, LAS unsigned char* lds) {
    const int tid = tid_of(a.wv), lane = tid & 63, wave = a.wv, fr = lane & 15, fq = lane >> 4;
    LAS bf16_t* Ah = (LAS bf16_t*)lds;
    LAS bf16_t* Al = (LAS bf16_t*)(lds + 33024);
    LAS float* red = (LAS float*)(lds + 66048);
    LAS int* hist = (LAS int*)(lds + 66048 + 16384);
    LAS int* base = hist + 32;
    LAS int* pk_e = base + 32;
    LAS int* pk_r = pk_e + 512;
    LAS int* pk_p = pk_r + 512;
    const float* mod = (const float*)(a.ws + WS_MOD); const float* g = a.in[I_GFFN];
    const bf16_t* WR = (const bf16_t*)(a.ws + WS_WR);
    unsigned char* HF = a.ws + WS_HF;
    float* PG = (float*)(a.ws + WS_PG);
    unsigned* cnt = (unsigned*)(a.ws + WS_CTL) + CW_CNT;
    unsigned* list = (unsigned*)(a.ws + WS_LIST);
    LAS float* lg = (LAS float*)(pk_p + 512);
    bf16x8 bh[4][2], bl[4][2];
#pragma unroll
    for (int ks = 0; ks < 4; ++ks)
#pragma unroll
        for (int j = 0; j < 2; ++j) { bh[ks][j] = *(const GAS bf16x8*)(WR + (size_t)(16 * j + fr) * 1024 + wave * 128 + 32 * ks + 8 * fq); bl[ks][j] = *(const GAS bf16x8*)(WR + 32768 + (size_t)(16 * j + fr) * 1024 + wave * 128 + 32 * ks + 8 * fq); }
    for (int tile = blockIdx.x; tile < T / 128; tile += gridDim.x) {
        __syncthreads();
        if (tid < 32) hist[tid] = 0;
        f32x4 v[2][4];
#pragma unroll
        for (int rr = 0; rr < 2; ++rr) { const float* xr = a.out + (size_t)(tile * 128 + wave * 2 + rr) * DM;
#pragma unroll
            for (int j = 0; j < 4; ++j) v[rr][j] = *(const GAS f32x4*)(xr + j * 256 + lane * 4); }
#pragma unroll 1
        for (int it = 0; it < 8; ++it) {
            const int tok0 = tile * 128 + it * 16;
#pragma unroll
            for (int rr = 0; rr < 2; ++rr) {
                const int row = wave * 2 + rr, tok = tok0 + row;
                const float* sh = mod + (tok >> 13) * 6144 + 3 * 1024; const float* sc = sh + 1024;
                float ss = 0.f;
#pragma unroll
                for (int j = 0; j < 4; ++j) ss += (v[rr][j].x * v[rr][j].x + v[rr][j].y * v[rr][j].y) + (v[rr][j].z * v[rr][j].z + v[rr][j].w * v[rr][j].w);
                const float rstd = rsqrtf(wave_sum(ss) * (1.f / DM) + EPS);
#pragma unroll
                for (int j = 0; j < 4; ++j) { const int c = j * 256 + lane * 4; const f32x4 gg = *(const GAS f32x4*)(g + c), s1 = *(const GAS f32x4*)(sc + c), s0 = *(const GAS f32x4*)(sh + c);
                    const f32x4 o = (v[rr][j] * rstd * gg) * (s1 + 1.f) + s0;
                    const unsigned h0 = f2bf(o.x), h1 = f2bf(o.y), h2 = f2bf(o.z), h3 = f2bf(o.w);
                    u32x2 wh; wh.x = h0 | (h1 << 16); wh.y = h2 | (h3 << 16);
                    u32x2 wl; wl.x = pk2(o.x - bf2f((bf16_t)h0), o.y - bf2f((bf16_t)h1)); wl.y = pk2(o.z - bf2f((bf16_t)h2), o.w - bf2f((bf16_t)h3));
                    *(GAS unsigned*)(HF + (size_t)tok * DM + c) = cvt4_fp8(o.x, o.y, o.z, o.w);
                    *(LAS u32x2*)(Ah + row * 1032 + c) = wh; *(LAS u32x2*)(Al + row * 1032 + c) = wl; }
            }
            if (it < 7) {
#pragma unroll
                for (int rr = 0; rr < 2; ++rr) { const float* xr = a.out + (size_t)(tok0 + 16 + wave * 2 + rr) * DM;
#pragma unroll
                    for (int j = 0; j < 4; ++j) v[rr][j] = *(const GAS f32x4*)(xr + j * 256 + lane * 4); } }
            __syncthreads();
            {
                f32x4 acc[2]; acc[0] = (f32x4){0.f, 0.f, 0.f, 0.f}; acc[1] = acc[0];
#pragma unroll
                for (int ks = 0; ks < 4; ++ks) { const bf16x8 ah = *(const LAS bf16x8*)(Ah + fr * 1032 + wave * 128 + 32 * ks + 8 * fq), al = *(const LAS bf16x8*)(Al + fr * 1032 + wave * 128 + 32 * ks + 8 * fq);
#pragma unroll
                    for (int j = 0; j < 2; ++j) { acc[j] = __builtin_amdgcn_mfma_f32_16x16x32_bf16(ah, bh[ks][j], acc[j], 0, 0, 0); acc[j] = __builtin_amdgcn_mfma_f32_16x16x32_bf16(al, bh[ks][j], acc[j], 0, 0, 0);
                        acc[j] = __builtin_amdgcn_mfma_f32_16x16x32_bf16(ah, bl[ks][j], acc[j], 0, 0, 0); } }
#pragma unroll
                for (int j = 0; j < 2; ++j)
#pragma unroll
                    for (int r = 0; r < 4; ++r) red[(wave * 16 + 4 * fq + r) * 32 + 16 * j + fr] = acc[j][r];
            }
            __syncthreads();
            { const int tk = tid >> 5, e = tid & 31; float sl = a.in[I_BR][e];
#pragma unroll
              for (int w = 0; w < 8; ++w) sl += red[(w * 16 + tk) * 32 + e];
              lg[tk * 32 + e] = sl; }
            __syncthreads();
            if (tid < 16) {
                const int tok = tok0 + tid;
                float best[4]; int bi[4];
#pragma unroll
                for (int k = 0; k < 4; ++k) { best[k] = -3.0e38f; bi[k] = 0; }
                for (int e = 0; e < 32; ++e) {
                    const float s = lg[tid * 32 + e];
                    if (s > best[3]) {
                        if (s > best[0]) { best[3] = best[2]; bi[3] = bi[2]; best[2] = best[1]; bi[2] = bi[1]; best[1] = best[0]; bi[1] = bi[0]; best[0] = s; bi[0] = e; }
                        else if (s > best[1]) { best[3] = best[2]; bi[3] = bi[2]; best[2] = best[1]; bi[2] = bi[1]; best[1] = s; bi[1] = e; }
                        else if (s > best[2]) { best[3] = best[2]; bi[3] = bi[2]; best[2] = s; bi[2] = e; }
                        else { best[3] = s; bi[3] = e; }
                    }
                }
                const float e1 = __expf(best[1] - best[0]), e2 = __expf(best[2] - best[0]), e3 = __expf(best[3] - best[0]);
                const float inv = 1.f / (1.f + e1 + e2 + e3);
                const float gk[4] = {inv, e1 * inv, e2 * inv, e3 * inv};
#pragma unroll
                for (int k = 0; k < 4; ++k) { const int slot = (it * 16 + tid) * 4 + k; const int rk = __hip_atomic_fetch_add(hist + bi[k], 1, __ATOMIC_RELAXED, __HIP_MEMORY_SCOPE_WORKGROUP);
                    pk_e[slot] = bi[k]; pk_r[slot] = rk; pk_p[slot] = tok * 4 + k; PG[tok * 4 + k] = gk[k]; }
            }
        }
        __syncthreads();
        if (tid < 32) base[tid] = (int)__hip_atomic_fetch_add(cnt + 64 * tid, (unsigned)hist[tid], __ATOMIC_RELAXED, __HIP_MEMORY_SCOPE_AGENT);
        __syncthreads();
        { const int e = pk_e[tid]; list[(size_t)e * 32768 + base[e] + pk_r[tid]] = (unsigned)pk_p[tid]; }
    }
}

__device__ __forceinline__ void phase_combine(const Args& a) {
    const int tid = tid_of(a.wv), lane = tid & 63, wave = tid >> 6;
    const int gw = blockIdx.x * 8 + wave, NGW = gridDim.x * 8;
    const float* mod = (const float*)(a.ws + WS_MOD);
    const unsigned char* Y = a.ws + WS_Y;
#if DIAG == 1
    const float dz = 0.1f;
#elif DIAG >= 2
    const float dz = sqrtf(__uint_as_float(__hip_atomic_load((unsigned*)(a.ws + WS_CTL) + CW_DIAG, __ATOMIC_RELAXED, __HIP_MEMORY_SCOPE_AGENT)));
#else
    const float dz = 0.f;
#endif
    for (int tok = gw; tok < T; tok += NGW) {
        const float* gate = mod + (tok >> 13) * 6144 + 5 * 1024;
        float* orow = a.out + (size_t)tok * DM;
#pragma unroll
        for (int j = 0; j < 4; ++j) { const int c = j * 256 + lane * 4;
            f32x4 s = (f32x4){0.f, 0.f, 0.f, 0.f};
#pragma unroll
            for (int k = 0; k < 4; ++k) { const int w = *(const GAS int*)(Y + ((size_t)tok * 4 + k) * DM + c);
                s[0] += __builtin_amdgcn_cvt_f32_fp8(w, 0); s[1] += __builtin_amdgcn_cvt_f32_fp8(w, 1); s[2] += __builtin_amdgcn_cvt_f32_fp8(w, 2); s[3] += __builtin_amdgcn_cvt_f32_fp8(w, 3); }
            s = s * pg8::YINV;
            const f32x4 xv = *(const GAS f32x4*)(orow + c), gv = *(const GAS f32x4*)(gate + c);
            *(GAS f32x4*)(orow + c) = xv + gv * s + dz; }
    }
}

constexpr int N_PHASES = 11;
constexpr int MOE_IT_ALL = 32 * (16 * 64 + 16 * 32), MOE_IT_P2 = 224 * 8 * 6;
__global__ void __launch_bounds__(512, 2) fwd_kernel(Args a0) {
    Args a;
    extern __shared__ __attribute__((aligned(16))) unsigned char lds_raw[];
    LAS unsigned char* lds = (LAS unsigned char*)lds_raw;
    volatile LAS unsigned* MISC = (volatile LAS unsigned*)(lds + LDS_MISC);
    const int wv0 = __builtin_amdgcn_readfirstlane((int)threadIdx.x >> 6);
    const int tid = threadIdx.x;
    if (tid < 64) MISC[tid] = 0u;
    __syncthreads();
    const int lo = sopaque(a0.ph_lo), hi = sopaque(a0.ph_hi);
#define use_bar ((hi - lo) > 1)
    XcdBarrier bar; bar.bar = (unsigned*)(a0.ws + WS_CTL) + CW_BAR; bar.x = 0; bar.st = MISC + 8;
    bar.wv = wv0;
    if (use_bar) bar = xcd_barrier_post((unsigned*)(a0.ws + WS_CTL) + CW_BAR, MISC + 8, wv0);
    const int G = sopaque((int)gridDim.x), bx = sopaque((int)blockIdx.x);
    const int vcu = (G % 8 == 0) ? (bx % 8) * (G / 8) + bx / 8 : bx;
#ifndef ONLY_PHASE
#define ONLY_PHASE -1
#endif
#ifndef PHASE_MASK
#define PHASE_MASK 0x7ff
#endif
#define IN(k) (lo <= (k) && (k) < hi && (ONLY_PHASE < 0 || ONLY_PHASE == (k)) && ((PHASE_MASK >> (k)) & 1))
#if DIAG >= 40
    unsigned long long tprev_ = __builtin_amdgcn_s_memrealtime();
#define TSTAMP(k) do { const unsigned long long tn_ = __builtin_amdgcn_s_memrealtime(); if (DIAG - 40 == (k) && blockIdx.x == 0 && tid == 0) MISC[40] = __float_as_uint(rintf((float)(tn_ - tprev_) * (1.f / 1000.f)) * 1e-5f); tprev_ = tn_; } while (0)
#else
#define TSTAMP(k) do { } while (0)
#endif
#define SEAM(k) do { if ((k) == 9) TSTAMP(k); if ((k) == 9 && DIAG >= 10 && blockIdx.x == 0 && tid == 0) __hip_atomic_store((unsigned*)(a0.ws + WS_CTL) + CW_DIAG, MISC[40], __ATOMIC_RELAXED, __HIP_MEMORY_SCOPE_AGENT); \
        if (use_bar && (k) + 1 < hi) xcd_barrier(bar); if ((k) != 9) TSTAMP(k); } while (0)
#ifndef REPEAT_MASK
#define REPEAT_MASK 0
#endif
#define REP(k) for (int rep_ = 0; rep_ <= ((REPEAT_MASK >> (k)) & 1); ++rep_)
    a = a0; a.wv = wv0;
    if (IN(0)) { phase_mod(a, lds); SEAM(0); }
    REP(1) if (IN(1)) { phase_prep(a, lds); SEAM(1); }
    {
        float* prm = (float*)(a0.ws + WS_PRM);
        a.ws = a0.ws; a.out = a0.out; a.in[I_X] = a0.in[I_X]; a.wv = wv0;
        a.in[I_GQL] = prm + PRM_GQL; a.in[I_GKVL] = prm + PRM_GKVL; a.in[I_GQH] = prm + PRM_GQH; a.in[I_GKH] = prm + PRM_GKH; a.in[I_DECAY] = prm + PRM_DECAY;
        a.in[I_GRET] = prm + PRM_GRET; a.in[I_BR] = prm + PRM_BR; a.in[I_GFFN] = prm + PRM_GFFN; a.in[I_B1] = prm + PRM_B1; a.in[I_B2] = prm + PRM_B2;
    }
    REP(2) if (IN(2)) {
        pg8::DenseOrder S; S.init(a.ws + WS_H, a.ws + WS_WIN, TA, DINP, 1024, G, bx);
        pg8::EpiP E{(bf16_t*)(a.ws + WS_P)};
        pg8::gemm_phase<pg8::EpiP, pg8::DenseOrder, false>(lds, nullptr, nullptr, 0, 1024, S, E, a.wv);
        if (G == 256 && bx >= 32) moe_convert(a, lds, (bx - 32) * 8, 224 * 8, MOE_IT_P2);
        SEAM(2);
    }
    REP(3) if (IN(3)) {
        if (G == 256) {
            int u0, nu;
            if (bx < 32) { u0 = 3 * bx; nu = 3; }
            else { const int c = bx - 32; u0 = 96 + 4 * c + (c < 64 ? c : 64); nu = 4 + (c < 64 ? 1 : 0); }
            for (int k2 = 0; k2 < (bx < 32 ? 2 : 1); ++k2) mla_tile(a, lds, k2 ? 256 + (bx >> 2) : bx, k2 ? 32 * (bx & 3) : 0, k2 ? 32 : 128);
            for (int u = u0; u < u0 + nu; ++u) ret_local_unit(a, lds, u);
        } else { for (int t = bx; t < TA / 128; t += G) mla_tile(a, lds, t); for (int u = bx; u < 16 * NSLOT; u += G) ret_local_unit(a, lds, u); }
        SEAM(3);
    }
    if (IN(4)) { phase_ret_scan(a); SEAM(4); }
    REP(5) if (IN(5)) {
        float negm;
        { float gq = 0.f, gk = 0.f; for (int i = 0; i < QK; ++i) { gq = fmaxf(gq, fabsf(a.in[I_GQH][i])); gk = fmaxf(gk, fabsf(a.in[I_GKH][i])); }
          negm = -(gq * gk * 96.f * QSCALE * 1.03f + 0.5f); negm = __uint_as_float(__builtin_amdgcn_readfirstlane(__float_as_uint(negm))); }
        const bool shift = negm < -64.f;
        __builtin_amdgcn_s_setreg((0 << 11) | (23 << 6) | 1, 1);
#ifndef REP5A
#define REP5A 0
#endif
#ifndef REP5B
#define REP5B 0
#endif
        if (G == 256) {
            const int xg = vcu >> 5, c = vcu & 31, cg = vcu & 3;
#pragma unroll 1
            for (int step = 0; step < 4; ++step) {
                if (step == cg) moe_convert(a, lds, MOE_IT_P2 + vcu * 8, 256 * 8, MOE_IT_ALL);
                if (step < 2) { const int bh = xg * 4 + 2 * step + (c >> 4), qb = c & 15; if (shift) att::unit64<true>(a, lds, bh, qb, negm); else att::unit64<false>(a, lds, bh, qb, negm); }
                else if (step == 2) { for (int u = bx; u < 16 * 64; u += G) ret_out_unit(a, lds, u); }
            }
        } else {
            for (int w = bx; w < 512; w += G) { if (shift) att::unit64<true>(a, lds, w >> 4, w & 15, negm); else att::unit64<false>(a, lds, w >> 4, w & 15, negm); }
            for (int u = bx; u < 16 * 64; u += G) ret_out_unit(a, lds, u);
        }
        SEAM(5);
    }
    REP(6) if (IN(6)) {
        pg8::DenseOrder S; S.init(a.ws + WS_MIX, a.ws + WS_WO, T, DM, 1024, G, bx);
        pg8::EpiOut E{a.in[I_X], (const float*)(a.ws + WS_MOD), a.out};
        pg8::gemm_phase<pg8::EpiOut, pg8::DenseOrder, false>(lds, nullptr, nullptr, 0, 1024, S, E, a.wv);
        SEAM(6);
    }
    if (IN(7)) { phase_router(a, lds); SEAM(7); }
    REP(8) if (IN(8)) {
        pg8::EpiM1 E{a.ws + WS_ACT};
        phase_moe_pg8<8>(a, lds, a.ws + WS_HF, 2, a.ws + WS_W1, (size_t)2048 * 1024, a.in[I_B1], 2048, nullptr, E);
        SEAM(8);
    }
    REP(9) if (IN(9)) {
        pg8::EpiM2 E{a.ws + WS_Y};
        phase_moe_pg8<4>(a, lds, a.ws + WS_ACT, 0, a.ws + WS_W2, (size_t)1024 * 1024, a.in[I_B2], 1024, (const float*)(a.ws + WS_PG), E);
        SEAM(9);
    }
    if (IN(10)) { phase_combine(a); }
#undef IN
#undef SEAM
#undef use_bar
}

extern "C" void kernel_launch(void* const* d_in, const int* in_sizes, int n_in, void* d_out, int out_size, void* d_ws, size_t ws_size, hipStream_t stream) {
    static int grid = 0;
    if (grid == 0) {
        if (n_in != 24 || out_size != T * DM || ws_size < WS_END) { fprintf(stderr, "kernel_launch: unexpected shapes (n_in %d out %d ws %zu)\n", n_in, out_size, ws_size); grid = -1; return; }
        int dev = 0, cus = 0, per_cu = 0;
        if (hipGetDevice(&dev) != hipSuccess || hipDeviceGetAttribute(&cus, hipDeviceAttributeMultiprocessorCount, dev) != hipSuccess) { grid = -1; return; }
        if (hipFuncSetAttribute((const void*)fwd_kernel, hipFuncAttributeMaxDynamicSharedMemorySize, LDS_BYTES) != hipSuccess) { fprintf(stderr, "kernel_launch: hipFuncSetAttribute failed\n"); grid = -1; return; }
        if (hipOccupancyMaxActiveBlocksPerMultiprocessor(&per_cu, (const void*)fwd_kernel, 512, LDS_BYTES) != hipSuccess || per_cu < 1) { fprintf(stderr, "kernel_launch: occupancy query says %d\n", per_cu); per_cu = 1; }
        (void)hipGetLastError();
        grid = cus;
    }
    if (grid < 0) return;
    (void)hipMemsetAsync((char*)d_ws + WS_CTL, 0, 128 * 1024, stream);
    Args a{};
    for (int i = 0; i < 24; ++i) a.in[i] = (const float*)d_in[i];
    a.out = (float*)d_out; a.ws = (unsigned char*)d_ws;
#if MK_N_LAUNCHES == 1
    a.ph_lo = 0; a.ph_hi = N_PHASES;
    void* params[] = {&a};
    hipError_t e = hipLaunchCooperativeKernel((const void*)fwd_kernel, dim3(grid), dim3(512), params, LDS_BYTES, stream);
    if (e != hipSuccess) fprintf(stderr, "kernel_launch: cooperative launch failed: %s (grid %d)\n", hipGetErrorString(e), grid);
#else
    for (int p = 0; p < N_PHASES; ++p) { a.ph_lo = p; a.ph_hi = p + 1; hipLaunchKernelGGL(fwd_kernel, dim3(grid), dim3(512), LDS_BYTES, stream, a); }
#endif
}
```

```cpp
#include <hip/hip_runtime.h>
#include <cstdio>
#include <cstdint>

#ifndef MK_N_LAUNCHES
#define MK_N_LAUNCHES 1
#endif

#define LAS __attribute__((address_space(3)))
#define GAS __attribute__((address_space(1)))
typedef unsigned short bf16_t;
typedef short bf16x8 __attribute__((ext_vector_type(8)));
typedef short s16x4 __attribute__((ext_vector_type(4)));
typedef float f32x4 __attribute__((ext_vector_type(4)));
typedef float f32x16 __attribute__((ext_vector_type(16)));
typedef unsigned u32x4 __attribute__((ext_vector_type(4)));
typedef unsigned u32x2 __attribute__((ext_vector_type(2)));

constexpr int DM = 1024, NB = 4, SEQ = 8192, LC = 256;
constexpr int T = NB * SEQ;
constexpr int TC = NB * LC;
constexpr int TA = T + TC;
constexpr int DIN = 1952, DINP = 2048;
constexpr int OFF_Q = 0, OFF_KV = 256, OFF_PE = 384, OFF_RQ = 416, OFF_RK = 672, OFF_RV = 928, OFF_RG = 1440;
constexpr int NH = 8, QK = 96, QK8 = 128, DV = 64, SKV = LC + SEQ;
constexpr int RH = 4, RDK = 64, RDV = 128, RC = 128, NSLOT = 66;
constexpr int NE = 32, DFF = 1024, NPAIR = T * 4;
constexpr float EPS = 1e-6f;
constexpr float QSCALE = 0.10206207261596577f * 1.4426950408889634f;

constexpr size_t MiB = 1ull << 20;
constexpr size_t WS_CTL = 0, CTL_BYTES = 1 * MiB;
constexpr size_t WS_MOD = 1 * MiB;
constexpr size_t WS_TABM = WS_MOD + 128 * 1024;
constexpr size_t WS_TABR = WS_TABM + 16 * 1024;
constexpr size_t WS_WIN = 2 * MiB;
constexpr size_t WS_WQ = 6 * MiB;
constexpr size_t WS_WKV = 6 * MiB + 512 * 1024;
constexpr size_t WS_WO = 7 * MiB;
constexpr size_t WS_WR = 9 * MiB;
constexpr size_t WS_W1 = 10 * MiB;
constexpr size_t WS_W2 = 138 * MiB;
constexpr size_t WS_HF = 202 * MiB;
constexpr size_t WS_PG = 266 * MiB;
constexpr size_t WS_LIST = 267 * MiB;
constexpr size_t WS_H = 272 * MiB;
constexpr size_t WS_P = 338 * MiB;
constexpr size_t WS_Q = 470 * MiB;
constexpr size_t WS_K = 518 * MiB;
constexpr size_t WS_VT = 568 * MiB;
constexpr size_t WS_LST = 601 * MiB;
constexpr size_t WS_MIX = 667 * MiB;
constexpr size_t WS_ACT = 272 * MiB;
constexpr size_t WS_Y = 528 * MiB;
constexpr size_t WS_END = 784 * MiB;
constexpr size_t WS_PRM = WS_MOD + 256 * 1024;
constexpr int PRM_GQL = 0, PRM_GKVL = 256, PRM_GQH = 384, PRM_GKH = 480, PRM_DECAY = 576, PRM_GRET = 584, PRM_BR = 1096, PRM_GFFN = 1128, PRM_B1 = 2152, PRM_B2 = 67688, PRM_END = 100456;
constexpr int CW_BAR = 4096;
constexpr int CW_CNT = 16384;
constexpr int CW_DIAG = 20480;
#ifndef DIAG
#define DIAG 0
#endif

constexpr int LDS_SCRATCH = 159744;
constexpr int LDS_MISC = LDS_SCRATCH;
constexpr int LDS_BYTES = LDS_SCRATCH + 256;

__device__ __forceinline__ float bf2f(bf16_t h) { return __uint_as_float((unsigned)h << 16); }
__device__ __forceinline__ unsigned f2bf(float f) { unsigned u = __float_as_uint(f); return (u + 0x7fffu + ((u >> 16) & 1u)) >> 16; }
__device__ __forceinline__ unsigned pk2(float lo, float hi) { return f2bf(lo) | (f2bf(hi) << 16); }
__device__ __forceinline__ float lo16(unsigned w) { return __uint_as_float(w << 16); }
__device__ __forceinline__ float hi16(unsigned w) { return __uint_as_float(w & 0xffff0000u); }
__device__ __forceinline__ float wave_sum(float v) {
#pragma unroll
    for (int o = 1; o < 64; o <<= 1) v += __shfl_xor(v, o);
    return v;
}
#define LDS_WAIT() asm volatile("s_waitcnt lgkmcnt(0)" ::: "memory")
__device__ __forceinline__ unsigned cvt4_fp8(float a, float b, float c, float d) { int p = 0; p = __builtin_amdgcn_cvt_pk_fp8_f32(a, b, p, false); p = __builtin_amdgcn_cvt_pk_fp8_f32(c, d, p, true); return (unsigned)p; }
constexpr float WQ_SCALE = 16.f, WKV_SCALE = 8.f, WKV_INV = 1.f / 8.f;
constexpr float WSCALE = 64.f, WINV = 1.f / 64.f;
__device__ __forceinline__ int opaque(int v) { asm volatile("" : "+v"(v)); return v; }
__device__ __forceinline__ int sopaque(int v) { asm volatile("" : "+s"(v)); return v; }
__device__ __forceinline__ int tid_of(int wv) { return sopaque(wv) * 64 + opaque((int)__builtin_amdgcn_mbcnt_hi(~0u, __builtin_amdgcn_mbcnt_lo(~0u, 0u))); }

#define XB_TMO      128
#define XB_XCNT(j)  (256  + 64 * (j))
#define XB_XSUB(j)  (1280 + 64 * (j))
#define XB_XGEN(j)  (2304 + 64 * (j))
#define XB_TOP      3328
#define XB_TOPGEN   3392
#define XCD_BAR_WORDS 3456
#define XB_SPIN_CAP (1u << 20)
__device__ __forceinline__ unsigned xb_ld(unsigned* p)              { return __hip_atomic_load(p, __ATOMIC_RELAXED, __HIP_MEMORY_SCOPE_AGENT); }
__device__ __forceinline__ unsigned xb_add(unsigned* p, unsigned v) { return __hip_atomic_fetch_add(p, v, __ATOMIC_RELAXED, __HIP_MEMORY_SCOPE_AGENT); }
__device__ __forceinline__ unsigned xb_xcc_id() { return (unsigned)__builtin_amdgcn_s_getreg((3 << 11) | 20) & 0xFu; }
#define XB_SPIN(cond, bar) do { unsigned _sp = 0; while (cond) { __builtin_amdgcn_s_sleep(1); \
    if ((++_sp & 255u) == 0u) { if (xb_ld(&(bar)[XB_TMO])) break; if (_sp > XB_SPIN_CAP) { atomicAdd(&(bar)[XB_TMO], 1u); break; } } } } while (0)
struct XcdBarrier { unsigned* bar; unsigned x; volatile LAS unsigned* st; int wv; };
__device__ __forceinline__ XcdBarrier xcd_barrier_post(unsigned* bar, volatile LAS unsigned* st, int wv) {
    XcdBarrier b; b.bar = bar; b.x = xb_xcc_id(); b.st = st; b.wv = wv;
    if (tid_of(wv) == 0) (void)xb_add(&bar[XB_XCNT(b.x)], 1u);
    return b;
}
__device__ __forceinline__ void xcd_barrier_complete(unsigned* bar, unsigned x, unsigned& nloc, unsigned& nx) {
    const unsigned G = gridDim.x * gridDim.y * gridDim.z;
    unsigned sum, cnt, mine, sp = 0u;
    for (;;) {
        sum = 0u; cnt = 0u; mine = 0u;
#pragma unroll 1
        for (unsigned j = 0; j < 16; ++j) { const unsigned c = xb_ld(&bar[XB_XCNT(j)]); sum += c; cnt += (c > 0u) ? 1u : 0u; mine = (j == x) ? c : mine; }
        if (sum == G) break;
        __builtin_amdgcn_s_sleep(1);
        if ((++sp & 255u) == 0u) { if (xb_ld(&bar[XB_TMO])) break; if (sp > XB_SPIN_CAP) { atomicAdd(&bar[XB_TMO], 1u); break; } }
    }
    nloc = mine > 0u ? mine : 1u; nx = cnt > 0u ? cnt : 1u;
}
__device__ __forceinline__ void xcd_barrier(const XcdBarrier& b) {
    asm volatile("s_waitcnt vmcnt(0)" ::: "memory");
    __syncthreads();
    if (tid_of(b.wv) == 0) {
        unsigned* bar = b.bar; asm volatile("" : "+s"(bar));
        __builtin_amdgcn_s_waitcnt(0);
        unsigned nloc = b.st[0], nx = b.st[1];
        if (nloc == 0u) { xcd_barrier_complete(bar, b.x, nloc, nx); b.st[0] = nloc; b.st[1] = nx; }
        const unsigned old = xb_add(&bar[XB_XSUB(b.x)], 1u);
        const unsigned gen = old / nloc;
        if (old + 1u == (gen + 1u) * nloc) {
            __builtin_amdgcn_fence(__ATOMIC_RELEASE, "agent");
            asm volatile("s_waitcnt vmcnt(0)" ::: "memory");
            const unsigned og = xb_add(&bar[XB_TOP], 1u);
            const unsigned tg = og / nx;
            if (og + 1u == (tg + 1u) * nx) xb_add(&bar[XB_TOPGEN], 1u);
            else XB_SPIN(xb_ld(&bar[XB_TOPGEN]) == tg, bar);
            __builtin_amdgcn_fence(__ATOMIC_ACQUIRE, "agent");
            xb_add(&bar[XB_XGEN(b.x)], 1u);
            asm volatile("s_waitcnt vmcnt(0)" ::: "memory");
        } else {
            XB_SPIN(xb_ld(&bar[XB_XGEN(b.x)]) == gen, bar);
            __builtin_amdgcn_fence(__ATOMIC_ACQUIRE, "agent");
            asm volatile("s_waitcnt vmcnt(0)" ::: "memory");
        }
    }
    __syncthreads();
}

struct Args { const float* in[24]; float* out; unsigned char* ws; int ph_lo, ph_hi; int wv, pad; };
#define CAS __attribute__((address_space(4)))
__device__ __forceinline__ Args load_args() { auto p = __builtin_amdgcn_kernarg_segment_ptr(); asm volatile("" : "+s"(p)); Args r; __builtin_memcpy(&r, p, sizeof(Args)); return r; }
enum { I_X = 0, I_C, I_CTX, I_CCTX, I_GATTN, I_GFFN, I_WADA, I_BADA, I_WIN, I_GQL, I_WQUP, I_GQH, I_GKVL, I_WKVUP, I_GKH, I_DECAY, I_GRET, I_WOUT,
       I_WR, I_BR, I_W1, I_B1, I_W2, I_B2 };

template <int MT, int NT, bool SWAP>
__device__ __forceinline__ void mma_ll(f32x4 (&acc)[MT][NT], const LAS bf16_t* sA, int lda, int m0, const LAS bf16_t* sB, int ldb, int n0, int K, int lane) {
    const int fr = lane & 15, fq = lane >> 4;
    for (int k = 0; k < K; k += 32) {
        bf16x8 a[MT], b[NT];
#pragma unroll
        for (int i = 0; i < MT; ++i) a[i] = *(const LAS bf16x8*)(sA + (m0 + 16 * i + fr) * lda + k + 8 * fq);
#pragma unroll
        for (int j = 0; j < NT; ++j) b[j] = *(const LAS bf16x8*)(sB + (n0 + 16 * j + fr) * ldb + k + 8 * fq);
#pragma unroll
        for (int i = 0; i < MT; ++i)
#pragma unroll
            for (int j = 0; j < NT; ++j)
                acc[i][j] = SWAP ? __builtin_amdgcn_mfma_f32_16x16x32_bf16(b[j], a[i], acc[i][j], 0, 0, 0) : __builtin_amdgcn_mfma_f32_16x16x32_bf16(a[i], b[j], acc[i][j], 0, 0, 0);
    }
}
template <int MT, int NT, bool SWAP>
__device__ __forceinline__ void mma_lg(f32x4 (&acc)[MT][NT], const LAS bf16_t* sA, int lda, int m0, const bf16_t* gB, int ldb, int n0, int K, int lane) {
    const int fr = lane & 15, fq = lane >> 4;
#pragma unroll 2
    for (int k = 0; k < K; k += 32) {
        bf16x8 a[MT], b[NT];
#pragma unroll
        for (int j = 0; j < NT; ++j) b[j] = *(const GAS bf16x8*)(gB + (size_t)(n0 + 16 * j + fr) * ldb + k + 8 * fq);
#pragma unroll
        for (int i = 0; i < MT; ++i) a[i] = *(const LAS bf16x8*)(sA + (m0 + 16 * i + fr) * lda + k + 8 * fq);
#pragma unroll
        for (int i = 0; i < MT; ++i)
#pragma unroll
            for (int j = 0; j < NT; ++j)
                acc[i][j] = SWAP ? __builtin_amdgcn_mfma_f32_16x16x32_bf16(b[j], a[i], acc[i][j], 0, 0, 0) : __builtin_amdgcn_mfma_f32_16x16x32_bf16(a[i], b[j], acc[i][j], 0, 0, 0);
    }
}

__device__ __forceinline__ void phase_mod(const Args& a, LAS unsigned char* lds) {
    const int tid = tid_of(a.wv), lane = tid & 63, wave = tid >> 6;
    LAS float* sv = (LAS float*)lds;
    LAS float* red = sv + 5 * 1024;
    float* mod = (float*)(a.ws + WS_MOD);
    for (int i = tid; i < 5 * 1024; i += 512) { const float v = (i < 4096) ? a.in[I_C][i] : a.in[I_CCTX][i - 4096]; sv[i] = v / (1.f + __expf(-v)); }
    __syncthreads();
    const float* W = a.in[I_WADA]; const float* bb = a.in[I_BADA];
    for (int u = blockIdx.x; u < 192; u += gridDim.x) {
        const int c32 = lane & 31, kh = lane >> 5, col = u * 32 + c32;
        float acc[5] = {0.f, 0.f, 0.f, 0.f, 0.f};
#pragma unroll 1
        for (int k0 = wave * 128; k0 < wave * 128 + 128; k0 += 64) {
            float w[32];
#pragma unroll
            for (int q = 0; q < 32; ++q) w[q] = W[(size_t)(k0 + 2 * q + kh) * 6144 + col];
#pragma unroll
            for (int q = 0; q < 32; ++q)
#pragma unroll
                for (int v = 0; v < 5; ++v) acc[v] += sv[v * 1024 + k0 + 2 * q + kh] * w[q];
        }
#pragma unroll
        for (int v = 0; v < 5; ++v) { acc[v] += __shfl_xor(acc[v], 32); if (kh == 0) red[(wave * 5 + v) * 32 + c32] = acc[v]; }
        __syncthreads();
        if (tid < 160) { const int v = tid >> 5, c = tid & 31; float s = bb[u * 32 + c];
#pragma unroll
            for (int w = 0; w < 8; ++w) s += red[(w * 5 + v) * 32 + c];
            mod[v * 6144 + u * 32 + c] = s; }
        __syncthreads();
    }
    const int gt = blockIdx.x * 512 + tid;
    if (gt < 192 * 8) { const int pi = gt >> 3, f = gt & 7; const float pos = (float)(pi < 128 ? pi : pi - 128);
        const float inv = exp2f(-(float)f * (13.287712379549449f / 8.f)); const float rev = pos * inv * 0.15915494309189535f;
        float* tm = (float*)(a.ws + WS_TABM); tm[gt * 2] = __builtin_amdgcn_cosf(rev); tm[gt * 2 + 1] = __builtin_amdgcn_sinf(rev); }
    else if (gt < 192 * 8 + 192 * 16) { const int g2 = gt - 192 * 8; const int pi = g2 >> 4, f = g2 & 15; const float pos = (float)(pi < 128 ? pi : pi - 128);
        const float inv = exp2f(-(float)f * (13.287712379549449f / 16.f)); const float rev = pos * inv * 0.15915494309189535f;
        float* tr = (float*)(a.ws + WS_TABR); tr[g2 * 2] = __builtin_amdgcn_cosf(rev); tr[g2 * 2 + 1] = __builtin_amdgcn_sinf(rev); }
}

__device__ __forceinline__ void transpose_item(const float* W, int K, int N, bf16_t* WT, LAS float* scr, int item, int lane) {
    const int nblk = N / 32, kb = item / nblk, nb = item % nblk, k0 = 64 * kb, n0 = 32 * nb;
    float wv_[32];
#pragma unroll
    for (int i = 0; i < 32; ++i) { const int kk = 2 * i + (lane >> 5); wv_[i] = W[(size_t)(k0 + kk) * N + n0 + (lane & 31)]; }
#pragma unroll
    for (int i = 0; i < 32; ++i) { const int kk = 2 * i + (lane >> 5); scr[kk * 33 + (lane & 31)] = wv_[i]; }
    LDS_WAIT();
    const int c = lane & 7;
#pragma unroll
    for (int j = 0; j < 4; ++j) { const int n = (lane >> 3) + 8 * j; const LAS float* s = scr + (8 * c) * 33 + n;
        u32x4 o; o.x = pk2(s[0 * 33], s[1 * 33]); o.y = pk2(s[2 * 33], s[3 * 33]); o.z = pk2(s[4 * 33], s[5 * 33]); o.w = pk2(s[6 * 33], s[7 * 33]);
        *(GAS u32x4*)(WT + (size_t)(n0 + n) * K + k0 + 8 * c) = o; }
    LDS_WAIT();
}
__device__ __forceinline__ void transpose_item8(const float* W, int K, int N, unsigned char* WT, float sc, LAS float* scr, int item, int lane) {
    const int nblk = N / 32, kb = item / nblk, nb = item % nblk, k0 = 64 * kb, n0 = 32 * nb;
    float wv_[32];
#pragma unroll
    for (int i = 0; i < 32; ++i) { const int kk = 2 * i + (lane >> 5); wv_[i] = W[(size_t)(k0 + kk) * N + n0 + (lane & 31)]; }
#pragma unroll
    for (int i = 0; i < 32; ++i) { const int kk = 2 * i + (lane >> 5); scr[kk * 33 + (lane & 31)] = wv_[i]; }
    LDS_WAIT();
    const int c = lane & 7;
#pragma unroll
    for (int j = 0; j < 4; ++j) { const int n = (lane >> 3) + 8 * j; const LAS float* s = scr + (8 * c) * 33 + n;
        u32x2 o; o.x = cvt4_fp8(s[0 * 33] * sc, s[1 * 33] * sc, s[2 * 33] * sc, s[3 * 33] * sc); o.y = cvt4_fp8(s[4 * 33] * sc, s[5 * 33] * sc, s[6 * 33] * sc, s[7 * 33] * sc);
        *(GAS u32x2*)(WT + (size_t)(n0 + n) * K + k0 + 8 * c) = o; }
    LDS_WAIT();
}
__device__ __forceinline__ void phase_prep(const Args& a, LAS unsigned char* lds) {
    const int tid = tid_of(a.wv), lane = tid & 63, wave = tid >> 6;
    LAS float* scr = (LAS float*)(lds + wave * 16384);
    const int gw = blockIdx.x * 8 + wave, NGW = gridDim.x * 8;
    constexpr int I_IN = 16 * 61, I_QU = 4 * 24, I_KVU = 2 * 32, I_O = 16 * 32, I_1 = 16 * 64, I_2 = 16 * 32;
    constexpr int NITEMS = I_IN + I_QU + I_KVU + I_O + 32 * I_1 + 32 * I_2;
    const int nitems = gridDim.x == 256 ? I_IN + I_QU + I_KVU + I_O : NITEMS;
    for (int it = gw; it < nitems; it += NGW) {
        int r = it;
        if (r < I_IN) { transpose_item(a.in[I_WIN], 1024, DIN, (bf16_t*)(a.ws + WS_WIN), scr, r, lane); continue; } r -= I_IN;
        if (r < I_QU) { transpose_item8(a.in[I_WQUP], 256, 768, a.ws + WS_WQ, WQ_SCALE, scr, r, lane); continue; } r -= I_QU;
        if (r < I_KVU) { transpose_item8(a.in[I_WKVUP], 128, 1024, a.ws + WS_WKV, WKV_SCALE, scr, r, lane); continue; } r -= I_KVU;
        if (r < I_O) { transpose_item(a.in[I_WOUT], 1024, 1024, (bf16_t*)(a.ws + WS_WO), scr, r, lane); continue; } r -= I_O;
        if (r < 32 * I_1) { const int e = r / I_1; transpose_item8(a.in[I_W1] + (size_t)e * 1024 * 2048, 1024, 2048, a.ws + WS_W1 + (size_t)e * 2048 * 1024, WSCALE, scr, r % I_1, lane); continue; } r -= 32 * I_1;
        { const int e = r / I_2; transpose_item8(a.in[I_W2] + (size_t)e * 1024 * 1024, 1024, 1024, a.ws + WS_W2 + (size_t)e * 1024 * 1024, WSCALE, scr, r % I_2, lane); }
    }
    const int gt = blockIdx.x * 512 + tid, NGT = gridDim.x * 512;
    for (int i = gt; i < 96 * 1024 / 8; i += NGT) *(GAS u32x4*)((bf16_t*)(a.ws + WS_WIN) + (size_t)DIN * 1024 + (size_t)i * 8) = (u32x4){0u, 0u, 0u, 0u};
    for (int i = gt; i < 32 * 1024; i += NGT) { const int n = i >> 10, k = i & 1023; const float w = a.in[I_WR][k * 32 + n]; const unsigned h = f2bf(w);
        bf16_t* wr = (bf16_t*)(a.ws + WS_WR); wr[i] = (bf16_t)h; wr[32768 + i] = (bf16_t)f2bf(w - bf2f((bf16_t)h)); }
    {
        float* prm = (float*)(a.ws + WS_PRM);
        for (int i = gt; i < PRM_END; i += NGT) {
            float v;
            if (i < PRM_GKVL) v = a.in[I_GQL][i - PRM_GQL]; else if (i < PRM_GQH) v = a.in[I_GKVL][i - PRM_GKVL]; else if (i < PRM_GKH) v = a.in[I_GQH][i - PRM_GQH];
            else if (i < PRM_DECAY) v = a.in[I_GKH][i - PRM_GKH]; else if (i < PRM_GRET) v = a.in[I_DECAY][i - PRM_DECAY]; else if (i < PRM_BR) v = a.in[I_GRET][i - PRM_GRET];
            else if (i < PRM_GFFN) v = a.in[I_BR][i - PRM_BR]; else if (i < PRM_B1) v = a.in[I_GFFN][i - PRM_GFFN]; else if (i < PRM_B2) v = a.in[I_B1][i - PRM_B1]; else v = a.in[I_B2][i - PRM_B2];
            prm[i] = v;
        }
    }
    const float* mod = (const float*)(a.ws + WS_MOD); const float* g = a.in[I_GATTN];
    for (int m = gw; m < TA; m += NGW) {
        const float* xr; int mv;
        if (m < T) { xr = a.in[I_X] + (size_t)m * DM; mv = m >> 13; } else { xr = a.in[I_CTX] + (size_t)(m - T) * DM; mv = 4; }
        const float* sh = mod + mv * 6144; const float* sc = sh + 1024;
        f32x4 v[4]; float ss = 0.f;
#pragma unroll
        for (int j = 0; j < 4; ++j) { v[j] = *(const GAS f32x4*)(xr + j * 256 + lane * 4); ss += (v[j].x * v[j].x + v[j].y * v[j].y) + (v[j].z * v[j].z + v[j].w * v[j].w); }
        const float rstd = rsqrtf(wave_sum(ss) * (1.f / DM) + EPS);
        bf16_t* hr = (bf16_t*)(a.ws + WS_H) + (size_t)m * DM;
#pragma unroll
        for (int j = 0; j < 4; ++j) { const int c = j * 256 + lane * 4; const f32x4 gg = *(const GAS f32x4*)(g + c), s1 = *(const GAS f32x4*)(sc + c), s0 = *(const GAS f32x4*)(sh + c);
            const f32x4 o = (v[j] * rstd * gg) * (s1 + 1.f) + s0; u32x2 w; w.x = pk2(o.x, o.y); w.y = pk2(o.z, o.w); *(GAS u32x2*)(hr + c) = w; }
    }
}

#define MOE_ITEM(it_, P_, D_, N_) do { constexpr int I_1 = 16 * 64, I_2 = 16 * 32; \
    const bool up_ = (it_) < 32 * I_1; const int r_ = up_ ? (it_) : (it_) - 32 * I_1; N_ = up_ ? 2048 : 1024; const int per_ = up_ ? I_1 : I_2, e_ = r_ / per_, item_ = r_ % per_; \
    const int nblk_ = N_ / 32, kb_ = item_ / nblk_, nb_ = item_ % nblk_, k0_ = 64 * kb_, n0_ = 32 * nb_; \
    P_ = (up_ ? a.in[I_W1] : a.in[I_W2]) + (size_t)e_ * 1024 * N_ + (size_t)(k0_ + (lane >> 5)) * N_ + n0_ + (lane & 31); \
    D_ = a.ws + (up_ ? WS_W1 : WS_W2) + (size_t)e_ * N_ * 1024 + (size_t)n0_ * 1024 + k0_; } while (0)
__device__ __forceinline__ void moe_convert(const Args& a, LAS unsigned char* lds, int it0, int itstep, int itend) {
    const int tid = tid_of(a.wv), lane = tid & 63, wave = tid >> 6;
    LAS float* scr = (LAS float*)(lds + wave * 16384);
    const int NIT = itend;
    __syncthreads();
    float wc[32], wn[32];
    int it = it0 + wave;
    if (it >= NIT) { __syncthreads(); return; }
    const float* pc; unsigned char* dc; int nc;
    MOE_ITEM(it, pc, dc, nc);
#pragma unroll
    for (int i = 0; i < 32; ++i) wc[i] = pc[(size_t)(2 * i) * nc];
#pragma unroll 1
    while (it < NIT) {
        const int itn = it + itstep; const bool more = itn < NIT;
        const float* pn; unsigned char* dn; int nn; const int itx = more ? itn : it;
        MOE_ITEM(itx, pn, dn, nn);
        if (more) {
#pragma unroll
            for (int i = 0; i < 32; ++i) wn[i] = pn[(size_t)(2 * i) * nn]; }
#pragma unroll
        for (int i = 0; i < 32; ++i) { const int kk = 2 * i + (lane >> 5); scr[kk * 33 + (lane & 31)] = wc[i]; }
        LDS_WAIT();
        const int c = lane & 7;
#pragma unroll
        for (int j = 0; j < 4; ++j) { const int n = (lane >> 3) + 8 * j; const LAS float* s_ = scr + (8 * c) * 33 + n;
            u32x2 o; o.x = cvt4_fp8(s_[0 * 33] * WSCALE, s_[1 * 33] * WSCALE, s_[2 * 33] * WSCALE, s_[3 * 33] * WSCALE); o.y = cvt4_fp8(s_[4 * 33] * WSCALE, s_[5 * 33] * WSCALE, s_[6 * 33] * WSCALE, s_[7 * 33] * WSCALE);
            *(GAS u32x2*)(dc + (size_t)n * 1024 + 8 * c) = o; }
        LDS_WAIT();
#pragma unroll
        for (int i = 0; i < 32; ++i) wc[i] = wn[i];
        dc = dn; it = itn;
    }
    __syncthreads();
}
#undef MOE_ITEM

struct GUnit { const bf16_t* Bt; int m0, n0, nvalid, e; };
template <class RowFn, class Epi>
__device__ __forceinline__ void gemm_tile(LAS unsigned char* lds, const bf16_t* A, int K, const GUnit& u, const RowFn& rowfn, const Epi& epi) {
    LAS bf16_t* sA = (LAS bf16_t*)lds;
    LAS bf16_t* sB = (LAS bf16_t*)(lds + 256 * 72 * 2);
    const int tid = opaque((int)threadIdx.x), lane = tid & 63, wave = tid >> 6, wm = wave >> 1, wn = wave & 1;
    const int ch = tid & 7, r0 = tid >> 3;
    const bf16_t* ap[4]; const bf16_t* bp[2];
#pragma unroll
    for (int i = 0; i < 4; ++i) { const int r = r0 + 64 * i; const int rr = r < u.nvalid ? r : 0; ap[i] = A + (size_t)rowfn(u, rr) * K + ch * 8; }
#pragma unroll
    for (int i = 0; i < 2; ++i) bp[i] = u.Bt + (size_t)(r0 + 64 * i) * K + ch * 8;
    f32x4 acc[4][4];
#pragma unroll
    for (int i = 0; i < 4; ++i)
#pragma unroll
        for (int j = 0; j < 4; ++j) acc[i][j] = (f32x4){0.f, 0.f, 0.f, 0.f};
    u32x4 ra[4], rb[2];
#pragma unroll
    for (int i = 0; i < 4; ++i) ra[i] = *(const GAS u32x4*)(ap[i]);
#pragma unroll
    for (int i = 0; i < 2; ++i) rb[i] = *(const GAS u32x4*)(bp[i]);
    const int nk = K / 64;
    for (int kt = 0; kt < nk; ++kt) {
        __syncthreads();
#pragma unroll
        for (int i = 0; i < 4; ++i) *(LAS u32x4*)(sA + (r0 + 64 * i) * 72 + ch * 8) = ra[i];
#pragma unroll
        for (int i = 0; i < 2; ++i) *(LAS u32x4*)(sB + (r0 + 64 * i) * 72 + ch * 8) = rb[i];
        __syncthreads();
        if (kt + 1 < nk) {
#pragma unroll
            for (int i = 0; i < 4; ++i) ra[i] = *(const GAS u32x4*)(ap[i] + (kt + 1) * 64);
#pragma unroll
            for (int i = 0; i < 2; ++i) rb[i] = *(const GAS u32x4*)(bp[i] + (kt + 1) * 64);
        }
        mma_ll<4, 4, true>(acc, sA, 72, wm * 64, sB, 72, wn * 64, 64, lane);
    }
    epi(acc, u, wm, wn, lane);
}
struct RowDense { __device__ __forceinline__ int operator()(const GUnit& u, int r) const { return u.m0 + r; } };
struct RowPairTok { const unsigned* list; __device__ __forceinline__ int operator()(const GUnit& u, int r) const { return (int)(list[(size_t)u.e * 32768 + u.m0 + r] >> 2); } };
struct RowPair { const unsigned* list; __device__ __forceinline__ int operator()(const GUnit& u, int r) const { return (int)list[(size_t)u.e * 32768 + u.m0 + r]; } };

struct EpiP { bf16_t* P;
    __device__ __forceinline__ void operator()(const f32x4 (&acc)[4][4], const GUnit& u, int wm, int wn, int lane) const {
        const int fr = lane & 15, fq = lane >> 4;
#pragma unroll
        for (int i = 0; i < 4; ++i) { const int row = u.m0 + wm * 64 + 16 * i + fr;
#pragma unroll
            for (int j = 0; j < 4; ++j) { const int col = u.n0 + wn * 64 + 16 * j + 4 * fq; u32x2 w; w.x = pk2(acc[i][j][0], acc[i][j][1]); w.y = pk2(acc[i][j][2], acc[i][j][3]);
                *(GAS u32x2*)(P + (size_t)row * DINP + col) = w; } }
    } };
struct EpiOut { const float* x; const float* mod; float* out;
    __device__ __forceinline__ void operator()(const f32x4 (&acc)[4][4], const GUnit& u, int wm, int wn, int lane) const {
        const int fr = lane & 15, fq = lane >> 4;
#pragma unroll
        for (int i = 0; i < 4; ++i) { const int row = u.m0 + wm * 64 + 16 * i + fr; const float* gate = mod + (row >> 13) * 6144 + 2 * 1024;
#pragma unroll
            for (int j = 0; j < 4; ++j) { const int col = u.n0 + wn * 64 + 16 * j + 4 * fq;
                const f32x4 xv = *(const GAS f32x4*)(x + (size_t)row * DM + col), gv = *(const GAS f32x4*)(gate + col);
                *(GAS f32x4*)(out + (size_t)row * DM + col) = xv + gv * acc[i][j]; } }
    } };
struct EpiM1 { const unsigned* list; const float* b1; bf16_t* act;
    __device__ __forceinline__ void operator()(const f32x4 (&acc)[4][4], const GUnit& u, int wm, int wn, int lane) const {
        const int fr = lane & 15, fq = lane >> 4;
#pragma unroll
        for (int i = 0; i < 4; ++i) { const int r = wm * 64 + 16 * i + fr; if (r >= u.nvalid) continue;
            const unsigned pair = list[(size_t)u.e * 32768 + u.m0 + r];
#pragma unroll
            for (int j = 0; j < 4; ++j) { const int col = u.n0 + wn * 64 + 16 * j + 4 * fq; const f32x4 bv = *(const GAS f32x4*)(b1 + (size_t)u.e * 2048 + col);
                const f32x4 v = acc[i][j] + bv;
                const float g0 = fminf(v[0], 7.f), l0 = fminf(fmaxf(v[1], -7.f), 7.f), g1 = fminf(v[2], 7.f), l1 = fminf(fmaxf(v[3], -7.f), 7.f);
                const float a0 = g0 / (1.f + __expf(-1.702f * g0)) * (l0 + 1.f), a1 = g1 / (1.f + __expf(-1.702f * g1)) * (l1 + 1.f);
                *(GAS unsigned*)(act + (size_t)pair * DFF + (col >> 1)) = pk2(a0, a1); } }
    } };
struct EpiM2 { const unsigned* list; const float* b2; const float* pg; bf16_t* y;
    __device__ __forceinline__ void operator()(const f32x4 (&acc)[4][4], const GUnit& u, int wm, int wn, int lane) const {
        const int fr = lane & 15, fq = lane >> 4;
#pragma unroll
        for (int i = 0; i < 4; ++i) { const int r = wm * 64 + 16 * i + fr; if (r >= u.nvalid) continue;
            const unsigned pair = list[(size_t)u.e * 32768 + u.m0 + r]; const float g = pg[pair];
#pragma unroll
            for (int j = 0; j < 4; ++j) { const int col = u.n0 + wn * 64 + 16 * j + 4 * fq; const f32x4 bv = *(const GAS f32x4*)(b2 + (size_t)u.e * 1024 + col);
                const f32x4 v = (acc[i][j] + bv) * g; u32x2 w; w.x = pk2(v[0], v[1]); w.y = pk2(v[2], v[3]);
                *(GAS u32x2*)(y + (size_t)pair * DM + col) = w; } }
    } };

namespace pg8 {
constexpr int BM = 256, BK = 64, HALF = 128, HTB = HALF * BK * 2, STAGE_BYTES = 8 * HTB, NXCD = 8, WGM = 8;
__host__ __device__ __forceinline__ int lds_byte(int r, int c) { const int st = (r >> 4) * 2 + (c >> 5), rr = r & 15, cc = c & 31, ob = rr * 64 + cc * 2; return st * 1024 + (ob ^ (((ob >> 9) & 1) << 5)); }
__host__ __device__ __forceinline__ void stage_rc(int b, int& R, int& C) { const int st = b / 1024, sb = b % 1024, swz = sb ^ (((sb >> 9) & 1) << 5); R = (st >> 1) * 16 + swz / 64; C = (st & 1) * 32 + (swz % 64) / 2; }
__host__ __device__ __forceinline__ int perm32(int rho) { const int n = rho >> 4, i = rho & 15; return 8 * (i >> 2) + 4 * n + (i & 3); }
struct Unit { int pm, pn; const char* A; const char* B; int e, nvalid, ul, rb; };
struct DenseOrder {
    int nM, nN, nwg, G, c; const char* A; const char* B; size_t tstep;
    __device__ void init(const void* A_, const void* B_, int M, int N, int K, int G_, int c_) { nM = M / BM; nN = N / BM; nwg = nM * nN; G = G_; c = c_; A = (const char*)A_; B = (const char*)B_; tstep = (size_t)BM * K * 2; }
    __device__ bool next(int i, Unit& u) const {
        const long L = (long)i * G + c; if (L >= nwg) return false;
        int wgid = (int)L; { const int q = nwg / NXCD, r = nwg % NXCD, xcd = wgid % NXCD, off = wgid / NXCD; wgid = (xcd < r ? xcd * (q + 1) : r * (q + 1) + (xcd - r) * q) + off; }
        const int nig = WGM * nN, gid = wgid / nig, fm = gid * WGM, gsz = (nM - fm) < WGM ? (nM - fm) : WGM;
        u.pm = fm + ((wgid % nig) % gsz); u.pn = (wgid % nig) / gsz; u.A = A + (size_t)u.pm * tstep; u.B = B + (size_t)u.pn * tstep; u.e = 0; u.nvalid = 256; u.ul = 0; u.rb = 0; return true;
    }
};
template <int NCT> struct ExpertOrder {
    const LAS int* pre; int G, c; const char* A; const char* W; size_t wstride; int rowbytes;
    __device__ bool next(int i, Unit& u) const {
        const int L = i * G + c; const int nunit = pre[32] * NCT; if (L >= nunit) return false;
        const int ti = L / NCT; u.pn = L % NCT; int e = 0;
        for (int k = 1; k < 32; ++k) if (pre[k] <= ti) e = k;
        u.pm = ti - pre[e]; u.e = e; const int cnt = pre[33 + e]; u.nvalid = (cnt - u.pm * 256) < 256 ? (cnt - u.pm * 256) : 256; u.ul = i;
        u.A = A; u.B = W + (size_t)e * wstride + (size_t)u.pn * 256 * rowbytes; u.rb = ti * 256; return true;
    }
};
__device__ __forceinline__ unsigned cvt_pk_bf16(float lo, float hi) { unsigned r; asm volatile("v_cvt_pk_bf16_f32 %0, %1, %2" : "=v"(r) : "v"(lo), "v"(hi)); return r; }
typedef int i32x4 __attribute__((ext_vector_type(4))); typedef int i32x8 __attribute__((ext_vector_type(8)));
__device__ __forceinline__ bf16x8 lo8(i32x8 v) { return __builtin_bit_cast(bf16x8, (i32x4)__builtin_shufflevector(v, v, 0, 1, 2, 3)); }
__device__ __forceinline__ bf16x8 hi8(i32x8 v) { return __builtin_bit_cast(bf16x8, (i32x4)__builtin_shufflevector(v, v, 4, 5, 6, 7)); }

template <class Epi, class Sched, bool GATHER, bool FP8 = false, bool SORTEDA = false>
__device__ __forceinline__ void gemm_phase(LAS unsigned char* lds, const LAS int* tab, const LAS bf16_t* aux, int ashift, int K, const Sched& S, const Epi& E, int wv) {
    const int tid = tid_of(wv), wid = wv, lane = tid & 63, wr = wid >> 2, wc = wid & 3, fr = lane & 15, fq = lane >> 4;
    const int nt = K / BK;
    unsigned voffA[2], voffB[2]; unsigned cb0 = 0; int rg0 = 0;
#pragma unroll
    for (int i = 0; i < 2; ++i) { int R, C; stage_rc(tid * 16 + i * 8192, R, C); const int Rb = (R & ~31) + perm32(R & 31);
        voffA[i] = (unsigned)(R * K + C) * 2u; voffB[i] = (unsigned)(Rb * K + C) * 2u; if (i == 0) { cb0 = (unsigned)C * 2u; rg0 = R; } }
    const size_t kstep = (size_t)(BK * 2);
    const size_t hstep = (size_t)HALF * K * 2;
    const size_t hstepA = GATHER ? 0 : hstep;
    const unsigned ldsw = (unsigned)wid * 1024u;
    const int aoff = lds_byte(wr * 64 + fr, fq * 8), boff = lds_byte(wc * 32 + fr, fq * 8);
    int cul = 0, nul = 0, crb = 0, nrb = 0;
#define PG8_SA(b, h) (((b) * 2 + (h)) * HTB)
#define PG8_SB(b, h) ((4 + (b) * 2 + (h)) * HTB)
#define PG8_STAGE(bufoff, gbase, voff) do { _Pragma("unroll") for (int _i = 0; _i < 2; ++_i) \
        __builtin_amdgcn_global_load_lds((const unsigned*)((const char*)(gbase) + (voff)[_i]), (LAS unsigned*)(lds + (bufoff) + ldsw + _i * 8192), 16, 0, 0); } while (0)
#define PG8_STAGE_A(bufoff, gbase, h, usenext) do { const int ulx_ = (usenext) ? nul : cul; _Pragma("unroll") for (int _i = 0; _i < 2; ++_i) { \
        unsigned vo_; if constexpr (SORTEDA) vo_ = (unsigned)(((usenext) ? nrb : crb) + (h) * 128 + rg0 + 64 * _i) * (unsigned)(K * 2) + cb0; \
        else if constexpr (GATHER) vo_ = (unsigned)(tab[ulx_ * 256 + (h) * 128 + rg0 + 64 * _i] >> ashift) * (unsigned)(K * 2) + cb0; else vo_ = voffA[_i]; \
        __builtin_amdgcn_global_load_lds((const unsigned*)((const char*)(gbase) + (h) * hstepA + vo_), (LAS unsigned*)(lds + (bufoff) + ldsw + _i * 8192), 16, 0, 0); } } while (0)
#define PG8_LDA(dst, b, h) do { _Pragma("unroll") for (int m = 0; m < 4; ++m) { const i32x4 lo_ = *(const LAS i32x4*)(lds + PG8_SA(b, h) + aoff + m * 2048), hi_ = *(const LAS i32x4*)(lds + PG8_SA(b, h) + aoff + m * 2048 + 1024); \
        dst[m] = __builtin_shufflevector(lo_, hi_, 0, 1, 2, 3, 4, 5, 6, 7); } } while (0)
#define PG8_LDB(dst, b, h) do { _Pragma("unroll") for (int n = 0; n < 2; ++n) { const i32x4 lo_ = *(const LAS i32x4*)(lds + PG8_SB(b, h) + boff + n * 2048), hi_ = *(const LAS i32x4*)(lds + PG8_SB(b, h) + boff + n * 2048 + 1024); \
        dst[n] = __builtin_shufflevector(lo_, hi_, 0, 1, 2, 3, 4, 5, 6, 7); } } while (0)
#define PG8_MMA(ai, bj, At, Bt) do { __builtin_amdgcn_s_setprio(1); _Pragma("unroll") for (int m = 0; m < 4; ++m) _Pragma("unroll") for (int n = 0; n < 2; ++n) { \
        if constexpr (FP8) { asm("v_mfma_f32_16x16x128_f8f6f4 %0, %1, %2, %0" : "+v"(acc[ai][bj][m][n]) : "v"(Bt[n]), "v"(At[m])); } \
        else { acc[ai][bj][m][n] = __builtin_amdgcn_mfma_f32_16x16x32_bf16(lo8(Bt[n]), lo8(At[m]), acc[ai][bj][m][n], 0, 0, 0); \
               acc[ai][bj][m][n] = __builtin_amdgcn_mfma_f32_16x16x32_bf16(hi8(Bt[n]), hi8(At[m]), acc[ai][bj][m][n], 0, 0, 0); } } \
        __builtin_amdgcn_s_setprio(0); } while (0)
#define PG8_WAIT_V(n) asm volatile("s_waitcnt vmcnt(" #n ")" ::: "memory")
#define PG8_WAIT_L(n) asm volatile("s_waitcnt lgkmcnt(" #n ")" ::: "memory")
#define PG8_BAR __builtin_amdgcn_s_barrier()
#define PG8_SCHED __builtin_amdgcn_sched_barrier(0)
    Unit cur, nxt; int ui = 0;
    if (!S.next(0, cur)) return;
    cul = cur.ul; nul = cur.ul; crb = cur.rb; nrb = cur.rb;
    f32x4 acc[2][2][4][2];
#pragma unroll
    for (int a = 0; a < 2; ++a)
#pragma unroll
        for (int b = 0; b < 2; ++b)
#pragma unroll
            for (int m = 0; m < 4; ++m)
#pragma unroll
                for (int n = 0; n < 2; ++n) acc[a][b][m][n] = (f32x4){0.f, 0.f, 0.f, 0.f};
    i32x8 At[4], B0[2], B1[2];
    const char* cA = cur.A; const char* cB = cur.B;
    PG8_STAGE(PG8_SB(0, 0), cB, voffB); PG8_STAGE(PG8_SB(0, 1), cB + hstep, voffB); PG8_STAGE_A(PG8_SA(0, 0), cA, 0, false); PG8_STAGE_A(PG8_SA(0, 1), cA, 1, false);
    if (wr == 1) PG8_BAR;
    PG8_WAIT_V(2); PG8_BAR;
    PG8_STAGE(PG8_SB(1, 0), cB + kstep, voffB); PG8_STAGE_A(PG8_SA(1, 0), cA + kstep, 0, false); PG8_STAGE(PG8_SB(1, 1), cB + hstep + kstep, voffB);
    PG8_WAIT_V(6); PG8_BAR;
    for (;;) {
        const bool has_next = S.next(ui + 1, nxt);
        const char* nA = has_next ? nxt.A : cA; const char* nB = has_next ? nxt.B : cB;
        nul = has_next ? nxt.ul : cur.ul; nrb = has_next ? nxt.rb : cur.rb;
#if DIAG >= 10
        long long tk0_ = 0; if (DIAG == 10 + Epi::ID && ui == 0) tk0_ = (long long)__builtin_amdgcn_s_memtime();
        if (DIAG == 20 + Epi::ID && ui <= 1) { const long long tn_ = (long long)__builtin_amdgcn_s_memtime();
            if (ui == 0) { if (blockIdx.x == 0 && tid == 0) { ((volatile LAS unsigned*)(lds + 159744))[41] = (unsigned)tn_; } }
            else if (blockIdx.x == 0 && tid == 0) { const unsigned d_ = (unsigned)tn_ - ((volatile LAS unsigned*)(lds + 159744))[41]; const float q = rintf((float)d_ * (1.f / 1000.f));
                ((volatile LAS unsigned*)(lds + 159744))[40] = __float_as_uint(q * 1e-5f); } }
#endif
#pragma unroll 1
        for (int t = 0; t < nt; t += 2) {
            const bool last = (t == nt - 2);
            const char* a1 = cA + (size_t)(t + 1) * kstep;
            const char* a2 = last ? nA : cA + (size_t)(t + 2) * kstep; const char* b2 = last ? nB : cB + (size_t)(t + 2) * kstep;
            const char* a3 = a2 + kstep; const char* b3 = b2 + kstep;
            PG8_LDB(B0, 0, 0); PG8_LDB(B1, 0, 1); PG8_SCHED; PG8_LDA(At, 0, 0); PG8_STAGE_A(PG8_SA(1, 1), a1, 1, false);
            PG8_WAIT_V(8); PG8_WAIT_L(0); PG8_BAR; PG8_MMA(0, 0, At, B0); PG8_MMA(0, 1, At, B1); PG8_BAR; PG8_SCHED;
            PG8_LDA(At, 0, 1); PG8_STAGE(PG8_SB(0, 0), b2, voffB); PG8_STAGE(PG8_SB(0, 1), b2 + hstep, voffB); PG8_STAGE_A(PG8_SA(0, 0), a2, 0, last);
            PG8_WAIT_V(8); PG8_WAIT_L(0); PG8_BAR; PG8_MMA(1, 0, At, B0); PG8_MMA(1, 1, At, B1); PG8_BAR; PG8_SCHED;
            PG8_LDB(B0, 1, 0); PG8_LDB(B1, 1, 1); PG8_SCHED; PG8_LDA(At, 1, 0); PG8_STAGE_A(PG8_SA(0, 1), a2, 1, last);
            PG8_WAIT_V(8); PG8_WAIT_L(0); PG8_BAR; PG8_MMA(0, 0, At, B0); PG8_MMA(0, 1, At, B1); PG8_BAR; PG8_SCHED;
            PG8_LDA(At, 1, 1); PG8_STAGE(PG8_SB(1, 0), b3, voffB); PG8_STAGE(PG8_SB(1, 1), b3 + hstep, voffB); PG8_STAGE_A(PG8_SA(1, 0), a3, 0, last);
            PG8_WAIT_V(8); PG8_WAIT_L(0); PG8_BAR; PG8_MMA(1, 0, At, B0); PG8_MMA(1, 1, At, B1); PG8_BAR; PG8_SCHED;
        }
#if DIAG >= 10
        if (DIAG == 10 + Epi::ID && ui == 0) { const long long tk1_ = (long long)__builtin_amdgcn_s_memtime();
            if (blockIdx.x == 0 && tid == 0) { const float perk = (float)(tk1_ - tk0_) / (float)nt; const float q = rintf(perk * (1.f / 250.f));
                ((volatile LAS unsigned*)(lds + 159744))[40] = __float_as_uint(q * 2e-5f); } }
#endif
        if (wr == 0) PG8_BAR;
        if constexpr (FP8) asm volatile("s_nop 15\n\ts_nop 7" ::: "memory");
        E(acc, cur, tab, aux, wr, wc, fr, fq);
        if (!has_next) break;
#pragma unroll
        for (int a = 0; a < 2; ++a)
#pragma unroll
            for (int b = 0; b < 2; ++b)
#pragma unroll
                for (int m = 0; m < 4; ++m)
#pragma unroll
                    for (int n = 0; n < 2; ++n) acc[a][b][m][n] = (f32x4){0.f, 0.f, 0.f, 0.f};
        cur = nxt; cA = nA; cB = nB; ++ui;
        cul = cur.ul; crb = cur.rb;
        if (wr == 1) PG8_BAR;
    }
    PG8_WAIT_V(0);
    PG8_BAR;
#undef PG8_SA
#undef PG8_SB
#undef PG8_STAGE
#undef PG8_STAGE_A
#undef PG8_LDA
#undef PG8_LDB
#undef PG8_MMA
#undef PG8_WAIT_V
#undef PG8_WAIT_L
#undef PG8_BAR
#undef PG8_SCHED
}

struct EpiP { static constexpr int ID = 2; bf16_t* P;
    __device__ __forceinline__ void operator()(const f32x4 (&acc)[2][2][4][2], const Unit& u, const LAS int*, const LAS bf16_t*, int wr, int wc, int fr, int fq) const {
        const int row0 = u.pm * BM + wr * 64 + fr, col0 = u.pn * BM + wc * 32 + 8 * fq;
#pragma unroll
        for (int ai = 0; ai < 2; ++ai)
#pragma unroll
            for (int m = 0; m < 4; ++m) { bf16_t* rowp = P + (size_t)(row0 + ai * HALF + m * 16) * DINP + col0;
#pragma unroll
                for (int bj = 0; bj < 2; ++bj) { const f32x4 v0 = acc[ai][bj][m][0], v1 = acc[ai][bj][m][1]; u32x4 w;
                    w.x = cvt_pk_bf16(v0[0], v0[1]); w.y = cvt_pk_bf16(v0[2], v0[3]); w.z = cvt_pk_bf16(v1[0], v1[1]); w.w = cvt_pk_bf16(v1[2], v1[3]);
                    *(GAS u32x4*)(rowp + bj * HALF) = w; } }
    } };
struct EpiOut { static constexpr int ID = 6; const float* x; const float* mod; float* out;
    __device__ __forceinline__ void operator()(const f32x4 (&acc)[2][2][4][2], const Unit& u, const LAS int*, const LAS bf16_t*, int wr, int wc, int fr, int fq) const {
        const int row0 = u.pm * BM + wr * 64 + fr, col0 = u.pn * BM + wc * 32 + 8 * fq;
        const float* gate = mod + (row0 >> 13) * 6144 + 2 * 1024;
#pragma unroll
        for (int bj = 0; bj < 2; ++bj) { const f32x4 g0 = *(const GAS f32x4*)(gate + col0 + bj * HALF), g1 = *(const GAS f32x4*)(gate + col0 + bj * HALF + 4);
#pragma unroll
            for (int ai = 0; ai < 2; ++ai)
#pragma unroll
                for (int m = 0; m < 4; ++m) { const size_t off = (size_t)(row0 + ai * HALF + m * 16) * DM + col0 + bj * HALF;
                    const f32x4 x0 = *(const GAS f32x4*)(x + off), x1 = *(const GAS f32x4*)(x + off + 4);
                    *(GAS f32x4*)(out + off) = x0 + g0 * acc[ai][bj][m][0]; *(GAS f32x4*)(out + off + 4) = x1 + g1 * acc[ai][bj][m][1]; } }
    } };
typedef _Float16 h2_t __attribute__((ext_vector_type(2))); typedef short s2_t __attribute__((ext_vector_type(2)));
struct EpiM1 { static constexpr int ID = 8; unsigned char* act;
    __device__ __forceinline__ void operator()(const f32x4 (&acc)[2][2][4][2], const Unit& u, const LAS int* tab, const LAS bf16_t* aux, int wr, int wc, int fr, int fq) const {
        const int cl = wc * 32 + 8 * fq, col0 = u.pn * BM + cl;
        h2_t bg[2][2], bl[2][2];
#pragma unroll
        for (int bj = 0; bj < 2; ++bj) { const u32x4 w = *(const LAS u32x4*)(aux + u.ul * 256 + bj * HALF + cl);
#pragma unroll
            for (int n = 0; n < 2; ++n) { bg[bj][n] = (h2_t){(_Float16)lo16(w[2 * n]), (_Float16)lo16(w[2 * n + 1])}; bl[bj][n] = (h2_t){(_Float16)hi16(w[2 * n]), (_Float16)hi16(w[2 * n + 1])}; } }
        const h2_t winv = {(_Float16)WINV, (_Float16)WINV}, seven = {(_Float16)7.f, (_Float16)7.f}, one = {(_Float16)1.f, (_Float16)1.f}, cexp = {(_Float16)-2.4554669595930156f, (_Float16)-2.4554669595930156f};
#pragma unroll
        for (int ai = 0; ai < 2; ++ai)
#pragma unroll
            for (int m = 0; m < 4; ++m) { const int r = ai * HALF + wr * 64 + m * 16 + fr; const bool ok = r < u.nvalid;
                unsigned char* rowp = act + (size_t)(u.rb + r) * DFF + (col0 >> 1);
#pragma unroll
                for (int bj = 0; bj < 2; ++bj) { s2_t pk = {0, 0};
#pragma unroll
                    for (int n = 0; n < 2; ++n) { const f32x4 v = acc[ai][bj][m][n];
                        h2_t g = __builtin_bit_cast(h2_t, __builtin_amdgcn_cvt_pkrtz(v[0], v[2])), l = __builtin_bit_cast(h2_t, __builtin_amdgcn_cvt_pkrtz(v[1], v[3]));
                        g = g * winv + bg[bj][n]; l = l * winv + bl[bj][n];
                        g = __builtin_elementwise_min(g, seven); l = __builtin_elementwise_min(__builtin_elementwise_max(l, -seven), seven);
                        const h2_t e = __builtin_elementwise_exp2(g * cexp);
                        const h2_t d = e + one; const h2_t rc = {(_Float16)__builtin_amdgcn_rcph(d[0]), (_Float16)__builtin_amdgcn_rcph(d[1])};
                        const h2_t o = (g * rc) * (l + one);
                        pk = n == 0 ? __builtin_amdgcn_cvt_scalef32_pk_fp8_f16(pk, o, 1.0f, false) : __builtin_amdgcn_cvt_scalef32_pk_fp8_f16(pk, o, 1.0f, true); }
                    if (ok) *(GAS unsigned*)(rowp + bj * (HALF / 2)) = __builtin_bit_cast(unsigned, pk); } }
    } };
constexpr float YSCALE = 8.f, YINV = 1.f / 8.f;
struct EpiM2 { static constexpr int ID = 9; unsigned char* y;
    __device__ __forceinline__ void operator()(const f32x4 (&acc)[2][2][4][2], const Unit& u, const LAS int* tab, const LAS bf16_t* aux, int wr, int wc, int fr, int fq) const {
        const int cl = wc * 32 + 8 * fq, col0 = u.pn * BM + cl;
        h2_t bv[2][2][2];
#pragma unroll
        for (int bj = 0; bj < 2; ++bj) { const u32x4 w = *(const LAS u32x4*)(aux + u.ul * 256 + bj * HALF + cl);
#pragma unroll
            for (int n = 0; n < 2; ++n) { bv[bj][n][0] = (h2_t){(_Float16)lo16(w[2 * n]), (_Float16)hi16(w[2 * n])}; bv[bj][n][1] = (h2_t){(_Float16)lo16(w[2 * n + 1]), (_Float16)hi16(w[2 * n + 1])}; } }
        const h2_t winv = {(_Float16)WINV, (_Float16)WINV};
#pragma unroll
        for (int ai = 0; ai < 2; ++ai)
#pragma unroll
            for (int m = 0; m < 4; ++m) { const int r = ai * HALF + wr * 64 + m * 16 + fr; const bool ok = r < u.nvalid;
                const int pair = tab[u.ul * 256 + r]; const _Float16 gs = (_Float16)(bf2f(aux[9 * 256 + u.ul * 256 + r]) * YSCALE); const h2_t g = {gs, gs}; unsigned char* rowp = y + (size_t)pair * DM + col0;
#pragma unroll
                for (int bj = 0; bj < 2; ++bj) { u32x2 w;
#pragma unroll
                    for (int n = 0; n < 2; ++n) { const f32x4 v = acc[ai][bj][m][n];
                        const h2_t p0 = (__builtin_bit_cast(h2_t, __builtin_amdgcn_cvt_pkrtz(v[0], v[1])) * winv + bv[bj][n][0]) * g, p1 = (__builtin_bit_cast(h2_t, __builtin_amdgcn_cvt_pkrtz(v[2], v[3])) * winv + bv[bj][n][1]) * g;
                        s2_t pk = {0, 0}; pk = __builtin_amdgcn_cvt_scalef32_pk_fp8_f16(pk, p0, 1.0f, false); pk = __builtin_amdgcn_cvt_scalef32_pk_fp8_f16(pk, p1, 1.0f, true);
                        w[n] = __builtin_bit_cast(unsigned, pk); }
                    if (ok) *(GAS u32x2*)(rowp + bj * HALF) = w; } }
    } };
}
constexpr int PG8_TAB_OFF = pg8::STAGE_BYTES;
constexpr int PG8_AUX_OFF = PG8_TAB_OFF + 18 * 1024;
constexpr int PG8_PRE_OFF = PG8_AUX_OFF + 9 * 1024;
static_assert(PG8_PRE_OFF + 512 <= LDS_SCRATCH, "LDS map");

template <int NCT, class Epi>
__device__ __forceinline__ void phase_moe_pg8(const Args& a, LAS unsigned char* lds, const unsigned char* A, int ashift, const unsigned char* Wt, size_t wstride, const float* bias, int nbias, const float* gates, const Epi& E) {
    LAS int* tab = (LAS int*)(lds + PG8_TAB_OFF); LAS int* pre = (LAS int*)(lds + PG8_PRE_OFF); LAS bf16_t* aux = (LAS bf16_t*)(lds + PG8_AUX_OFF);
    const unsigned* cnt = (const unsigned*)(a.ws + WS_CTL) + CW_CNT; const unsigned* list = (const unsigned*)(a.ws + WS_LIST);
    __syncthreads();
    const int tidm = tid_of(a.wv);
    if (tidm < NE) pre[33 + tidm] = (int)__hip_atomic_load(cnt + 64 * tidm, __ATOMIC_RELAXED, __HIP_MEMORY_SCOPE_AGENT);
    __syncthreads();
    if (tidm == 0) { int s = 0;
#pragma unroll 1
        for (int e = 0; e < NE; ++e) { const int c = pre[33 + e]; pre[e] = s; s += (c + 255) >> 8; } pre[32] = s; }
    __syncthreads();
    const int G_ = (int)gridDim.x, bx_ = (int)blockIdx.x, vcu_ = (G_ % 8 == 0) ? (bx_ % 8) * (G_ / 8) + bx_ / 8 : bx_;
    pg8::ExpertOrder<NCT> S{pre, G_, vcu_, (const char*)A, (const char*)Wt, wstride, 1024};
    constexpr int NU = NCT == 8 ? 18 : 9; constexpr bool HASG = NCT == 4;
    const int nunit_ = pre[32] * NCT;
    unsigned val[NU]; float gv[NU];
#pragma unroll
    for (int i = 0; i < NU; ++i) { pg8::Unit u; val[i] = 0u;
        if (S.next(i, u)) { if (tidm < 256) val[i] = list[(size_t)u.e * 32768 + u.pm * 256 + (tidm < u.nvalid ? tidm : 0)]; else val[i] = __float_as_uint(bias[(size_t)u.e * nbias + u.pn * 256 + tidm - 256]); } }
#pragma unroll
    for (int i = 0; i < NU; ++i) { gv[i] = 0.f; if (HASG && tidm < 256 && i * G_ + vcu_ < nunit_) gv[i] = gates[val[i]]; }
#pragma unroll
    for (int i = 0; i < NU; ++i) if (i * G_ + vcu_ < nunit_) {
        if (tidm < 256) { tab[i * 256 + tidm] = (int)val[i]; if (HASG) aux[9 * 256 + i * 256 + tidm] = (bf16_t)f2bf(gv[i]); }
        else aux[i * 256 + tidm - 256] = (bf16_t)f2bf(__uint_as_float(val[i])); }
    __syncthreads();
    pg8::gemm_phase<Epi, pg8::ExpertOrder<NCT>, true, true, NCT == 4>(lds, tab, aux, ashift, 512, S, E, a.wv);
}

__device__ __forceinline__ void mla_tile(const Args& a, LAS unsigned char* lds, int tile, int r0 = 0, int nrows = 128) {
    const int tid = tid_of(a.wv), lane = tid & 63, wave = a.wv, fr = lane & 15, fq = lane >> 4;
    const bool lat = tile < 256;
    const int prow0 = tile * 128;
    const int b = lat ? (prow0 >> 13) : ((prow0 - T) >> 8);
    const int tpos0 = lat ? (prow0 & 8191) : ((prow0 - T) & 255);
    const int key0 = lat ? (LC + tpos0) : tpos0;
    LAS unsigned char* Aq = lds;
    LAS unsigned char* Akv = lds + 34816;
    LAS float* kpe = (LAS float*)(lds + 34816 + 18432);
    LAS float* sspe = (LAS float*)(lds + 34816 + 18432 + 16384);
    const bf16_t* P = (const bf16_t*)(a.ws + WS_P);
    const float* tabm = (const float*)(a.ws + WS_TABM);
    __syncthreads();
    if ((tid >> 2) >= r0 && (tid >> 2) < r0 + nrows) {
        const int r = tid >> 2, part = tid & 3;
        const bf16_t* pr = P + (size_t)(prow0 + r) * DINP;
        u32x4 q[8]; float ss = 0.f;
#pragma unroll
        for (int i = 0; i < 8; ++i) { q[i] = *(const GAS u32x4*)(pr + OFF_Q + part * 64 + i * 8);
#pragma unroll
            for (int e = 0; e < 4; ++e) { const float lo = lo16(q[i][e]), hi = hi16(q[i][e]); ss += lo * lo + hi * hi; } }
        ss += __shfl_xor(ss, 1); ss += __shfl_xor(ss, 2);
        float rstd = rsqrtf(ss * (1.f / 256.f) + EPS);
        const float* gq = a.in[I_GQL] + part * 64;
#pragma unroll
        for (int i = 0; i < 8; ++i) { u32x2 o;
#pragma unroll
            for (int e = 0; e < 2; ++e) o[e] = cvt4_fp8(lo16(q[i][2 * e]) * rstd * gq[i * 8 + 4 * e], hi16(q[i][2 * e]) * rstd * gq[i * 8 + 4 * e + 1], lo16(q[i][2 * e + 1]) * rstd * gq[i * 8 + 4 * e + 2], hi16(q[i][2 * e + 1]) * rstd * gq[i * 8 + 4 * e + 3]);
            *(LAS u32x2*)(Aq + r * 272 + part * 64 + i * 8) = o; }
        u32x4 kv[4]; ss = 0.f;
#pragma unroll
        for (int i = 0; i < 4; ++i) { kv[i] = *(const GAS u32x4*)(pr + OFF_KV + part * 32 + i * 8);
#pragma unroll
            for (int e = 0; e < 4; ++e) { const float lo = lo16(kv[i][e]), hi = hi16(kv[i][e]); ss += lo * lo + hi * hi; } }
        ss += __shfl_xor(ss, 1); ss += __shfl_xor(ss, 2);
        rstd = rsqrtf(ss * (1.f / 128.f) + EPS);
        const float* gkv = a.in[I_GKVL] + part * 32;
#pragma unroll
        for (int i = 0; i < 4; ++i) { u32x2 o;
#pragma unroll
            for (int e = 0; e < 2; ++e) o[e] = cvt4_fp8(lo16(kv[i][2 * e]) * rstd * gkv[i * 8 + 4 * e], hi16(kv[i][2 * e]) * rstd * gkv[i * 8 + 4 * e + 1], lo16(kv[i][2 * e + 1]) * rstd * gkv[i * 8 + 4 * e + 2], hi16(kv[i][2 * e + 1]) * rstd * gkv[i * 8 + 4 * e + 3]);
            *(LAS u32x2*)(Akv + r * 144 + part * 32 + i * 8) = o; }
        const u32x4 pe = *(const GAS u32x4*)(pr + OFF_PE + part * 8); ss = 0.f;
#pragma unroll
        for (int e = 0; e < 4; ++e) { const float lo = lo16(pe[e]), hi = hi16(pe[e]); ss += lo * lo + hi * hi; kpe[r * 32 + part * 8 + 2 * e] = lo; kpe[r * 32 + part * 8 + 2 * e + 1] = hi; }
        ss += __shfl_xor(ss, 1); ss += __shfl_xor(ss, 2);
        if (part == 0) sspe[r] = ss;
    }
    __syncthreads();
    const int h = wave, bh = b * NH + h;
    typedef int i32x4m __attribute__((ext_vector_type(4))); typedef int i32x8m __attribute__((ext_vector_type(8)));
#define LD32G(p) __builtin_shufflevector(*(const GAS i32x4m*)(p), *(const GAS i32x4m*)((p) + 16), 0, 1, 2, 3, 4, 5, 6, 7)
#define LD32L(p) __builtin_shufflevector(*(const LAS i32x4m*)(p), *(const LAS i32x4m*)((p) + 16), 0, 1, 2, 3, 4, 5, 6, 7)
    if (lat) {
        const unsigned char* WQ = a.ws + WS_WQ + (size_t)h * QK * 256;
        const float* gqh = a.in[I_GQH];
        unsigned char* Qo = a.ws + WS_Q + ((size_t)bh * SEQ + tpos0) * QK8;
        i32x8m bq[2][6];
#pragma unroll
        for (int s2 = 0; s2 < 2; ++s2)
#pragma unroll
            for (int j = 0; j < 6; ++j) bq[s2][j] = LD32G(WQ + (size_t)(16 * j + fr) * 256 + 128 * s2 + 32 * fq);
        f32x4 gqv[6];
#pragma unroll
        for (int j = 0; j < 6; ++j) gqv[j] = *(const GAS f32x4*)(gqh + 16 * j + 4 * fq);
#pragma unroll 1
        for (int rq = 0; rq < 8; ++rq) {
            const int row = rq * 16 + fr, t = tpos0 + row;
            f32x4 csq[2][2];
#pragma unroll
            for (int ax = 0; ax < 2; ++ax) { const int pi = ax == 0 ? (t >> 6) : 128 + (t & 63); const float* cs = tabm + (pi * 8 + 4 * (fq & 1)) * 2;
                csq[ax][0] = *(const GAS f32x4*)(cs); csq[ax][1] = *(const GAS f32x4*)(cs + 4); }
            f32x4 acc[6];
#pragma unroll
            for (int j = 0; j < 6; ++j) acc[j] = (f32x4){0.f, 0.f, 0.f, 0.f};
#pragma unroll
            for (int s2 = 0; s2 < 2; ++s2) { const i32x8m af = LD32L(Aq + row * 272 + 128 * s2 + 32 * fq);
#pragma unroll
                for (int j = 0; j < 6; ++j) acc[j] = __builtin_amdgcn_mfma_scale_f32_16x16x128_f8f6f4(bq[s2][j], af, acc[j], 0, 0, 0, 0, 0, 0); }
            float ss = 0.f;
#pragma unroll
            for (int j = 0; j < 6; ++j) ss += (acc[j][0] * acc[j][0] + acc[j][1] * acc[j][1]) + (acc[j][2] * acc[j][2] + acc[j][3] * acc[j][3]);
            ss += __shfl_xor(ss, 16); ss += __shfl_xor(ss, 32);
            const float rstd = rsqrtf(ss * (1.f / 96.f) + EPS * (WQ_SCALE * WQ_SCALE)) * QSCALE;
#pragma unroll
            for (int j = 0; j < 6; ++j) {
                const int col = 16 * j + 4 * fq; const f32x4 gv = gqv[j];
                f32x4 v = acc[j] * gv * rstd;
                if (j >= 4) {
                    const int ax = j - 4;
#pragma unroll
                    for (int r = 0; r < 4; ++r) { const float other = __shfl_xor(v[r], 32); const float c = csq[ax][r >> 1][2 * (r & 1)], sn = csq[ax][r >> 1][2 * (r & 1) + 1];
                        v[r] = (fq < 2) ? (v[r] * c - other * sn) : (v[r] * c + other * sn); }
                }
                *(GAS unsigned*)(Qo + (size_t)row * QK8 + col) = cvt4_fp8(v[0], v[1], v[2], v[3]);
            }
            *(GAS u32x2*)(Qo + (size_t)row * QK8 + QK + 8 * fq) = (u32x2){0u, 0u};
        }
    }
    {
        const unsigned char* WKV = a.ws + WS_WKV + (size_t)h * 128 * 128;
        const float* gkh = a.in[I_GKH];
        unsigned char* Ko = a.ws + WS_K + ((size_t)bh * SKV + key0) * QK8;
        unsigned char* Vo = a.ws + WS_VT + (size_t)bh * DV * SKV + key0;
        i32x8m bkv[8];
#pragma unroll
        for (int j = 0; j < 8; ++j) bkv[j] = LD32G(WKV + (size_t)(16 * j + fr) * 128 + 32 * fq);
        f32x4 gkv[4]; float gp0[4], gp1[4];
#pragma unroll
        for (int j = 0; j < 4; ++j) gkv[j] = *(const GAS f32x4*)(gkh + 16 * j + 4 * fq);
#pragma unroll
        for (int r = 0; r < 4; ++r) { const int c0 = (fq >> 1) * 16 + 4 * (fq & 1) + r; gp0[r] = gkh[64 + c0]; gp1[r] = gkh[64 + c0 + 8]; }
#pragma unroll 1
        for (int rq = r0 >> 4; rq < ((r0 + nrows) >> 4); ++rq) {
            f32x4 csk[2];
            { const int t = tpos0 + rq * 16 + fr, ax = fq >> 1, pi = ax == 0 ? (t >> 6) : 128 + (t & 63); const float* cs = tabm + (pi * 8 + 4 * (fq & 1)) * 2;
              csk[0] = *(const GAS f32x4*)(cs); csk[1] = *(const GAS f32x4*)(cs + 4); }
            f32x4 acc[1][8];
#pragma unroll
            for (int i = 0; i < 1; ++i)
#pragma unroll
                for (int j = 0; j < 8; ++j) acc[i][j] = (f32x4){0.f, 0.f, 0.f, 0.f};
            { const i32x8m af = LD32L(Akv + (rq * 16 + fr) * 144 + 32 * fq);
#pragma unroll
              for (int j = 0; j < 8; ++j) acc[0][j] = __builtin_amdgcn_mfma_scale_f32_16x16x128_f8f6f4(bkv[j], af, acc[0][j], 0, 0, 0, 0, 0, 0) ; }
#pragma unroll
            for (int j = 0; j < 8; ++j) acc[0][j] = acc[0][j] * WKV_INV;
#pragma unroll
            for (int i = 0; i < 1; ++i) {
                const int row = rq * 16 + 16 * i + fr, t = tpos0 + row;
                const int kk = row & 63; const int vrow = (row & 64) + 32 * ((kk >> 2) & 1) + (kk & 3) + 4 * ((kk & 31) >> 3) + 16 * (kk >> 5);
                float ss = 0.f;
#pragma unroll
                for (int j = 0; j < 4; ++j) ss += (acc[i][j][0] * acc[i][j][0] + acc[i][j][1] * acc[i][j][1]) + (acc[i][j][2] * acc[i][j][2] + acc[i][j][3] * acc[i][j][3]);
                ss += __shfl_xor(ss, 16); ss += __shfl_xor(ss, 32);
                const float rstd = rsqrtf((ss + sspe[row]) * (1.f / 96.f) + EPS);
#pragma unroll
                for (int j = 0; j < 4; ++j) { const int col = 16 * j + 4 * fq; const f32x4 gv = gkv[j]; const f32x4 v = acc[i][j] * gv * rstd;
                    *(GAS unsigned*)(Ko + (size_t)row * QK8 + col) = cvt4_fp8(v[0], v[1], v[2], v[3]); }
                {
                    const int ax = fq >> 1, f0 = 4 * (fq & 1);
                    float o0[4], o1[4];
#pragma unroll
                    for (int r = 0; r < 4; ++r) { const int c0 = ax * 16 + f0 + r, c1 = c0 + 8;
                        const float x0 = kpe[row * 32 + c0] * rstd * gp0[r], x1 = kpe[row * 32 + c1] * rstd * gp1[r];
                        const float c = lat ? csk[r >> 1][2 * (r & 1)] : 1.f, s = lat ? csk[r >> 1][2 * (r & 1) + 1] : 0.f;
                        o0[r] = x0 * c - x1 * s; o1[r] = x1 * c + x0 * s; }
                    *(GAS unsigned*)(Ko + (size_t)row * QK8 + 64 + ax * 16 + f0) = cvt4_fp8(o0[0], o0[1], o0[2], o0[3]);
                    *(GAS unsigned*)(Ko + (size_t)row * QK8 + 64 + ax * 16 + 8 + f0) = cvt4_fp8(o1[0], o1[1], o1[2], o1[3]);
                    *(GAS u32x2*)(Ko + (size_t)row * QK8 + QK + 8 * fq) = (u32x2){0u, 0u};
                }
#pragma unroll
                for (int j = 4; j < 8; ++j)
#pragma unroll
                    for (int r = 0; r < 4; ++r) { const int d = 16 * (j - 4) + 4 * fq + r; Vo[(size_t)d * SKV + vrow] = (unsigned char)(cvt4_fp8(acc[i][j][r], 0.f, 0.f, 0.f) & 0xffu); }
            }
        }
    }
}

__device__ __forceinline__ float log_gamma(const float* logit) { const float x = *logit; return -log1pf(__expf(-x)); }

__device__ __forceinline__ void rope16(float (&out)[16], const bf16_t* rowp  , int part, const float* cs  , float scale) {
    const u32x4 a0 = *(const GAS u32x4*)(rowp + part * 16), a1 = *(const GAS u32x4*)(rowp + part * 16 + 8);
    const u32x4 b0 = *(const GAS u32x4*)(rowp + (part ^ 1) * 16), b1 = *(const GAS u32x4*)(rowp + (part ^ 1) * 16 + 8);
    float xs[16], xo[16];
#pragma unroll
    for (int e = 0; e < 4; ++e) { xs[2 * e] = lo16(a0[e]); xs[2 * e + 1] = hi16(a0[e]); xs[8 + 2 * e] = lo16(a1[e]); xs[8 + 2 * e + 1] = hi16(a1[e]);
        xo[2 * e] = lo16(b0[e]); xo[2 * e + 1] = hi16(b0[e]); xo[8 + 2 * e] = lo16(b1[e]); xo[8 + 2 * e + 1] = hi16(b1[e]); }
    if (cs) {
        const float sg = (part & 1) ? 1.f : -1.f;
#pragma unroll
        for (int q = 0; q < 8; ++q) { const f32x4 t = *(const GAS f32x4*)(cs + 4 * q);
            out[2 * q] = (xs[2 * q] * t[0] + sg * xo[2 * q] * t[1]) * scale; out[2 * q + 1] = (xs[2 * q + 1] * t[2] + sg * xo[2 * q + 1] * t[3]) * scale; }
    } else {
#pragma unroll
        for (int f = 0; f < 16; ++f) out[f] = xs[f] * scale;
    }
}

__device__ __forceinline__ void ret_local_unit(const Args& a, LAS unsigned char* lds, int unit) {
    const int tid = tid_of(a.wv), lane = tid & 63, wave = a.wv, fr = lane & 15, fq = lane >> 4;
    const int bh = unit / NSLOT, slot = unit % NSLOT, b = bh >> 2, h = bh & 3;
    const bool lat = slot >= 2;
    const int prow0 = lat ? b * SEQ + (slot - 2) * RC : T + b * LC + slot * RC;
    const int tpos0 = lat ? (slot - 2) * RC : 0;
    LAS bf16_t* KfT = (LAS bf16_t*)lds;
    LAS bf16_t* KbT = (LAS bf16_t*)(lds + 17408);
    LAS bf16_t* VT = (LAS bf16_t*)(lds + 34816);
    const bf16_t* P = (const bf16_t*)(a.ws + WS_P);
    const float* tabr = (const float*)(a.ws + WS_TABR);
    const float lgf = log_gamma(a.in[I_DECAY] + h), lgb = log_gamma(a.in[I_DECAY] + 4 + h);
    __syncthreads();
    {
        const int j = tid >> 2, part = tid & 3, t = tpos0 + j, ax = part >> 1;
        const int pi = ax == 0 ? (t >> 6) : 128 + (t & 63);
        float o[16]; rope16(o, P + (size_t)(prow0 + j) * DINP + OFF_RK + h * 64, part, lat ? tabr + pi * 32 : nullptr, 0.125f);
        const float wf = __expf(lgf * (float)(127 - j)), wb = __expf(lgb * (float)j);
#pragma unroll
        for (int f = 0; f < 16; ++f) { const int d = part * 16 + f; KfT[d * 136 + j] = (bf16_t)f2bf(o[f] * wf); KbT[d * 136 + j] = (bf16_t)f2bf(o[f] * wb); }
    }
    for (int idx = tid; idx < 128 * 16; idx += 512) {
        const int j = idx >> 4, c = idx & 15;
        const u32x4 v = *(const GAS u32x4*)(P + (size_t)(prow0 + j) * DINP + OFF_RV + h * 128 + c * 8);
#pragma unroll
        for (int e = 0; e < 4; ++e) { VT[(c * 8 + 2 * e) * 136 + j] = (bf16_t)(v[e] & 0xffffu); VT[(c * 8 + 2 * e + 1) * 136 + j] = (bf16_t)(v[e] >> 16); }
    }
    __syncthreads();
    const int dir = wave >> 2, mi = wave & 3;
    f32x4 acc[1][8];
#pragma unroll
    for (int j = 0; j < 8; ++j) acc[0][j] = (f32x4){0.f, 0.f, 0.f, 0.f};
    mma_ll<1, 8, false>(acc, dir ? KbT : KfT, 136, 16 * mi, VT, 136, 0, 128, lane);
    float* out = (float*)(a.ws + WS_LST) + ((size_t)(bh * 2 + dir) * NSLOT + slot) * 8192;
#pragma unroll
    for (int j = 0; j < 8; ++j) *(GAS f32x4*)(out + (size_t)(16 * j + fr) * 64 + 16 * mi + 4 * fq) = acc[0][j];
}

__device__ __forceinline__ void phase_ret_scan(const Args& a) {
    const int gt = blockIdx.x * 512 + tid_of(a.wv);
    if (gt >= 32 * 2048) return;
    const int bd = gt >> 11, v4 = gt & 2047, dir = bd & 1, h = (bd >> 1) & 3;
    const float lg = log_gamma(a.in[I_DECAY] + dir * 4 + h);
    const float g = __expf(lg * 128.f);
    float* base = (float*)(a.ws + WS_LST) + (size_t)bd * NSLOT * 8192 + v4 * 4;
    f32x4 S = (f32x4){0.f, 0.f, 0.f, 0.f};
#pragma unroll 1
    for (int bt = 0; bt < 5; ++bt) {
        f32x4 L[13];
#pragma unroll
        for (int q = 0; q < 13; ++q) { const int n = bt * 13 + q; const int slot = dir == 0 ? n : (n == 0 ? 1 : (n == 1 ? 0 : 67 - n)); L[q] = *(const GAS f32x4*)(base + (size_t)slot * 8192); }
#pragma unroll
        for (int q = 0; q < 13; ++q) { const int n = bt * 13 + q; const int slot = dir == 0 ? n : (n == 0 ? 1 : (n == 1 ? 0 : 67 - n)); S = S * g + L[q]; *(GAS f32x4*)(base + (size_t)slot * 8192) = S; }
    }
}

__device__ __forceinline__ void ret_out_unit(const Args& a, LAS unsigned char* lds, int unit) {
    const int tid = tid_of(a.wv), lane = tid & 63, wave = a.wv, fr = lane & 15, fq = lane >> 4;
    const int bh = unit >> 6, c = unit & 63, b = bh >> 2, h = bh & 3;
    const int prow0 = b * SEQ + c * RC, tpos0 = c * RC;
    LAS bf16_t* Qs = (LAS bf16_t*)lds;
    LAS bf16_t* Ks = (LAS bf16_t*)(lds + 18432);
    LAS bf16_t* VT = (LAS bf16_t*)(lds + 36864);
    LAS bf16_t* SfT = (LAS bf16_t*)(lds + 71680);
    LAS bf16_t* SbT = (LAS bf16_t*)(lds + 90112);
    LAS bf16_t* Ws = (LAS bf16_t*)(lds + 108544);
    const bf16_t* P = (const bf16_t*)(a.ws + WS_P);
    const float* tabr = (const float*)(a.ws + WS_TABR);
    const float lgf = log_gamma(a.in[I_DECAY] + h), lgb = log_gamma(a.in[I_DECAY] + 4 + h);
    __syncthreads();
    {
        const int j = tid >> 2, part = tid & 3, t = tpos0 + j, ax = part >> 1;
        const int pi = ax == 0 ? (t >> 6) : 128 + (t & 63);
        float oq[16], ok[16];
        rope16(oq, P + (size_t)(prow0 + j) * DINP + OFF_RQ + h * 64, part, tabr + pi * 32, 1.f);
        rope16(ok, P + (size_t)(prow0 + j) * DINP + OFF_RK + h * 64, part, tabr + pi * 32, 0.125f);
        u32x4 w0, w1;
        w0 = (u32x4){pk2(oq[0], oq[1]), pk2(oq[2], oq[3]), pk2(oq[4], oq[5]), pk2(oq[6], oq[7])}; w1 = (u32x4){pk2(oq[8], oq[9]), pk2(oq[10], oq[11]), pk2(oq[12], oq[13]), pk2(oq[14], oq[15])};
        *(LAS u32x4*)(Qs + j * 72 + part * 16) = w0; *(LAS u32x4*)(Qs + j * 72 + part * 16 + 8) = w1;
        w0 = (u32x4){pk2(ok[0], ok[1]), pk2(ok[2], ok[3]), pk2(ok[4], ok[5]), pk2(ok[6], ok[7])}; w1 = (u32x4){pk2(ok[8], ok[9]), pk2(ok[10], ok[11]), pk2(ok[12], ok[13]), pk2(ok[14], ok[15])};
        *(LAS u32x4*)(Ks + j * 72 + part * 16) = w0; *(LAS u32x4*)(Ks + j * 72 + part * 16 + 8) = w1;
    }
    for (int idx = tid; idx < 128 * 16; idx += 512) {
        const int j = idx >> 4, cch = idx & 15;
        const u32x4 v = *(const GAS u32x4*)(P + (size_t)(prow0 + j) * DINP + OFF_RV + h * 128 + cch * 8);
#pragma unroll
        for (int e = 0; e < 4; ++e) { VT[(cch * 8 + 2 * e) * 136 + j] = (bf16_t)(v[e] & 0xffffu); VT[(cch * 8 + 2 * e + 1) * 136 + j] = (bf16_t)(v[e] >> 16); }
    }
    {
        const float* sf = (const float*)(a.ws + WS_LST) + ((size_t)(bh * 2 + 0) * NSLOT + (c + 1)) * 8192;
        const float* sb = (const float*)(a.ws + WS_LST) + ((size_t)(bh * 2 + 1) * NSLOT + (c == 63 ? 0 : c + 3)) * 8192;
        for (int idx = tid; idx < 2048; idx += 512) {
            const int e = idx >> 4, d = (idx & 15) * 4;
            const f32x4 x = *(const GAS f32x4*)(sf + idx * 4), y = *(const GAS f32x4*)(sb + idx * 4);
            u32x2 w; w.x = pk2(x[0], x[1]); w.y = pk2(x[2], x[3]); *(LAS u32x2*)(SfT + e * 72 + d) = w;
            w.x = pk2(y[0], y[1]); w.y = pk2(y[2], y[3]); *(LAS u32x2*)(SbT + e * 72 + d) = w;
        }
    }
    __syncthreads();
    const int i0 = 16 * wave, irow = i0 + fr;
    u32x2 gwv[8];
    { const bf16_t* pg_ = P + (size_t)(prow0 + irow) * DINP + OFF_RG + h * 128;
#pragma unroll
      for (int j = 0; j < 8; ++j) gwv[j] = *(const GAS u32x2*)(pg_ + 16 * j + 4 * fq); }
    f32x4 accS[1][8], accF[1][8], accB[1][8], accO[1][8];
#pragma unroll
    for (int j = 0; j < 8; ++j) { accS[0][j] = (f32x4){0.f, 0.f, 0.f, 0.f}; accF[0][j] = accS[0][j]; accB[0][j] = accS[0][j]; accO[0][j] = accS[0][j]; }
    mma_ll<1, 8, true>(accS, Qs, 72, i0, Ks, 72, 0, 64, lane);
    mma_ll<1, 8, true>(accF, Qs, 72, i0, SfT, 72, 0, 64, lane);
    mma_ll<1, 8, true>(accB, Qs, 72, i0, SbT, 72, 0, 64, lane);
#pragma unroll
    for (int j = 0; j < 8; ++j) {
        float w[4];
#pragma unroll
        for (int r = 0; r < 4; ++r) { const int jj = 16 * j + 4 * fq + r; const int df = irow - jj;
            const float dec = df > 0 ? __expf(lgf * (float)df) : (df < 0 ? __expf(lgb * (float)(-df)) : 2.f);
            w[r] = accS[0][j][r] * dec; }
        u32x2 pw; pw.x = pk2(w[0], w[1]); pw.y = pk2(w[2], w[3]);
        *(LAS u32x2*)(Ws + irow * 136 + 16 * j + 4 * fq) = pw;
    }
    LDS_WAIT(); __builtin_amdgcn_wave_barrier();
    mma_ll<1, 8, true>(accO, Ws, 136, i0, VT, 136, 0, 128, lane);
    const float wf = __expf(lgf * (float)(irow + 1)), wb = __expf(lgb * (float)(128 - irow));
    float ss = 0.f;
#pragma unroll
    for (int j = 0; j < 8; ++j) { accO[0][j] = accO[0][j] + accF[0][j] * wf + accB[0][j] * wb;
        ss += (accO[0][j][0] * accO[0][j][0] + accO[0][j][1] * accO[0][j][1]) + (accO[0][j][2] * accO[0][j][2] + accO[0][j][3] * accO[0][j][3]); }
    ss += __shfl_xor(ss, 16); ss += __shfl_xor(ss, 32);
    const float rstd = rsqrtf(ss * (1.f / 128.f) + EPS);
    const float* gro = a.in[I_GRET] + h * 128;
    bf16_t* mix = (bf16_t*)(a.ws + WS_MIX) + (size_t)(prow0 + irow) * DM + 512 + h * 128;
#pragma unroll
    for (int j = 0; j < 8; ++j) { const int e = 16 * j + 4 * fq; const f32x4 gv = *(const GAS f32x4*)(gro + e); const u32x2 gw = gwv[j];
        const float g0 = lo16(gw.x), g1 = hi16(gw.x), g2 = lo16(gw.y), g3 = hi16(gw.y);
        f32x4 v = accO[0][j] * gv * rstd;
        v[0] *= g0 / (1.f + __expf(-g0)); v[1] *= g1 / (1.f + __expf(-g1)); v[2] *= g2 / (1.f + __expf(-g2)); v[3] *= g3 / (1.f + __expf(-g3));
        u32x2 w; w.x = pk2(v[0], v[1]); w.y = pk2(v[2], v[3]); *(GAS u32x2*)(mix + e) = w; }
}

namespace att {
constexpr int KLD8 = 144  , VLD8 = 80  , KBUF = 64 * KLD8, VBUF = 64 * VLD8, NKB = 3, NVB = 4;
constexpr int L_K = 0, L_V = NKB * KBUF, L_WS = NKB * KBUF + NVB * VBUF;
__device__ __forceinline__ int crow(int r, int hi) { return (r & 3) + 8 * (r >> 2) + 4 * hi; }
typedef __bf16 bf16x2_t __attribute__((ext_vector_type(2))); typedef float f32x2_t __attribute__((ext_vector_type(2)));
__device__ __forceinline__ unsigned cvtpk(float lo, float hi) { f32x2_t v = {lo, hi}; bf16x2_t b = __builtin_convertvector(v, bf16x2_t); return __builtin_bit_cast(unsigned, b); }
#define SBAR() __builtin_amdgcn_sched_barrier(0)
typedef int i32x4 __attribute__((ext_vector_type(4))); typedef int i32x8 __attribute__((ext_vector_type(8)));
constexpr float PSHIFT = 2.f;
template <bool SHIFT>
__device__ __forceinline__ i32x8 softmax_pack8(f32x16& p0, f32x16& p1, float negm) {
    const float sh = negm + 8.f - PSHIFT;
#pragma unroll
    for (int r = 0; r < 16; ++r) { p0[r] = __builtin_amdgcn_exp2f(SHIFT ? p0[r] + sh : p0[r]); p1[r] = __builtin_amdgcn_exp2f(SHIFT ? p1[r] + sh : p1[r]); }
    i32x8 w;
#pragma unroll
    for (int q = 0; q < 4; ++q) { w[q] = (int)cvt4_fp8(p0[4 * q], p0[4 * q + 1], p0[4 * q + 2], p0[4 * q + 3]); w[4 + q] = (int)cvt4_fp8(p1[4 * q], p1[4 * q + 1], p1[4 * q + 2], p1[4 * q + 3]); }
    return w;
}
template <bool SHIFT>
__device__ __forceinline__ void unit64(const Args& a, LAS unsigned char* lds, int bh, int qb, float negm) {
    const int wid = sopaque(a.wv), tid = tid_of(wid), lane = tid & 63, r32 = lane & 31, hi = lane >> 5;
    const unsigned char* QwA = a.ws + WS_Q + ((size_t)bh * SEQ + qb * 512 + wid * 64 + r32) * QK8 + hi * 32;
    const unsigned char* Kh = a.ws + WS_K + (size_t)bh * SKV * QK8;
    const unsigned char* Vh = a.ws + WS_VT + (size_t)bh * DV * SKV;
    LAS unsigned char* Kl = lds + L_K; LAS unsigned char* Vl = lds + L_V;
    LAS float* wsf = (LAS float*)(lds + L_WS) + wid * 64;
    i32x8 qA8[2], qB8[2];
#pragma unroll
    for (int s2 = 0; s2 < 2; ++s2) { const i32x4 a0_ = *(const GAS i32x4*)(QwA + 64 * s2), a1_ = *(const GAS i32x4*)(QwA + 64 * s2 + 16), b0_ = *(const GAS i32x4*)(QwA + 32 * QK8 + 64 * s2), b1_ = *(const GAS i32x4*)(QwA + 32 * QK8 + 64 * s2 + 16);
        qA8[s2] = __builtin_shufflevector(a0_, a1_, 0, 1, 2, 3, 4, 5, 6, 7); qB8[s2] = __builtin_shufflevector(b0_, b1_, 0, 1, 2, 3, 4, 5, 6, 7); }
    unsigned soff[2]; int dsto[2];
#pragma unroll
    for (int m = 0; m < 2; ++m) { const int j = (wid + 8 * m) < 14 ? wid + 8 * m : wid + 8 * m - 8;
        if (j < 9) { const int p = j * 64 + lane, row = p / 9, c = p % 9; soff[m] = (unsigned)(row * QK8 + (c < 8 ? c : 7) * 16); dsto[m] = L_K + j * 1024; }
        else { const int jv = j - 9, p = jv * 64 + lane, d = p / 5, c = p % 5; soff[m] = (unsigned)(d * SKV + (c < 4 ? c : 3) * 16); dsto[m] = L_V + jv * 1024; } }
    const char* Kb = (const char*)Kh; const char* Vb = (const char*)Vh;
#define DMA(t, kslot, vslot) do { _Pragma("unroll") for (int pm_ = 0; pm_ < 2; ++pm_) { const int j_ = (wid + 8 * pm_) < 14 ? wid + 8 * pm_ : wid + 8 * pm_ - 8; { \
        const char* src_ = (j_ < 9 ? Kb + (size_t)(t) * (64 * QK8) : Vb + (size_t)(t) * 64) + soff[pm_]; \
        __builtin_amdgcn_global_load_lds((const unsigned*)src_, (LAS unsigned*)(lds + dsto[pm_] + (j_ < 9 ? (kslot) * KBUF : (vslot) * VBUF)), 16, 0, 0); } } } while (0)
    i32x8 ones8;
#pragma unroll
    for (int q = 0; q < 8; ++q) ones8[q] = r32 == 0 ? 0x38383838 : 0;
    f32x16 oA[2], oB[2], sA, sB;
#pragma unroll
    for (int r = 0; r < 16; ++r) { oA[0][r] = 0.f; oA[1][r] = 0.f; oB[0][r] = 0.f; oB[1][r] = 0.f; sA[r] = 0.f; sB[r] = 0.f; }
    constexpr int NT = SKV / 64;
    __syncthreads();
    DMA(0, 0, 0); DMA(1, 1, 1); __syncthreads();
#ifndef ATT_STAGGER
#define ATT_STAGGER 0
#endif
    const bool late = ATT_STAGGER && wid >= 4;
#define TILE_BAR(more) do { if (more) asm volatile("s_waitcnt vmcnt(2) lgkmcnt(0)\n\ts_barrier" ::: "memory"); else asm volatile("s_waitcnt vmcnt(0) lgkmcnt(0)\n\ts_barrier" ::: "memory"); } while (0)
    int ks = 0, vs = 0;
    for (int i = 0; i < NT; ++i) {
        const bool more = i + 2 < NT;
        if (more) DMA(i + 2, (ks == 0 ? 2 : ks - 1), ((vs + 2) & 3));
        SBAR();
        f32x16 pA0, pA1, pB0, pB1;
#pragma unroll
        for (int r = 0; r < 16; ++r) { pA0[r] = PSHIFT; pA1[r] = PSHIFT; pB0[r] = PSHIFT; pB1[r] = PSHIFT; }
        const LAS unsigned char* Ks = Kl + ks * KBUF + r32 * KLD8 + 32 * hi;
#pragma unroll
        for (int s2 = 0; s2 < 2; ++s2) {
            const i32x4 c0_ = *(const LAS i32x4*)(Ks + 64 * s2), c1_ = *(const LAS i32x4*)(Ks + 64 * s2 + 16), d0_ = *(const LAS i32x4*)(Ks + 32 * KLD8 + 64 * s2), d1_ = *(const LAS i32x4*)(Ks + 32 * KLD8 + 64 * s2 + 16);
            const i32x8 k0 = __builtin_shufflevector(c0_, c1_, 0, 1, 2, 3, 4, 5, 6, 7), k1 = __builtin_shufflevector(d0_, d1_, 0, 1, 2, 3, 4, 5, 6, 7);
            pA0 = __builtin_amdgcn_mfma_scale_f32_32x32x64_f8f6f4(k0, qA8[s2], pA0, 0, 0, 0, 0, 0, 0); pB0 = __builtin_amdgcn_mfma_scale_f32_32x32x64_f8f6f4(k0, qB8[s2], pB0, 0, 0, 0, 0, 0, 0);
            pA1 = __builtin_amdgcn_mfma_scale_f32_32x32x64_f8f6f4(k1, qA8[s2], pA1, 0, 0, 0, 0, 0, 0); pB1 = __builtin_amdgcn_mfma_scale_f32_32x32x64_f8f6f4(k1, qB8[s2], pB1, 0, 0, 0, 0, 0, 0);
        }
        SBAR();
        if (late) TILE_BAR(more);
        const LAS unsigned char* Vs = Vl + vs * VBUF + r32 * VLD8 + 32 * hi;
        const i32x4 e0_ = *(const LAS i32x4*)(Vs), e1_ = *(const LAS i32x4*)(Vs + 16), f0_ = *(const LAS i32x4*)(Vs + 32 * VLD8), f1_ = *(const LAS i32x4*)(Vs + 32 * VLD8 + 16);
        const i32x8 v0 = __builtin_shufflevector(e0_, e1_, 0, 1, 2, 3, 4, 5, 6, 7), v1 = __builtin_shufflevector(f0_, f1_, 0, 1, 2, 3, 4, 5, 6, 7);
        { const i32x8 pa = softmax_pack8<SHIFT>(pA0, pA1, negm);
          oA[0] = __builtin_amdgcn_mfma_scale_f32_32x32x64_f8f6f4(pa, v0, oA[0], 0, 0, 0, 0, 0, 0); oA[1] = __builtin_amdgcn_mfma_scale_f32_32x32x64_f8f6f4(pa, v1, oA[1], 0, 0, 0, 0, 0, 0);
          sA = __builtin_amdgcn_mfma_scale_f32_32x32x64_f8f6f4(pa, ones8, sA, 0, 0, 0, 0, 0, 0); }
        { const i32x8 pa = softmax_pack8<SHIFT>(pB0, pB1, negm);
          oB[0] = __builtin_amdgcn_mfma_scale_f32_32x32x64_f8f6f4(pa, v0, oB[0], 0, 0, 0, 0, 0, 0); oB[1] = __builtin_amdgcn_mfma_scale_f32_32x32x64_f8f6f4(pa, v1, oB[1], 0, 0, 0, 0, 0, 0);
          sB = __builtin_amdgcn_mfma_scale_f32_32x32x64_f8f6f4(pa, ones8, sB, 0, 0, 0, 0, 0, 0); }
        SBAR();
        if (!late) TILE_BAR(more);
        ks = ks == 2 ? 0 : ks + 1; vs = (vs + 1) & 3;
    }
#undef DMA
#undef TILE_BAR
    if (r32 == 0) {
#pragma unroll
        for (int r = 0; r < 16; ++r) { wsf[crow(r, hi)] = sA[r]; wsf[32 + crow(r, hi)] = sB[r]; } }
    LDS_WAIT(); __builtin_amdgcn_wave_barrier();
    const int b = bh >> 3, h = bh & 7;
    const int lz = opaque(lane), r32z = lz & 31, hiz = lz >> 5;
    bf16_t* Ow = (bf16_t*)(a.ws + WS_MIX) + ((size_t)b * SEQ + qb * 512 + wid * 64) * DM + h * DV;
    const unsigned ooff = (unsigned)(4 * hiz * DM + r32z);
#pragma unroll
    for (int r = 0; r < 16; ++r) { const int orow = crow(r, hiz); const float rlA = 1.f / wsf[orow], rlB = 1.f / wsf[32 + orow];
        const unsigned off = ooff + (unsigned)(((r & 3) + 8 * (r >> 2)) * DM);
        Ow[off] = (bf16_t)f2bf(oA[0][r] * rlA); Ow[off + 32] = (bf16_t)f2bf(oA[1][r] * rlA);
        Ow[off + 32 * DM] = (bf16_t)f2bf(oB[0][r] * rlB); Ow[off + 32 * DM + 32] = (bf16_t)f2bf(oB[1][r] * rlB); }
}
#undef SBAR
}


#if DIAG == 5
__device__ __forceinline__ void attn_selfcheck(const Args& a, LAS unsigned char* lds) {
    const int tid = tid_of(a.wv);
    LAS float* red = (LAS float*)lds;
    __syncthreads();
    if (blockIdx.x == 0) {
        const int row = tid >> 3, ds = (tid & 7) * 8;
        const unsigned char* q = a.ws + WS_Q + (size_t)row * QK8; const unsigned char* K = a.ws + WS_K; const unsigned char* V = a.ws + WS_VT;
        float qf[96];
        float acc[8] = {0.f, 0.f, 0.f, 0.f, 0.f, 0.f, 0.f, 0.f}; float l = 0.f;
        for (int key = 0; key < SKV; ++key) {
            float s = 0.f;
            for (int c = 0; c < 96; c += 4) { const int kw = *(const GAS int*)(K + (size_t)key * QK8 + c), qw = *(const GAS int*)(q + c);
                s += __builtin_amdgcn_cvt_f32_fp8(kw, 0) * __builtin_amdgcn_cvt_f32_fp8(qw, 0) + __builtin_amdgcn_cvt_f32_fp8(kw, 1) * __builtin_amdgcn_cvt_f32_fp8(qw, 1)
                   + __builtin_amdgcn_cvt_f32_fp8(kw, 2) * __builtin_amdgcn_cvt_f32_fp8(qw, 2) + __builtin_amdgcn_cvt_f32_fp8(kw, 3) * __builtin_amdgcn_cvt_f32_fp8(qw, 3); }
            const float p = exp2f(s);
            const int kk = key & 63, pos = (key & ~63) + 32 * ((kk >> 2) & 1) + (kk & 3) + 4 * ((kk & 31) >> 3) + 16 * (kk >> 5);
            l += p;
#pragma unroll
            for (int e = 0; e < 8; ++e) { const int w = V[(size_t)(ds + e) * SKV + pos]; acc[e] += p * __builtin_amdgcn_cvt_f32_fp8(w, 0); }
        }
        (void)qf;
        float emax = 0.f, omax = 0.f;
        const bf16_t* mix = (const bf16_t*)(a.ws + WS_MIX) + (size_t)row * DM + ds;
#pragma unroll
        for (int e = 0; e < 8; ++e) { const float o = acc[e] / l; emax = fmaxf(emax, fabsf(o - bf2f(mix[e]))); omax = fmaxf(omax, fabsf(o)); }
        red[tid] = emax; red[512 + tid] = omax;
        __syncthreads();
        if (tid == 0) { float e = 0.f, o = 0.f; for (int i = 0; i < 512; ++i) { e = fmaxf(e, red[i]); o = fmaxf(o, red[512 + i]); }
            ((unsigned*)(a.ws + WS_CTL))[CW_DIAG] = __float_as_uint(e / o * 0.1f); }
    }
    __syncthreads();
}
#endif

__device__ __forceinline__ void phase_router(const Args& a, LAS unsigned char* lds) {
    const int tid = tid_of(a.wv), lane = tid & 63, wave = a.wv, fr = lane & 15, fq = lane >> 4;
    LAS bf16_t* Ah = (LAS bf16_t*)lds;
    LAS bf16_t* Al = (LAS bf16_t*)(lds + 33024);
    LAS float* red = (LAS float*)(lds + 66048);
    LAS int* hist = (LAS int*)(lds + 66048 + 16384);
    LAS int* base = hist + 32;
    LAS int* pk_e = base + 32;
    LAS int* pk_r = pk_e + 512;
    LAS int* pk_p = pk_r + 512;
    const float* mod = (const float*)(a.ws + WS_MOD); const float* g = a.in[I_GFFN];
    const bf16_t* WR = (const bf16_t*)(a.ws + WS_WR);
    unsigned char* HF = a.ws + WS_HF;
    float* PG = (float*)(a.ws + WS_PG);
    unsigned* cnt = (unsigned*)(a.ws + WS_CTL) + CW_CNT;
    unsigned* list = (unsigned*)(a.ws + WS_LIST);
    LAS float* lg = (LAS float*)(pk_p + 512);
    bf16x8 bh[4][2], bl[4][2];
#pragma unroll
    for (int ks = 0; ks < 4; ++ks)
#pragma unroll
        for (int j = 0; j < 2; ++j) { bh[ks][j] = *(const GAS bf16x8*)(WR + (size_t)(16 * j + fr) * 1024 + wave * 128 + 32 * ks + 8 * fq); bl[ks][j] = *(const GAS bf16x8*)(WR + 32768 + (size_t)(16 * j + fr) * 1024 + wave * 128 + 32 * ks + 8 * fq); }
    for (int tile = blockIdx.x; tile < T / 128; tile += gridDim.x) {
        __syncthreads();
        if (tid < 32) hist[tid] = 0;
        f32x4 v[2][4];
#pragma unroll
        for (int rr = 0; rr < 2; ++rr) { const float* xr = a.out + (size_t)(tile * 128 + wave * 2 + rr) * DM;
#pragma unroll
            for (int j = 0; j < 4; ++j) v[rr][j] = *(const GAS f32x4*)(xr + j * 256 + lane * 4); }
#pragma unroll 1
        for (int it = 0; it < 8; ++it) {
            const int tok0 = tile * 128 + it * 16;
#pragma unroll
            for (int rr = 0; rr < 2; ++rr) {
                const int row = wave * 2 + rr, tok = tok0 + row;
                const float* sh = mod + (tok >> 13) * 6144 + 3 * 1024; const float* sc = sh + 1024;
                float ss = 0.f;
#pragma unroll
                for (int j = 0; j < 4; ++j) ss += (v[rr][j].x * v[rr][j].x + v[rr][j].y * v[rr][j].y) + (v[rr][j].z * v[rr][j].z + v[rr][j].w * v[rr][j].w);
                const float rstd = rsqrtf(wave_sum(ss) * (1.f / DM) + EPS);
#pragma unroll
                for (int j = 0; j < 4; ++j) { const int c = j * 256 + lane * 4; const f32x4 gg = *(const GAS f32x4*)(g + c), s1 = *(const GAS f32x4*)(sc + c), s0 = *(const GAS f32x4*)(sh + c);
                    const f32x4 o = (v[rr][j] * rstd * gg) * (s1 + 1.f) + s0;
                    const unsigned h0 = f2bf(o.x), h1 = f2bf(o.y), h2 = f2bf(o.z), h3 = f2bf(o.w);
                    u32x2 wh; wh.x = h0 | (h1 << 16); wh.y = h2 | (h3 << 16);
                    u32x2 wl; wl.x = pk2(o.x - bf2f((bf16_t)h0), o.y - bf2f((bf16_t)h1)); wl.y = pk2(o.z - bf2f((bf16_t)h2), o.w - bf2f((bf16_t)h3));
                    *(GAS unsigned*)(HF + (size_t)tok * DM + c) = cvt4_fp8(o.x, o.y, o.z, o.w);
                    *(LAS u32x2*)(Ah + row * 1032 + c) = wh; *(LAS u32x2*)(Al + row * 1032 + c) = wl; }
            }
            if (it < 7) {
#pragma unroll
                for (int rr = 0; rr < 2; ++rr) { const float* xr = a.out + (size_t)(tok0 + 16 + wave * 2 + rr) * DM;
#pragma unroll
                    for (int j = 0; j < 4; ++j) v[rr][j] = *(const GAS f32x4*)(xr + j * 256 + lane * 4); } }
            __syncthreads();
            {
                f32x4 acc[2]; acc[0] = (f32x4){0.f, 0.f, 0.f, 0.f}; acc[1] = acc[0];
#pragma unroll
                for (int ks = 0; ks < 4; ++ks) { const bf16x8 ah = *(const LAS bf16x8*)(Ah + fr * 1032 + wave * 128 + 32 * ks + 8 * fq), al = *(const LAS bf16x8*)(Al + fr * 1032 + wave * 128 + 32 * ks + 8 * fq);
#pragma unroll
                    for (int j = 0; j < 2; ++j) { acc[j] = __builtin_amdgcn_mfma_f32_16x16x32_bf16(ah, bh[ks][j], acc[j], 0, 0, 0); acc[j] = __builtin_amdgcn_mfma_f32_16x16x32_bf16(al, bh[ks][j], acc[j], 0, 0, 0);
                        acc[j] = __builtin_amdgcn_mfma_f32_16x16x32_bf16(ah, bl[ks][j], acc[j], 0, 0, 0); } }
#pragma unroll
                for (int j = 0; j < 2; ++j)
#pragma unroll
                    for (int r = 0; r < 4; ++r) red[(wave * 16 + 4 * fq + r) * 32 + 16 * j + fr] = acc[j][r];
            }
            __syncthreads();
            { const int tk = tid >> 5, e = tid & 31; float sl = a.in[I_BR][e];
#pragma unroll
              for (int w = 0; w < 8; ++w) sl += red[(w * 16 + tk) * 32 + e];
              lg[tk * 32 + e] = sl; }
            __syncthreads();
            if (tid < 16) {
                const int tok = tok0 + tid;
                float best[4]; int bi[4];
#pragma unroll
                for (int k = 0; k < 4; ++k) { best[k] = -3.0e38f; bi[k] = 0; }
                for (int e = 0; e < 32; ++e) {
                    const float s = lg[tid * 32 + e];
                    if (s > best[3]) {
                        if (s > best[0]) { best[3] = best[2]; bi[3] = bi[2]; best[2] = best[1]; bi[2] = bi[1]; best[1] = best[0]; bi[1] = bi[0]; best[0] = s; bi[0] = e; }
                        else if (s > best[1]) { best[3] = best[2]; bi[3] = bi[2]; best[2] = best[1]; bi[2] = bi[1]; best[1] = s; bi[1] = e; }
                        else if (s > best[2]) { best[3] = best[2]; bi[3] = bi[2]; best[2] = s; bi[2] = e; }
                        else { best[3] = s; bi[3] = e; }
                    }
                }
                const float e1 = __expf(best[1] - best[0]), e2 = __expf(best[2] - best[0]), e3 = __expf(best[3] - best[0]);
                const float inv = 1.f / (1.f + e1 + e2 + e3);
                const float gk[4] = {inv, e1 * inv, e2 * inv, e3 * inv};
#pragma unroll
                for (int k = 0; k < 4; ++k) { const int slot = (it * 16 + tid) * 4 + k; const int rk = __hip_atomic_fetch_add(hist + bi[k], 1, __ATOMIC_RELAXED, __HIP_MEMORY_SCOPE_WORKGROUP);
                    pk_e[slot] = bi[k]; pk_r[slot] = rk; pk_p[slot] = tok * 4 + k; PG[tok * 4 + k] = gk[k]; }
            }
        }
        __syncthreads();
        if (tid < 32) base[tid] = (int)__hip_atomic_fetch_add(cnt + 64 * tid, (unsigned)hist[tid], __ATOMIC_RELAXED, __HIP_MEMORY_SCOPE_AGENT);
        __syncthreads();
        { const int e = pk_e[tid]; list[(size_t)e * 32768 + base[e] + pk_r[tid]] = (unsigned)pk_p[tid]; }
    }
}

__device__ __forceinline__ void phase_combine(const Args& a) {
    const int tid = tid_of(a.wv), lane = tid & 63, wave = tid >> 6;
    const int gw = blockIdx.x * 8 + wave, NGW = gridDim.x * 8;
    const float* mod = (const float*)(a.ws + WS_MOD);
    const unsigned char* Y = a.ws + WS_Y;
#if DIAG == 1
    const float dz = 0.1f;
#elif DIAG >= 2
    const float dz = sqrtf(__uint_as_float(__hip_atomic_load((unsigned*)(a.ws + WS_CTL) + CW_DIAG, __ATOMIC_RELAXED, __HIP_MEMORY_SCOPE_AGENT)));
#else
    const float dz = 0.f;
#endif
    for (int tok = gw; tok < T; tok += NGW) {
        const float* gate = mod + (tok >> 13) * 6144 + 5 * 1024;
        float* orow = a.out + (size_t)tok * DM;
#pragma unroll
        for (int j = 0; j < 4; ++j) { const int c = j * 256 + lane * 4;
            f32x4 s = (f32x4){0.f, 0.f, 0.f, 0.f};
#pragma unroll
            for (int k = 0; k < 4; ++k) { const int w = *(const GAS int*)(Y + ((size_t)tok * 4 + k) * DM + c);
                s[0] += __builtin_amdgcn_cvt_f32_fp8(w, 0); s[1] += __builtin_amdgcn_cvt_f32_fp8(w, 1); s[2] += __builtin_amdgcn_cvt_f32_fp8(w, 2); s[3] += __builtin_amdgcn_cvt_f32_fp8(w, 3); }
            s = s * pg8::YINV;
            const f32x4 xv = *(const GAS f32x4*)(orow + c), gv = *(const GAS f32x4*)(gate + c);
            *(GAS f32x4*)(orow + c) = xv + gv * s + dz; }
    }
}

constexpr int N_PHASES = 11;
constexpr int MOE_IT_ALL = 32 * (16 * 64 + 16 * 32), MOE_IT_P2 = 224 * 8 * 6;
__global__ void __launch_bounds__(512, 2) fwd_kernel(Args a0) {
    Args a;
    extern __shared__ __attribute__((aligned(16))) unsigned char lds_raw[];
    LAS unsigned char* lds = (LAS unsigned char*)lds_raw;
    volatile LAS unsigned* MISC = (volatile LAS unsigned*)(lds + LDS_MISC);
    const int wv0 = __builtin_amdgcn_readfirstlane((int)threadIdx.x >> 6);
    const int tid = threadIdx.x;
    if (tid < 64) MISC[tid] = 0u;
    __syncthreads();
    const int lo = sopaque(a0.ph_lo), hi = sopaque(a0.ph_hi);
#define use_bar ((hi - lo) > 1)
    XcdBarrier bar; bar.bar = (unsigned*)(a0.ws + WS_CTL) + CW_BAR; bar.x = 0; bar.st = MISC + 8;
    bar.wv = wv0;
    if (use_bar) bar = xcd_barrier_post((unsigned*)(a0.ws + WS_CTL) + CW_BAR, MISC + 8, wv0);
    const int G = sopaque((int)gridDim.x), bx = sopaque((int)blockIdx.x);
    const int vcu = (G % 8 == 0) ? (bx % 8) * (G / 8) + bx / 8 : bx;
#ifndef ONLY_PHASE
#define ONLY_PHASE -1
#endif
#ifndef PHASE_MASK
#define PHASE_MASK 0x7ff
#endif
#define IN(k) (lo <= (k) && (k) < hi && (ONLY_PHASE < 0 || ONLY_PHASE == (k)) && ((PHASE_MASK >> (k)) & 1))
#if DIAG >= 40
    unsigned long long tprev_ = __builtin_amdgcn_s_memrealtime();
#define TSTAMP(k) do { const unsigned long long tn_ = __builtin_amdgcn_s_memrealtime(); if (DIAG - 40 == (k) && blockIdx.x == 0 && tid == 0) MISC[40] = __float_as_uint(rintf((float)(tn_ - tprev_) * (1.f / 1000.f)) * 1e-5f); tprev_ = tn_; } while (0)
#else
#define TSTAMP(k) do { } while (0)
#endif
#define SEAM(k) do { if ((k) == 9) TSTAMP(k); if ((k) == 9 && DIAG >= 10 && blockIdx.x == 0 && tid == 0) __hip_atomic_store((unsigned*)(a0.ws + WS_CTL) + CW_DIAG, MISC[40], __ATOMIC_RELAXED, __HIP_MEMORY_SCOPE_AGENT); \
        if (use_bar && (k) + 1 < hi) xcd_barrier(bar); if ((k) != 9) TSTAMP(k); } while (0)
#ifndef REPEAT_MASK
#define REPEAT_MASK 0
#endif
#define REP(k) for (int rep_ = 0; rep_ <= ((REPEAT_MASK >> (k)) & 1); ++rep_)
    a = a0; a.wv = wv0;
    if (IN(0)) { phase_mod(a, lds); SEAM(0); }
    REP(1) if (IN(1)) { phase_prep(a, lds); SEAM(1); }
    {
        float* prm = (float*)(a0.ws + WS_PRM);
        a.ws = a0.ws; a.out = a0.out; a.in[I_X] = a0.in[I_X]; a.wv = wv0;
        a.in[I_GQL] = prm + PRM_GQL; a.in[I_GKVL] = prm + PRM_GKVL; a.in[I_GQH] = prm + PRM_GQH; a.in[I_GKH] = prm + PRM_GKH; a.in[I_DECAY] = prm + PRM_DECAY;
        a.in[I_GRET] = prm + PRM_GRET; a.in[I_BR] = prm + PRM_BR; a.in[I_GFFN] = prm + PRM_GFFN; a.in[I_B1] = prm + PRM_B1; a.in[I_B2] = prm + PRM_B2;
    }
    REP(2) if (IN(2)) {
        pg8::DenseOrder S; S.init(a.ws + WS_H, a.ws + WS_WIN, TA, DINP, 1024, G, bx);
        pg8::EpiP E{(bf16_t*)(a.ws + WS_P)};
        pg8::gemm_phase<pg8::EpiP, pg8::DenseOrder, false>(lds, nullptr, nullptr, 0, 1024, S, E, a.wv);
        if (G == 256 && bx >= 32) moe_convert(a, lds, (bx - 32) * 8, 224 * 8, MOE_IT_P2);
        SEAM(2);
    }
    REP(3) if (IN(3)) {
        if (G == 256) {
            int u0, nu;
            if (bx < 32) { u0 = 3 * bx; nu = 3; }
            else { const int c = bx - 32; u0 = 96 + 4 * c + (c < 64 ? c : 64); nu = 4 + (c < 64 ? 1 : 0); }
            for (int k2 = 0; k2 < (bx < 32 ? 2 : 1); ++k2) mla_tile(a, lds, k2 ? 256 + (bx >> 2) : bx, k2 ? 32 * (bx & 3) : 0, k2 ? 32 : 128);
            for (int u = u0; u < u0 + nu; ++u) ret_local_unit(a, lds, u);
        } else { for (int t = bx; t < TA / 128; t += G) mla_tile(a, lds, t); for (int u = bx; u < 16 * NSLOT; u += G) ret_local_unit(a, lds, u); }
        SEAM(3);
    }
    if (IN(4)) { phase_ret_scan(a); SEAM(4); }
    REP(5) if (IN(5)) {
        float negm;
        { float gq = 0.f, gk = 0.f; for (int i = 0; i < QK; ++i) { gq = fmaxf(gq, fabsf(a.in[I_GQH][i])); gk = fmaxf(gk, fabsf(a.in[I_GKH][i])); }
          negm = -(gq * gk * 96.f * QSCALE * 1.03f + 0.5f); negm = __uint_as_float(__builtin_amdgcn_readfirstlane(__float_as_uint(negm))); }
        const bool shift = negm < -64.f;
        __builtin_amdgcn_s_setreg((0 << 11) | (23 << 6) | 1, 1);
#ifndef REP5A
#define REP5A 0
#endif
#ifndef REP5B
#define REP5B 0
#endif
        if (G == 256) {
            const int xg = vcu >> 5, c = vcu & 31, cg = vcu & 3;
#pragma unroll 1
            for (int step = 0; step < 4; ++step) {
                if (step == cg) moe_convert(a, lds, MOE_IT_P2 + vcu * 8, 256 * 8, MOE_IT_ALL);
                if (step < 2) { const int bh = xg * 4 + 2 * step + (c >> 4), qb = c & 15; if (shift) att::unit64<true>(a, lds, bh, qb, negm); else att::unit64<false>(a, lds, bh, qb, negm); }
                else if (step == 2) { for (int u = bx; u < 16 * 64; u += G) ret_out_unit(a, lds, u); }
            }
        } else {
            for (int w = bx; w < 512; w += G) { if (shift) att::unit64<true>(a, lds, w >> 4, w & 15, negm); else att::unit64<false>(a, lds, w >> 4, w & 15, negm); }
            for (int u = bx; u < 16 * 64; u += G) ret_out_unit(a, lds, u);
        }
        SEAM(5);
    }
    REP(6) if (IN(6)) {
        pg8::DenseOrder S; S.init(a.ws + WS_MIX, a.ws + WS_WO, T, DM, 1024, G, bx);
        pg8::EpiOut E{a.in[I_X], (const float*)(a.ws + WS_MOD), a.out};
        pg8::gemm_phase<pg8::EpiOut, pg8::DenseOrder, false>(lds, nullptr, nullptr, 0, 1024, S, E, a.wv);
        SEAM(6);
    }
    if (IN(7)) { phase_router(a, lds); SEAM(7); }
    REP(8) if (IN(8)) {
        pg8::EpiM1 E{a.ws + WS_ACT};
        phase_moe_pg8<8>(a, lds, a.ws + WS_HF, 2, a.ws + WS_W1, (size_t)2048 * 1024, a.in[I_B1], 2048, nullptr, E);
        SEAM(8);
    }
    REP(9) if (IN(9)) {
        pg8::EpiM2 E{a.ws + WS_Y};
        phase_moe_pg8<4>(a, lds, a.ws + WS_ACT, 0, a.ws + WS_W2, (size_t)1024 * 1024, a.in[I_B2], 1024, (const float*)(a.ws + WS_PG), E);
        SEAM(9);
    }
    if (IN(10)) { phase_combine(a); }
#undef IN
#undef SEAM
#undef use_bar
}

extern "C" void kernel_launch(void* const* d_in, const int* in_sizes, int n_in, void* d_out, int out_size, void* d_ws, size_t ws_size, hipStream_t stream) {
    static int grid = 0;
    if (grid == 0) {
        if (n_in != 24 || out_size != T * DM || ws_size < WS_END) { fprintf(stderr, "kernel_launch: unexpected shapes (n_in %d out %d ws %zu)\n", n_in, out_size, ws_size); grid = -1; return; }
        int dev = 0, cus = 0, per_cu = 0;
        if (hipGetDevice(&dev) != hipSuccess || hipDeviceGetAttribute(&cus, hipDeviceAttributeMultiprocessorCount, dev) != hipSuccess) { grid = -1; return; }
        if (hipFuncSetAttribute((const void*)fwd_kernel, hipFuncAttributeMaxDynamicSharedMemorySize, LDS_BYTES) != hipSuccess) { fprintf(stderr, "kernel_launch: hipFuncSetAttribute failed\n"); grid = -1; return; }
        if (hipOccupancyMaxActiveBlocksPerMultiprocessor(&per_cu, (const void*)fwd_kernel, 512, LDS_BYTES) != hipSuccess || per_cu < 1) { fprintf(stderr, "kernel_launch: occupancy query says %d\n", per_cu); per_cu = 1; }
        (void)hipGetLastError();
        grid = cus;
    }
    if (grid < 0) return;
    (void)hipMemsetAsync((char*)d_ws + WS_CTL, 0, 128 * 1024, stream);
    Args a{};
    for (int i = 0; i < 24; ++i) a.in[i] = (const float*)d_in[i];
    a.out = (float*)d_out; a.ws = (unsigned char*)d_ws;
#if MK_N_LAUNCHES == 1
    a.ph_lo = 0; a.ph_hi = N_PHASES;
    void* params[] = {&a};
    hipError_t e = hipLaunchCooperativeKernel((const void*)fwd_kernel, dim3(grid), dim3(512), params, LDS_BYTES, stream);
    if (e != hipSuccess) fprintf(stderr, "kernel_launch: cooperative launch failed: %s (grid %d)\n", hipGetErrorString(e), grid);
#else
    for (int p = 0; p < N_PHASES; ++p) { a.ph_lo = p; a.ph_hi = p + 1; hipLaunchKernelGGL(fwd_kernel, dim3(grid), dim3(512), LDS_BYTES, stream, a); }
#endif
}
```
